# Optimizing an MI355X kernel written in HIP

```python
import math
import jax, jax.numpy as jnp
from jax import lax
import numpy as np

D_MODEL = 1024
BATCH = 8
SEQ = 4096
DEPTH = 4

CTX_LEN = 256
GRID_W = 64

D_HYENA = 512
D_SCONV = 512
NA_HEADS = 8
NA_HEAD_DIM = 64
D_NA = NA_HEADS * NA_HEAD_DIM
N_BRANCH = 3
NA_WIN_ROWS = 8
NA_WIN_COLS = 16
NA_QBLK = 16
NA_KBLK = NA_QBLK + NA_WIN_COLS
HY_BANDS = 16
HY_EMB = 1 + 2 * HY_BANDS
HY_FILTER_DIM = 64
HY_FAST_DECAY = 0.3
HY_SLOW_DECAY = 1.5
HY_TARGET = 1e-2
N_EXPERTS = 64
N_GROUPS = 8
TOPK_GROUPS = 4
TOP_K = 8
D_EXPERT = 256
D_SHARED = 256
ROUTED_SCALE = 2.5
MOE_BLOCK = 256
LN_EPS = 1e-5
NEG_INF = -1e30

OFF_HY = 0
OFF_SC = OFF_HY + 3 * D_HYENA
OFF_NA = OFF_SC + 3 * D_SCONV
OFF_GATE = OFF_NA + 3 * D_NA
D_IN_PROJ = OFF_GATE + N_BRANCH * D_MODEL

kernel_name = 'hybrid_hyena_shortconv_natten_moe_trunk'


def _deepnorm_alpha():
    return (2.0 * DEPTH) ** 0.25


def _deepnorm_beta():
    return (8.0 * DEPTH) ** -0.25


def layer_norm(x, g, b):
    xf = x.astype(jnp.float32)
    mu = jnp.mean(xf, -1, keepdims=True)
    var = jnp.mean(jnp.square(xf - mu), -1, keepdims=True)
    y = (xf - mu) * lax.rsqrt(var + LN_EPS) * g.astype(jnp.float32) + b.astype(jnp.float32)
    return y.astype(x.dtype)


def dwconv3(u, w):
    up = jnp.pad(u, ((0, 0), (1, 1), (0, 0)))
    return up[:, :-2] * w[0] + up[:, 1:-1] * w[1] + up[:, 2:] * w[2]


def hyena_filter(L, w1, b1, w2, b2, w3, sin_freq):
    f32 = jnp.float32
    t = jnp.linspace(0.0, 1.0, L, dtype=f32)[:, None]
    ang = (2.0 * math.pi / L) * jnp.arange(L, dtype=f32)[:, None]
    bands = jnp.linspace(1e-4, HY_BANDS - 1, HY_BANDS, dtype=f32)[None, :]
    feats = jnp.concatenate([t, jnp.cos(bands * ang), -jnp.sin(bands * ang)], -1)
    z = jnp.sin(sin_freq[0].astype(f32) * (feats @ w1.astype(f32) + b1.astype(f32)))
    z = jnp.sin(sin_freq[1].astype(f32) * (z @ w2.astype(f32) + b2.astype(f32)))
    h = z @ w3.astype(f32)
    deltas = jnp.abs(jnp.linspace(math.log(HY_TARGET) / HY_SLOW_DECAY, math.log(HY_TARGET) / HY_FAST_DECAY, D_HYENA, dtype=f32))
    decay = jnp.exp(-t * deltas[None, :])
    h_fwd = h[:, :D_HYENA] * decay
    h_bwd = h[:, D_HYENA:] * decay
    return jnp.concatenate([h_fwd, jnp.zeros((1, D_HYENA), f32), h_bwd[:0:-1]], 0)


def hyena_mix(u3, conv_w, conv_b, w1, b1, w2, b2, w3, sin_freq, bias_d):
    L = u3.shape[1]
    uc = dwconv3(u3, conv_w) + conv_b
    x0, x1, v = jnp.split(uc, 3, axis=-1)
    z = v * x1
    g = hyena_filter(L, w1, b1, w2, b2, w3, sin_freq)
    n = 2 * L
    zf = jnp.fft.rfft(z.astype(jnp.float32), n=n, axis=1)
    y = jnp.fft.irfft(zf * jnp.fft.rfft(g, axis=0)[None], n=n, axis=1)[:, :L]
    return x0 * (y.astype(z.dtype) + z * bias_d)


def short_conv_mix(u3, conv_w):
    bg, cg, xs = jnp.split(u3, 3, axis=-1)
    return bg * dwconv3(cg * xs, conv_w)


def _heads(t):
    b, l, _ = t.shape
    return t.reshape(b, l, NA_HEADS, NA_HEAD_DIM).transpose(0, 2, 1, 3)


def context_attention(q, k, v):
    b, l, _ = q.shape
    qh, kh, vh = _heads(q), _heads(k), _heads(v)
    s = jnp.einsum('bhqd,bhkd->bhqk', qh, kh, preferred_element_type=jnp.float32) * (NA_HEAD_DIM ** -0.5)
    p = jax.nn.softmax(s, axis=-1).astype(vh.dtype)
    o = jnp.einsum('bhqk,bhkd->bhqd', p, vh)
    return o.transpose(0, 2, 1, 3).reshape(b, l, D_NA)


def _na_col_layout():
    wc = min(NA_WIN_COLS, GRID_W)
    qcol = np.arange(GRID_W)
    cstart = np.clip(qcol - wc // 2, 0, GRID_W - wc)
    ncb = GRID_W // NA_QBLK
    kbw = min(NA_KBLK, GRID_W)
    kb = np.minimum(cstart[::NA_QBLK], GRID_W - kbw)
    kcol = kb[:, None] + np.arange(kbw)[None, :]
    qc = qcol.reshape(ncb, NA_QBLK)
    cs = cstart.reshape(ncb, NA_QBLK)
    inwin = (kcol[:, None, :] >= cs[:, :, None]) & (kcol[:, None, :] < cs[:, :, None] + wc)
    rel = np.clip(kcol[:, None, :] - qc[:, :, None] + NA_WIN_COLS - 1, 0, 2 * NA_WIN_COLS - 2)
    return ncb, kbw, kcol, inwin, rel


def neighbourhood_attention(q, k, v, k_ctx, v_ctx, rpb):
    b, s, _ = q.shape
    rows = s // GRID_W
    wr = min(NA_WIN_ROWS, rows)
    ncb, kbw, kcol, inwin, rel = _na_col_layout()
    scale = NA_HEAD_DIM ** -0.5
    n_loc = wr * kbw

    def grid(t):
        return t.reshape(b, rows, GRID_W, NA_HEADS, NA_HEAD_DIM).transpose(1, 0, 3, 2, 4)

    qg = grid(q)
    kg = grid(k)[:, :, :, kcol]
    vg = grid(v)[:, :, :, kcol]
    kc, vc = _heads(k_ctx), _heads(v_ctx)
    bias_cols = rpb[:, :, rel]
    mask = jnp.asarray(np.broadcast_to(inwin[:, :, None, :], (ncb, NA_QBLK, wr, kbw)).reshape(ncb, NA_QBLK, n_loc))

    def row_step(r):
        rs = jnp.clip(r - wr // 2, 0, rows - wr)
        kr = lax.dynamic_slice_in_dim(kg, rs, wr, axis=0).transpose(1, 2, 3, 0, 4, 5).reshape(b, NA_HEADS, ncb, n_loc, NA_HEAD_DIM)
        vr = lax.dynamic_slice_in_dim(vg, rs, wr, axis=0).transpose(1, 2, 3, 0, 4, 5).reshape(b, NA_HEADS, ncb, n_loc, NA_HEAD_DIM)
        qr = qg[r].reshape(b, NA_HEADS, ncb, NA_QBLK, NA_HEAD_DIM)
        ridx = rs - r + jnp.arange(wr) + NA_WIN_ROWS - 1
        bias = bias_cols[:, ridx].transpose(0, 2, 3, 1, 4).reshape(NA_HEADS, ncb, NA_QBLK, n_loc)
        s_loc = jnp.einsum('bhnqd,bhnkd->bhnqk', qr, kr, preferred_element_type=jnp.float32) * scale + bias.astype(jnp.float32)
        s_loc = jnp.where(mask, s_loc, NEG_INF)
        s_ctx = jnp.einsum('bhnqd,bhcd->bhnqc', qr, kc, preferred_element_type=jnp.float32) * scale
        p = jax.nn.softmax(jnp.concatenate([s_loc, s_ctx], -1), axis=-1).astype(vr.dtype)
        o = jnp.einsum('bhnqk,bhnkd->bhnqd', p[..., :n_loc], vr) + jnp.einsum('bhnqc,bhcd->bhnqd', p[..., n_loc:], vc)
        return o.reshape(b, NA_HEADS, GRID_W, NA_HEAD_DIM)

    o = lax.map(row_step, jnp.arange(rows))
    return o.transpose(1, 0, 3, 2, 4).reshape(b, s, D_NA)


def mixer_output(p, y_attn, hy, sc_conv_w, hy_proj, sc_proj, na_proj, w_o):
    y_hy = hyena_mix(p[..., OFF_HY:OFF_SC], *hy)
    y_sc = short_conv_mix(p[..., OFF_SC:OFF_NA], sc_conv_w)
    g_hy, g_sc, g_na = jnp.split(jax.nn.sigmoid(p[..., OFF_GATE:]), 3, axis=-1)
    merged = g_hy * (y_hy @ hy_proj) + g_sc * (y_sc @ sc_proj) + g_na * (y_attn @ na_proj)
    return merged @ w_o


def moe_ffn(h, router_w, router_b, w1, w3, w2, s1, s3, s2):
    t_tok, d = h.shape
    scores = jax.nn.sigmoid((h @ router_w).astype(jnp.float32))
    sel = scores + router_b.astype(jnp.float32)
    per_group = N_EXPERTS // N_GROUPS
    group_score = lax.top_k(sel.reshape(t_tok, N_GROUPS, per_group), 2)[0].sum(-1)
    _, top_groups = lax.top_k(group_score, TOPK_GROUPS)
    group_mask = (top_groups[..., None] == jnp.arange(N_GROUPS)).any(axis=1)
    expert_mask = jnp.repeat(group_mask, per_group, axis=1)
    _, top_e = lax.top_k(jnp.where(expert_mask, sel, -jnp.inf), TOP_K)
    w = jnp.take_along_axis(scores, top_e, axis=1)
    w = w / jnp.sum(w, -1, keepdims=True) * ROUTED_SCALE
    tk = t_tok * TOP_K
    flat_e = top_e.reshape(tk)
    order = jnp.argsort(flat_e)
    e_s = flat_e[order]
    tok_s = (order // TOP_K).astype(jnp.int32)
    w_s = w.reshape(tk)[order]
    counts = jnp.bincount(flat_e, length=N_EXPERTS)
    padded = (counts + MOE_BLOCK - 1) // MOE_BLOCK * MOE_BLOCK
    start = jnp.cumsum(counts) - counts
    pstart = jnp.cumsum(padded) - padded
    dest = pstart[e_s] + jnp.arange(tk, dtype=jnp.int32) - start[e_s]
    n_blocks = -(-tk // MOE_BLOCK) + N_EXPERTS
    tok_buf = jnp.full((n_blocks * MOE_BLOCK,), t_tok, jnp.int32).at[dest].set(tok_s)
    w_buf = jnp.zeros((n_blocks * MOE_BLOCK,), h.dtype).at[dest].set(w_s.astype(h.dtype))
    blk_expert = jnp.minimum(jnp.searchsorted(jnp.cumsum(padded) // MOE_BLOCK, jnp.arange(n_blocks), side='right'), N_EXPERTS - 1)
    h_pad = jnp.concatenate([h, jnp.zeros((1, d), h.dtype)], 0)

    def block_step(acc, blk):
        tb, wb, e = blk
        xb = h_pad[tb]
        yb = (jax.nn.silu(xb @ w1[e]) * (xb @ w3[e])) @ w2[e]
        return acc.at[tb].add(yb * wb[:, None]), None

    routed, _ = lax.scan(block_step, jnp.zeros((t_tok + 1, d), h.dtype),
                         (tok_buf.reshape(n_blocks, MOE_BLOCK), w_buf.reshape(n_blocks, MOE_BLOCK), blk_expert))
    shared = (jax.nn.silu(h @ s1) * (h @ s3)) @ s2
    return routed[:t_tok] + shared


def setup_inputs(seed: int = 0) -> dict:
    key = jax.random.key(seed)
    ks = iter(jax.random.split(key, 40))
    beta = _deepnorm_beta()
    L = DEPTH

    def nrm(shape, scale):
        return jax.random.normal(next(ks), shape, jnp.float32) * scale

    return {
        'x': nrm((BATCH, SEQ, D_MODEL), 1.0),
        'c': nrm((BATCH, D_MODEL), 1.0),
        'ctx': nrm((BATCH, CTX_LEN, D_MODEL), 1.0),
        'c_ctx': nrm((D_MODEL,), 1.0),
        'w_ada': nrm((L, D_MODEL, 6 * D_MODEL), 0.5 * D_MODEL ** -0.5),
        'b_ada': nrm((L, 6 * D_MODEL), 0.01),
        'w_in': nrm((L, D_MODEL, D_IN_PROJ), D_MODEL ** -0.5),
        'hy_conv_w': nrm((L, 3, 3 * D_HYENA), 3 ** -0.5),
        'hy_conv_b': nrm((L, 3 * D_HYENA), 0.01),
        'hy_w1': nrm((L, HY_EMB, HY_FILTER_DIM), HY_EMB ** -0.5),
        'hy_b1': nrm((L, HY_FILTER_DIM), 0.01),
        'hy_w2': nrm((L, HY_FILTER_DIM, HY_FILTER_DIM), HY_FILTER_DIM ** -0.5),
        'hy_b2': nrm((L, HY_FILTER_DIM), 0.01),
        'hy_w3': nrm((L, HY_FILTER_DIM, 2 * D_HYENA), 0.03 * HY_FILTER_DIM ** -0.5),
        'hy_sin_freq': 1.0 + nrm((L, 2, HY_FILTER_DIM), 0.01),
        'hy_bias_d': nrm((L, D_HYENA), 0.1),
        'hy_proj': nrm((L, D_HYENA, D_MODEL), beta * D_HYENA ** -0.5),
        'sc_conv_w': nrm((L, 3, D_SCONV), 3 ** -0.5),
        'sc_proj': nrm((L, D_SCONV, D_MODEL), beta * D_SCONV ** -0.5),
        'na_rpb': nrm((L, NA_HEADS, 2 * NA_WIN_ROWS - 1, 2 * NA_WIN_COLS - 1), 0.02),
        'na_proj': nrm((L, D_NA, D_MODEL), beta * D_NA ** -0.5),
        'w_o': nrm((L, D_MODEL, D_MODEL), beta * D_MODEL ** -0.5),
        'ln1_g': 1.0 + nrm((L, D_MODEL), 0.01),
        'ln1_b': nrm((L, D_MODEL), 0.01),
        'ln2_g': 1.0 + nrm((L, D_MODEL), 0.01),
        'ln2_b': nrm((L, D_MODEL), 0.01),
        'moe_router': nrm((L, D_MODEL, N_EXPERTS), D_MODEL ** -0.5),
        'moe_bias': nrm((L, N_EXPERTS), 0.01),
        'moe_w1': nrm((L, N_EXPERTS, D_MODEL, D_EXPERT), D_MODEL ** -0.5),
        'moe_w3': nrm((L, N_EXPERTS, D_MODEL, D_EXPERT), D_MODEL ** -0.5),
        'moe_w2': nrm((L, N_EXPERTS, D_EXPERT, D_MODEL), beta * D_EXPERT ** -0.5),
        'sh_w1': nrm((L, D_MODEL, D_SHARED), D_MODEL ** -0.5),
        'sh_w3': nrm((L, D_MODEL, D_SHARED), D_MODEL ** -0.5),
        'sh_w2': nrm((L, D_SHARED, D_MODEL), beta * D_SHARED ** -0.5),
    }


def reference(x, c, ctx, c_ctx, w_ada, b_ada, w_in, hy_conv_w, hy_conv_b, hy_w1, hy_b1, hy_w2, hy_b2, hy_w3,
              hy_sin_freq, hy_bias_d, hy_proj, sc_conv_w, sc_proj, na_rpb, na_proj, w_o, ln1_g, ln1_b, ln2_g, ln2_b,
              moe_router, moe_bias, moe_w1, moe_w3, moe_w2, sh_w1, sh_w3, sh_w2):
    alpha = _deepnorm_alpha()
    b, s, d = x.shape
    n_lat = b * s
    cond = jax.nn.silu(c)
    cond_ctx = jax.nn.silu(c_ctx)
    xl, xc = x, ctx
    for i in range(DEPTH):
        last = i == DEPTH - 1
        mod_l = jnp.split((cond @ w_ada[i] + b_ada[i])[:, None, :], 6, axis=-1)
        mod_c = jnp.split(cond_ctx @ w_ada[i] + b_ada[i], 6, axis=-1)
        hy = (hy_conv_w[i], hy_conv_b[i], hy_w1[i], hy_b1[i], hy_w2[i], hy_b2[i], hy_w3[i], hy_sin_freq[i], hy_bias_d[i])

        hl = xl * (1 + mod_l[1]) + mod_l[0]
        hc = xc * (1 + mod_c[1]) + mod_c[0]
        pl = hl @ w_in[i]
        if last:
            k_c, v_c = jnp.split(hc @ w_in[i][:, OFF_NA + D_NA:OFF_GATE], 2, axis=-1)
        else:
            pc = hc @ w_in[i]
            q_c, k_c, v_c = jnp.split(pc[..., OFF_NA:OFF_GATE], 3, axis=-1)
        q_l, k_l, v_l = jnp.split(pl[..., OFF_NA:OFF_GATE], 3, axis=-1)
        att_l = neighbourhood_attention(q_l, k_l, v_l, k_c, v_c, na_rpb[i])
        out_l = mixer_output(pl, att_l, hy, sc_conv_w[i], hy_proj[i], sc_proj[i], na_proj[i], w_o[i])
        xl = layer_norm(alpha * xl + mod_l[2] * out_l, ln1_g[i], ln1_b[i])
        if not last:
            att_c = context_attention(q_c, k_c, v_c)
            out_c = mixer_output(pc, att_c, hy, sc_conv_w[i], hy_proj[i], sc_proj[i], na_proj[i], w_o[i])
            xc = layer_norm(alpha * xc + mod_c[2] * out_c, ln1_g[i], ln1_b[i])

        tokens = (xl * (1 + mod_l[4]) + mod_l[3]).reshape(n_lat, d)
        if not last:
            hc2 = xc * (1 + mod_c[4]) + mod_c[3]
            tokens = jnp.concatenate([tokens, hc2.reshape(-1, d)], 0)
        f = moe_ffn(tokens, moe_router[i], moe_bias[i], moe_w1[i], moe_w3[i], moe_w2[i], sh_w1[i], sh_w3[i], sh_w2[i])
        xl = layer_norm(alpha * xl + mod_l[5] * f[:n_lat].reshape(b, s, d), ln2_g[i], ln2_b[i])
        if not last:
            xc = layer_norm(alpha * xc + mod_c[5] * f[n_lat:].reshape(xc.shape), ln2_g[i], ln2_b[i])
    return xl
```

```cpp
#include <hip/hip_runtime.h>
#include <cstdio>
#include <cstdint>
namespace nv {
constexpr int B = 8, S = 4096, CL = 256, SE = S + CL, T = B * SE, D = 1024, DEPTH = 4;
constexpr int DH = 512, DIN = 7680, OFF_SC = 1536, OFF_NA = 3072, OFF_GATE = 4608;
constexpr int NE = 64, TOPK = 8, DEXP = 256;
constexpr int GRIDW = 64, NHEAD = 8, HDIM = 64;
constexpr float LN_EPS = 1e-5f;
constexpr float ALPHA = 1.681792830507429f;

__device__ __forceinline__ float sigmoidf_(float x) { return 1.f / (1.f + expf(-x)); }
__device__ __forceinline__ float siluf_(float x) { return x / (1.f + expf(-x)); }
__device__ __forceinline__ float wsum(float v) {
#pragma unroll
    for (int o = 1; o < 64; o <<= 1) v += __shfl_xor(v, o);
    return v;
}
__device__ __forceinline__ float wmax(float v) {
#pragma unroll
    for (int o = 1; o < 64; o <<= 1) v = fmaxf(v, __shfl_xor(v, o));
    return v;
}

__global__ void k_cond(const float* c, const float* c_ctx, float* cond) {
    int i = blockIdx.x * blockDim.x + threadIdx.x;
    if (i < 9 * D) { float v = i < 8 * D ? c[i] : c_ctx[i - 8 * D]; cond[i] = siluf_(v); }
}
__global__ void k_mods(const float* cond, const float* w_ada, const float* b_ada, float* mods) {
    int j = blockIdx.x * blockDim.x + threadIdx.x;
    if (j >= DEPTH * 6 * D) return;
    int l = j / (6 * D), col = j % (6 * D);
    float acc[9];
#pragma unroll
    for (int r = 0; r < 9; ++r) acc[r] = 0.f;
    const float* w = w_ada + (size_t)l * D * 6 * D + col;
    for (int k = 0; k < D; ++k) { float wv = w[(size_t)k * 6 * D];
#pragma unroll
        for (int r = 0; r < 9; ++r) acc[r] += cond[r * D + k] * wv; }
    float bb = b_ada[l * 6 * D + col];
#pragma unroll
    for (int r = 0; r < 9; ++r) mods[((size_t)l * 9 + r) * 6 * D + col] = acc[r] + bb;
}
__global__ void k_init_x(const float* x, const float* ctx, float* X) {
    size_t i = (size_t)blockIdx.x * blockDim.x + threadIdx.x;
    if (i >= (size_t)T * D) return;
    int row = (int)(i / D), d = (int)(i % D), b = row / SE, ii = row % SE;
    X[i] = ii < S ? x[((size_t)b * S + ii) * D + d] : ctx[((size_t)b * CL + (ii - S)) * D + d];
}
__global__ void k_modulate(const float* X, const float* mods_l, float* HM, int which) {
    size_t i = (size_t)blockIdx.x * blockDim.x + threadIdx.x;
    if (i >= (size_t)T * D) return;
    int row = (int)(i / D), d = (int)(i % D), b = row / SE, ii = row % SE, mb = ii < S ? b : 8;
    const float* m = mods_l + (size_t)mb * 6 * D;
    HM[i] = X[i] * (1.f + m[(which + 1) * D + d]) + m[which * D + d];
}
struct GemmP { const float* A; int lda; const int* gidx; const float* Bm; int ldb; float* C; int ldc; int M; const int* Mdev; int N, K; int mode;
               const int* sidx; const float* sw; long long eB, eG; const int* coff; const int* aoff; };
__global__ void __launch_bounds__(256) k_gemm(GemmP p) {
    __shared__ float As[16][68];
    __shared__ float Bs[16][64];
    const int z = blockIdx.z;
    const int M = p.Mdev ? p.Mdev[z] : p.M;
    const int row0 = blockIdx.y * 64, col0 = blockIdx.x * 64;
    if (row0 >= M) return;
    const float* A = p.A; const float* Bm = p.Bm + (size_t)z * p.eB;
    const int* gidx = p.gidx ? p.gidx + (size_t)z * p.eG : nullptr;
    const int* sidx = p.sidx ? p.sidx + (size_t)z * p.eG : nullptr;
    const float* sw = p.sw ? p.sw + (size_t)z * p.eG : nullptr;
    const int crow_off = p.coff ? p.coff[z] : 0;
    const int arow_off = p.aoff ? p.aoff[z] : 0;
    float* C = p.C;
    const int tid = threadIdx.x, tx = tid & 15, ty = tid >> 4;
    const int ar = tid >> 2, ak = (tid & 3) * 4;
    const int bk = tid >> 4, bn = (tid & 15) * 4;
    int arow = row0 + ar; if (arow >= M) arow = M - 1;
    const size_t asrc = gidx ? (size_t)gidx[arow] : (size_t)(arow_off + arow);
    const float* ap = A + asrc * p.lda + ak;
    const float* bp = Bm + (size_t)bk * p.ldb + col0 + bn;
    float acc[4][4];
#pragma unroll
    for (int i = 0; i < 4; ++i)
#pragma unroll
        for (int j = 0; j < 4; ++j) acc[i][j] = 0.f;
    for (int k0 = 0; k0 < p.K; k0 += 16) {
        float4 av = *(const float4*)(ap + k0);
        float4 bv = *(const float4*)(bp + (size_t)k0 * p.ldb);
        As[ak + 0][ar] = av.x; As[ak + 1][ar] = av.y; As[ak + 2][ar] = av.z; As[ak + 3][ar] = av.w;
        *(float4*)&Bs[bk][bn] = bv;
        __syncthreads();
#pragma unroll
        for (int kk = 0; kk < 16; ++kk) {
            float4 a4 = *(const float4*)&As[kk][ty * 4];
            float4 b4 = *(const float4*)&Bs[kk][tx * 4];
            float a[4] = {a4.x, a4.y, a4.z, a4.w}, b[4] = {b4.x, b4.y, b4.z, b4.w};
#pragma unroll
            for (int i = 0; i < 4; ++i)
#pragma unroll
                for (int j = 0; j < 4; ++j) acc[i][j] += a[i] * b[j];
        }
        __syncthreads();
    }
#pragma unroll
    for (int i = 0; i < 4; ++i) {
        int r = row0 + ty * 4 + i; if (r >= M) continue;
        if (p.mode == 0) {
            float* cp = C + (size_t)(crow_off + r) * p.ldc + col0 + tx * 4;
            *(float4*)cp = make_float4(acc[i][0], acc[i][1], acc[i][2], acc[i][3]);
        } else {
            int tok = sidx[r]; float w = sw[r];
            float* cp = C + (size_t)tok * p.ldc + col0 + tx * 4;
#pragma unroll
            for (int j = 0; j < 4; ++j) atomicAdd(cp + j, w * acc[i][j]);
        }
    }
}
static void gemm(hipStream_t st, const float* A, int lda, const float* Bm, int ldb, float* C, int ldc, int M, int N, int K) {
    GemmP p{}; p.A = A; p.lda = lda; p.Bm = Bm; p.ldb = ldb; p.C = C; p.ldc = ldc; p.M = M; p.N = N; p.K = K; p.mode = 0;
    hipLaunchKernelGGL(k_gemm, dim3(N / 64, (M + 63) / 64, 1), dim3(256), 0, st, p);
}

__global__ void k_hy_z2(const float* w1, const float* b1, const float* w2, const float* b2, const float* sf, int L, float* z2tab) {
    const int t = blockIdx.x * (blockDim.x / 64) + (threadIdx.x >> 6), lane = threadIdx.x & 63;
    if (t >= L) return;
    const double PI2 = 6.283185307179586476925;
    float tt = (float)((double)t / (double)(L - 1));
    float ang = (float)(PI2 / (double)L) * (float)t;
    float a = b1[lane];
    a += tt * w1[0 * 64 + lane];
    for (int j = 0; j < 16; ++j) {
        float band = (float)(1e-4 + (double)j * ((15.0 - 1e-4) / 15.0));
        float arg = band * ang;
        a += cosf(arg) * w1[(1 + j) * 64 + lane];
        a += -sinf(arg) * w1[(17 + j) * 64 + lane];
    }
    float z1 = sinf(sf[lane] * a);
    float a2 = b2[lane];
    for (int i = 0; i < 64; ++i) a2 += __shfl(z1, i) * w2[i * 64 + lane];
    z2tab[(size_t)t * 64 + lane] = sinf(sf[64 + lane] * a2);
}
__global__ void k_hy_filt(const float* z2tab, const float* w3, int L, float* hf, float* hb) {
    int i = blockIdx.x * blockDim.x + threadIdx.x;
    if (i >= L * DH) return;
    int t = i / DH, c = i % DH;
    float af = 0.f, ab = 0.f;
    for (int j = 0; j < 64; ++j) { float z = z2tab[(size_t)t * 64 + j]; af += z * w3[j * 1024 + c]; ab += z * w3[j * 1024 + 512 + c]; }
    const double la = log(1e-2) / 1.5, lb = log(1e-2) / 0.3;
    float delta = fabsf((float)(la + (double)c * ((lb - la) / 511.0)));
    float tt = (float)((double)t / (double)(L - 1));
    float dec = expf(-tt * delta);
    hf[i] = af * dec; hb[i] = ab * dec;
}
__global__ void k_hy_conv(const float* PB, const float* cw, const float* cb, float* UC) {
    int idx = blockIdx.x * blockDim.x + threadIdx.x;
    if (idx >= SE * 1536) return;
    int i = idx / 1536, c = idx % 1536;
    int lo = i < S ? 0 : S, hi = i < S ? S : SE;
    float v = PB[(size_t)i * DIN + c] * cw[1536 + c];
    if (i - 1 >= lo) v += PB[(size_t)(i - 1) * DIN + c] * cw[c];
    if (i + 1 < hi) v += PB[(size_t)(i + 1) * DIN + c] * cw[2 * 1536 + c];
    UC[idx] = v + cb[c];
}
__global__ void k_hy_z(const float* UC, float* Z) {
    int idx = blockIdx.x * blockDim.x + threadIdx.x;
    if (idx >= SE * DH) return;
    int i = idx / DH, c = idx % DH;
    Z[idx] = UC[(size_t)i * 1536 + 1024 + c] * UC[(size_t)i * 1536 + 512 + c];
}
__global__ void k_hy_long(const float* Z, const float* UC, const float* hf, const float* hb, const float* hfc, const float* hbc, const float* bias_d, float* YHY) {
    int idx = blockIdx.x * blockDim.x + threadIdx.x;
    if (idx >= SE * DH) return;
    int i = idx / DH, c = idx % DH;
    int lo = i < S ? 0 : S, L = i < S ? S : CL;
    const float* f = i < S ? hf : hfc; const float* g = i < S ? hb : hbc;
    int t = i - lo;
    float acc = 0.f;
    for (int s = 0; s <= t; ++s) acc += f[(size_t)(t - s) * DH + c] * Z[(size_t)(lo + s) * DH + c];
    for (int s = t + 1; s < L; ++s) acc += g[(size_t)(s - t) * DH + c] * Z[(size_t)(lo + s) * DH + c];
    float z = Z[idx];
    YHY[idx] = UC[(size_t)i * 1536 + c] * (acc + z * bias_d[c]);
}
__global__ void k_sconv(const float* PB, const float* cw, float* YSC) {
    int idx = blockIdx.x * blockDim.x + threadIdx.x;
    if (idx >= SE * DH) return;
    int i = idx / DH, c = idx % DH;
    int lo = i < S ? 0 : S, hi = i < S ? S : SE;
    const float* p = PB + OFF_SC;
    float v = p[(size_t)i * DIN + 512 + c] * p[(size_t)i * DIN + 1024 + c] * cw[512 + c];
    if (i - 1 >= lo) v += p[(size_t)(i - 1) * DIN + 512 + c] * p[(size_t)(i - 1) * DIN + 1024 + c] * cw[c];
    if (i + 1 < hi) v += p[(size_t)(i + 1) * DIN + 512 + c] * p[(size_t)(i + 1) * DIN + 1024 + c] * cw[1024 + c];
    YSC[idx] = p[(size_t)i * DIN + c] * v;
}
__global__ void k_attn(const float* PB, const float* rpb, float* YAT) {
    const int wt = blockIdx.x * (blockDim.x / 64) + (threadIdx.x >> 6), lane = threadIdx.x & 63;
    if (wt >= SE * NHEAD) return;
    const int i = wt / NHEAD, h = wt % NHEAD;
    const float* Q = PB + OFF_NA + h * HDIM; const float* Kp = PB + OFF_NA + 512 + h * HDIM; const float* V = PB + OFF_NA + 1024 + h * HDIM;
    const float q = Q[(size_t)i * DIN + lane];
    float m = -3.0e38f, l = 0.f, o = 0.f;
    if (i < S) {
        const int r = i / GRIDW, qc = i % GRIDW;
        int rs = r - 4; rs = rs < 0 ? 0 : (rs > 56 ? 56 : rs);
        int cs = qc - 8; cs = cs < 0 ? 0 : (cs > 48 ? 48 : cs);
        for (int j = 0; j < 8; ++j) for (int kc = cs; kc < cs + 16; ++kc) {
            const int kt = (rs + j) * GRIDW + kc;
            float s = wsum(q * Kp[(size_t)kt * DIN + lane]) * 0.125f + rpb[(h * 15 + (rs + j - r + 7)) * 31 + (kc - qc + 15)];
            float mn = fmaxf(m, s), a = expf(m - mn), pp = expf(s - mn);
            l = l * a + pp; o = o * a + pp * V[(size_t)kt * DIN + lane]; m = mn;
        }
    }
    for (int kt = S; kt < SE; ++kt) {
        float s = wsum(q * Kp[(size_t)kt * DIN + lane]) * 0.125f;
        float mn = fmaxf(m, s), a = expf(m - mn), pp = expf(s - mn);
        l = l * a + pp; o = o * a + pp * V[(size_t)kt * DIN + lane]; m = mn;
    }
    YAT[(size_t)i * DH + h * HDIM + lane] = o / l;
}
__global__ void k_merge(const float* PB, const float* T0, const float* T1, const float* T2, float* MG) {
    int idx = blockIdx.x * blockDim.x + threadIdx.x;
    if (idx >= SE * D) return;
    int i = idx / D, c = idx % D;
    const float* g = PB + (size_t)i * DIN + OFF_GATE;
    MG[idx] = sigmoidf_(g[c]) * T0[idx] + sigmoidf_(g[D + c]) * T1[idx] + sigmoidf_(g[2 * D + c]) * T2[idx];
}
__global__ void k_res_ln(float* X, const float* O, const float* mods_l, int gate_idx, const float* lg, const float* lb, int row0, int n) {
    const int w = blockIdx.x * (blockDim.x / 64) + (threadIdx.x >> 6), lane = threadIdx.x & 63;
    if (w >= n) return;
    const int row = row0 + w, b = row / SE, ii = row % SE, mb = ii < S ? b : 8;
    const float* gt = mods_l + (size_t)mb * 6 * D + gate_idx * D;
    float v[16]; float s = 0.f;
#pragma unroll
    for (int j = 0; j < 16; ++j) { int d = lane + 64 * j; v[j] = ALPHA * X[(size_t)row * D + d] + gt[d] * O[(size_t)w * D + d]; s += v[j]; }
    const float mu = wsum(s) * (1.f / D); float q = 0.f;
#pragma unroll
    for (int j = 0; j < 16; ++j) { v[j] -= mu; q += v[j] * v[j]; }
    const float rstd = rsqrtf(wsum(q) * (1.f / D) + LN_EPS);
#pragma unroll
    for (int j = 0; j < 16; ++j) { int d = lane + 64 * j; X[(size_t)row * D + d] = v[j] * rstd * lg[d] + lb[d]; }
}
__global__ void k_route(const float* logits, const float* rbias, int* cnt, int* ltok, float* lw) {
    const int tok = blockIdx.x * (blockDim.x / 64) + (threadIdx.x >> 6), lane = threadIdx.x & 63;
    if (tok >= T) return;
    const float score = sigmoidf_(logits[(size_t)tok * NE + lane]);
    const float sel = score + rbias[lane];
    float m1 = sel;
    m1 = fmaxf(m1, __shfl_xor(m1, 1)); m1 = fmaxf(m1, __shfl_xor(m1, 2)); m1 = fmaxf(m1, __shfl_xor(m1, 4));
    unsigned long long eq = __ballot(sel == m1);
    const int g = lane >> 3;
    const unsigned geq = (unsigned)((eq >> (g * 8)) & 0xffull);
    const int first = __ffs(geq) - 1;
    float s2 = ((lane & 7) == first) ? -3.0e38f : sel;
    s2 = fmaxf(s2, __shfl_xor(s2, 1)); s2 = fmaxf(s2, __shfl_xor(s2, 2)); s2 = fmaxf(s2, __shfl_xor(s2, 4));
    const float gs = m1 + s2;
    int grank = 0;
    for (int gg = 0; gg < 8; ++gg) { float o = __shfl(gs, gg * 8); if (o > gs || (o == gs && gg < g)) ++grank; }
    const bool gsel = grank < 4;
    const float val = gsel ? sel : -3.0e38f;
    int rank = 0;
    for (int j = 0; j < 64; ++j) { float o = __shfl(val, j); if (o > val || (o == val && j < lane)) ++rank; }
    const bool chosen = gsel && rank < TOPK;
    const float tot = wsum(chosen ? score : 0.f);
    if (chosen) {
        const float w = score / tot * 2.5f;
        int pos = atomicAdd(&cnt[lane], 1);
        ltok[(size_t)lane * T + pos] = tok; lw[(size_t)lane * T + pos] = w;
    }
}
__global__ void k_prefix(const int* cnt, int* off) { if (threadIdx.x == 0) { int a = 0; for (int e = 0; e < NE; ++e) { off[e] = a; a += cnt[e]; } } }
__global__ void k_swiglu(const float* U1, const float* U3, float* H, size_t n) {
    size_t i = (size_t)blockIdx.x * blockDim.x + threadIdx.x;
    if (i < n) H[i] = siluf_(U1[i]) * U3[i];
}
__global__ void k_final(const float* X, float* out) {
    size_t i = (size_t)blockIdx.x * blockDim.x + threadIdx.x;
    if (i >= (size_t)B * S * D) return;
    int d = (int)(i % D); size_t r = i / D; int b = (int)(r / S), t = (int)(r % S);
    out[i] = X[((size_t)b * SE + t) * D + d];
}

struct In {
    const float *x, *c, *ctx, *c_ctx, *w_ada, *b_ada, *w_in, *hy_conv_w, *hy_conv_b, *hy_w1, *hy_b1, *hy_w2, *hy_b2, *hy_w3, *hy_sin_freq, *hy_bias_d,
        *hy_proj, *sc_conv_w, *sc_proj, *na_rpb, *na_proj, *w_o, *ln1_g, *ln1_b, *ln2_g, *ln2_b, *moe_router, *moe_bias, *moe_w1, *moe_w3, *moe_w2, *sh_w1, *sh_w3, *sh_w2;
};

static void forward(const In& in, float* out, unsigned char* ws, hipStream_t st) {
    size_t o = 0; auto alloc = [&](size_t bytes) { size_t r = o; o += (bytes + 255) & ~(size_t)255; return (void*)(ws + r); };
    float* X = (float*)alloc((size_t)T * D * 4);
    float* HM = (float*)alloc((size_t)T * D * 4);
    float* cond = (float*)alloc(9 * D * 4);
    float* mods = (float*)alloc((size_t)DEPTH * 9 * 6 * D * 4);
    float* MIX = (float*)alloc((size_t)SE * 16384 * 4);
    float* PB = MIX;
    float* UC = PB + (size_t)SE * DIN;
    float* Z = UC + (size_t)SE * 1536;
    float* YB = Z + (size_t)SE * DH;
    float* T0 = YB + (size_t)SE * 1536; float* T1 = T0 + (size_t)SE * D; float* T2 = T1 + (size_t)SE * D;
    float* MG = T2 + (size_t)SE * D; float* OB = MG + (size_t)SE * D;
    float* z2a = (float*)alloc((size_t)S * 64 * 4); float* z2c = (float*)alloc((size_t)CL * 64 * 4);
    float* hf = (float*)alloc((size_t)S * DH * 4); float* hb = (float*)alloc((size_t)S * DH * 4);
    float* hfc = (float*)alloc((size_t)CL * DH * 4); float* hbc = (float*)alloc((size_t)CL * DH * 4);
    float* logits = (float*)alloc((size_t)T * NE * 4);
    int* cnt = (int*)alloc(256); int* off = (int*)alloc(256);
    int* ltok = (int*)alloc((size_t)NE * T * 4); float* lw = (float*)alloc((size_t)NE * T * 4);
    float* U1 = (float*)alloc((size_t)T * TOPK * DEXP * 4);
    float* U3 = MIX;
    float* F = MIX + (size_t)32 * 1024 * 1024;
    float* YHY = YB, *YSC = YB + (size_t)SE * DH, *YAT = YB + 2 * (size_t)SE * DH;

    hipLaunchKernelGGL(k_cond, dim3((9 * D + 255) / 256), dim3(256), 0, st, in.c, in.c_ctx, cond);
    hipLaunchKernelGGL(k_mods, dim3(DEPTH * 6 * D / 256), dim3(256), 0, st, cond, in.w_ada, in.b_ada, mods);
    hipLaunchKernelGGL(k_init_x, dim3((unsigned)(((size_t)T * D + 255) / 256)), dim3(256), 0, st, in.x, in.ctx, X);
    const unsigned gTD = (unsigned)(((size_t)T * D + 255) / 256);
    for (int l = 0; l < DEPTH; ++l) {
        const float* ml = mods + (size_t)l * 9 * 6 * D;
        hipLaunchKernelGGL(k_hy_z2, dim3(S / 4), dim3(256), 0, st, in.hy_w1 + l * 33 * 64, in.hy_b1 + l * 64, in.hy_w2 + l * 4096, in.hy_b2 + l * 64, in.hy_sin_freq + l * 128, S, z2a);
        hipLaunchKernelGGL(k_hy_z2, dim3(CL / 4), dim3(256), 0, st, in.hy_w1 + l * 33 * 64, in.hy_b1 + l * 64, in.hy_w2 + l * 4096, in.hy_b2 + l * 64, in.hy_sin_freq + l * 128, CL, z2c);
        hipLaunchKernelGGL(k_hy_filt, dim3(S * DH / 256), dim3(256), 0, st, z2a, in.hy_w3 + (size_t)l * 64 * 1024, S, hf, hb);
        hipLaunchKernelGGL(k_hy_filt, dim3(CL * DH / 256), dim3(256), 0, st, z2c, in.hy_w3 + (size_t)l * 64 * 1024, CL, hfc, hbc);
        hipLaunchKernelGGL(k_modulate, dim3(gTD), dim3(256), 0, st, X, ml, HM, 0);
        for (int b = 0; b < B; ++b) {
            gemm(st, HM + (size_t)b * SE * D, D, in.w_in + (size_t)l * D * DIN, DIN, PB, DIN, SE, DIN, D);
            hipLaunchKernelGGL(k_hy_conv, dim3(SE * 1536 / 256), dim3(256), 0, st, PB, in.hy_conv_w + l * 3 * 1536, in.hy_conv_b + l * 1536, UC);
            hipLaunchKernelGGL(k_hy_z, dim3(SE * DH / 256), dim3(256), 0, st, UC, Z);
            hipLaunchKernelGGL(k_hy_long, dim3(SE * DH / 256), dim3(256), 0, st, Z, UC, hf, hb, hfc, hbc, in.hy_bias_d + l * DH, YHY);
            hipLaunchKernelGGL(k_sconv, dim3(SE * DH / 256), dim3(256), 0, st, PB, in.sc_conv_w + l * 3 * DH, YSC);
            hipLaunchKernelGGL(k_attn, dim3(SE * NHEAD / 4), dim3(256), 0, st, PB, in.na_rpb + l * NHEAD * 15 * 31, YAT);
            gemm(st, YHY, DH, in.hy_proj + (size_t)l * DH * D, D, T0, D, SE, D, DH);
            gemm(st, YSC, DH, in.sc_proj + (size_t)l * DH * D, D, T1, D, SE, D, DH);
            gemm(st, YAT, DH, in.na_proj + (size_t)l * DH * D, D, T2, D, SE, D, DH);
            hipLaunchKernelGGL(k_merge, dim3(SE * D / 256), dim3(256), 0, st, PB, T0, T1, T2, MG);
            gemm(st, MG, D, in.w_o + (size_t)l * D * D, D, OB, D, SE, D, D);
            hipLaunchKernelGGL(k_res_ln, dim3(SE / 4), dim3(256), 0, st, X, OB, ml, 2, in.ln1_g + l * D, in.ln1_b + l * D, b * SE, SE);
        }
        hipLaunchKernelGGL(k_modulate, dim3(gTD), dim3(256), 0, st, X, ml, HM, 3);
        gemm(st, HM, D, in.moe_router + (size_t)l * D * NE, NE, logits, NE, T, NE, D);
        (void)hipMemsetAsync(cnt, 0, 256, st);
        hipLaunchKernelGGL(k_route, dim3(T / 4), dim3(256), 0, st, logits, in.moe_bias + l * NE, cnt, ltok, lw);
        hipLaunchKernelGGL(k_prefix, dim3(1), dim3(64), 0, st, cnt, off);
        {
            GemmP p{}; p.A = HM; p.lda = D; p.gidx = ltok; p.eG = T; p.ldb = DEXP; p.ldc = DEXP; p.Mdev = cnt; p.N = DEXP; p.K = D; p.mode = 0; p.eB = (long long)D * DEXP; p.coff = off;
            p.Bm = in.moe_w1 + (size_t)l * NE * D * DEXP; p.C = U1;
            hipLaunchKernelGGL(k_gemm, dim3(DEXP / 64, T / 64, NE), dim3(256), 0, st, p);
            p.Bm = in.moe_w3 + (size_t)l * NE * D * DEXP; p.C = U3;
            hipLaunchKernelGGL(k_gemm, dim3(DEXP / 64, T / 64, NE), dim3(256), 0, st, p);
        }
        hipLaunchKernelGGL(k_swiglu, dim3((unsigned)(((size_t)T * TOPK * DEXP + 255) / 256)), dim3(256), 0, st, U1, U3, U1, (size_t)T * TOPK * DEXP);
        {
            float* V1 = U3; float* V3 = U3 + (size_t)T * DEXP;
            gemm(st, HM, D, in.sh_w1 + (size_t)l * D * DEXP, DEXP, V1, DEXP, T, DEXP, D);
            gemm(st, HM, D, in.sh_w3 + (size_t)l * D * DEXP, DEXP, V3, DEXP, T, DEXP, D);
            hipLaunchKernelGGL(k_swiglu, dim3((unsigned)(((size_t)T * DEXP + 255) / 256)), dim3(256), 0, st, V1, V3, V1, (size_t)T * DEXP);
            gemm(st, V1, DEXP, in.sh_w2 + (size_t)l * DEXP * D, D, F, D, T, D, DEXP);
        }
        {
            GemmP p{}; p.A = U1; p.lda = DEXP; p.aoff = off; p.sidx = ltok; p.sw = lw; p.eG = T; p.Bm = in.moe_w2 + (size_t)l * NE * DEXP * D; p.ldb = D; p.C = F; p.ldc = D; p.Mdev = cnt; p.N = D; p.K = DEXP; p.mode = 1;
            p.eB = (long long)DEXP * D;
            hipLaunchKernelGGL(k_gemm, dim3(D / 64, T / 64, NE), dim3(256), 0, st, p);
        }
        hipLaunchKernelGGL(k_res_ln, dim3(T / 4), dim3(256), 0, st, X, F, ml, 5, in.ln2_g + l * D, in.ln2_b + l * D, 0, T);
    }
    hipLaunchKernelGGL(k_final, dim3((unsigned)(((size_t)B * S * D + 255) / 256)), dim3(256), 0, st, X, out);
}
}
extern "C" void kernel_launch(void* const* d_in, const int* in_sizes, int n_in, void* d_out, int out_size, void* d_ws, size_t ws_size, hipStream_t stream) {
    nv::In in{};
    const float** f = (const float**)&in;
    for (int i = 0; i < 34 && i < n_in; ++i) f[i] = (const float*)d_in[i];
    nv::forward(in, (float*)d_out, (unsigned char*)d_ws, stream);
}
```

```cpp
#define HYB 4

#include <hip/hip_runtime.h>
#include <cstdio>
#include <cstdint>
namespace nv {
constexpr int B = 8, S = 4096, CL = 256, SE = S + CL, T = B * SE, D = 1024, DEPTH = 4;
constexpr int DH = 512, DIN = 7680, OFF_SC = 1536, OFF_NA = 3072, OFF_GATE = 4608;
constexpr int NE = 64, TOPK = 8, DEXP = 256;
constexpr int GRIDW = 64, NHEAD = 8, HDIM = 64;
constexpr float LN_EPS = 1e-5f;
constexpr float ALPHA = 1.681792830507429f;

__device__ __forceinline__ float sigmoidf_(float x) { return 1.f / (1.f + expf(-x)); }
__device__ __forceinline__ float siluf_(float x) { return x / (1.f + expf(-x)); }
__device__ __forceinline__ float wsum(float v) {
#pragma unroll
    for (int o = 1; o < 64; o <<= 1) v += __shfl_xor(v, o);
    return v;
}
__device__ __forceinline__ float wmax(float v) {
#pragma unroll
    for (int o = 1; o < 64; o <<= 1) v = fmaxf(v, __shfl_xor(v, o));
    return v;
}

__global__ void k_cond(const float* c, const float* c_ctx, float* cond) {
    int i = blockIdx.x * blockDim.x + threadIdx.x;
    if (i < 9 * D) { float v = i < 8 * D ? c[i] : c_ctx[i - 8 * D]; cond[i] = siluf_(v); }
}
__global__ void k_mods(const float* cond, const float* w_ada, const float* b_ada, float* mods) {
    int j = blockIdx.x * blockDim.x + threadIdx.x;
    if (j >= DEPTH * 6 * D) return;
    int l = j / (6 * D), col = j % (6 * D);
    float acc[9];
#pragma unroll
    for (int r = 0; r < 9; ++r) acc[r] = 0.f;
    const float* w = w_ada + (size_t)l * D * 6 * D + col;
    for (int k = 0; k < D; ++k) { float wv = w[(size_t)k * 6 * D];
#pragma unroll
        for (int r = 0; r < 9; ++r) acc[r] += cond[r * D + k] * wv; }
    float bb = b_ada[l * 6 * D + col];
#pragma unroll
    for (int r = 0; r < 9; ++r) mods[((size_t)l * 9 + r) * 6 * D + col] = acc[r] + bb;
}
__global__ void k_init_x(const float* x, const float* ctx, float* X) {
    size_t i = (size_t)blockIdx.x * blockDim.x + threadIdx.x;
    if (i >= (size_t)T * D) return;
    int row = (int)(i / D), d = (int)(i % D), b = row / SE, ii = row % SE;
    X[i] = ii < S ? x[((size_t)b * S + ii) * D + d] : ctx[((size_t)b * CL + (ii - S)) * D + d];
}
__global__ void k_modulate(const float* X, const float* mods_l, float* HM, int which) {
    size_t i = (size_t)blockIdx.x * blockDim.x + threadIdx.x;
    if (i >= (size_t)T * D) return;
    int row = (int)(i / D), d = (int)(i % D), b = row / SE, ii = row % SE, mb = ii < S ? b : 8;
    const float* m = mods_l + (size_t)mb * 6 * D;
    HM[i] = X[i] * (1.f + m[(which + 1) * D + d]) + m[which * D + d];
}
struct GemmP { const float* A; int lda; const int* gidx; const float* Bm; int ldb; float* C; int ldc; int M; const int* Mdev; int N, K; int mode;
               const int* sidx; const float* sw; long long eB, eG; const int* coff; const int* aoff; };
__global__ void __launch_bounds__(256) k_gemm(GemmP p) {
    __shared__ float As[16][68];
    __shared__ float Bs[16][64];
    const int z = blockIdx.z;
    const int M = p.Mdev ? p.Mdev[z] : p.M;
    const int row0 = blockIdx.y * 64, col0 = blockIdx.x * 64;
    if (row0 >= M) return;
    const float* A = p.A; const float* Bm = p.Bm + (size_t)z * p.eB;
    const int* gidx = p.gidx ? p.gidx + (size_t)z * p.eG : nullptr;
    const int* sidx = p.sidx ? p.sidx + (size_t)z * p.eG : nullptr;
    const float* sw = p.sw ? p.sw + (size_t)z * p.eG : nullptr;
    const int crow_off = p.coff ? p.coff[z] : 0;
    const int arow_off = p.aoff ? p.aoff[z] : 0;
    float* C = p.C;
    const int tid = threadIdx.x, tx = tid & 15, ty = tid >> 4;
    const int ar = tid >> 2, ak = (tid & 3) * 4;
    const int bk = tid >> 4, bn = (tid & 15) * 4;
    int arow = row0 + ar; if (arow >= M) arow = M - 1;
    const size_t asrc = gidx ? (size_t)gidx[arow] : (size_t)(arow_off + arow);
    const float* ap = A + asrc * p.lda + ak;
    const float* bp = Bm + (size_t)bk * p.ldb + col0 + bn;
    float acc[4][4];
#pragma unroll
    for (int i = 0; i < 4; ++i)
#pragma unroll
        for (int j = 0; j < 4; ++j) acc[i][j] = 0.f;
    for (int k0 = 0; k0 < p.K; k0 += 16) {
        float4 av = *(const float4*)(ap + k0);
        float4 bv = *(const float4*)(bp + (size_t)k0 * p.ldb);
        As[ak + 0][ar] = av.x; As[ak + 1][ar] = av.y; As[ak + 2][ar] = av.z; As[ak + 3][ar] = av.w;
        *(float4*)&Bs[bk][bn] = bv;
        __syncthreads();
#pragma unroll
        for (int kk = 0; kk < 16; ++kk) {
            float4 a4 = *(const float4*)&As[kk][ty * 4];
            float4 b4 = *(const float4*)&Bs[kk][tx * 4];
            float a[4] = {a4.x, a4.y, a4.z, a4.w}, b[4] = {b4.x, b4.y, b4.z, b4.w};
#pragma unroll
            for (int i = 0; i < 4; ++i)
#pragma unroll
                for (int j = 0; j < 4; ++j) acc[i][j] += a[i] * b[j];
        }
        __syncthreads();
    }
#pragma unroll
    for (int i = 0; i < 4; ++i) {
        int r = row0 + ty * 4 + i; if (r >= M) continue;
        if (p.mode == 0) {
            float* cp = C + (size_t)(crow_off + r) * p.ldc + col0 + tx * 4;
            *(float4*)cp = make_float4(acc[i][0], acc[i][1], acc[i][2], acc[i][3]);
        } else {
            int tok = sidx[r]; float w = sw[r];
            float* cp = C + (size_t)tok * p.ldc + col0 + tx * 4;
#pragma unroll
            for (int j = 0; j < 4; ++j) atomicAdd(cp + j, w * acc[i][j]);
        }
    }
}
static void gemm(hipStream_t st, const float* A, int lda, const float* Bm, int ldb, float* C, int ldc, int M, int N, int K) {
    GemmP p{}; p.A = A; p.lda = lda; p.Bm = Bm; p.ldb = ldb; p.C = C; p.ldc = ldc; p.M = M; p.N = N; p.K = K; p.mode = 0;
    hipLaunchKernelGGL(k_gemm, dim3(N / 64, (M + 63) / 64, 1), dim3(256), 0, st, p);
}

__global__ void k_hy_z2(const float* w1, const float* b1, const float* w2, const float* b2, const float* sf, int L, float* z2tab) {
    const int t = blockIdx.x * (blockDim.x / 64) + (threadIdx.x >> 6), lane = threadIdx.x & 63;
    if (t >= L) return;
    const double PI2 = 6.283185307179586476925;
    float tt = (float)((double)t / (double)(L - 1));
    float ang = (float)(PI2 / (double)L) * (float)t;
    float a = b1[lane];
    a += tt * w1[0 * 64 + lane];
    for (int j = 0; j < 16; ++j) {
        float band = (float)(1e-4 + (double)j * ((15.0 - 1e-4) / 15.0));
        float arg = band * ang;
        a += cosf(arg) * w1[(1 + j) * 64 + lane];
        a += -sinf(arg) * w1[(17 + j) * 64 + lane];
    }
    float z1 = sinf(sf[lane] * a);
    float a2 = b2[lane];
    for (int i = 0; i < 64; ++i) a2 += __shfl(z1, i) * w2[i * 64 + lane];
    z2tab[(size_t)t * 64 + lane] = sinf(sf[64 + lane] * a2);
}
__global__ void k_hy_filt(const float* z2tab, const float* w3, int L, float* hf, float* hb) {
    int i = blockIdx.x * blockDim.x + threadIdx.x;
    if (i >= L * DH) return;
    int t = i / DH, c = i % DH;
    float af = 0.f, ab = 0.f;
    for (int j = 0; j < 64; ++j) { float z = z2tab[(size_t)t * 64 + j]; af += z * w3[j * 1024 + c]; ab += z * w3[j * 1024 + 512 + c]; }
    const double la = log(1e-2) / 1.5, lb = log(1e-2) / 0.3;
    float delta = fabsf((float)(la + (double)c * ((lb - la) / 511.0)));
    float tt = (float)((double)t / (double)(L - 1));
    float dec = expf(-tt * delta);
    hf[i] = af * dec; hb[i] = ab * dec;
}
__global__ void k_hy_conv(const float* PB, const float* cw, const float* cb, float* UC) {
    int idx = blockIdx.x * blockDim.x + threadIdx.x;
    if (idx >= SE * 1536) return;
    int i = idx / 1536, c = idx % 1536;
    int lo = i < S ? 0 : S, hi = i < S ? S : SE;
    float v = PB[(size_t)i * DIN + c] * cw[1536 + c];
    if (i - 1 >= lo) v += PB[(size_t)(i - 1) * DIN + c] * cw[c];
    if (i + 1 < hi) v += PB[(size_t)(i + 1) * DIN + c] * cw[2 * 1536 + c];
    UC[idx] = v + cb[c];
}
__global__ void k_hy_z(const float* UC, float* Z) {
    int idx = blockIdx.x * blockDim.x + threadIdx.x;
    if (idx >= SE * DH) return;
    int i = idx / DH, c = idx % DH;
    Z[idx] = UC[(size_t)i * 1536 + 1024 + c] * UC[(size_t)i * 1536 + 512 + c];
}
__global__ void k_hy_long(const float* Z, const float* UC, const float* hf, const float* hb, const float* hfc, const float* hbc, const float* bias_d, float* YHY) {
    int idx = blockIdx.x * blockDim.x + threadIdx.x;
    if (idx >= SE * DH) return;
    int i = idx / DH, c = idx % DH;
    int lo = i < S ? 0 : S, L = i < S ? S : CL;
    const float* f = i < S ? hf : hfc; const float* g = i < S ? hb : hbc;
    int t = i - lo;
    float acc = 0.f;
    for (int s = 0; s <= t; ++s) acc += f[(size_t)(t - s) * DH + c] * Z[(size_t)(lo + s) * DH + c];
    for (int s = t + 1; s < L; ++s) acc += g[(size_t)(s - t) * DH + c] * Z[(size_t)(lo + s) * DH + c];
    float z = Z[idx];
    YHY[idx] = UC[(size_t)i * 1536 + c] * (acc + z * bias_d[c]);
}
__global__ void k_sconv(const float* PB, const float* cw, float* YSC) {
    int idx = blockIdx.x * blockDim.x + threadIdx.x;
    if (idx >= SE * DH) return;
    int i = idx / DH, c = idx % DH;
    int lo = i < S ? 0 : S, hi = i < S ? S : SE;
    const float* p = PB + OFF_SC;
    float v = p[(size_t)i * DIN + 512 + c] * p[(size_t)i * DIN + 1024 + c] * cw[512 + c];
    if (i - 1 >= lo) v += p[(size_t)(i - 1) * DIN + 512 + c] * p[(size_t)(i - 1) * DIN + 1024 + c] * cw[c];
    if (i + 1 < hi) v += p[(size_t)(i + 1) * DIN + 512 + c] * p[(size_t)(i + 1) * DIN + 1024 + c] * cw[1024 + c];
    YSC[idx] = p[(size_t)i * DIN + c] * v;
}
__global__ void k_attn(const float* PB, const float* rpb, float* YAT) {
    const int wt = blockIdx.x * (blockDim.x / 64) + (threadIdx.x >> 6), lane = threadIdx.x & 63;
    if (wt >= SE * NHEAD) return;
    const int i = wt / NHEAD, h = wt % NHEAD;
    const float* Q = PB + OFF_NA + h * HDIM; const float* Kp = PB + OFF_NA + 512 + h * HDIM; const float* V = PB + OFF_NA + 1024 + h * HDIM;
    const float q = Q[(size_t)i * DIN + lane];
    float m = -3.0e38f, l = 0.f, o = 0.f;
    if (i < S) {
        const int r = i / GRIDW, qc = i % GRIDW;
        int rs = r - 4; rs = rs < 0 ? 0 : (rs > 56 ? 56 : rs);
        int cs = qc - 8; cs = cs < 0 ? 0 : (cs > 48 ? 48 : cs);
        for (int j = 0; j < 8; ++j) for (int kc = cs; kc < cs + 16; ++kc) {
            const int kt = (rs + j) * GRIDW + kc;
            float s = wsum(q * Kp[(size_t)kt * DIN + lane]) * 0.125f + rpb[(h * 15 + (rs + j - r + 7)) * 31 + (kc - qc + 15)];
            float mn = fmaxf(m, s), a = expf(m - mn), pp = expf(s - mn);
            l = l * a + pp; o = o * a + pp * V[(size_t)kt * DIN + lane]; m = mn;
        }
    }
    for (int kt = S; kt < SE; ++kt) {
        float s = wsum(q * Kp[(size_t)kt * DIN + lane]) * 0.125f;
        float mn = fmaxf(m, s), a = expf(m - mn), pp = expf(s - mn);
        l = l * a + pp; o = o * a + pp * V[(size_t)kt * DIN + lane]; m = mn;
    }
    YAT[(size_t)i * DH + h * HDIM + lane] = o / l;
}
__global__ void k_merge(const float* PB, const float* T0, const float* T1, const float* T2, float* MG) {
    int idx = blockIdx.x * blockDim.x + threadIdx.x;
    if (idx >= SE * D) return;
    int i = idx / D, c = idx % D;
    const float* g = PB + (size_t)i * DIN + OFF_GATE;
    MG[idx] = sigmoidf_(g[c]) * T0[idx] + sigmoidf_(g[D + c]) * T1[idx] + sigmoidf_(g[2 * D + c]) * T2[idx];
}
__global__ void k_res_ln(float* X, const float* O, const float* mods_l, int gate_idx, const float* lg, const float* lb, int row0, int n) {
    const int w = blockIdx.x * (blockDim.x / 64) + (threadIdx.x >> 6), lane = threadIdx.x & 63;
    if (w >= n) return;
    const int row = row0 + w, b = row / SE, ii = row % SE, mb = ii < S ? b : 8;
    const float* gt = mods_l + (size_t)mb * 6 * D + gate_idx * D;
    float v[16]; float s = 0.f;
#pragma unroll
    for (int j = 0; j < 16; ++j) { int d = lane + 64 * j; v[j] = ALPHA * X[(size_t)row * D + d] + gt[d] * O[(size_t)w * D + d]; s += v[j]; }
    const float mu = wsum(s) * (1.f / D); float q = 0.f;
#pragma unroll
    for (int j = 0; j < 16; ++j) { v[j] -= mu; q += v[j] * v[j]; }
    const float rstd = rsqrtf(wsum(q) * (1.f / D) + LN_EPS);
#pragma unroll
    for (int j = 0; j < 16; ++j) { int d = lane + 64 * j; X[(size_t)row * D + d] = v[j] * rstd * lg[d] + lb[d]; }
}
__global__ void k_route(const float* logits, const float* rbias, int* cnt, int* ltok, float* lw) {
    const int tok = blockIdx.x * (blockDim.x / 64) + (threadIdx.x >> 6), lane = threadIdx.x & 63;
    if (tok >= T) return;
    const float score = sigmoidf_(logits[(size_t)tok * NE + lane]);
    const float sel = score + rbias[lane];
    float m1 = sel;
    m1 = fmaxf(m1, __shfl_xor(m1, 1)); m1 = fmaxf(m1, __shfl_xor(m1, 2)); m1 = fmaxf(m1, __shfl_xor(m1, 4));
    unsigned long long eq = __ballot(sel == m1);
    const int g = lane >> 3;
    const unsigned geq = (unsigned)((eq >> (g * 8)) & 0xffull);
    const int first = __ffs(geq) - 1;
    float s2 = ((lane & 7) == first) ? -3.0e38f : sel;
    s2 = fmaxf(s2, __shfl_xor(s2, 1)); s2 = fmaxf(s2, __shfl_xor(s2, 2)); s2 = fmaxf(s2, __shfl_xor(s2, 4));
    const float gs = m1 + s2;
    int grank = 0;
    for (int gg = 0; gg < 8; ++gg) { float o = __shfl(gs, gg * 8); if (o > gs || (o == gs && gg < g)) ++grank; }
    const bool gsel = grank < 4;
    const float val = gsel ? sel : -3.0e38f;
    int rank = 0;
    for (int j = 0; j < 64; ++j) { float o = __shfl(val, j); if (o > val || (o == val && j < lane)) ++rank; }
    const bool chosen = gsel && rank < TOPK;
    const float tot = wsum(chosen ? score : 0.f);
    if (chosen) {
        const float w = score / tot * 2.5f;
        int pos = atomicAdd(&cnt[lane], 1);
        ltok[(size_t)lane * T + pos] = tok; lw[(size_t)lane * T + pos] = w;
    }
}
__global__ void k_prefix(const int* cnt, int* off) { if (threadIdx.x == 0) { int a = 0; for (int e = 0; e < NE; ++e) { off[e] = a; a += cnt[e]; } } }
__global__ void k_swiglu(const float* U1, const float* U3, float* H, size_t n) {
    size_t i = (size_t)blockIdx.x * blockDim.x + threadIdx.x;
    if (i < n) H[i] = siluf_(U1[i]) * U3[i];
}
__global__ void k_final(const float* X, float* out) {
    size_t i = (size_t)blockIdx.x * blockDim.x + threadIdx.x;
    if (i >= (size_t)B * S * D) return;
    int d = (int)(i % D); size_t r = i / D; int b = (int)(r / S), t = (int)(r % S);
    out[i] = X[((size_t)b * SE + t) * D + d];
}

struct In {
    const float *x, *c, *ctx, *c_ctx, *w_ada, *b_ada, *w_in, *hy_conv_w, *hy_conv_b, *hy_w1, *hy_b1, *hy_w2, *hy_b2, *hy_w3, *hy_sin_freq, *hy_bias_d,
        *hy_proj, *sc_conv_w, *sc_proj, *na_rpb, *na_proj, *w_o, *ln1_g, *ln1_b, *ln2_g, *ln2_b, *moe_router, *moe_bias, *moe_w1, *moe_w3, *moe_w2, *sh_w1, *sh_w3, *sh_w2;
};


struct Ctx {
    float *X, *HM, *cond, *mods, *MIX, *PB, *UC, *Z, *YB, *T0, *T1, *T2, *MG, *OB, *z2a, *z2c, *hf, *hb, *hfc, *hbc, *logits, *lw, *U1, *U3, *F, *YHY, *YSC, *YAT;
    int *cnt, *off, *ltok;
};
static Ctx make_ctx(unsigned char* ws, size_t dyn_off) {
    Ctx c{};
    c.X = (float*)(ws + (size_t)2 * 1024 * 1024); c.mods = (float*)(ws + (size_t)1024 * 1024); c.cond = (float*)(ws + (size_t)256 * 1024);
    size_t o = dyn_off; auto alloc = [&](size_t bytes) { size_t r = o; o += (bytes + 255) & ~(size_t)255; return (void*)(ws + r); };
    c.HM = (float*)alloc((size_t)T * D * 4);
    c.MIX = (float*)alloc((size_t)SE * 16384 * 4);
    c.PB = c.MIX; c.UC = c.PB + (size_t)SE * DIN; c.Z = c.UC + (size_t)SE * 1536; c.YB = c.Z + (size_t)SE * DH;
    c.T0 = c.YB + (size_t)SE * 1536; c.T1 = c.T0 + (size_t)SE * D; c.T2 = c.T1 + (size_t)SE * D; c.MG = c.T2 + (size_t)SE * D; c.OB = c.MG + (size_t)SE * D;
    c.z2a = (float*)alloc((size_t)S * 64 * 4); c.z2c = (float*)alloc((size_t)CL * 64 * 4);
    c.hf = (float*)alloc((size_t)S * DH * 4); c.hb = (float*)alloc((size_t)S * DH * 4);
    c.hfc = (float*)alloc((size_t)CL * DH * 4); c.hbc = (float*)alloc((size_t)CL * DH * 4);
    c.logits = (float*)alloc((size_t)T * NE * 4);
    c.cnt = (int*)alloc(256); c.off = (int*)alloc(256);
    c.ltok = (int*)alloc((size_t)NE * T * 4); c.lw = (float*)alloc((size_t)NE * T * 4);
    c.U1 = (float*)alloc((size_t)T * TOPK * DEXP * 4);
    c.U3 = c.MIX; c.F = c.MIX + (size_t)32 * 1024 * 1024;
    c.YHY = c.YB; c.YSC = c.YB + (size_t)SE * DH; c.YAT = c.YB + 2 * (size_t)SE * DH;
    return c;
}
static void prologue(const In& in, const Ctx& c, hipStream_t st) {
    hipLaunchKernelGGL(k_cond, dim3((9 * D + 255) / 256), dim3(256), 0, st, in.c, in.c_ctx, c.cond);
    hipLaunchKernelGGL(k_mods, dim3(DEPTH * 6 * D / 256), dim3(256), 0, st, c.cond, in.w_ada, in.b_ada, c.mods);
    hipLaunchKernelGGL(k_init_x, dim3((unsigned)(((size_t)T * D + 255) / 256)), dim3(256), 0, st, in.x, in.ctx, c.X);
}
static void mixer_layer(const In& in, const Ctx& c, int l, hipStream_t st) {
    const unsigned gTD = (unsigned)(((size_t)T * D + 255) / 256);
    const float* ml = c.mods + (size_t)l * 9 * 6 * D;
    hipLaunchKernelGGL(k_hy_z2, dim3(S / 4), dim3(256), 0, st, in.hy_w1 + l * 33 * 64, in.hy_b1 + l * 64, in.hy_w2 + l * 4096, in.hy_b2 + l * 64, in.hy_sin_freq + l * 128, S, c.z2a);
    hipLaunchKernelGGL(k_hy_z2, dim3(CL / 4), dim3(256), 0, st, in.hy_w1 + l * 33 * 64, in.hy_b1 + l * 64, in.hy_w2 + l * 4096, in.hy_b2 + l * 64, in.hy_sin_freq + l * 128, CL, c.z2c);
    hipLaunchKernelGGL(k_hy_filt, dim3(S * DH / 256), dim3(256), 0, st, c.z2a, in.hy_w3 + (size_t)l * 64 * 1024, S, c.hf, c.hb);
    hipLaunchKernelGGL(k_hy_filt, dim3(CL * DH / 256), dim3(256), 0, st, c.z2c, in.hy_w3 + (size_t)l * 64 * 1024, CL, c.hfc, c.hbc);
    hipLaunchKernelGGL(k_modulate, dim3(gTD), dim3(256), 0, st, c.X, ml, c.HM, 0);
    for (int b = 0; b < B; ++b) {
        gemm(st, c.HM + (size_t)b * SE * D, D, in.w_in + (size_t)l * D * DIN, DIN, c.PB, DIN, SE, DIN, D);
        hipLaunchKernelGGL(k_hy_conv, dim3(SE * 1536 / 256), dim3(256), 0, st, c.PB, in.hy_conv_w + l * 3 * 1536, in.hy_conv_b + l * 1536, c.UC);
        hipLaunchKernelGGL(k_hy_z, dim3(SE * DH / 256), dim3(256), 0, st, c.UC, c.Z);
        hipLaunchKernelGGL(k_hy_long, dim3(SE * DH / 256), dim3(256), 0, st, c.Z, c.UC, c.hf, c.hb, c.hfc, c.hbc, in.hy_bias_d + l * DH, c.YHY);
        hipLaunchKernelGGL(k_sconv, dim3(SE * DH / 256), dim3(256), 0, st, c.PB, in.sc_conv_w + l * 3 * DH, c.YSC);
        hipLaunchKernelGGL(k_attn, dim3(SE * NHEAD / 4), dim3(256), 0, st, c.PB, in.na_rpb + l * NHEAD * 15 * 31, c.YAT);
        gemm(st, c.YHY, DH, in.hy_proj + (size_t)l * DH * D, D, c.T0, D, SE, D, DH);
        gemm(st, c.YSC, DH, in.sc_proj + (size_t)l * DH * D, D, c.T1, D, SE, D, DH);
        gemm(st, c.YAT, DH, in.na_proj + (size_t)l * DH * D, D, c.T2, D, SE, D, DH);
        hipLaunchKernelGGL(k_merge, dim3(SE * D / 256), dim3(256), 0, st, c.PB, c.T0, c.T1, c.T2, c.MG);
        gemm(st, c.MG, D, in.w_o + (size_t)l * D * D, D, c.OB, D, SE, D, D);
        hipLaunchKernelGGL(k_res_ln, dim3(SE / 4), dim3(256), 0, st, c.X, c.OB, ml, 2, in.ln1_g + l * D, in.ln1_b + l * D, b * SE, SE);
    }
}
static void moe_layer(const In& in, const Ctx& c, int l, hipStream_t st) {
    const unsigned gTD = (unsigned)(((size_t)T * D + 255) / 256);
    const float* ml = c.mods + (size_t)l * 9 * 6 * D;
    hipLaunchKernelGGL(k_modulate, dim3(gTD), dim3(256), 0, st, c.X, ml, c.HM, 3);
    gemm(st, c.HM, D, in.moe_router + (size_t)l * D * NE, NE, c.logits, NE, T, NE, D);
    (void)hipMemsetAsync(c.cnt, 0, 256, st);
    hipLaunchKernelGGL(k_route, dim3(T / 4), dim3(256), 0, st, c.logits, in.moe_bias + l * NE, c.cnt, c.ltok, c.lw);
    hipLaunchKernelGGL(k_prefix, dim3(1), dim3(64), 0, st, c.cnt, c.off);
    {
        GemmP p{}; p.A = c.HM; p.lda = D; p.gidx = c.ltok; p.eG = T; p.ldb = DEXP; p.ldc = DEXP; p.Mdev = c.cnt; p.N = DEXP; p.K = D; p.mode = 0; p.eB = (long long)D * DEXP; p.coff = c.off;
        p.Bm = in.moe_w1 + (size_t)l * NE * D * DEXP; p.C = c.U1;
        hipLaunchKernelGGL(k_gemm, dim3(DEXP / 64, T / 64, NE), dim3(256), 0, st, p);
        p.Bm = in.moe_w3 + (size_t)l * NE * D * DEXP; p.C = c.U3;
        hipLaunchKernelGGL(k_gemm, dim3(DEXP / 64, T / 64, NE), dim3(256), 0, st, p);
    }
    hipLaunchKernelGGL(k_swiglu, dim3((unsigned)(((size_t)T * TOPK * DEXP + 255) / 256)), dim3(256), 0, st, c.U1, c.U3, c.U1, (size_t)T * TOPK * DEXP);
    {
        float* V1 = c.U3; float* V3 = c.U3 + (size_t)T * DEXP;
        gemm(st, c.HM, D, in.sh_w1 + (size_t)l * D * DEXP, DEXP, V1, DEXP, T, DEXP, D);
        gemm(st, c.HM, D, in.sh_w3 + (size_t)l * D * DEXP, DEXP, V3, DEXP, T, DEXP, D);
        hipLaunchKernelGGL(k_swiglu, dim3((unsigned)(((size_t)T * DEXP + 255) / 256)), dim3(256), 0, st, V1, V3, V1, (size_t)T * DEXP);
        gemm(st, V1, DEXP, in.sh_w2 + (size_t)l * DEXP * D, D, c.F, D, T, D, DEXP);
    }
    {
        GemmP p{}; p.A = c.U1; p.lda = DEXP; p.aoff = c.off; p.sidx = c.ltok; p.sw = c.lw; p.eG = T; p.Bm = in.moe_w2 + (size_t)l * NE * DEXP * D; p.ldb = D; p.C = c.F; p.ldc = D; p.Mdev = c.cnt; p.N = D; p.K = DEXP; p.mode = 1;
        p.eB = (long long)DEXP * D;
        hipLaunchKernelGGL(k_gemm, dim3(D / 64, T / 64, NE), dim3(256), 0, st, p);
    }
    hipLaunchKernelGGL(k_res_ln, dim3(T / 4), dim3(256), 0, st, c.X, c.F, ml, 5, in.ln2_g + l * D, in.ln2_b + l * D, 0, T);
}
static void finalize(const Ctx& c, float* out, hipStream_t st) {
    hipLaunchKernelGGL(k_final, dim3((unsigned)(((size_t)B * S * D + 255) / 256)), dim3(256), 0, st, c.X, out);
}
}
namespace fk {
#define LAS __attribute__((address_space(3)))
#define GAS __attribute__((address_space(1)))
typedef _Float16 f16;
typedef _Float16 h8 __attribute__((ext_vector_type(8)));
typedef _Float16 h4 __attribute__((ext_vector_type(4)));
typedef _Float16 h2 __attribute__((ext_vector_type(2)));
typedef float f32x4 __attribute__((ext_vector_type(4)));
typedef float f32x2 __attribute__((ext_vector_type(2)));
typedef unsigned u32x4 __attribute__((ext_vector_type(4)));
typedef unsigned u32x2 __attribute__((ext_vector_type(2)));

constexpr int B = 8, S = 4096, CL = 256, SE = S + CL, T = B * SE, D = 1024, DEPTH = 4;
constexpr int DH = 512, DIN = 7680, OFF_SC = 1536, OFF_NA = 3072, OFF_GATE = 4608;
constexpr int NE = 64, TOPK = 8, DEXP = 256;
constexpr int GRIDW = 64, NHEAD = 8, HDIM = 64;
constexpr float LN_EPS = 1e-5f;
constexpr float ALPHA = 1.681792830507429f;
constexpr int NWAVES = 8, NTHR = 512;
constexpr int TH = T / 2;
constexpr int MAXT_H = TH * TOPK / 256 + NE;
constexpr int SH_T = TH / 256;

__device__ __forceinline__ unsigned pkh(float a, float b) { f32x2 v = {a, b}; h2 h = __builtin_convertvector(v, h2); return __builtin_bit_cast(unsigned, h); }
__device__ __forceinline__ float sigm(float x) { return 1.f / (1.f + __expf(-x)); }
__device__ __forceinline__ float bperm(int src, float v) { return __int_as_float(__builtin_amdgcn_ds_bpermute(src << 2, __float_as_int(v))); }
__device__ __forceinline__ int bpermi(int src, int v) { return __builtin_amdgcn_ds_bpermute(src << 2, v); }
#define SHX(v, o) bperm(lane ^ (o), (v))
__device__ __forceinline__ float wsum(float v, int lane) {
#pragma unroll
    for (int o = 1; o < 64; o <<= 1) v += SHX(v, o);
    return v;
}
__device__ __forceinline__ int lane_id() { return (int)__builtin_amdgcn_mbcnt_hi(~0u, __builtin_amdgcn_mbcnt_lo(~0u, 0u)); }
#define LDS_WAIT() asm volatile("s_waitcnt lgkmcnt(0)" ::: "memory")
#define VM_WAIT() asm volatile("s_waitcnt vmcnt(0)" ::: "memory")

#define XB_TMO      128
#define XB_XCNT(j)  (256  + 64 * (j))
#define XB_XSUB(j)  (1280 + 64 * (j))
#define XB_XGEN(j)  (2304 + 64 * (j))
#define XB_TOP      3328
#define XB_TOPGEN   3392
#define XCD_BAR_WORDS 3456
#define XB_SPIN_CAP (1u << 18)
__device__ __forceinline__ unsigned xb_ld(unsigned* p)              { return __hip_atomic_load(p, __ATOMIC_RELAXED, __HIP_MEMORY_SCOPE_AGENT); }
__device__ __forceinline__ unsigned xb_add(unsigned* p, unsigned v) { return __hip_atomic_fetch_add(p, v, __ATOMIC_RELAXED, __HIP_MEMORY_SCOPE_AGENT); }
__device__ __forceinline__ unsigned xb_xcc_id() { return (unsigned)__builtin_amdgcn_s_getreg((3 << 11) | 20) & 0xFu; }
#define XB_SPIN(cond, bar) do { unsigned _sp = 0; while (cond) { __builtin_amdgcn_s_sleep(1); \
    if ((++_sp & 255u) == 0u) { if (xb_ld(&(bar)[XB_TMO])) break; if (_sp > XB_SPIN_CAP) { atomicAdd(&(bar)[XB_TMO], 1u); break; } } } } while (0)
struct XcdBarrier { unsigned* bar; unsigned x; volatile LAS unsigned* st; };
__device__ __forceinline__ XcdBarrier xcd_barrier_post(unsigned* bar, volatile LAS unsigned* st, int tid) {
    XcdBarrier b; b.bar = bar; b.x = xb_xcc_id(); b.st = st;
    if (tid == 0) (void)xb_add(&bar[XB_XCNT(b.x)], 1u);
    return b;
}
__device__ __forceinline__ void xcd_barrier_complete(unsigned* bar, unsigned x, unsigned& nloc, unsigned& nx) {
    const unsigned G = gridDim.x * gridDim.y * gridDim.z;
    unsigned sum, cnt, mine, sp = 0u;
    for (;;) {
        sum = 0u; cnt = 0u; mine = 0u;
#pragma unroll
        for (unsigned j = 0; j < 16; ++j) { const unsigned c = xb_ld(&bar[XB_XCNT(j)]); sum += c; cnt += (c > 0u) ? 1u : 0u; mine = (j == x) ? c : mine; }
        if (sum == G) break;
        __builtin_amdgcn_s_sleep(1);
        if ((++sp & 255u) == 0u) { if (xb_ld(&bar[XB_TMO])) break; if (sp > XB_SPIN_CAP) { atomicAdd(&bar[XB_TMO], 1u); break; } }
    }
    nloc = mine > 0u ? mine : 1u; nx = cnt > 0u ? cnt : 1u;
}
__device__ __forceinline__ void xcd_barrier(const XcdBarrier& b, int tid) {
    asm volatile("s_waitcnt vmcnt(0)" ::: "memory");
    __syncthreads();
    if (tid == 0) {
        unsigned* bar = b.bar;
        __builtin_amdgcn_s_waitcnt(0);
        unsigned nloc = b.st[0], nx = b.st[1];
        if (nloc == 0u) { xcd_barrier_complete(bar, b.x, nloc, nx); b.st[0] = nloc; b.st[1] = nx; }
        const unsigned old = xb_add(&bar[XB_XSUB(b.x)], 1u);
        const unsigned gen = old / nloc;
        if (old + 1u == (gen + 1u) * nloc) {
            __builtin_amdgcn_fence(__ATOMIC_RELEASE, "agent");
            asm volatile("s_waitcnt vmcnt(0)" ::: "memory");
            const unsigned og = xb_add(&bar[XB_TOP], 1u);
            const unsigned tg = og / nx;
            if (og + 1u == (tg + 1u) * nx) xb_add(&bar[XB_TOPGEN], 1u);
            else XB_SPIN(xb_ld(&bar[XB_TOPGEN]) == tg, bar);
            __builtin_amdgcn_fence(__ATOMIC_ACQUIRE, "agent");
            xb_add(&bar[XB_XGEN(b.x)], 1u);
            asm volatile("s_waitcnt vmcnt(0)" ::: "memory");
        } else {
            XB_SPIN(xb_ld(&bar[XB_XGEN(b.x)]) == gen, bar);
            __builtin_amdgcn_fence(__ATOMIC_ACQUIRE, "agent");
            asm volatile("s_waitcnt vmcnt(0)" ::: "memory");
        }
    }
    __syncthreads();
}

namespace pg {
constexpr int BM = 256, BK = 64, HALF = 128, HTB = HALF * BK * 2, STAGE_BYTES = 8 * HTB;
__host__ __device__ __forceinline__ int lds_byte(int r, int c) { const int st = (r >> 4) * 2 + (c >> 5), rr = r & 15, cc = c & 31, ob = rr * 64 + cc * 2; return st * 1024 + (ob ^ (((ob >> 9) & 1) << 5)); }
__host__ __device__ __forceinline__ void stage_rc(int b, int& R, int& C) { const int st = b / 1024, sb = b % 1024, swz = sb ^ (((sb >> 9) & 1) << 5); R = (st >> 1) * 16 + swz / 64; C = (st & 1) * 32 + (swz % 64) / 2; }
__host__ __device__ __forceinline__ int perm32(int rho) { const int n = rho >> 4, i = rho & 15; return 8 * (i >> 2) + 4 * n + (i & 3); }

struct Unit { const char* A; const char* B; int pm, pn, e, nrows, aux0; };

template <class Epi, class Sched, bool ALIGN_EPI>
__device__ __forceinline__ void gemm_phase(LAS unsigned char* lds, const int wave, const int K, const int lda, const int ldb, const Sched& S, const Epi& E) {
    int tid_ = wave * 64 + lane_id(); asm volatile("" : "+v"(tid_));
    const int tid = tid_, wid = __builtin_amdgcn_readfirstlane(tid >> 6), lane = tid & 63, wr = wid >> 2, wc = wid & 3, fr = lane & 15, fq = lane >> 4;
    const int nt = K / BK;
    int sR[2], sC[2];
    unsigned voffB[2];
#pragma unroll
    for (int i = 0; i < 2; ++i) { int R, C; stage_rc(tid * 16 + i * 8192, R, C); sR[i] = R; sC[i] = C; const int Rb = Epi::PERM ? ((R & ~31) + perm32(R & 31)) : R;
        voffB[i] = (unsigned)(Rb * ldb + C) * 2u; }
    const size_t kstep = (size_t)(BK * 2);
    const size_t hstepB = (size_t)HALF * ldb * 2;
    const unsigned ldsw = (unsigned)wid * 1024u;
    const int aoff = lds_byte(wr * 64 + fr, fq * 8), boff = lds_byte(wc * 32 + fr, fq * 8);
#define PG_SA(b, h) (((b) * 2 + (h)) * HTB)
#define PG_SB(b, h) ((4 + (b) * 2 + (h)) * HTB)
#define PG_STAGE2(bufoff, gbase, o0, o1) do { \
        __builtin_amdgcn_global_load_lds((const unsigned*)((const char*)(gbase) + (o0)), (LAS unsigned*)(lds + (bufoff) + ldsw), 16, 0, 0); \
        __builtin_amdgcn_global_load_lds((const unsigned*)((const char*)(gbase) + (o1)), (LAS unsigned*)(lds + (bufoff) + ldsw + 8192), 16, 0, 0); } while (0)
#define PG_STAGEB(bufoff, gbase) PG_STAGE2(bufoff, gbase, voffB[0], voffB[1])
#define PG_LDA(dst, b, h) do { _Pragma("unroll") for (int m = 0; m < 4; ++m) _Pragma("unroll") for (int k = 0; k < 2; ++k) dst[m][k] = *(const LAS h8*)(lds + PG_SA(b, h) + aoff + m * 2048 + k * 1024); } while (0)
#define PG_LDB(dst, b, h) do { _Pragma("unroll") for (int n = 0; n < 2; ++n) _Pragma("unroll") for (int k = 0; k < 2; ++k) dst[n][k] = *(const LAS h8*)(lds + PG_SB(b, h) + boff + n * 2048 + k * 1024); } while (0)
#define PG_MMA(ai, bj, At, Bt) do { __builtin_amdgcn_s_setprio(1); _Pragma("unroll") for (int m = 0; m < 4; ++m) _Pragma("unroll") for (int n = 0; n < 2; ++n) _Pragma("unroll") for (int k = 0; k < 2; ++k) \
        acc[ai][bj][m][n] = __builtin_amdgcn_mfma_f32_16x16x32_f16(Bt[n][k], At[m][k], acc[ai][bj][m][n], 0, 0, 0); __builtin_amdgcn_s_setprio(0); } while (0)
#define PG_WAIT_V(n) asm volatile("s_waitcnt vmcnt(" #n ")" ::: "memory")
#define PG_WAIT_L(n) asm volatile("s_waitcnt lgkmcnt(" #n ")" ::: "memory")
#define PG_BAR __builtin_amdgcn_s_barrier()
#define PG_SCHED __builtin_amdgcn_sched_barrier(0)
    Unit cur, nxt; int ui = 0;
    if (!S.next(0, cur)) return;
    unsigned c00, c01, c10, c11;
    LAS unsigned* otab = (LAS unsigned*)(lds + STAGE_BYTES + 2048) + tid;
    { c00 = (unsigned)(S.arow(cur, sR[0]) * lda + sC[0]) * 2u; c01 = (unsigned)(S.arow(cur, sR[1]) * lda + sC[1]) * 2u;
      c10 = (unsigned)(S.arow(cur, HALF + sR[0]) * lda + sC[0]) * 2u; c11 = (unsigned)(S.arow(cur, HALF + sR[1]) * lda + sC[1]) * 2u; }
    f32x4 acc[2][2][4][2];
#pragma unroll
    for (int a = 0; a < 2; ++a)
#pragma unroll
        for (int b = 0; b < 2; ++b)
#pragma unroll
            for (int m = 0; m < 4; ++m)
#pragma unroll
                for (int n = 0; n < 2; ++n) acc[a][b][m][n] = (f32x4){0.f, 0.f, 0.f, 0.f};
    h8 At[4][2], B0[2][2], B1[2][2];
    const char* cA = cur.A; const char* cB = cur.B;
    PG_STAGEB(PG_SB(0, 0), cB); PG_STAGEB(PG_SB(0, 1), cB + hstepB); PG_STAGE2(PG_SA(0, 0), cA, c00, c01); PG_STAGE2(PG_SA(0, 1), cA, c10, c11);
    if (wr == 1) PG_BAR;
    PG_WAIT_V(2); PG_BAR;
    PG_STAGEB(PG_SB(1, 0), cB + kstep); PG_STAGE2(PG_SA(1, 0), cA + kstep, c00, c01); PG_STAGEB(PG_SB(1, 1), cB + hstepB + kstep);
    PG_WAIT_V(6); PG_BAR;
    for (;;) {
        const bool has_next = S.next(ui + 1, nxt);
        const char* nA = has_next ? nxt.A : cA; const char* nB = has_next ? nxt.B : cB;
        if (Sched::GATHER) {
            if (has_next) { otab[0] = (unsigned)(S.arow(nxt, sR[0]) * lda + sC[0]) * 2u; otab[512] = (unsigned)(S.arow(nxt, sR[1]) * lda + sC[1]) * 2u;
                            otab[1024] = (unsigned)(S.arow(nxt, HALF + sR[0]) * lda + sC[0]) * 2u; otab[1536] = (unsigned)(S.arow(nxt, HALF + sR[1]) * lda + sC[1]) * 2u; }
            else { otab[0] = c00; otab[512] = c01; otab[1024] = c10; otab[1536] = c11; }
        }
#pragma unroll 1
        for (int t = 0; t < nt; t += 2) {
            const bool last = (t == nt - 2);
            const char* a1 = cA + (size_t)(t + 1) * kstep;
            const char* a2 = last ? nA : cA + (size_t)(t + 2) * kstep; const char* b2 = last ? nB : cB + (size_t)(t + 2) * kstep;
            const char* a3 = a2 + kstep; const char* b3 = b2 + kstep;
            unsigned q00 = c00, q01 = c01, q10 = c10, q11 = c11;
            if (Sched::GATHER) { if (last) { q00 = otab[0]; q01 = otab[512]; q10 = otab[1024]; q11 = otab[1536]; } }
            PG_LDB(B0, 0, 0); PG_LDB(B1, 0, 1); PG_SCHED; PG_LDA(At, 0, 0); PG_STAGE2(PG_SA(1, 1), a1, c10, c11);
            PG_WAIT_V(8); PG_WAIT_L(0); PG_BAR; PG_MMA(0, 0, At, B0); PG_MMA(0, 1, At, B1); PG_BAR; PG_SCHED;
            PG_LDA(At, 0, 1); PG_STAGEB(PG_SB(0, 0), b2); PG_STAGEB(PG_SB(0, 1), b2 + hstepB); PG_STAGE2(PG_SA(0, 0), a2, q00, q01);
            PG_WAIT_V(8); PG_WAIT_L(0); PG_BAR; PG_MMA(1, 0, At, B0); PG_MMA(1, 1, At, B1); PG_BAR; PG_SCHED;
            PG_LDB(B0, 1, 0); PG_LDB(B1, 1, 1); PG_SCHED; PG_LDA(At, 1, 0); PG_STAGE2(PG_SA(0, 1), a2, q10, q11);
            PG_WAIT_V(8); PG_WAIT_L(0); PG_BAR; PG_MMA(0, 0, At, B0); PG_MMA(0, 1, At, B1); PG_BAR; PG_SCHED;
            PG_LDA(At, 1, 1); PG_STAGEB(PG_SB(1, 0), b3); PG_STAGEB(PG_SB(1, 1), b3 + hstepB); PG_STAGE2(PG_SA(1, 0), a3, q00, q01);
            PG_WAIT_V(8); PG_WAIT_L(0); PG_BAR; PG_MMA(1, 0, At, B0); PG_MMA(1, 1, At, B1); PG_BAR; PG_SCHED;
        }
        if constexpr (ALIGN_EPI) { if (wr == 0) PG_BAR; }
        E(acc, cur, wr, wc, fr, fq);
        if (!has_next) break;
#pragma unroll
        for (int a = 0; a < 2; ++a)
#pragma unroll
            for (int b = 0; b < 2; ++b)
#pragma unroll
                for (int m = 0; m < 4; ++m)
#pragma unroll
                    for (int n = 0; n < 2; ++n) acc[a][b][m][n] = (f32x4){0.f, 0.f, 0.f, 0.f};
        cur = nxt; cA = nA; cB = nB; ++ui;
        if (Sched::GATHER) { c00 = otab[0]; c01 = otab[512]; c10 = otab[1024]; c11 = otab[1536]; }
        if constexpr (ALIGN_EPI) { if (wr == 1) PG_BAR; }
    }
    PG_WAIT_V(0);
    if constexpr (!ALIGN_EPI) { if (wr == 0) PG_BAR; }
    PG_BAR;
#undef PG_SA
#undef PG_SB
#undef PG_STAGE2
#undef PG_STAGEB
#undef PG_LDA
#undef PG_LDB
#undef PG_MMA
#undef PG_WAIT_V
#undef PG_WAIT_L
#undef PG_BAR
#undef PG_SCHED
}
}
constexpr size_t MiB = 1u << 20;
constexpr size_t al256(size_t x) { return (x + 255) & ~(size_t)255; }
constexpr size_t WS_CTL = 0, CTL_ZERO_BYTES = 2 * MiB;
constexpr size_t WS_MODS = 1 * MiB;
constexpr size_t WS_X = 2 * MiB;
constexpr size_t WS_Z2 = WS_X + (size_t)T * D * 4;
constexpr size_t WS_DYN = al256(WS_Z2 + (size_t)DEPTH * SE * 64 * 4);
constexpr size_t WS_WIN = WS_DYN;
constexpr size_t WS_PJ = WS_WIN + (size_t)DIN * D * 2;
constexpr size_t WS_WO = WS_PJ + (size_t)3 * D * DH * 2;
constexpr size_t WS_RT = WS_WO + (size_t)D * D * 2;
constexpr size_t WS_SD = WS_RT + (size_t)2 * NE * D * 2;
constexpr size_t WS_GC = al256(WS_SD + (size_t)256 * 4097 * 16);
constexpr size_t WS_HMH = WS_GC + (size_t)DH * 512 * 4;
constexpr size_t WS_LIST = WS_HMH + (size_t)T * D * 2;
constexpr size_t WS_P = WS_LIST + (size_t)2 * NE * TH * 8;
constexpr size_t P_BYTES = (size_t)T * DIN * 2;
constexpr size_t WS_SLOT = WS_P;
constexpr size_t WS_W13 = WS_SLOT + (size_t)TH * 9 * D * 2;
constexpr size_t WS_W2 = WS_W13 + (size_t)65 * 512 * D * 2;
constexpr size_t WS_H = WS_W2 + (size_t)65 * D * DEXP * 2;
static_assert(WS_H + (size_t)(MAXT_H + SH_T) * 256 * DEXP * 2 <= WS_P + P_BYTES, "MoE overlay fits the P region");
constexpr size_t WS_ZT = WS_P + P_BYTES;
constexpr size_t WS_VT = WS_ZT + (size_t)B * DH * SE * 2;
constexpr size_t WS_SCR = WS_ZT;
static_assert((size_t)256 * 32 * 512 * 16 <= (size_t)2 * B * DH * SE * 2, "scratch fits ZT|VT");
constexpr size_t WS_Y = WS_VT + (size_t)B * DH * SE * 2;
constexpr size_t WS_END = WS_Y + (size_t)T * 1536 * 2;
constexpr int CW_BAR = 4096;
constexpr int CW_CNT = 16384;
constexpr int CW_DBG = 32768;

struct In {
    const float *x, *c, *ctx, *c_ctx, *w_ada, *b_ada, *w_in, *hy_conv_w, *hy_conv_b, *hy_w1, *hy_b1, *hy_w2, *hy_b2, *hy_w3, *hy_sin_freq, *hy_bias_d,
        *hy_proj, *sc_conv_w, *sc_proj, *na_rpb, *na_proj, *w_o, *ln1_g, *ln1_b, *ln2_g, *ln2_b, *moe_router, *moe_bias, *moe_w1, *moe_w3, *moe_w2, *sh_w1, *sh_w3, *sh_w2;
};
struct Args { In in; float* out; unsigned char* ws; int ph_lo, ph_hi, use_bar, flags; };

typedef const __attribute__((address_space(4))) In& CIN;
typedef const __attribute__((address_space(4))) Args* CArgsP;
struct Frame {
    LAS unsigned char* lds;
    int tid, lane, wave, vcu, G, bid;
    unsigned char* ws;
};
__device__ __forceinline__ int mod_row(int row) { const int b = row / SE, ii = row - b * SE; return ii < S ? b : 8; }

__device__ __forceinline__ void tr_item(const float* W, int K, int N, f16* WT, int row_off, int row_mul, LAS float* scr, int item, int lane) {
    const int nblk = N / 32, kb = item / nblk, nb = item % nblk, k0 = 64 * kb, n0 = 32 * nb;
#pragma unroll 8
    for (int i = 0; i < 32; ++i) { const int kk = 2 * i + (lane >> 5); scr[kk * 33 + (lane & 31)] = W[(size_t)(k0 + kk) * N + n0 + (lane & 31)]; }
    LDS_WAIT(); asm volatile("" ::: "memory");
    const int c = lane & 7;
#pragma unroll
    for (int j = 0; j < 4; ++j) { const int n = (lane >> 3) + 8 * j; const LAS float* s = scr + (8 * c) * 33 + n;
        u32x4 o; o.x = pkh(s[0 * 33], s[1 * 33]); o.y = pkh(s[2 * 33], s[3 * 33]); o.z = pkh(s[4 * 33], s[5 * 33]); o.w = pkh(s[6 * 33], s[7 * 33]);
        *(u32x4*)(WT + (size_t)(row_off + (n0 + n) * row_mul) * K + k0 + 8 * c) = o; }
    LDS_WAIT(); asm volatile("" ::: "memory");
}
__device__ __forceinline__ void convert_mixer_weights(Frame& F, CIN in, int l) {
    LAS float* scr = (LAS float*)(F.lds + F.wave * 16384);
    const int gw = F.vcu * NWAVES + F.wave, NGW = F.G * NWAVES;
    constexpr int I_IN = (D / 64) * (DIN / 32), I_PJ = (DH / 64) * (D / 32), I_O = (D / 64) * (D / 32);
    constexpr int NIT = I_IN + 3 * I_PJ + I_O;
    f16* win = (f16*)(F.ws + WS_WIN); f16* pj = (f16*)(F.ws + WS_PJ); f16* wo = (f16*)(F.ws + WS_WO);
    for (int it = gw; it < NIT; it += NGW) {
        int r = it;
        if (r < I_IN) { tr_item(in.w_in + (size_t)l * D * DIN, D, DIN, win, 0, 1, scr, r, F.lane); continue; } r -= I_IN;
        if (r < I_PJ) { tr_item(in.hy_proj + (size_t)l * DH * D, DH, D, pj, 0, 1, scr, r, F.lane); continue; } r -= I_PJ;
        if (r < I_PJ) { tr_item(in.sc_proj + (size_t)l * DH * D, DH, D, pj, D, 1, scr, r, F.lane); continue; } r -= I_PJ;
        if (r < I_PJ) { tr_item(in.na_proj + (size_t)l * DH * D, DH, D, pj, 2 * D, 1, scr, r, F.lane); continue; } r -= I_PJ;
        tr_item(in.w_o + (size_t)l * D * D, D, D, wo, 0, 1, scr, r, F.lane);
    }
}
__device__ __forceinline__ void convert_moe_weights(Frame& F, CIN in, int l) {
    LAS float* scr = (LAS float*)(F.lds + F.wave * 16384);
    const int gw = F.vcu * NWAVES + F.wave, NGW = F.G * NWAVES;
    constexpr int I_UP = (D / 64) * (DEXP / 32)  , I_DN = (DEXP / 64) * (D / 32)  ;
    constexpr int PER_E = 2 * I_UP + I_DN;
    constexpr int NIT = 65 * PER_E;
    f16* w13 = (f16*)(F.ws + WS_W13); f16* w2 = (f16*)(F.ws + WS_W2);
    for (int it = gw; it < NIT; it += NGW) {
        const int e = it / PER_E; int r = it - e * PER_E;
        const float* s1 = e < NE ? in.moe_w1 + ((size_t)l * NE + e) * D * DEXP : in.sh_w1 + (size_t)l * D * DEXP;
        const float* s3 = e < NE ? in.moe_w3 + ((size_t)l * NE + e) * D * DEXP : in.sh_w3 + (size_t)l * D * DEXP;
        const float* s2 = e < NE ? in.moe_w2 + ((size_t)l * NE + e) * DEXP * D : in.sh_w2 + (size_t)l * DEXP * D;
        if (r < I_UP) { tr_item(s1, D, DEXP, w13 + (size_t)e * 512 * D, 0, 2, scr, r, F.lane); continue; } r -= I_UP;
        if (r < I_UP) { tr_item(s3, D, DEXP, w13 + (size_t)e * 512 * D, 1, 2, scr, r, F.lane); continue; } r -= I_UP;
        tr_item(s2, DEXP, D, w2 + (size_t)e * D * DEXP, 0, 1, scr, r, F.lane);
    }
    f16* rth = (f16*)(F.ws + WS_RT); f16* rtl = rth + NE * D;
    const float* rw = in.moe_router + (size_t)l * D * NE;
    for (int i = (F.vcu * NTHR + F.tid); i < NE * D; i += F.G * NTHR) { const int k = i / NE, n = i % NE; const float w = rw[i]; const f16 h = (f16)w; rth[n * D + k] = h; rtl[n * D + k] = (f16)(w - (float)h); }
}

struct MoeTab { int ptile[NE + 2]; };
__device__ __forceinline__ void moe_build_tab(Frame& F, const int* cnt, LAS int* tab) {
    if (F.tid < 64) {
        const int c = __hip_atomic_load(cnt + F.tid, __ATOMIC_RELAXED, __HIP_MEMORY_SCOPE_AGENT); int tl = (c + 255) >> 8; int inc = tl;
#pragma unroll
        for (int o = 1; o < 64; o <<= 1) { const int v = bpermi(F.lane - o, inc); if (F.lane >= o) inc += v; }
        tab[F.tid] = inc - tl; tab[128 + F.tid] = c;
        if (F.tid == 63) tab[64] = inc;
    }
    __syncthreads();
}
template <int NPN, bool UP>
struct MoeSched {
    static constexpr bool GATHER = UP;
    const LAS int* tab; int G, c, half; const unsigned long long* list; const char* Abase; const char* Bbase; int NT;
    __device__ __forceinline__ bool next(int i, pg::Unit& u) const {
        const int L = i * G + c; const int nun = (NT + SH_T) * NPN;
        if (L >= nun) return false;
        const int tile = L / NPN; u.pn = L - tile * NPN;
        int e;
        if (tile < NT) { e = 0;
#pragma unroll
            for (int s = 32; s >= 1; s >>= 1) { const int v = __builtin_amdgcn_readfirstlane(tab[(e + s) & 63]); if (e + s < NE && v <= tile) e += s; }
            u.pm = tile - __builtin_amdgcn_readfirstlane(tab[e]); int nr = __builtin_amdgcn_readfirstlane(tab[128 + e]) - u.pm * 256; u.nrows = nr > 256 ? 256 : nr;
        } else { e = NE; u.pm = tile - NT; u.nrows = 256; }
        u.e = e;
        if (UP) { u.A = Abase; u.B = Bbase + ((size_t)e * 512 + (size_t)u.pn * 256) * D * 2; }
        else { u.A = Abase + (size_t)tile * 256 * DEXP * 2; u.B = Bbase + ((size_t)e * D + (size_t)u.pn * 256) * DEXP * 2; }
        u.aux0 = tile;
        return true;
    }
    __device__ __forceinline__ int arow(const pg::Unit& u, int r) const {
        if (!UP) return r;
        if (u.e == NE) return half * TH + u.pm * 256 + r;
        int rr = u.pm * 256 + r; const int n = __builtin_amdgcn_readfirstlane(tab[128 + u.e]); if (rr >= n) rr = n - 1;
        const unsigned long long en = list[((size_t)half * NE + u.e) * TH + rr];
        return half * TH + (int)(en >> 36);
    }
};
struct EpiUp {
    static constexpr bool PERM = true;
    f16* H;
    __device__ __forceinline__ void operator()(const f32x4 (&acc)[2][2][4][2], const pg::Unit& u, int wr, int wc, int fr, int fq) const {
#pragma unroll
        for (int ai = 0; ai < 2; ++ai)
#pragma unroll
            for (int m = 0; m < 4; ++m) { const int r = ai * 128 + wr * 64 + m * 16 + fr; f16* rowp = H + ((size_t)u.aux0 * 256 + r) * DEXP + u.pn * 128;
#pragma unroll
                for (int bj = 0; bj < 2; ++bj) { const f32x4 v0 = acc[ai][bj][m][0], v1 = acc[ai][bj][m][1];
                    const float h0 = v0[0] * sigm(v0[0]) * v0[1], h1 = v0[2] * sigm(v0[2]) * v0[3], h2_ = v1[0] * sigm(v1[0]) * v1[1], h3 = v1[2] * sigm(v1[2]) * v1[3];
                    u32x2 w; w.x = pkh(h0, h1); w.y = pkh(h2_, h3);
                    *(u32x2*)(rowp + (bj * 128 + wc * 32 + 8 * fq) / 2) = w; }
                asm volatile("" ::: "memory"); }
    }
};
struct EpiDown {
    static constexpr bool PERM = true;
    f16* SL; const unsigned long long* list; int half;
    __device__ __forceinline__ void operator()(const f32x4 (&acc)[2][2][4][2], const pg::Unit& u, int wr, int wc, int fr, int fq) const {
#pragma unroll
        for (int ai = 0; ai < 2; ++ai)
#pragma unroll
            for (int m = 0; m < 4; ++m) { const int r = ai * 128 + wr * 64 + m * 16 + fr;
                float w = 1.f; int srow = (u.pm * 256 + r) * 9 + 8; bool ok = true;
                if (u.e < NE) { ok = r < u.nrows; const int rr = ok ? u.pm * 256 + r : 0;
                    const unsigned long long en = list[((size_t)half * NE + u.e) * TH + rr]; w = __uint_as_float((unsigned)en); const unsigned hi = (unsigned)(en >> 32); srow = (int)(hi >> 4) * 9 + (int)(hi & 15u); }
                if (ok) { f16* rowp = SL + (size_t)srow * D + u.pn * 256 + wc * 32 + 8 * fq;
#pragma unroll
                    for (int bj = 0; bj < 2; ++bj) { const f32x4 v0 = acc[ai][bj][m][0] * w, v1 = acc[ai][bj][m][1] * w;
                        u32x4 o; o.x = pkh(v0[0], v0[1]); o.y = pkh(v0[2], v0[3]); o.z = pkh(v1[0], v1[1]); o.w = pkh(v1[2], v1[3]);
                        *(u32x4*)(rowp + bj * 128) = o; } }
                asm volatile("" ::: "memory"); }
    }
};
template <bool DO_LN>
__device__ __forceinline__ void ln1_rows(Frame& F, CIN in, int l) {
    const int gw = F.vcu * NWAVES + F.wave, NGW = F.G * NWAVES;
    float* X = (float*)(F.ws + WS_X); f16* HM = (f16*)(F.ws + WS_HMH);
    const float* mods = (const float*)(F.ws + WS_MODS) + (size_t)l * 9 * 6 * D;
    const f32x4* g4 = (const f32x4*)(in.ln1_g + l * D) + F.lane; const f32x4* b4 = (const f32x4*)(in.ln1_b + l * D) + F.lane;
    for (int row = gw; row < T; row += NGW) {
        f32x4* xr = (f32x4*)(X + (size_t)row * D) + F.lane;
        f32x4 v[4];
#pragma unroll
        for (int j = 0; j < 4; ++j) v[j] = xr[64 * j];
        if (DO_LN) {
            float s = 0.f;
#pragma unroll
            for (int j = 0; j < 4; ++j) s += (v[j].x + v[j].y) + (v[j].z + v[j].w);
            const float mean = wsum(s, F.lane) * (1.f / D); float s2 = 0.f;
#pragma unroll
            for (int j = 0; j < 4; ++j) { v[j] = v[j] - mean; s2 += (v[j].x * v[j].x + v[j].y * v[j].y) + (v[j].z * v[j].z + v[j].w * v[j].w); }
            const float rstd = 1.f / sqrtf(wsum(s2, F.lane) * (1.f / D) + LN_EPS);
#pragma unroll
            for (int j = 0; j < 4; ++j) { v[j] = v[j] * rstd * g4[64 * j] + b4[64 * j]; xr[64 * j] = v[j]; }
        }
        const float* m = mods + (size_t)mod_row(row) * 6 * D;
        const f32x4* sh = (const f32x4*)(m + 3 * D) + F.lane; const f32x4* sc = (const f32x4*)(m + 4 * D) + F.lane;
        u32x2* o8 = (u32x2*)(HM + (size_t)row * D) + F.lane;
#pragma unroll
        for (int j = 0; j < 4; ++j) { const f32x4 h = v[j] * (sc[64 * j] + 1.f) + sh[64 * j]; u32x2 w; w.x = pkh(h.x, h.y); w.y = pkh(h.z, h.w); o8[64 * j] = w; }
    }
}

__device__ __forceinline__ void router_phase(Frame& F, CIN in, int l) {
    const int gw = F.vcu * NWAVES + F.wave, NGW = F.G * NWAVES, lane = F.lane, fr = lane & 15, fq = lane >> 4;
    const float* X = (const float*)(F.ws + WS_X);
    const float* mods = (const float*)(F.ws + WS_MODS) + (size_t)l * 9 * 6 * D;
    const f16* rth = (const f16*)(F.ws + WS_RT); const f16* rtl = rth + NE * D;
    int* cntl = (int*)(F.ws + WS_CTL) + CW_CNT + l * 128;
    unsigned long long* list = (unsigned long long*)(F.ws + WS_LIST);
    LAS float* lgs = (LAS float*)(F.lds + F.wave * 4096);
    const float rb = in.moe_bias[l * NE + lane];
    for (int task = gw; task < T / 16; task += NGW) {
        const int row0 = task * 16;
        const float* m = mods + (size_t)mod_row(row0) * 6 * D;
        const float* xr = X + (size_t)(row0 + fr) * D + fq * 8;
        f32x4 acc[4];
#pragma unroll
        for (int nb = 0; nb < 4; ++nb) acc[nb] = (f32x4){0.f, 0.f, 0.f, 0.f};
#pragma unroll 2
        for (int s = 0; s < 32; ++s) {
            const int k = s * 32 + fq * 8;
            const f32x4 x0 = *(const f32x4*)(xr + s * 32), x1 = *(const f32x4*)(xr + s * 32 + 4);
            const f32x4 sc0 = *(const f32x4*)(m + 4 * D + k), sc1 = *(const f32x4*)(m + 4 * D + k + 4);
            const f32x4 sh0 = *(const f32x4*)(m + 3 * D + k), sh1 = *(const f32x4*)(m + 3 * D + k + 4);
            const f32x4 h0 = x0 * (sc0 + 1.f) + sh0, h1 = x1 * (sc1 + 1.f) + sh1;
            h8 ahi, alo;
#pragma unroll
            for (int j = 0; j < 4; ++j) { ahi[j] = (f16)h0[j]; alo[j] = (f16)(h0[j] - (float)ahi[j]); ahi[4 + j] = (f16)h1[j]; alo[4 + j] = (f16)(h1[j] - (float)ahi[4 + j]); }
#pragma unroll
            for (int nb = 0; nb < 4; ++nb) {
                const h8 bhi = *(const h8*)(rth + (size_t)(nb * 16 + fr) * D + k), blo = *(const h8*)(rtl + (size_t)(nb * 16 + fr) * D + k);
                acc[nb] = __builtin_amdgcn_mfma_f32_16x16x32_f16(ahi, bhi, acc[nb], 0, 0, 0);
                acc[nb] = __builtin_amdgcn_mfma_f32_16x16x32_f16(alo, bhi, acc[nb], 0, 0, 0);
                acc[nb] = __builtin_amdgcn_mfma_f32_16x16x32_f16(ahi, blo, acc[nb], 0, 0, 0);
            }
        }
#pragma unroll
        for (int nb = 0; nb < 4; ++nb)
#pragma unroll
            for (int i = 0; i < 4; ++i) lgs[(4 * fq + i) * 64 + nb * 16 + fr] = acc[nb][i];
        LDS_WAIT(); asm volatile("" ::: "memory");
        unsigned chosen_mask = 0u; float wv[16]; int kv[16];
#pragma unroll
        for (int t = 0; t < 16; ++t) {
            const float score = 1.f / (1.f + expf(-lgs[t * 64 + lane]));
            const float sel = score + rb;
            float m1 = sel;
            m1 = fmaxf(m1, SHX(m1, 1)); m1 = fmaxf(m1, SHX(m1, 2)); m1 = fmaxf(m1, SHX(m1, 4));
            const unsigned long long eq = __ballot(sel == m1);
            const int g = lane >> 3;
            const unsigned geq = (unsigned)((eq >> (g * 8)) & 0xffull);
            const int first = __ffs(geq) - 1;
            float s2 = ((lane & 7) == first) ? -3.0e38f : sel;
            s2 = fmaxf(s2, SHX(s2, 1)); s2 = fmaxf(s2, SHX(s2, 2)); s2 = fmaxf(s2, SHX(s2, 4));
            const float gs = m1 + s2;
            int grank = 0;
#pragma unroll
            for (int gg = 0; gg < 8; ++gg) { const float o = bperm(gg * 8, gs); grank += (o > gs || (o == gs && gg < g)) ? 1 : 0; }
            const bool gsel = grank < 4;
            const float val = gsel ? sel : -3.0e38f;
            int rank = 0;
            for (int j = 0; j < 64; ++j) { const float o = bperm(j, val); rank += (o > val || (o == val && j < lane)) ? 1 : 0; }
            const bool ch = gsel && rank < TOPK;
            const float tot = wsum(ch ? score : 0.f, lane);
            wv[t] = score / tot * 2.5f; kv[t] = rank;
            chosen_mask |= ch ? (1u << t) : 0u;
        }
        const int half = row0 >= TH ? 1 : 0;
        const int nch = __popc(chosen_mask);
        int base = 0;
        if (nch) base = atomicAdd(cntl + half * 64 + lane, nch);
        unsigned long long* lp = list + ((size_t)half * NE + lane) * TH;
        int pos = base;
#pragma unroll
        for (int t = 0; t < 16; ++t) if (chosen_mask & (1u << t)) {
            const unsigned tokh = (unsigned)(row0 + t - half * TH);
            lp[pos++] = ((unsigned long long)((tokh << 4) | (unsigned)kv[t]) << 32) | (unsigned long long)__float_as_uint(wv[t]);
        }
        LDS_WAIT(); asm volatile("" ::: "memory");
    }
}

__device__ __forceinline__ void moe_up_phase(Frame& F, int l, int half) {
    LAS int* tab = (LAS int*)(F.lds + pg::STAGE_BYTES);
    const int* cnt = (const int*)(F.ws + WS_CTL) + CW_CNT + l * 128 + half * 64;
    moe_build_tab(F, cnt, tab);
    MoeSched<2, true> Sc; Sc.tab = tab; Sc.G = F.G; Sc.c = F.bid; Sc.half = half; Sc.list = (const unsigned long long*)(F.ws + WS_LIST);
    Sc.Abase = (const char*)(F.ws + WS_HMH); Sc.Bbase = (const char*)(F.ws + WS_W13); Sc.NT = __builtin_amdgcn_readfirstlane(tab[64]);
    EpiUp E; E.H = (f16*)(F.ws + WS_H);
    pg::gemm_phase<EpiUp, MoeSched<2, true>, true>(F.lds, F.wave, D, D, D, Sc, E);
}
__device__ __forceinline__ void moe_down_phase(Frame& F, int l, int half) {
    LAS int* tab = (LAS int*)(F.lds + pg::STAGE_BYTES);
    const int* cnt = (const int*)(F.ws + WS_CTL) + CW_CNT + l * 128 + half * 64;
    moe_build_tab(F, cnt, tab);
    MoeSched<4, false> Sc; Sc.tab = tab; Sc.G = F.G; Sc.c = F.bid; Sc.half = half; Sc.list = (const unsigned long long*)(F.ws + WS_LIST);
    Sc.Abase = (const char*)(F.ws + WS_H); Sc.Bbase = (const char*)(F.ws + WS_W2); Sc.NT = __builtin_amdgcn_readfirstlane(tab[64]);
    EpiDown E; E.SL = (f16*)(F.ws + WS_SLOT); E.list = Sc.list; E.half = half;
    pg::gemm_phase<EpiDown, MoeSched<4, false>, true>(F.lds, F.wave, DEXP, DEXP, DEXP, Sc, E);
}
__device__ __forceinline__ void ln2_rows(Frame& F, CIN in, float* out, int l, int half) {
    const int gw = F.vcu * NWAVES + F.wave, NGW = F.G * NWAVES;
    float* X = (float*)(F.ws + WS_X); f16* HM = (f16*)(F.ws + WS_HMH); const f16* SL = (const f16*)(F.ws + WS_SLOT);
    const float* mods = (const float*)(F.ws + WS_MODS) + (size_t)l * 9 * 6 * D;
    const f32x4* g4 = (const f32x4*)(in.ln2_g + l * D) + F.lane; const f32x4* b4 = (const f32x4*)(in.ln2_b + l * D) + F.lane;
    for (int th = gw; th < TH; th += NGW) {
        const int row = half * TH + th;
        const float* m = mods + (size_t)mod_row(row) * 6 * D;
        f32x4* xr = (f32x4*)(X + (size_t)row * D) + F.lane;
        const f32x4* gt = (const f32x4*)(m + 5 * D) + F.lane;
        f32x4 v[4]; float s = 0.f;
#pragma unroll
        for (int j = 0; j < 4; ++j) {
            f32x4 f = (f32x4){0.f, 0.f, 0.f, 0.f};
#pragma unroll
            for (int k = 0; k < 9; ++k) { const h4 q = *((const h4*)(SL + ((size_t)th * 9 + k) * D) + F.lane + 64 * j); f += (f32x4){(float)q[0], (float)q[1], (float)q[2], (float)q[3]}; }
            v[j] = xr[64 * j] * ALPHA + gt[64 * j] * f; s += (v[j].x + v[j].y) + (v[j].z + v[j].w);
        }
        const float mean = wsum(s, F.lane) * (1.f / D); float s2 = 0.f;
#pragma unroll
        for (int j = 0; j < 4; ++j) { v[j] = v[j] - mean; s2 += (v[j].x * v[j].x + v[j].y * v[j].y) + (v[j].z * v[j].z + v[j].w * v[j].w); }
        const float rstd = 1.f / sqrtf(wsum(s2, F.lane) * (1.f / D) + LN_EPS);
#pragma unroll
        for (int j = 0; j < 4; ++j) { v[j] = v[j] * rstd * g4[64 * j] + b4[64 * j]; xr[64 * j] = v[j]; }
        if (l + 1 < DEPTH) {
            const float* mn = mods + (size_t)9 * 6 * D + (size_t)mod_row(row) * 6 * D;
            const f32x4* sh = (const f32x4*)(mn) + F.lane; const f32x4* sc = (const f32x4*)(mn + D) + F.lane;
            u32x2* o8 = (u32x2*)(HM + (size_t)row * D) + F.lane;
#pragma unroll
            for (int j = 0; j < 4; ++j) { const f32x4 h = v[j] * (sc[64 * j] + 1.f) + sh[64 * j]; u32x2 w; w.x = pkh(h.x, h.y); w.y = pkh(h.z, h.w); o8[64 * j] = w; }
        } else {
            const int b = row / SE, ii = row - b * SE;
            if (ii < S) { f32x4* o = (f32x4*)(out + ((size_t)b * S + ii) * D) + F.lane;
#pragma unroll
                for (int j = 0; j < 4; ++j) o[64 * j] = v[j]; }
        }
    }
}
#ifndef FFT_HD
#define FFT_HD __host__ __device__ __forceinline__
#endif
namespace fft {
constexpr int N = 8192, LOGN = 13, NPAD = N + N / 8;
FFT_HD int pidx(int i) { return i + (i >> 3); }
FFT_HD int brev(int k) { return (int)(__builtin_bitreverse32((unsigned)k) >> (32 - LOGN)); }
typedef float c2 __attribute__((ext_vector_type(2)));
FFT_HD c2 cmul(c2 a, c2 b) { return c2{a.x * b.x - a.y * b.y, a.x * b.y + a.y * b.x}; }
FFT_HD c2 cmulc(c2 a, c2 b) { return c2{a.x * b.x + a.y * b.y, a.y * b.x - a.x * b.y}; }
FFT_HD c2 tw(float frac) {
#if defined(__HIP_DEVICE_COMPILE__)
    return c2{__builtin_amdgcn_cosf(frac), -__builtin_amdgcn_sinf(frac)};
#else
    return c2{(float)cos(6.283185307179586 * (double)frac), (float)-sin(6.283185307179586 * (double)frac)};
#endif
}
template <int LOG, bool INV, class BP>
FFT_HD void pass_group(BP buf, int h2, int gidx) {
    constexpr int R = 1 << LOG;
    const int hi = gidx / h2, lo = gidx - hi * h2, base = hi * (R * h2) + lo;
    c2 x[R];
#pragma unroll
    for (int m = 0; m < R; ++m) x[m] = buf[pidx(base + m * h2)];
    if (!INV) {
#pragma unroll
        for (int q = 0; q < LOG; ++q) { const int mq = R >> (q + 1); const float sc = 1.0f / (float)(2 * mq * h2);
#pragma unroll
            for (int m = 0; m < R; ++m) if ((m & mq) == 0) { const c2 w = tw((float)((m % mq) * h2 + lo) * sc); const c2 a = x[m], b = x[m + mq];
                x[m] = c2{a.x + b.x, a.y + b.y}; x[m + mq] = cmul(c2{a.x - b.x, a.y - b.y}, w); } }
    } else {
#pragma unroll
        for (int q = LOG - 1; q >= 0; --q) { const int mq = R >> (q + 1); const float sc = 1.0f / (float)(2 * mq * h2);
#pragma unroll
            for (int m = 0; m < R; ++m) if ((m & mq) == 0) { const c2 w = tw((float)((m % mq) * h2 + lo) * sc); const c2 a = x[m], t = cmulc(x[m + mq], w);
                x[m] = c2{a.x + t.x, a.y + t.y}; x[m + mq] = c2{a.x - t.x, a.y - t.y}; } }
    }
#pragma unroll
    for (int m = 0; m < R; ++m) buf[pidx(base + m * h2)] = x[m];
}
}
__device__ __forceinline__ void pro_mods(Frame& F, CIN in) {
    const int gw = F.vcu * NWAVES + F.wave, NGW = F.G * NWAVES, lane = F.lane;
    float* mods = (float*)(F.ws + WS_MODS);
    for (int task = gw; task < DEPTH * 96 * 16; task += NGW) {
        const int l = task / 1536, r0 = task - l * 1536, jb = r0 >> 4, kc = r0 & 15, col = jb * 64 + lane, k = kc * 64 + lane;
        float cv[9];
#pragma unroll
        for (int r = 0; r < 9; ++r) { const float v = r < 8 ? in.c[r * D + k] : in.c_ctx[k]; cv[r] = v / (1.f + expf(-v)); }
        float acc[9];
#pragma unroll
        for (int r = 0; r < 9; ++r) acc[r] = 0.f;
        const float* w = in.w_ada + ((size_t)l * D + kc * 64) * 6 * D + col;
#pragma unroll 4
        for (int kk = 0; kk < 64; ++kk) { const float wv = w[(size_t)kk * 6 * D];
#pragma unroll
            for (int r = 0; r < 9; ++r) acc[r] += __shfl(cv[r], kk) * wv; }
        const float bb = kc == 0 ? in.b_ada[l * 6 * D + col] : 0.f;
#pragma unroll
        for (int r = 0; r < 9; ++r) atomicAdd(&mods[((size_t)l * 9 + r) * 6 * D + col], acc[r] + bb);
    }
}
__device__ __forceinline__ void pro_init_x(Frame& F, CIN in) {
    const int gw = F.vcu * NWAVES + F.wave, NGW = F.G * NWAVES;
    float* X = (float*)(F.ws + WS_X);
    for (int row = gw; row < T; row += NGW) {
        const int b = row / SE, ii = row - b * SE;
        const f32x4* src = (const f32x4*)(ii < S ? in.x + ((size_t)b * S + ii) * D : in.ctx + ((size_t)b * CL + (ii - S)) * D) + F.lane;
        f32x4* dst = (f32x4*)(X + (size_t)row * D) + F.lane;
#pragma unroll
        for (int j = 0; j < 4; ++j) dst[64 * j] = src[64 * j];
    }
}
__device__ __forceinline__ void pro_z2(Frame& F, CIN in) {
    const int gw = F.vcu * NWAVES + F.wave, NGW = F.G * NWAVES, lane = F.lane;
    float* Z2 = (float*)(F.ws + WS_Z2);
    for (int task = gw; task < DEPTH * SE; task += NGW) {
        const int l = task / SE, ti = task - l * SE, L = ti < S ? S : CL, t = ti < S ? ti : ti - S;
        const float* w1 = in.hy_w1 + l * 33 * 64; const float* w2 = in.hy_w2 + l * 4096; const float* sf = in.hy_sin_freq + l * 128;
        const double PI2 = 6.283185307179586476925;
        const float tt = (float)((double)t / (double)(L - 1));
        const float ang = (float)(PI2 / (double)L) * (float)t;
        float a = in.hy_b1[l * 64 + lane];
        a += tt * w1[lane];
        for (int j = 0; j < 16; ++j) {
            const float band = (float)(1e-4 + (double)j * ((15.0 - 1e-4) / 15.0));
            const float arg = band * ang;
            a += cosf(arg) * w1[(1 + j) * 64 + lane];
            a += -sinf(arg) * w1[(17 + j) * 64 + lane];
        }
        const float z1 = sinf(sf[lane] * a);
        float a2 = in.hy_b2[l * 64 + lane];
        for (int i = 0; i < 64; ++i) a2 += __shfl(z1, i) * w2[i * 64 + lane];
        Z2[(size_t)task * 64 + lane] = sinf(sf[64 + lane] * a2);
    }
}
__device__ __forceinline__ void mod1_rows(Frame& F, int l) {
    const int gw = F.vcu * NWAVES + F.wave, NGW = F.G * NWAVES;
    const float* X = (const float*)(F.ws + WS_X); f16* HM = (f16*)(F.ws + WS_HMH);
    const float* mods = (const float*)(F.ws + WS_MODS) + (size_t)l * 9 * 6 * D;
    for (int row = gw; row < T; row += NGW) {
        const f32x4* xr = (const f32x4*)(X + (size_t)row * D) + F.lane;
        const float* m = mods + (size_t)mod_row(row) * 6 * D;
        const f32x4* sh = (const f32x4*)(m) + F.lane; const f32x4* sc = (const f32x4*)(m + D) + F.lane;
        u32x2* o8 = (u32x2*)(HM + (size_t)row * D) + F.lane;
#pragma unroll
        for (int j = 0; j < 4; ++j) { const f32x4 h = xr[64 * j] * (sc[64 * j] + 1.f) + sh[64 * j]; u32x2 w; w.x = pkh(h.x, h.y); w.y = pkh(h.z, h.w); o8[64 * j] = w; }
    }
}

typedef LAS fft::c2* LBuf;
#define FFT_OPQ(t) asm volatile("" : "+v"(t))
__device__ __forceinline__ void fft_fwd(LBuf buf, int tid) {
    FFT_OPQ(tid); fft::pass_group<4, false>(buf, 512, tid); __syncthreads();
    FFT_OPQ(tid); fft::pass_group<3, false>(buf, 64, tid); FFT_OPQ(tid); fft::pass_group<3, false>(buf, 64, tid + 512); __syncthreads();
    FFT_OPQ(tid); fft::pass_group<3, false>(buf, 8, tid); FFT_OPQ(tid); fft::pass_group<3, false>(buf, 8, tid + 512); __syncthreads();
    FFT_OPQ(tid); fft::pass_group<3, false>(buf, 1, tid); FFT_OPQ(tid); fft::pass_group<3, false>(buf, 1, tid + 512); __syncthreads();
}
__device__ __forceinline__ void fft_inv(LBuf buf, int tid) {
    FFT_OPQ(tid); fft::pass_group<3, true>(buf, 1, tid); FFT_OPQ(tid); fft::pass_group<3, true>(buf, 1, tid + 512); __syncthreads();
    FFT_OPQ(tid); fft::pass_group<3, true>(buf, 8, tid); FFT_OPQ(tid); fft::pass_group<3, true>(buf, 8, tid + 512); __syncthreads();
    FFT_OPQ(tid); fft::pass_group<3, true>(buf, 64, tid); FFT_OPQ(tid); fft::pass_group<3, true>(buf, 64, tid + 512); __syncthreads();
    FFT_OPQ(tid); fft::pass_group<4, true>(buf, 512, tid); __syncthreads();
}
__device__ __forceinline__ float hy_delta(int c) { const float la = -3.0701134573253944f  , st = (-15.350567286626972f + 3.0701134573253944f) / 511.0f; return fabsf(la + (float)c * st); }
__device__ __forceinline__ void filters_phase(Frame& F, CIN in, int l) {
    LBuf buf = (LBuf)F.lds;
    LAS float* w3s = (LAS float*)(F.lds + 81920);
    const float* Z2 = (const float*)(F.ws + WS_Z2) + (size_t)l * SE * 64;
    const float* w3 = in.hy_w3 + (size_t)l * 64 * 1024;
    f32x4* SD = (f32x4*)(F.ws + WS_SD);
    for (int p = F.bid; p < 256; p += F.G) {
        int tid = F.tid; asm volatile("" : "+v"(tid));
        const int ca = 2 * p, cb = 2 * p + 1;
        __syncthreads();
        if (tid < 256) { const int j = tid & 63, which = tid >> 6; const int col = (which & 1 ? cb : ca) + (which >> 1 ? 512 : 0); w3s[which * 64 + j] = w3[j * 1024 + col]; }
        __syncthreads();
        const float da = hy_delta(ca), db = hy_delta(cb);
        for (int i = 0; i < 8; ++i) {
            const int t = tid + 512 * i;
            const f32x4* zr = (const f32x4*)(Z2 + (size_t)t * 64);
            float fa = 0.f, fb = 0.f, ba = 0.f, bb = 0.f;
#pragma unroll 4
            for (int j4 = 0; j4 < 16; ++j4) { const f32x4 z = zr[j4];
#pragma unroll
                for (int u = 0; u < 4; ++u) { const int j = 4 * j4 + u; fa += z[u] * w3s[j]; fb += z[u] * w3s[64 + j]; ba += z[u] * w3s[128 + j]; bb += z[u] * w3s[192 + j]; } }
            const float tt = (float)t * (1.0f / (float)(S - 1));
            const float ea = expf(-tt * da), eb = expf(-tt * db);
            buf[fft::pidx(t)] = fft::c2{fa * ea, fb * eb};
            if (t == 0) buf[fft::pidx(S)] = fft::c2{0.f, 0.f}; else buf[fft::pidx(2 * S - t)] = fft::c2{ba * ea, bb * eb};
        }
        __syncthreads();
        fft_fwd(buf, tid);
        for (int k = tid; k <= S; k += NTHR) {
            const fft::c2 Xk = buf[fft::pidx(fft::brev(k))], Xp = buf[fft::pidx(fft::brev((fft::N - k) & (fft::N - 1)))];
            const float gar = 0.5f * (Xk.x + Xp.x), gai = 0.5f * (Xk.y - Xp.y);
            const float ur = Xk.x - Xp.x, ui = Xk.y + Xp.y;
            const float gbr = 0.5f * ui, gbi = -0.5f * ur;
            SD[(size_t)p * 4097 + k] = (f32x4){0.5f * (gar + gbr), 0.5f * (gai + gbi), 0.5f * (gar - gbr), 0.5f * (gai - gbi)};
        }
    }
    __syncthreads();
    const int gw = F.vcu * NWAVES + F.wave, NGW = F.G * NWAVES, lane = F.lane;
    float* GC = (float*)(F.ws + WS_GC);
    const float* Z2c = Z2 + (size_t)S * 64;
    for (int c = gw; c < DH; c += NGW) {
        const float dl = hy_delta(c);
        for (int i = 0; i < 8; ++i) {
            const int idx = lane + 64 * i, d = idx - 256, t = d < 0 ? -d : d;
            float v = 0.f;
            if (idx >= 1 && t < CL) {
                const int col = d < 0 ? 512 + c : c; float a = 0.f;
                for (int j = 0; j < 64; ++j) a += Z2c[(size_t)t * 64 + j] * w3[j * 1024 + col];
                const float tt = (float)t * (1.0f / (float)(CL - 1));
                v = a * expf(-tt * dl);
            }
            GC[(size_t)c * 512 + idx] = v;
        }
    }
}

__device__ __forceinline__ void transpose_phase(Frame& F, CIN in, int l) {
    LAS f16* tile = (LAS f16*)F.lds;
    const f16* P = (const f16*)(F.ws + WS_P);
    f16* ZT = (f16*)(F.ws + WS_ZT); f16* VT = (f16*)(F.ws + WS_VT);
    const float* cw = in.hy_conv_w + l * 3 * 1536; const float* cbias = in.hy_conv_b + l * 1536;
    const int tid = F.tid, t = tid & 63, cg = tid >> 6;
    for (int task = F.bid; task < B * 68 * 16; task += F.G) {
        const int cb = task & 15, r0 = task >> 4, tl = r0 % 68, b = r0 / 68;
        const int i = tl * 64 + t, lo = i < S ? 0 : S, hi = i < S ? S : SE;
        const f16* prow = P + ((size_t)b * SE + i) * DIN;
        h8 outv;
        if (cb < 8) {
            const int c0 = cb * 64 + cg * 8;
            float z[8];
#pragma unroll
            for (int part = 0; part < 2; ++part) {
                const int col = 512 * (part + 1) + c0;
                const h8 cur = *(const h8*)(prow + col);
                h8 prv, nxt;
#pragma unroll
                for (int j = 0; j < 8; ++j) { prv[j] = (f16)0.f; nxt[j] = (f16)0.f; }
                if (i - 1 >= lo) prv = *(const h8*)(prow - DIN + col);
                if (i + 1 < hi) nxt = *(const h8*)(prow + DIN + col);
#pragma unroll
                for (int j = 0; j < 8; ++j) { const float u = (float)prv[j] * cw[col + j] + (float)cur[j] * cw[1536 + col + j] + (float)nxt[j] * cw[3072 + col + j] + cbias[col + j];
                    z[j] = part == 0 ? u : z[j] * u; }
            }
#pragma unroll
            for (int j = 0; j < 8; ++j) outv[j] = (f16)z[j];
        } else {
            outv = *(const h8*)(prow + OFF_NA + 1024 + (cb - 8) * 64 + cg * 8);
        }
        __syncthreads();
#pragma unroll
        for (int j = 0; j < 8; ++j) tile[(cg * 8 + j) * 72 + t] = outv[j];
        __syncthreads();
        {
            const int ch = tid >> 3, part = tid & 7;
            const h8 v = *(const LAS h8*)(tile + ch * 72 + part * 8);
            f16* dst = (cb < 8 ? ZT + ((size_t)b * DH + cb * 64 + ch) * SE : VT + ((size_t)b * DH + (cb - 8) * 64 + ch) * SE) + tl * 64 + part * 8;
            *(h8*)dst = v;
        }
    }
    __syncthreads();
}

__device__ __forceinline__ void fftconv_tasks(Frame& F, CIN in, int l) {
    LBuf buf = (LBuf)F.lds;
    f16* ZT = (f16*)(F.ws + WS_ZT);
    const f32x4* SD = (const f32x4*)(F.ws + WS_SD);
    const float* bd = in.hy_bias_d + l * DH;
    for (int task = F.bid; task < B * 256; task += F.G) {
        int tid = F.tid; asm volatile("" : "+v"(tid));
        const int b = task & 7, p = task >> 3;
        f16* za = ZT + ((size_t)b * DH + 2 * p) * SE; f16* zb = za + SE;
        const int t0 = tid * 8;
        const h8 va = *(const h8*)(za + t0), vb = *(const h8*)(zb + t0);
        __syncthreads();
#pragma unroll
        for (int j = 0; j < 8; ++j) { buf[fft::pidx(t0 + j)] = fft::c2{(float)va[j], (float)vb[j]}; buf[fft::pidx(S + t0 + j)] = fft::c2{0.f, 0.f}; }
        __syncthreads();
        fft_fwd(buf, tid);
        for (int k = tid; k <= S; k += NTHR) {
            const int pa = fft::pidx(fft::brev(k)), pp = fft::pidx(fft::brev((fft::N - k) & (fft::N - 1)));
            const fft::c2 Xk = buf[pa], Xp = buf[pp]; const f32x4 sd = SD[(size_t)p * 4097 + k];
            const fft::c2 Sv{sd[0], sd[1]}, Dv{sd[2], sd[3]};
            const fft::c2 t1 = fft::cmul(Xk, Sv), t2 = fft::cmul(fft::c2{Xp.x, -Xp.y}, Dv);
            const fft::c2 u1 = fft::cmulc(Xp, Sv), u2 = fft::cmulc(fft::c2{Xk.x, -Xk.y}, Dv);
            buf[pa] = fft::c2{t1.x + t2.x, t1.y + t2.y};
            if (pp != pa) buf[pp] = fft::c2{u1.x + u2.x, u1.y + u2.y};
        }
        __syncthreads();
        fft_inv(buf, tid);
        const float ba = bd[2 * p], bb = bd[2 * p + 1];
        h8 oa, ob;
#pragma unroll
        for (int j = 0; j < 8; ++j) { const fft::c2 y = buf[fft::pidx(t0 + j)]; oa[j] = (f16)(y.x * (1.f / fft::N) + (float)va[j] * ba); ob[j] = (f16)(y.y * (1.f / fft::N) + (float)vb[j] * bb); }
        *(h8*)(za + t0) = oa; *(h8*)(zb + t0) = ob;
    }
    __syncthreads();
}
__device__ __forceinline__ void ctxconv_tasks(Frame& F, CIN in, int l) {
    const int gw = F.vcu * NWAVES + F.wave, NGW = F.G * NWAVES, lane = F.lane;
    f16* ZT = (f16*)(F.ws + WS_ZT);
    const float* GC = (const float*)(F.ws + WS_GC);
    for (int task = gw; task < B * DH; task += NGW) {
        const int c = task & (DH - 1);
        f16* zp = ZT + (size_t)task * SE + S;
        float zv[4], acc[4];
#pragma unroll
        for (int j = 0; j < 4; ++j) { zv[j] = (float)zp[lane + 64 * j]; acc[j] = 0.f; }
        const float* g = GC + (size_t)c * 512 + 256 + lane;
#pragma unroll
        for (int sj = 0; sj < 4; ++sj)
            for (int s0 = 0; s0 < 64; ++s0) { const float zs = bperm(s0, zv[sj]); const int s = sj * 64 + s0;
#pragma unroll
                for (int j = 0; j < 4; ++j) acc[j] += g[64 * j - s] * zs; }
        const float bdv = in.hy_bias_d[l * DH + c];
#pragma unroll
        for (int j = 0; j < 4; ++j) zp[lane + 64 * j] = (f16)(acc[j] + zv[j] * bdv);
    }
}
template <bool LOCAL>
__device__ __forceinline__ void attn_task(Frame& F, const float* rpb_l, int id) {
    const int lane = F.lane, fr = lane & 15, fq = lane >> 4;
    const f16* P = (const f16*)(F.ws + WS_P); const f16* VT = (const f16*)(F.ws + WS_VT); f16* Y = (f16*)(F.ws + WS_Y);
    int b, h, r = 0, n = 0, qrow0;
    if (LOCAL) { n = id & 3; h = (id >> 2) & 7; r = (id >> 5) & 63; b = id >> 11; qrow0 = r * 64 + 16 * n; }
    else { const int qb = id & 15; h = (id >> 4) & 7; b = id >> 7; qrow0 = S + 16 * qb; }
    const int rs = r - 4 < 0 ? 0 : (r - 4 > 56 ? 56 : r - 4);
    const int kb = n == 0 ? 0 : (n == 1 ? 8 : (n == 2 ? 24 : 32));
    const f16* Pb = P + (size_t)b * SE * DIN;
    const f16* qp = Pb + (size_t)(qrow0 + fr) * DIN + OFF_NA + h * 64 + fq * 8;
    const h8 bq0 = *(const h8*)qp, bq1 = *(const h8*)(qp + 32);
    constexpr int NCH = LOCAL ? 2 : 1;
    const f16* kbase = Pb + OFF_NA + 512 + h * 64 + fq * 8;
    const f16* vbase = VT + ((size_t)b * DH + h * 64 + fr) * SE + 4 * fq;
    const int qc = 16 * n + fr; const int cs = qc - 8 < 0 ? 0 : (qc - 8 > 48 ? 48 : qc - 8);
    float mrun = -3.0e38f, lsum = 0.f;
    f32x4 o[4];
#pragma unroll
    for (int d = 0; d < 4; ++d) o[d] = (f32x4){0.f, 0.f, 0.f, 0.f};
#pragma unroll
    for (int ch = 0; ch < NCH; ++ch) {
        const bool loc = LOCAL && ch == 0;
        f32x4 st[16];
#pragma unroll
        for (int tl = 0; tl < 16; ++tl) {
            const int krow = loc ? (rs + (tl >> 1)) * 64 + kb + 16 * (tl & 1) + fr : S + 16 * tl + fr;
            const f16* kp = kbase + (size_t)krow * DIN;
            const h8 a0 = *(const h8*)kp, a1 = *(const h8*)(kp + 32);
            f32x4 acc = (f32x4){0.f, 0.f, 0.f, 0.f};
            acc = __builtin_amdgcn_mfma_f32_16x16x32_f16(a0, bq0, acc, 0, 0, 0);
            acc = __builtin_amdgcn_mfma_f32_16x16x32_f16(a1, bq1, acc, 0, 0, 0);
            st[tl] = acc;
            if ((tl & 3) == 3) asm volatile("" ::: "memory");
        }
        float mx = -3.0e38f;
#pragma unroll
        for (int tl = 0; tl < 16; ++tl)
#pragma unroll
            for (int i = 0; i < 4; ++i) {
                float sv = st[tl][i] * 0.125f;
                if (loc) { const int j = tl >> 1, kcol = kb + 16 * (tl & 1) + 4 * fq + i; const bool ok = kcol >= cs && kcol < cs + 16;
                    const int ri = rs + j - r + 7, ci = kcol - qc + 15;
                    sv = ok ? sv + rpb_l[(h * 15 + ri) * 31 + (ok ? ci : 0)] : -1.0e30f; }
                st[tl][i] = sv; mx = fmaxf(mx, sv);
                if (i == 3 && (tl & 3) == 3) asm volatile("" ::: "memory");
            }
        mx = fmaxf(mx, SHX(mx, 16)); mx = fmaxf(mx, SHX(mx, 32));
        const float mnew = fmaxf(mrun, mx), alpha = __expf(mrun - mnew);
        mrun = mnew;
        float ps = 0.f;
#pragma unroll
        for (int tl = 0; tl < 16; ++tl)
#pragma unroll
            for (int i = 0; i < 4; ++i) { const float pv = __expf(st[tl][i] - mnew); st[tl][i] = pv; ps += pv; }
        ps += SHX(ps, 16); ps += SHX(ps, 32);
        lsum = lsum * alpha + ps;
        if (ch > 0) {
#pragma unroll
            for (int i = 0; i < 4; ++i) { const float al = bperm(4 * fq + i, alpha);
#pragma unroll
                for (int d = 0; d < 4; ++d) o[d][i] *= al; }
        }
#pragma unroll
        for (int sp = 0; sp < 8; ++sp) {
            h8 pa;
#pragma unroll
            for (int i = 0; i < 4; ++i) { pa[i] = (f16)st[2 * sp][i]; pa[4 + i] = (f16)st[2 * sp + 1][i]; }
            const int t0 = loc ? (rs + sp) * 64 + kb : S + 32 * sp;
#pragma unroll
            for (int d = 0; d < 4; ++d) {
                const f16* vp = vbase + (size_t)d * 16 * SE + t0;
                const h4 v0 = *(const h4*)vp, v1 = *(const h4*)(vp + 16);
                h8 bv;
#pragma unroll
                for (int i = 0; i < 4; ++i) { bv[i] = v0[i]; bv[4 + i] = v1[i]; }
                o[d] = __builtin_amdgcn_mfma_f32_16x16x32_f16(pa, bv, o[d], 0, 0, 0);
            }
            if (sp & 1) asm volatile("" ::: "memory");
        }
    }
    const float inv = 1.f / lsum;
    f16* yb = Y + ((size_t)b * SE + qrow0) * 1536 + 1024 + h * 64 + fr;
#pragma unroll
    for (int i = 0; i < 4; ++i) { const float sc = bperm(4 * fq + i, inv);
#pragma unroll
        for (int d = 0; d < 4; ++d) yb[(size_t)(4 * fq + i) * 1536 + 16 * d] = (f16)(o[d][i] * sc); }
}
__device__ __forceinline__ void attn_tasks(Frame& F, CIN in, int l) {
    const int gw = F.vcu * NWAVES + F.wave, NGW = F.G * NWAVES;
    const float* rpb_l = in.na_rpb + (size_t)l * NHEAD * 15 * 31;
    for (int id = gw; id < B * 64 * 8 * 4; id += NGW) attn_task<true>(F, rpb_l, id);
    for (int id = gw; id < B * 8 * 16; id += NGW) attn_task<false>(F, rpb_l, id);
}

__device__ __forceinline__ void ymix_phase(Frame& F, CIN in, int l) {
    LAS f16* tile = (LAS f16*)F.lds;
    const f16* P = (const f16*)(F.ws + WS_P); const f16* ZT = (const f16*)(F.ws + WS_ZT); f16* Y = (f16*)(F.ws + WS_Y);
    const float* cw = in.hy_conv_w + l * 3 * 1536; const float* cbias = in.hy_conv_b + l * 1536; const float* scw = in.sc_conv_w + l * 3 * DH;
    const int tid = F.tid, t = tid & 63, cg = tid >> 6;
    for (int task = F.bid; task < B * 68 * 16; task += F.G) {
        const int cb = task & 15, r0 = task >> 4, tl = r0 % 68, b = r0 / 68;
        const int i = tl * 64 + t, lo = i < S ? 0 : S, hi = i < S ? S : SE;
        const f16* prow = P + ((size_t)b * SE + i) * DIN;
        f16* yrow = Y + ((size_t)b * SE + i) * 1536;
        if (cb < 8) {
            __syncthreads();
            { const int ch = tid >> 3, part = tid & 7;
              *(LAS h8*)(tile + ch * 72 + part * 8) = *(const h8*)(ZT + ((size_t)b * DH + cb * 64 + ch) * SE + tl * 64 + part * 8); }
            __syncthreads();
            const int c0 = cb * 64 + cg * 8;
            const h8 cur = *(const h8*)(prow + c0);
            h8 prv, nxt;
#pragma unroll
            for (int j = 0; j < 8; ++j) { prv[j] = (f16)0.f; nxt[j] = (f16)0.f; }
            if (i - 1 >= lo) prv = *(const h8*)(prow - DIN + c0);
            if (i + 1 < hi) nxt = *(const h8*)(prow + DIN + c0);
            h8 o;
#pragma unroll
            for (int j = 0; j < 8; ++j) { const float x0 = (float)prv[j] * cw[c0 + j] + (float)cur[j] * cw[1536 + c0 + j] + (float)nxt[j] * cw[3072 + c0 + j] + cbias[c0 + j];
                o[j] = (f16)(x0 * (float)tile[(cg * 8 + j) * 72 + t]); }
            *(h8*)(yrow + c0) = o;
        } else {
            const int c0 = (cb - 8) * 64 + cg * 8;
            const f16* ps = prow + OFF_SC;
            const h8 bg = *(const h8*)(ps + c0);
            const h8 c1 = *(const h8*)(ps + 512 + c0), x1 = *(const h8*)(ps + 1024 + c0);
            h8 c0v, x0v, c2v, x2v;
#pragma unroll
            for (int j = 0; j < 8; ++j) { c0v[j] = (f16)0.f; x0v[j] = (f16)0.f; c2v[j] = (f16)0.f; x2v[j] = (f16)0.f; }
            if (i - 1 >= lo) { c0v = *(const h8*)(ps - DIN + 512 + c0); x0v = *(const h8*)(ps - DIN + 1024 + c0); }
            if (i + 1 < hi) { c2v = *(const h8*)(ps + DIN + 512 + c0); x2v = *(const h8*)(ps + DIN + 1024 + c0); }
            h8 o;
#pragma unroll
            for (int j = 0; j < 8; ++j) { const float v = (float)c0v[j] * (float)x0v[j] * scw[c0 + j] + (float)c1[j] * (float)x1[j] * scw[512 + c0 + j] + (float)c2v[j] * (float)x2v[j] * scw[1024 + c0 + j];
                o[j] = (f16)((float)bg[j] * v); }
            *(h8*)(yrow + 512 + c0) = o;
        }
    }
    __syncthreads();
}

struct TileOrder {
    int nM, nN, nwg, G, c;
    __device__ __forceinline__ void init(int M, int N, int G_, int c_) { nM = M / 256; nN = N / 256; nwg = nM * nN; G = G_; c = c_; }
    __device__ __forceinline__ bool tile(int i, int& pm, int& pn) const {
        const long L = (long)i * G + c; if (L >= nwg) return false;
        int wgid = (int)L; { const int q = nwg / 8, r = nwg % 8, xcd = wgid % 8, off = wgid / 8; wgid = (xcd < r ? xcd * (q + 1) : r * (q + 1) + (xcd - r) * q) + off; }
        const int nig = 8 * nN, gid = wgid / nig, fm = gid * 8, gsz = (nM - fm) < 8 ? (nM - fm) : 8;
        pm = fm + ((wgid % nig) % gsz); pn = (wgid % nig) / gsz; return true;
    }
};
template <int SUB>
struct DenseSched {
    static constexpr bool GATHER = false;
    TileOrder O; const char* A; const char* Bm; int lda, ldb; size_t a_sub, b_sub;
    __device__ __forceinline__ bool next(int i, pg::Unit& u) const {
        const int ti = i / SUB, s = i - ti * SUB; int pm, pn;
        if (!O.tile(ti, pm, pn)) return false;
        u.pm = pm; u.pn = pn; u.e = s; u.nrows = 256; u.aux0 = 0;
        u.A = A + (size_t)pm * 256 * lda * 2 + s * a_sub; u.B = Bm + (size_t)pn * 256 * ldb * 2 + s * b_sub;
        return true;
    }
    __device__ __forceinline__ int arow(const pg::Unit&, int r) const { return r; }
};
struct EpiInproj {
    static constexpr bool PERM = true;
    f16* O;
    __device__ __forceinline__ void operator()(const f32x4 (&acc)[2][2][4][2], const pg::Unit& u, int wr, int wc, int fr, int fq) const {
#pragma unroll
        for (int ai = 0; ai < 2; ++ai)
#pragma unroll
            for (int m = 0; m < 4; ++m) { f16* rowp = O + (size_t)(u.pm * 256 + ai * 128 + wr * 64 + m * 16 + fr) * DIN + u.pn * 256 + wc * 32 + 8 * fq;
#pragma unroll
                for (int bj = 0; bj < 2; ++bj) { const f32x4 v0 = acc[ai][bj][m][0], v1 = acc[ai][bj][m][1];
                    u32x4 o; o.x = pkh(v0[0], v0[1]); o.y = pkh(v0[2], v0[3]); o.z = pkh(v1[0], v1[1]); o.w = pkh(v1[2], v1[3]);
                    *(u32x4*)(rowp + bj * 128) = o; } }
    }
};
struct EpiBranch {
    static constexpr bool PERM = true;
    const f16* P; f16* MG; f32x4* scr; int tid;
    __device__ __forceinline__ void operator()(const f32x4 (&acc)[2][2][4][2], const pg::Unit& u, int wr, int wc, int fr, int fq) const {
        const int br = u.e;
        const int col0 = u.pn * 256 + wc * 32 + 8 * fq;
        const size_t row0 = (size_t)(u.pm * 256 + wr * 64 + fr);
        const f16* gp = P + row0 * DIN + OFF_GATE + br * D + col0;
        f16* mp = MG + row0 * D + col0;
        f32x4* sp = scr + tid;
#pragma unroll
        for (int ai = 0; ai < 2; ++ai)
#pragma unroll
            for (int m = 0; m < 4; ++m) {
#pragma unroll
                for (int bj = 0; bj < 2; ++bj) {
                    const h8 g = *(const h8*)(gp + bj * 128);
                    f32x4 v0 = acc[ai][bj][m][0], v1 = acc[ai][bj][m][1];
#pragma unroll
                    for (int j = 0; j < 4; ++j) { v0[j] *= sigm((float)g[j]); v1[j] *= sigm((float)g[4 + j]); }
                    if (br > 0) { v0 += sp[(size_t)(2 * bj) * NTHR]; v1 += sp[(size_t)(2 * bj + 1) * NTHR]; }
                    if (br < 2) { sp[(size_t)(2 * bj) * NTHR] = v0; sp[(size_t)(2 * bj + 1) * NTHR] = v1; }
                    else { u32x4 o; o.x = pkh(v0[0], v0[1]); o.y = pkh(v0[2], v0[3]); o.z = pkh(v1[0], v1[1]); o.w = pkh(v1[2], v1[3]);
                           *(u32x4*)(mp + bj * 128) = o; }
                }
                gp += (m == 3 ? (size_t)(128 - 48) : (size_t)16) * DIN; mp += (m == 3 ? (size_t)(128 - 48) : (size_t)16) * D; sp += 4 * NTHR;
                asm volatile("" : "+v"(gp), "+v"(mp), "+v"(sp) :: "memory"); }
    }
};
struct EpiOut {
    static constexpr bool PERM = false;
    float* X; const float* mods_l;
    __device__ __forceinline__ void operator()(const f32x4 (&acc)[2][2][4][2], const pg::Unit& u, int wr, int wc, int fr, int fq) const {
        const int row_t = u.pm * 256;
        const float* gt = mods_l + (size_t)mod_row(row_t) * 6 * D + 2 * D + u.pn * 256 + wc * 32 + 4 * fq;
        f32x4 gv[2][2];
#pragma unroll
        for (int bj = 0; bj < 2; ++bj)
#pragma unroll
            for (int n = 0; n < 2; ++n) gv[bj][n] = *(const f32x4*)(gt + bj * 128 + n * 16);
#pragma unroll
        for (int ai = 0; ai < 2; ++ai)
#pragma unroll
            for (int m = 0; m < 4; ++m) { float* rowp = X + (size_t)(row_t + ai * 128 + wr * 64 + m * 16 + fr) * D + u.pn * 256 + wc * 32 + 4 * fq;
#pragma unroll
                for (int bj = 0; bj < 2; ++bj)
#pragma unroll
                    for (int n = 0; n < 2; ++n) { f32x4* p = (f32x4*)(rowp + bj * 128 + n * 16); *p = *p * ALPHA + gv[bj][n] * acc[ai][bj][m][n]; }
                asm volatile("" ::: "memory"); }
    }
};
__device__ __forceinline__ void inproj_phase(Frame& F) {
    DenseSched<1> Sc; Sc.O.init(T, DIN, F.G, F.bid); Sc.A = (const char*)(F.ws + WS_HMH); Sc.Bm = (const char*)(F.ws + WS_WIN); Sc.lda = D; Sc.ldb = D; Sc.a_sub = 0; Sc.b_sub = 0;
    EpiInproj E; E.O = (f16*)(F.ws + WS_P);
    pg::gemm_phase<EpiInproj, DenseSched<1>, true>(F.lds, F.wave, D, D, D, Sc, E);
}
__device__ __forceinline__ void branch_phase(Frame& F) {
    DenseSched<3> Sc; Sc.O.init(T, D, F.G, F.bid); Sc.A = (const char*)(F.ws + WS_Y); Sc.Bm = (const char*)(F.ws + WS_PJ); Sc.lda = 1536; Sc.ldb = DH; Sc.a_sub = (size_t)DH * 2; Sc.b_sub = (size_t)D * DH * 2;
    EpiBranch E; E.P = (const f16*)(F.ws + WS_P); E.MG = (f16*)(F.ws + WS_HMH); E.scr = (f32x4*)(F.ws + WS_SCR) + (size_t)F.bid * 32 * NTHR; E.tid = F.tid;
    pg::gemm_phase<EpiBranch, DenseSched<3>, true>(F.lds, F.wave, DH, 1536, DH, Sc, E);
}
__device__ __forceinline__ void outproj_phase(Frame& F, int l) {
    DenseSched<1> Sc; Sc.O.init(T, D, F.G, F.bid); Sc.A = (const char*)(F.ws + WS_HMH); Sc.Bm = (const char*)(F.ws + WS_WO); Sc.lda = D; Sc.ldb = D; Sc.a_sub = 0; Sc.b_sub = 0;
    EpiOut E; E.X = (float*)(F.ws + WS_X); E.mods_l = (const float*)(F.ws + WS_MODS) + (size_t)l * 9 * 6 * D;
    pg::gemm_phase<EpiOut, DenseSched<1>, true>(F.lds, F.wave, D, D, D, Sc, E);
}
constexpr int LDS_TAB_OFF = pg::STAGE_BYTES;
constexpr int LDS_MISC_OFF = LDS_TAB_OFF + 1024;
constexpr int LDS_BYTES = 147456;
constexpr int NPH_L = 13, NPHASE = 2 + NPH_L * DEPTH;
constexpr int FLAG_HYB_MOE = 1;
constexpr int FLAG_HYB_MIX = 2;

template <class P> __device__ __forceinline__ P launder_uniform(P p) {
    unsigned long long v = (unsigned long long)p; unsigned lo = (unsigned)v, hi = (unsigned)(v >> 32);
    asm volatile("" : "+v"(lo), "+v"(hi));
    lo = __builtin_amdgcn_readfirstlane(lo); hi = __builtin_amdgcn_readfirstlane(hi);
    return (P)(((unsigned long long)hi << 32) | lo);
}
__device__ __forceinline__ int launder_int(int v) { asm volatile("" : "+v"(v)); return __builtin_amdgcn_readfirstlane(v); }
__device__ __forceinline__ void launder(Frame& F, CArgsP& ap) { F.lane = lane_id(); asm volatile("" : "+v"(F.lane)); F.ws = launder_uniform(F.ws); ap = launder_uniform(ap); F.G = launder_int(F.G); F.bid = launder_int(F.bid); F.vcu = launder_int(F.vcu); F.wave = launder_int(F.wave); F.tid = F.wave * 64 + F.lane; }
__global__ void __launch_bounds__(NTHR, 2) fwd(Args a_unused) {
    CArgsP ap = (CArgsP)__builtin_amdgcn_kernarg_segment_ptr();
    extern __shared__ __attribute__((aligned(16))) unsigned char lds_raw[];
    Frame F;
    F.lds = (LAS unsigned char*)lds_raw;
    F.tid = threadIdx.x; F.lane = F.tid & 63; F.wave = __builtin_amdgcn_readfirstlane(F.tid >> 6);
    F.G = gridDim.x; F.bid = blockIdx.x; { const int bx = blockIdx.x; F.vcu = (F.G % 8 == 0) ? (bx % 8) * (F.G / 8) + bx / 8 : bx; }
    F.ws = ap->ws;
    for (int u = F.tid; u < (1024 + 64) / 4; u += NTHR) ((LAS unsigned*)(F.lds + LDS_TAB_OFF))[u] = 0u;
    __syncthreads();
    XcdBarrier bar; bar.bar = (unsigned*)(F.ws + WS_CTL) + CW_BAR; bar.x = 0; bar.st = nullptr;
    if (ap->use_bar) bar = xcd_barrier_post((unsigned*)(F.ws + WS_CTL) + CW_BAR, (volatile LAS unsigned*)(F.lds + LDS_MISC_OFF + 32), F.tid);
#define IN(k) (launder(F, ap), ap->ph_lo <= (k) && (k) < ap->ph_hi)
#define SEAM(k) do { if (IN(k) && IN((k) + 1)) { bar.bar = launder_uniform(bar.bar); bar.x = (unsigned)launder_int((int)bar.x); xcd_barrier(bar, F.tid); } } while (0)
    if (IN(0)) { pro_mods(F, ap->in); pro_init_x(F, ap->in); pro_z2(F, ap->in); convert_mixer_weights(F, ap->in, 0); }
    SEAM(0);
    if (IN(1)) { filters_phase(F, ap->in, 0); mod1_rows(F, 0); }
    SEAM(1);
    for (int l = 0; l < DEPTH; ++l) {
        const int pb = 2 + NPH_L * l;
        if (IN(pb + 0)) inproj_phase(F);
        SEAM(pb + 0);
        if (IN(pb + 1)) transpose_phase(F, ap->in, l);
        SEAM(pb + 1);
        if (IN(pb + 2)) { fftconv_tasks(F, ap->in, l); ctxconv_tasks(F, ap->in, l); attn_tasks(F, ap->in, l); }
        SEAM(pb + 2);
        if (IN(pb + 3)) ymix_phase(F, ap->in, l);
        SEAM(pb + 3);
        if (IN(pb + 4)) branch_phase(F);
        SEAM(pb + 4);
        if (IN(pb + 5)) outproj_phase(F, l);
        SEAM(pb + 5);
        if (IN(pb + 6)) { if (ap->flags & FLAG_HYB_MOE) ln1_rows<false>(F, ap->in, l); else ln1_rows<true>(F, ap->in, l); convert_moe_weights(F, ap->in, l); }
        SEAM(pb + 6);
        if (IN(pb + 7)) router_phase(F, ap->in, l);
        SEAM(pb + 7);
        if (IN(pb + 8)) moe_up_phase(F, l, 0);
        SEAM(pb + 8);
        if (IN(pb + 9)) moe_down_phase(F, l, 0);
        SEAM(pb + 9);
        if (IN(pb + 10)) { moe_up_phase(F, l, 1); ln2_rows(F, ap->in, ap->out, l, 0); }
        SEAM(pb + 10);
        if (IN(pb + 11)) moe_down_phase(F, l, 1);
        SEAM(pb + 11);
        if (IN(pb + 12)) {
            if (!(ap->flags & FLAG_HYB_MIX)) ln2_rows(F, ap->in, ap->out, l, 1);
            if (l + 1 < DEPTH && !(ap->flags & FLAG_HYB_MOE)) {
                __syncthreads(); convert_mixer_weights(F, ap->in, l + 1); __syncthreads(); filters_phase(F, ap->in, l + 1);
                if (ap->flags & FLAG_HYB_MIX) mod1_rows(F, l + 1);
            }
        }
        SEAM(pb + 12);
    }
#undef IN
#undef SEAM
}

static int g_grid = 0;
static bool setup_grid() {
    if (g_grid) return g_grid > 0;
    int dev = 0, cus = 0, per_cu = 0;
    if (hipGetDevice(&dev) != hipSuccess || hipDeviceGetAttribute(&cus, hipDeviceAttributeMultiprocessorCount, dev) != hipSuccess) { g_grid = -1; return false; }
    if (hipFuncSetAttribute((const void*)fwd, hipFuncAttributeMaxDynamicSharedMemorySize, LDS_BYTES) != hipSuccess) { fprintf(stderr, "hipFuncSetAttribute failed\n"); g_grid = -1; return false; }
    if (hipOccupancyMaxActiveBlocksPerMultiprocessor(&per_cu, (const void*)fwd, NTHR, LDS_BYTES) != hipSuccess || per_cu < 1) { fprintf(stderr, "occupancy query: %d\n", per_cu); (void)hipGetLastError(); g_grid = -1; return false; }
    g_grid = cus;
    return true;
}
static void launch_phases(const Args& base, int lo, int hi, int use_bar, hipStream_t st) {
    Args a = base; a.ph_lo = lo; a.ph_hi = hi; a.use_bar = use_bar;
    hipLaunchKernelGGL(fwd, dim3(g_grid), dim3(NTHR), LDS_BYTES, st, a);
}
}
#ifndef HYB
#define HYB 1
#endif
extern "C" void kernel_launch(void* const* d_in, const int* in_sizes, int n_in, void* d_out, int out_size, void* d_ws, size_t ws_size, hipStream_t stream) {
    if (n_in != 34 || ws_size < fk::WS_END + (size_t)64 * fk::MiB) { fprintf(stderr, "kernel_launch: unexpected inputs / workspace (%d, %zu)\n", n_in, ws_size); return; }
    nv::In in{};
    { const float** f = (const float**)&in; for (int i = 0; i < 34; ++i) f[i] = (const float*)d_in[i]; }
    fk::Args a{};
    { const float** f = (const float**)&a.in; for (int i = 0; i < 34; ++i) f[i] = (const float*)d_in[i]; }
    a.out = (float*)d_out; a.ws = (unsigned char*)d_ws;
    if (!fk::setup_grid()) return;
    (void)hipMemsetAsync((char*)d_ws + fk::WS_CTL, 0, fk::CTL_ZERO_BYTES, stream);
    nv::Ctx c = nv::make_ctx((unsigned char*)d_ws, fk::WS_DYN);
#if HYB == 0
    nv::prologue(in, c, stream);
    for (int l = 0; l < 4; ++l) { nv::mixer_layer(in, c, l, stream); nv::moe_layer(in, c, l, stream); }
    nv::finalize(c, (float*)d_out, stream);
#elif HYB == 1
    a.flags = fk::FLAG_HYB_MOE;
    nv::prologue(in, c, stream);
    for (int l = 0; l < 4; ++l) {
        nv::mixer_layer(in, c, l, stream);
        const int pb = 2 + fk::NPH_L * l;
        for (int p = pb + 6; p <= pb + 12; ++p) fk::launch_phases(a, p, p + 1, 0, stream);
    }
#elif HYB == 2
    a.flags = fk::FLAG_HYB_MIX;
    fk::launch_phases(a, 0, 1, 0, stream); fk::launch_phases(a, 1, 2, 0, stream);
    for (int l = 0; l < 4; ++l) {
        const int pb = 2 + fk::NPH_L * l;
        for (int p = pb; p <= pb + 6; ++p) fk::launch_phases(a, p, p + 1, 0, stream);
        nv::moe_layer(in, c, l, stream);
        if (l < 3) fk::launch_phases(a, pb + 12, pb + 13, 0, stream);
    }
    nv::finalize(c, (float*)d_out, stream);
#elif HYB == 3
    for (int p = 0; p < fk::NPHASE; ++p) fk::launch_phases(a, p, p + 1, 0, stream);
#elif HYB == 4
    fk::launch_phases(a, 0, fk::NPHASE, 1, stream);
#endif
}
```

```cpp
#define HYB 4
#define PROBE_REP -1
#define PROBE_SLO -1
#define PROBE_SHI -1
#define PROBE_PH -1
#define PROBE_XFLAGS 0

#include <hip/hip_runtime.h>
#include <cstdio>
#include <cstdint>
namespace nv {
constexpr int B = 8, S = 4096, CL = 256, SE = S + CL, T = B * SE, D = 1024, DEPTH = 4;
constexpr int DH = 512, DIN = 7680, OFF_SC = 1536, OFF_NA = 3072, OFF_GATE = 4608;
constexpr int NE = 64, TOPK = 8, DEXP = 256;
constexpr int GRIDW = 64, NHEAD = 8, HDIM = 64;
constexpr float LN_EPS = 1e-5f;
constexpr float ALPHA = 1.681792830507429f;

__device__ __forceinline__ float sigmoidf_(float x) { return 1.f / (1.f + expf(-x)); }
__device__ __forceinline__ float siluf_(float x) { return x / (1.f + expf(-x)); }
__device__ __forceinline__ float wsum(float v) {
#pragma unroll
    for (int o = 1; o < 64; o <<= 1) v += __shfl_xor(v, o);
    return v;
}
__device__ __forceinline__ float wmax(float v) {
#pragma unroll
    for (int o = 1; o < 64; o <<= 1) v = fmaxf(v, __shfl_xor(v, o));
    return v;
}

__global__ void k_cond(const float* c, const float* c_ctx, float* cond) {
    int i = blockIdx.x * blockDim.x + threadIdx.x;
    if (i < 9 * D) { float v = i < 8 * D ? c[i] : c_ctx[i - 8 * D]; cond[i] = siluf_(v); }
}
__global__ void k_mods(const float* cond, const float* w_ada, const float* b_ada, float* mods) {
    int j = blockIdx.x * blockDim.x + threadIdx.x;
    if (j >= DEPTH * 6 * D) return;
    int l = j / (6 * D), col = j % (6 * D);
    float acc[9];
#pragma unroll
    for (int r = 0; r < 9; ++r) acc[r] = 0.f;
    const float* w = w_ada + (size_t)l * D * 6 * D + col;
    for (int k = 0; k < D; ++k) { float wv = w[(size_t)k * 6 * D];
#pragma unroll
        for (int r = 0; r < 9; ++r) acc[r] += cond[r * D + k] * wv; }
    float bb = b_ada[l * 6 * D + col];
#pragma unroll
    for (int r = 0; r < 9; ++r) mods[((size_t)l * 9 + r) * 6 * D + col] = acc[r] + bb;
}
__global__ void k_init_x(const float* x, const float* ctx, float* X) {
    size_t i = (size_t)blockIdx.x * blockDim.x + threadIdx.x;
    if (i >= (size_t)T * D) return;
    int row = (int)(i / D), d = (int)(i % D), b = row / SE, ii = row % SE;
    X[i] = ii < S ? x[((size_t)b * S + ii) * D + d] : ctx[((size_t)b * CL + (ii - S)) * D + d];
}
__global__ void k_modulate(const float* X, const float* mods_l, float* HM, int which) {
    size_t i = (size_t)blockIdx.x * blockDim.x + threadIdx.x;
    if (i >= (size_t)T * D) return;
    int row = (int)(i / D), d = (int)(i % D), b = row / SE, ii = row % SE, mb = ii < S ? b : 8;
    const float* m = mods_l + (size_t)mb * 6 * D;
    HM[i] = X[i] * (1.f + m[(which + 1) * D + d]) + m[which * D + d];
}
struct GemmP { const float* A; int lda; const int* gidx; const float* Bm; int ldb; float* C; int ldc; int M; const int* Mdev; int N, K; int mode;
               const int* sidx; const float* sw; long long eB, eG; const int* coff; const int* aoff; };
__global__ void __launch_bounds__(256) k_gemm(GemmP p) {
    __shared__ float As[16][68];
    __shared__ float Bs[16][64];
    const int z = blockIdx.z;
    const int M = p.Mdev ? p.Mdev[z] : p.M;
    const int row0 = blockIdx.y * 64, col0 = blockIdx.x * 64;
    if (row0 >= M) return;
    const float* A = p.A; const float* Bm = p.Bm + (size_t)z * p.eB;
    const int* gidx = p.gidx ? p.gidx + (size_t)z * p.eG : nullptr;
    const int* sidx = p.sidx ? p.sidx + (size_t)z * p.eG : nullptr;
    const float* sw = p.sw ? p.sw + (size_t)z * p.eG : nullptr;
    const int crow_off = p.coff ? p.coff[z] : 0;
    const int arow_off = p.aoff ? p.aoff[z] : 0;
    float* C = p.C;
    const int tid = threadIdx.x, tx = tid & 15, ty = tid >> 4;
    const int ar = tid >> 2, ak = (tid & 3) * 4;
    const int bk = tid >> 4, bn = (tid & 15) * 4;
    int arow = row0 + ar; if (arow >= M) arow = M - 1;
    const size_t asrc = gidx ? (size_t)gidx[arow] : (size_t)(arow_off + arow);
    const float* ap = A + asrc * p.lda + ak;
    const float* bp = Bm + (size_t)bk * p.ldb + col0 + bn;
    float acc[4][4];
#pragma unroll
    for (int i = 0; i < 4; ++i)
#pragma unroll
        for (int j = 0; j < 4; ++j) acc[i][j] = 0.f;
    for (int k0 = 0; k0 < p.K; k0 += 16) {
        float4 av = *(const float4*)(ap + k0);
        float4 bv = *(const float4*)(bp + (size_t)k0 * p.ldb);
        As[ak + 0][ar] = av.x; As[ak + 1][ar] = av.y; As[ak + 2][ar] = av.z; As[ak + 3][ar] = av.w;
        *(float4*)&Bs[bk][bn] = bv;
        __syncthreads();
#pragma unroll
        for (int kk = 0; kk < 16; ++kk) {
            float4 a4 = *(const float4*)&As[kk][ty * 4];
            float4 b4 = *(const float4*)&Bs[kk][tx * 4];
            float a[4] = {a4.x, a4.y, a4.z, a4.w}, b[4] = {b4.x, b4.y, b4.z, b4.w};
#pragma unroll
            for (int i = 0; i < 4; ++i)
#pragma unroll
                for (int j = 0; j < 4; ++j) acc[i][j] += a[i] * b[j];
        }
        __syncthreads();
    }
#pragma unroll
    for (int i = 0; i < 4; ++i) {
        int r = row0 + ty * 4 + i; if (r >= M) continue;
        if (p.mode == 0) {
            float* cp = C + (size_t)(crow_off + r) * p.ldc + col0 + tx * 4;
            *(float4*)cp = make_float4(acc[i][0], acc[i][1], acc[i][2], acc[i][3]);
        } else {
            int tok = sidx[r]; float w = sw[r];
            float* cp = C + (size_t)tok * p.ldc + col0 + tx * 4;
#pragma unroll
            for (int j = 0; j < 4; ++j) atomicAdd(cp + j, w * acc[i][j]);
        }
    }
}
static void gemm(hipStream_t st, const float* A, int lda, const float* Bm, int ldb, float* C, int ldc, int M, int N, int K) {
    GemmP p{}; p.A = A; p.lda = lda; p.Bm = Bm; p.ldb = ldb; p.C = C; p.ldc = ldc; p.M = M; p.N = N; p.K = K; p.mode = 0;
    hipLaunchKernelGGL(k_gemm, dim3(N / 64, (M + 63) / 64, 1), dim3(256), 0, st, p);
}

__global__ void k_hy_z2(const float* w1, const float* b1, const float* w2, const float* b2, const float* sf, int L, float* z2tab) {
    const int t = blockIdx.x * (blockDim.x / 64) + (threadIdx.x >> 6), lane = threadIdx.x & 63;
    if (t >= L) return;
    const double PI2 = 6.283185307179586476925;
    float tt = (float)((double)t / (double)(L - 1));
    float ang = (float)(PI2 / (double)L) * (float)t;
    float a = b1[lane];
    a += tt * w1[0 * 64 + lane];
    for (int j = 0; j < 16; ++j) {
        float band = (float)(1e-4 + (double)j * ((15.0 - 1e-4) / 15.0));
        float arg = band * ang;
        a += cosf(arg) * w1[(1 + j) * 64 + lane];
        a += -sinf(arg) * w1[(17 + j) * 64 + lane];
    }
    float z1 = sinf(sf[lane] * a);
    float a2 = b2[lane];
    for (int i = 0; i < 64; ++i) a2 += __shfl(z1, i) * w2[i * 64 + lane];
    z2tab[(size_t)t * 64 + lane] = sinf(sf[64 + lane] * a2);
}
__global__ void k_hy_filt(const float* z2tab, const float* w3, int L, float* hf, float* hb) {
    int i = blockIdx.x * blockDim.x + threadIdx.x;
    if (i >= L * DH) return;
    int t = i / DH, c = i % DH;
    float af = 0.f, ab = 0.f;
    for (int j = 0; j < 64; ++j) { float z = z2tab[(size_t)t * 64 + j]; af += z * w3[j * 1024 + c]; ab += z * w3[j * 1024 + 512 + c]; }
    const double la = log(1e-2) / 1.5, lb = log(1e-2) / 0.3;
    float delta = fabsf((float)(la + (double)c * ((lb - la) / 511.0)));
    float tt = (float)((double)t / (double)(L - 1));
    float dec = expf(-tt * delta);
    hf[i] = af * dec; hb[i] = ab * dec;
}
__global__ void k_hy_conv(const float* PB, const float* cw, const float* cb, float* UC) {
    int idx = blockIdx.x * blockDim.x + threadIdx.x;
    if (idx >= SE * 1536) return;
    int i = idx / 1536, c = idx % 1536;
    int lo = i < S ? 0 : S, hi = i < S ? S : SE;
    float v = PB[(size_t)i * DIN + c] * cw[1536 + c];
    if (i - 1 >= lo) v += PB[(size_t)(i - 1) * DIN + c] * cw[c];
    if (i + 1 < hi) v += PB[(size_t)(i + 1) * DIN + c] * cw[2 * 1536 + c];
    UC[idx] = v + cb[c];
}
__global__ void k_hy_z(const float* UC, float* Z) {
    int idx = blockIdx.x * blockDim.x + threadIdx.x;
    if (idx >= SE * DH) return;
    int i = idx / DH, c = idx % DH;
    Z[idx] = UC[(size_t)i * 1536 + 1024 + c] * UC[(size_t)i * 1536 + 512 + c];
}
__global__ void k_hy_long(const float* Z, const float* UC, const float* hf, const float* hb, const float* hfc, const float* hbc, const float* bias_d, float* YHY) {
    int idx = blockIdx.x * blockDim.x + threadIdx.x;
    if (idx >= SE * DH) return;
    int i = idx / DH, c = idx % DH;
    int lo = i < S ? 0 : S, L = i < S ? S : CL;
    const float* f = i < S ? hf : hfc; const float* g = i < S ? hb : hbc;
    int t = i - lo;
    float acc = 0.f;
    for (int s = 0; s <= t; ++s) acc += f[(size_t)(t - s) * DH + c] * Z[(size_t)(lo + s) * DH + c];
    for (int s = t + 1; s < L; ++s) acc += g[(size_t)(s - t) * DH + c] * Z[(size_t)(lo + s) * DH + c];
    float z = Z[idx];
    YHY[idx] = UC[(size_t)i * 1536 + c] * (acc + z * bias_d[c]);
}
__global__ void k_sconv(const float* PB, const float* cw, float* YSC) {
    int idx = blockIdx.x * blockDim.x + threadIdx.x;
    if (idx >= SE * DH) return;
    int i = idx / DH, c = idx % DH;
    int lo = i < S ? 0 : S, hi = i < S ? S : SE;
    const float* p = PB + OFF_SC;
    float v = p[(size_t)i * DIN + 512 + c] * p[(size_t)i * DIN + 1024 + c] * cw[512 + c];
    if (i - 1 >= lo) v += p[(size_t)(i - 1) * DIN + 512 + c] * p[(size_t)(i - 1) * DIN + 1024 + c] * cw[c];
    if (i + 1 < hi) v += p[(size_t)(i + 1) * DIN + 512 + c] * p[(size_t)(i + 1) * DIN + 1024 + c] * cw[1024 + c];
    YSC[idx] = p[(size_t)i * DIN + c] * v;
}
__global__ void k_attn(const float* PB, const float* rpb, float* YAT) {
    const int wt = blockIdx.x * (blockDim.x / 64) + (threadIdx.x >> 6), lane = threadIdx.x & 63;
    if (wt >= SE * NHEAD) return;
    const int i = wt / NHEAD, h = wt % NHEAD;
    const float* Q = PB + OFF_NA + h * HDIM; const float* Kp = PB + OFF_NA + 512 + h * HDIM; const float* V = PB + OFF_NA + 1024 + h * HDIM;
    const float q = Q[(size_t)i * DIN + lane];
    float m = -3.0e38f, l = 0.f, o = 0.f;
    if (i < S) {
        const int r = i / GRIDW, qc = i % GRIDW;
        int rs = r - 4; rs = rs < 0 ? 0 : (rs > 56 ? 56 : rs);
        int cs = qc - 8; cs = cs < 0 ? 0 : (cs > 48 ? 48 : cs);
        for (int j = 0; j < 8; ++j) for (int kc = cs; kc < cs + 16; ++kc) {
            const int kt = (rs + j) * GRIDW + kc;
            float s = wsum(q * Kp[(size_t)kt * DIN + lane]) * 0.125f + rpb[(h * 15 + (rs + j - r + 7)) * 31 + (kc - qc + 15)];
            float mn = fmaxf(m, s), a = expf(m - mn), pp = expf(s - mn);
            l = l * a + pp; o = o * a + pp * V[(size_t)kt * DIN + lane]; m = mn;
        }
    }
    for (int kt = S; kt < SE; ++kt) {
        float s = wsum(q * Kp[(size_t)kt * DIN + lane]) * 0.125f;
        float mn = fmaxf(m, s), a = expf(m - mn), pp = expf(s - mn);
        l = l * a + pp; o = o * a + pp * V[(size_t)kt * DIN + lane]; m = mn;
    }
    YAT[(size_t)i * DH + h * HDIM + lane] = o / l;
}
__global__ void k_merge(const float* PB, const float* T0, const float* T1, const float* T2, float* MG) {
    int idx = blockIdx.x * blockDim.x + threadIdx.x;
    if (idx >= SE * D) return;
    int i = idx / D, c = idx % D;
    const float* g = PB + (size_t)i * DIN + OFF_GATE;
    MG[idx] = sigmoidf_(g[c]) * T0[idx] + sigmoidf_(g[D + c]) * T1[idx] + sigmoidf_(g[2 * D + c]) * T2[idx];
}
__global__ void k_res_ln(float* X, const float* O, const float* mods_l, int gate_idx, const float* lg, const float* lb, int row0, int n) {
    const int w = blockIdx.x * (blockDim.x / 64) + (threadIdx.x >> 6), lane = threadIdx.x & 63;
    if (w >= n) return;
    const int row = row0 + w, b = row / SE, ii = row % SE, mb = ii < S ? b : 8;
    const float* gt = mods_l + (size_t)mb * 6 * D + gate_idx * D;
    float v[16]; float s = 0.f;
#pragma unroll
    for (int j = 0; j < 16; ++j) { int d = lane + 64 * j; v[j] = ALPHA * X[(size_t)row * D + d] + gt[d] * O[(size_t)w * D + d]; s += v[j]; }
    const float mu = wsum(s) * (1.f / D); float q = 0.f;
#pragma unroll
    for (int j = 0; j < 16; ++j) { v[j] -= mu; q += v[j] * v[j]; }
    const float rstd = rsqrtf(wsum(q) * (1.f / D) + LN_EPS);
#pragma unroll
    for (int j = 0; j < 16; ++j) { int d = lane + 64 * j; X[(size_t)row * D + d] = v[j] * rstd * lg[d] + lb[d]; }
}
__global__ void k_route(const float* logits, const float* rbias, int* cnt, int* ltok, float* lw) {
    const int tok = blockIdx.x * (blockDim.x / 64) + (threadIdx.x >> 6), lane = threadIdx.x & 63;
    if (tok >= T) return;
    const float score = sigmoidf_(logits[(size_t)tok * NE + lane]);
    const float sel = score + rbias[lane];
    float m1 = sel;
    m1 = fmaxf(m1, __shfl_xor(m1, 1)); m1 = fmaxf(m1, __shfl_xor(m1, 2)); m1 = fmaxf(m1, __shfl_xor(m1, 4));
    unsigned long long eq = __ballot(sel == m1);
    const int g = lane >> 3;
    const unsigned geq = (unsigned)((eq >> (g * 8)) & 0xffull);
    const int first = __ffs(geq) - 1;
    float s2 = ((lane & 7) == first) ? -3.0e38f : sel;
    s2 = fmaxf(s2, __shfl_xor(s2, 1)); s2 = fmaxf(s2, __shfl_xor(s2, 2)); s2 = fmaxf(s2, __shfl_xor(s2, 4));
    const float gs = m1 + s2;
    int grank = 0;
    for (int gg = 0; gg < 8; ++gg) { float o = __shfl(gs, gg * 8); if (o > gs || (o == gs && gg < g)) ++grank; }
    const bool gsel = grank < 4;
    const float val = gsel ? sel : -3.0e38f;
    int rank = 0;
    for (int j = 0; j < 64; ++j) { float o = __shfl(val, j); if (o > val || (o == val && j < lane)) ++rank; }
    const bool chosen = gsel && rank < TOPK;
    const float tot = wsum(chosen ? score : 0.f);
    if (chosen) {
        const float w = score / tot * 2.5f;
        int pos = atomicAdd(&cnt[lane], 1);
        ltok[(size_t)lane * T + pos] = tok; lw[(size_t)lane * T + pos] = w;
    }
}
__global__ void k_prefix(const int* cnt, int* off) { if (threadIdx.x == 0) { int a = 0; for (int e = 0; e < NE; ++e) { off[e] = a; a += cnt[e]; } } }
__global__ void k_swiglu(const float* U1, const float* U3, float* H, size_t n) {
    size_t i = (size_t)blockIdx.x * blockDim.x + threadIdx.x;
    if (i < n) H[i] = siluf_(U1[i]) * U3[i];
}
__global__ void k_final(const float* X, float* out) {
    size_t i = (size_t)blockIdx.x * blockDim.x + threadIdx.x;
    if (i >= (size_t)B * S * D) return;
    int d = (int)(i % D); size_t r = i / D; int b = (int)(r / S), t = (int)(r % S);
    out[i] = X[((size_t)b * SE + t) * D + d];
}

struct In {
    const float *x, *c, *ctx, *c_ctx, *w_ada, *b_ada, *w_in, *hy_conv_w, *hy_conv_b, *hy_w1, *hy_b1, *hy_w2, *hy_b2, *hy_w3, *hy_sin_freq, *hy_bias_d,
        *hy_proj, *sc_conv_w, *sc_proj, *na_rpb, *na_proj, *w_o, *ln1_g, *ln1_b, *ln2_g, *ln2_b, *moe_router, *moe_bias, *moe_w1, *moe_w3, *moe_w2, *sh_w1, *sh_w3, *sh_w2;
};


struct Ctx {
    float *X, *HM, *cond, *mods, *MIX, *PB, *UC, *Z, *YB, *T0, *T1, *T2, *MG, *OB, *z2a, *z2c, *hf, *hb, *hfc, *hbc, *logits, *lw, *U1, *U3, *F, *YHY, *YSC, *YAT;
    int *cnt, *off, *ltok;
};
static Ctx make_ctx(unsigned char* ws, size_t dyn_off) {
    Ctx c{};
    c.X = (float*)(ws + (size_t)2 * 1024 * 1024); c.mods = (float*)(ws + (size_t)1024 * 1024); c.cond = (float*)(ws + (size_t)256 * 1024);
    size_t o = dyn_off; auto alloc = [&](size_t bytes) { size_t r = o; o += (bytes + 255) & ~(size_t)255; return (void*)(ws + r); };
    c.HM = (float*)alloc((size_t)T * D * 4);
    c.MIX = (float*)alloc((size_t)SE * 16384 * 4);
    c.PB = c.MIX; c.UC = c.PB + (size_t)SE * DIN; c.Z = c.UC + (size_t)SE * 1536; c.YB = c.Z + (size_t)SE * DH;
    c.T0 = c.YB + (size_t)SE * 1536; c.T1 = c.T0 + (size_t)SE * D; c.T2 = c.T1 + (size_t)SE * D; c.MG = c.T2 + (size_t)SE * D; c.OB = c.MG + (size_t)SE * D;
    c.z2a = (float*)alloc((size_t)S * 64 * 4); c.z2c = (float*)alloc((size_t)CL * 64 * 4);
    c.hf = (float*)alloc((size_t)S * DH * 4); c.hb = (float*)alloc((size_t)S * DH * 4);
    c.hfc = (float*)alloc((size_t)CL * DH * 4); c.hbc = (float*)alloc((size_t)CL * DH * 4);
    c.logits = (float*)alloc((size_t)T * NE * 4);
    c.cnt = (int*)alloc(256); c.off = (int*)alloc(256);
    c.ltok = (int*)alloc((size_t)NE * T * 4); c.lw = (float*)alloc((size_t)NE * T * 4);
    c.U1 = (float*)alloc((size_t)T * TOPK * DEXP * 4);
    c.U3 = c.MIX; c.F = c.MIX + (size_t)32 * 1024 * 1024;
    c.YHY = c.YB; c.YSC = c.YB + (size_t)SE * DH; c.YAT = c.YB + 2 * (size_t)SE * DH;
    return c;
}
static void prologue(const In& in, const Ctx& c, hipStream_t st) {
    hipLaunchKernelGGL(k_cond, dim3((9 * D + 255) / 256), dim3(256), 0, st, in.c, in.c_ctx, c.cond);
    hipLaunchKernelGGL(k_mods, dim3(DEPTH * 6 * D / 256), dim3(256), 0, st, c.cond, in.w_ada, in.b_ada, c.mods);
    hipLaunchKernelGGL(k_init_x, dim3((unsigned)(((size_t)T * D + 255) / 256)), dim3(256), 0, st, in.x, in.ctx, c.X);
}
static void mixer_layer(const In& in, const Ctx& c, int l, hipStream_t st) {
    const unsigned gTD = (unsigned)(((size_t)T * D + 255) / 256);
    const float* ml = c.mods + (size_t)l * 9 * 6 * D;
    hipLaunchKernelGGL(k_hy_z2, dim3(S / 4), dim3(256), 0, st, in.hy_w1 + l * 33 * 64, in.hy_b1 + l * 64, in.hy_w2 + l * 4096, in.hy_b2 + l * 64, in.hy_sin_freq + l * 128, S, c.z2a);
    hipLaunchKernelGGL(k_hy_z2, dim3(CL / 4), dim3(256), 0, st, in.hy_w1 + l * 33 * 64, in.hy_b1 + l * 64, in.hy_w2 + l * 4096, in.hy_b2 + l * 64, in.hy_sin_freq + l * 128, CL, c.z2c);
    hipLaunchKernelGGL(k_hy_filt, dim3(S * DH / 256), dim3(256), 0, st, c.z2a, in.hy_w3 + (size_t)l * 64 * 1024, S, c.hf, c.hb);
    hipLaunchKernelGGL(k_hy_filt, dim3(CL * DH / 256), dim3(256), 0, st, c.z2c, in.hy_w3 + (size_t)l * 64 * 1024, CL, c.hfc, c.hbc);
    hipLaunchKernelGGL(k_modulate, dim3(gTD), dim3(256), 0, st, c.X, ml, c.HM, 0);
    for (int b = 0; b < B; ++b) {
        gemm(st, c.HM + (size_t)b * SE * D, D, in.w_in + (size_t)l * D * DIN, DIN, c.PB, DIN, SE, DIN, D);
        hipLaunchKernelGGL(k_hy_conv, dim3(SE * 1536 / 256), dim3(256), 0, st, c.PB, in.hy_conv_w + l * 3 * 1536, in.hy_conv_b + l * 1536, c.UC);
        hipLaunchKernelGGL(k_hy_z, dim3(SE * DH / 256), dim3(256), 0, st, c.UC, c.Z);
        hipLaunchKernelGGL(k_hy_long, dim3(SE * DH / 256), dim3(256), 0, st, c.Z, c.UC, c.hf, c.hb, c.hfc, c.hbc, in.hy_bias_d + l * DH, c.YHY);
        hipLaunchKernelGGL(k_sconv, dim3(SE * DH / 256), dim3(256), 0, st, c.PB, in.sc_conv_w + l * 3 * DH, c.YSC);
        hipLaunchKernelGGL(k_attn, dim3(SE * NHEAD / 4), dim3(256), 0, st, c.PB, in.na_rpb + l * NHEAD * 15 * 31, c.YAT);
        gemm(st, c.YHY, DH, in.hy_proj + (size_t)l * DH * D, D, c.T0, D, SE, D, DH);
        gemm(st, c.YSC, DH, in.sc_proj + (size_t)l * DH * D, D, c.T1, D, SE, D, DH);
        gemm(st, c.YAT, DH, in.na_proj + (size_t)l * DH * D, D, c.T2, D, SE, D, DH);
        hipLaunchKernelGGL(k_merge, dim3(SE * D / 256), dim3(256), 0, st, c.PB, c.T0, c.T1, c.T2, c.MG);
        gemm(st, c.MG, D, in.w_o + (size_t)l * D * D, D, c.OB, D, SE, D, D);
        hipLaunchKernelGGL(k_res_ln, dim3(SE / 4), dim3(256), 0, st, c.X, c.OB, ml, 2, in.ln1_g + l * D, in.ln1_b + l * D, b * SE, SE);
    }
}
static void moe_layer(const In& in, const Ctx& c, int l, hipStream_t st) {
    const unsigned gTD = (unsigned)(((size_t)T * D + 255) / 256);
    const float* ml = c.mods + (size_t)l * 9 * 6 * D;
    hipLaunchKernelGGL(k_modulate, dim3(gTD), dim3(256), 0, st, c.X, ml, c.HM, 3);
    gemm(st, c.HM, D, in.moe_router + (size_t)l * D * NE, NE, c.logits, NE, T, NE, D);
    (void)hipMemsetAsync(c.cnt, 0, 256, st);
    hipLaunchKernelGGL(k_route, dim3(T / 4), dim3(256), 0, st, c.logits, in.moe_bias + l * NE, c.cnt, c.ltok, c.lw);
    hipLaunchKernelGGL(k_prefix, dim3(1), dim3(64), 0, st, c.cnt, c.off);
    {
        GemmP p{}; p.A = c.HM; p.lda = D; p.gidx = c.ltok; p.eG = T; p.ldb = DEXP; p.ldc = DEXP; p.Mdev = c.cnt; p.N = DEXP; p.K = D; p.mode = 0; p.eB = (long long)D * DEXP; p.coff = c.off;
        p.Bm = in.moe_w1 + (size_t)l * NE * D * DEXP; p.C = c.U1;
        hipLaunchKernelGGL(k_gemm, dim3(DEXP / 64, T / 64, NE), dim3(256), 0, st, p);
        p.Bm = in.moe_w3 + (size_t)l * NE * D * DEXP; p.C = c.U3;
        hipLaunchKernelGGL(k_gemm, dim3(DEXP / 64, T / 64, NE), dim3(256), 0, st, p);
    }
    hipLaunchKernelGGL(k_swiglu, dim3((unsigned)(((size_t)T * TOPK * DEXP + 255) / 256)), dim3(256), 0, st, c.U1, c.U3, c.U1, (size_t)T * TOPK * DEXP);
    {
        float* V1 = c.U3; float* V3 = c.U3 + (size_t)T * DEXP;
        gemm(st, c.HM, D, in.sh_w1 + (size_t)l * D * DEXP, DEXP, V1, DEXP, T, DEXP, D);
        gemm(st, c.HM, D, in.sh_w3 + (size_t)l * D * DEXP, DEXP, V3, DEXP, T, DEXP, D);
        hipLaunchKernelGGL(k_swiglu, dim3((unsigned)(((size_t)T * DEXP + 255) / 256)), dim3(256), 0, st, V1, V3, V1, (size_t)T * DEXP);
        gemm(st, V1, DEXP, in.sh_w2 + (size_t)l * DEXP * D, D, c.F, D, T, D, DEXP);
    }
    {
        GemmP p{}; p.A = c.U1; p.lda = DEXP; p.aoff = c.off; p.sidx = c.ltok; p.sw = c.lw; p.eG = T; p.Bm = in.moe_w2 + (size_t)l * NE * DEXP * D; p.ldb = D; p.C = c.F; p.ldc = D; p.Mdev = c.cnt; p.N = D; p.K = DEXP; p.mode = 1;
        p.eB = (long long)DEXP * D;
        hipLaunchKernelGGL(k_gemm, dim3(D / 64, T / 64, NE), dim3(256), 0, st, p);
    }
    hipLaunchKernelGGL(k_res_ln, dim3(T / 4), dim3(256), 0, st, c.X, c.F, ml, 5, in.ln2_g + l * D, in.ln2_b + l * D, 0, T);
}
static void finalize(const Ctx& c, float* out, hipStream_t st) {
    hipLaunchKernelGGL(k_final, dim3((unsigned)(((size_t)B * S * D + 255) / 256)), dim3(256), 0, st, c.X, out);
}
}
namespace fk {
#define LAS __attribute__((address_space(3)))
#define GAS __attribute__((address_space(1)))
typedef _Float16 f16;
typedef _Float16 h8 __attribute__((ext_vector_type(8)));
typedef _Float16 h4 __attribute__((ext_vector_type(4)));
typedef _Float16 h2 __attribute__((ext_vector_type(2)));
typedef float f32x4 __attribute__((ext_vector_type(4)));
typedef float f32x2 __attribute__((ext_vector_type(2)));
typedef unsigned u32x4 __attribute__((ext_vector_type(4)));
typedef unsigned u32x2 __attribute__((ext_vector_type(2)));

constexpr int B = 8, S = 4096, CL = 256, SE = S + CL, T = B * SE, D = 1024, DEPTH = 4;
constexpr int DH = 512, DIN = 7680, OFF_SC = 1536, OFF_NA = 3072, OFF_GATE = 4608;
constexpr int NE = 64, TOPK = 8, DEXP = 256;
constexpr int GRIDW = 64, NHEAD = 8, HDIM = 64;
constexpr float LN_EPS = 1e-5f;
constexpr float ALPHA = 1.681792830507429f;
constexpr int NWAVES = 8, NTHR = 512;
constexpr int TH = T / 2;
constexpr int MAXT_H = TH * TOPK / 256 + NE;
constexpr int SH_T = TH / 256;

__device__ __forceinline__ unsigned pkh(float a, float b) { f32x2 v = {a, b}; h2 h = __builtin_convertvector(v, h2); return __builtin_bit_cast(unsigned, h); }
__device__ __forceinline__ float sigm(float x) { return __builtin_amdgcn_rcpf(1.f + __expf(-x)); }
__device__ __forceinline__ float bperm(int src, float v) { return __int_as_float(__builtin_amdgcn_ds_bpermute(src << 2, __float_as_int(v))); }
__device__ __forceinline__ int bpermi(int src, int v) { return __builtin_amdgcn_ds_bpermute(src << 2, v); }
#define SHX(v, o) bperm(lane ^ (o), (v))
__device__ __forceinline__ float wsum(float v, int lane) {
#pragma unroll
    for (int o = 1; o < 64; o <<= 1) v += SHX(v, o);
    return v;
}
__device__ __forceinline__ int lane_id() { int v; asm volatile("v_mbcnt_lo_u32_b32 %0, -1, 0\n\tv_mbcnt_hi_u32_b32 %0, -1, %0" : "=v"(v)); return v; }
#define LDS_WAIT() asm volatile("s_waitcnt lgkmcnt(0)" ::: "memory")
#define VM_WAIT() asm volatile("s_waitcnt vmcnt(0)" ::: "memory")

#define XB_TMO      128
#define XB_XCNT(j)  (256  + 64 * (j))
#define XB_XSUB(j)  (1280 + 64 * (j))
#define XB_XGEN(j)  (2304 + 64 * (j))
#define XB_TOP      3328
#define XB_TOPGEN   3392
#define XCD_BAR_WORDS 3456
#define XB_SPIN_CAP (1u << 18)
__device__ __forceinline__ unsigned xb_ld(unsigned* p)              { return __hip_atomic_load(p, __ATOMIC_RELAXED, __HIP_MEMORY_SCOPE_AGENT); }
__device__ __forceinline__ unsigned xb_add(unsigned* p, unsigned v) { return __hip_atomic_fetch_add(p, v, __ATOMIC_RELAXED, __HIP_MEMORY_SCOPE_AGENT); }
__device__ __forceinline__ unsigned xb_xcc_id() { return (unsigned)__builtin_amdgcn_s_getreg((3 << 11) | 20) & 0xFu; }
#define XB_SPIN(cond, bar) do { unsigned _sp = 0; while (cond) { __builtin_amdgcn_s_sleep(1); \
    if ((++_sp & 255u) == 0u) { if (xb_ld(&(bar)[XB_TMO])) break; if (_sp > XB_SPIN_CAP) { atomicAdd(&(bar)[XB_TMO], 1u); break; } } } } while (0)
struct XcdBarrier { unsigned* bar; unsigned x; volatile LAS unsigned* st; };
__device__ __forceinline__ XcdBarrier xcd_barrier_post(unsigned* bar, volatile LAS unsigned* st, int tid) {
    XcdBarrier b; b.bar = bar; b.x = xb_xcc_id(); b.st = st;
    if (tid == 0) (void)xb_add(&bar[XB_XCNT(b.x)], 1u);
    return b;
}
__device__ __forceinline__ void xcd_barrier_complete(unsigned* bar, unsigned x, unsigned& nloc, unsigned& nx) {
    const unsigned G = gridDim.x * gridDim.y * gridDim.z;
    unsigned sum, cnt, mine, sp = 0u;
    for (;;) {
        sum = 0u; cnt = 0u; mine = 0u;
#pragma unroll
        for (unsigned j = 0; j < 16; ++j) { const unsigned c = xb_ld(&bar[XB_XCNT(j)]); sum += c; cnt += (c > 0u) ? 1u : 0u; mine = (j == x) ? c : mine; }
        if (sum == G) break;
        __builtin_amdgcn_s_sleep(1);
        if ((++sp & 255u) == 0u) { if (xb_ld(&bar[XB_TMO])) break; if (sp > XB_SPIN_CAP) { atomicAdd(&bar[XB_TMO], 1u); break; } }
    }
    nloc = mine > 0u ? mine : 1u; nx = cnt > 0u ? cnt : 1u;
}
__device__ __forceinline__ void xcd_barrier(const XcdBarrier& b, int tid) {
    asm volatile("s_waitcnt vmcnt(0)" ::: "memory");
    __syncthreads();
    if (tid == 0) {
        unsigned* bar = b.bar;
        __builtin_amdgcn_s_waitcnt(0);
        unsigned nloc = b.st[0], nx = b.st[1];
        if (nloc == 0u) { xcd_barrier_complete(bar, b.x, nloc, nx); b.st[0] = nloc; b.st[1] = nx; }
        const unsigned old = xb_add(&bar[XB_XSUB(b.x)], 1u);
        const unsigned gen = old / nloc;
        if (old + 1u == (gen + 1u) * nloc) {
            __builtin_amdgcn_fence(__ATOMIC_RELEASE, "agent");
            asm volatile("s_waitcnt vmcnt(0)" ::: "memory");
            const unsigned og = xb_add(&bar[XB_TOP], 1u);
            const unsigned tg = og / nx;
            if (og + 1u == (tg + 1u) * nx) xb_add(&bar[XB_TOPGEN], 1u);
            else XB_SPIN(xb_ld(&bar[XB_TOPGEN]) == tg, bar);
            __builtin_amdgcn_fence(__ATOMIC_ACQUIRE, "agent");
            xb_add(&bar[XB_XGEN(b.x)], 1u);
            asm volatile("s_waitcnt vmcnt(0)" ::: "memory");
        } else {
            XB_SPIN(xb_ld(&bar[XB_XGEN(b.x)]) == gen, bar);
            __builtin_amdgcn_fence(__ATOMIC_ACQUIRE, "agent");
            asm volatile("s_waitcnt vmcnt(0)" ::: "memory");
        }
    }
    __syncthreads();
}

namespace pg {
constexpr int BM = 256, BK = 64, HALF = 128, HTB = HALF * BK * 2, STAGE_BYTES = 8 * HTB;
__host__ __device__ __forceinline__ int lds_byte(int r, int c) { const int st = (r >> 4) * 2 + (c >> 5), rr = r & 15, cc = c & 31, ob = rr * 64 + cc * 2; return st * 1024 + (ob ^ (((ob >> 9) & 1) << 5)); }
__host__ __device__ __forceinline__ void stage_rc(int b, int& R, int& C) { const int st = b / 1024, sb = b % 1024, swz = sb ^ (((sb >> 9) & 1) << 5); R = (st >> 1) * 16 + swz / 64; C = (st & 1) * 32 + (swz % 64) / 2; }
__host__ __device__ __forceinline__ int perm32(int rho) { const int n = rho >> 4, i = rho & 15; return 8 * (i >> 2) + 4 * n + (i & 3); }

struct Unit { const char* A; const char* B; int pm, pn, e, nrows, aux0; };

template <int N> __device__ __forceinline__ void wait_vm() { asm volatile("s_waitcnt vmcnt(%0)" :: "n"(N) : "memory"); }
template <class Epi, class Sched, bool ALIGN_EPI>
__device__ __forceinline__ void gemm_phase(LAS unsigned char* lds, const int wave, const int K, const int lda, const int ldb, const Sched& S, const Epi& E) {
    int tid_ = wave * 64 + lane_id(); asm volatile("" : "+v"(tid_));
    const int tid = tid_, wid = __builtin_amdgcn_readfirstlane(tid >> 6), lane = tid & 63, wr = wid >> 2, wc = wid & 3, fr = lane & 15, fq = lane >> 4;
    const int nt = K / BK;
    int sR[2], sC[2];
    unsigned voffB[2];
#pragma unroll
    for (int i = 0; i < 2; ++i) { int R, C; stage_rc(tid * 16 + i * 8192, R, C); sR[i] = R; sC[i] = C; const int Rb = Epi::PERM ? (64 * (R >> 5) + perm32(R & 31)) : R;
        voffB[i] = (unsigned)(Rb * ldb + C) * 2u; }
    const size_t kstep = (size_t)(BK * 2);
    const size_t hstepB = (size_t)(Epi::PERM ? 32 : HALF) * ldb * 2;
    const unsigned ldsw = (unsigned)wid * 1024u;
    const int aoff = lds_byte(wr * 64 + fr, fq * 8), boff = lds_byte(wc * 32 + fr, fq * 8);
#define PG_SA(b, h) (((b) * 2 + (h)) * HTB)
#define PG_SB(b, h) ((4 + (b) * 2 + (h)) * HTB)
#define PG_STAGE2(bufoff, gbase, o0, o1) do { \
        __builtin_amdgcn_global_load_lds((const unsigned*)((const char*)(gbase) + (o0)), (LAS unsigned*)(lds + (bufoff) + ldsw), 16, 0, 0); \
        __builtin_amdgcn_global_load_lds((const unsigned*)((const char*)(gbase) + (o1)), (LAS unsigned*)(lds + (bufoff) + ldsw + 8192), 16, 0, 0); } while (0)
#define PG_STAGEB(bufoff, gbase) PG_STAGE2(bufoff, gbase, voffB[0], voffB[1])
#define PG_LDA(dst, b, h) do { _Pragma("unroll") for (int m = 0; m < 4; ++m) _Pragma("unroll") for (int k = 0; k < 2; ++k) dst[m][k] = *(const LAS h8*)(lds + PG_SA(b, h) + aoff + m * 2048 + k * 1024); } while (0)
#define PG_LDB(dst, b, h) do { _Pragma("unroll") for (int n = 0; n < 2; ++n) _Pragma("unroll") for (int k = 0; k < 2; ++k) dst[n][k] = *(const LAS h8*)(lds + PG_SB(b, h) + boff + n * 2048 + k * 1024); } while (0)
#define PG_MMA(ai, bj, At, Bt) do { __builtin_amdgcn_s_setprio(1); _Pragma("unroll") for (int m = 0; m < 4; ++m) _Pragma("unroll") for (int n = 0; n < 2; ++n) _Pragma("unroll") for (int k = 0; k < 2; ++k) \
        acc[ai][bj][m][n] = __builtin_amdgcn_mfma_f32_16x16x32_f16(Bt[n][k], At[m][k], acc[ai][bj][m][n], 0, 0, 0); __builtin_amdgcn_s_setprio(0); } while (0)
#define PG_WAIT_V(n) asm volatile("s_waitcnt vmcnt(" #n ")" ::: "memory")
#define PG_WAIT_L(n) asm volatile("s_waitcnt lgkmcnt(" #n ")" ::: "memory")
#define PG_BAR __builtin_amdgcn_s_barrier()
#define PG_SCHED __builtin_amdgcn_sched_barrier(0)
    constexpr bool RELAX = !Sched::GATHER && Epi::NVM > 0;
    bool prev_full = false;
    Unit cur, nxt; int ui = 0;
    if (!S.next(0, cur)) return;
    unsigned c00, c01, c10, c11;
    LAS unsigned* otab = (LAS unsigned*)(lds + STAGE_BYTES + 2048) + tid;
    { c00 = (unsigned)(S.arow(cur, sR[0]) * lda + sC[0]) * 2u; c01 = (unsigned)(S.arow(cur, sR[1]) * lda + sC[1]) * 2u;
      c10 = (unsigned)(S.arow(cur, HALF + sR[0]) * lda + sC[0]) * 2u; c11 = (unsigned)(S.arow(cur, HALF + sR[1]) * lda + sC[1]) * 2u; }
    f32x4 acc[2][2][4][2];
#pragma unroll
    for (int a = 0; a < 2; ++a)
#pragma unroll
        for (int b = 0; b < 2; ++b)
#pragma unroll
            for (int m = 0; m < 4; ++m)
#pragma unroll
                for (int n = 0; n < 2; ++n) acc[a][b][m][n] = (f32x4){0.f, 0.f, 0.f, 0.f};
    h8 At[4][2], B0[2][2], B1[2][2];
    const char* cA = cur.A; const char* cB = cur.B;
    PG_STAGEB(PG_SB(0, 0), cB); PG_STAGEB(PG_SB(0, 1), cB + hstepB); PG_STAGE2(PG_SA(0, 0), cA, c00, c01); PG_STAGE2(PG_SA(0, 1), cA, c10, c11);
    if (wr == 1) PG_BAR;
    PG_WAIT_V(2); PG_BAR;
    PG_STAGEB(PG_SB(1, 0), cB + kstep); PG_STAGE2(PG_SA(1, 0), cA + kstep, c00, c01); PG_STAGEB(PG_SB(1, 1), cB + hstepB + kstep);
    PG_WAIT_V(6); PG_BAR;
    for (;;) {
        const bool has_next = S.next(ui + 1, nxt);
        const char* nA = has_next ? nxt.A : cA; const char* nB = has_next ? nxt.B : cB;
        if (Sched::GATHER) {
            if (has_next) { otab[0] = (unsigned)(S.arow(nxt, sR[0]) * lda + sC[0]) * 2u; otab[512] = (unsigned)(S.arow(nxt, sR[1]) * lda + sC[1]) * 2u;
                            otab[1024] = (unsigned)(S.arow(nxt, HALF + sR[0]) * lda + sC[0]) * 2u; otab[1536] = (unsigned)(S.arow(nxt, HALF + sR[1]) * lda + sC[1]) * 2u; }
            else { otab[0] = c00; otab[512] = c01; otab[1024] = c10; otab[1536] = c11; }
        }
#pragma unroll 1
        for (int t = 0; t < nt; t += 2) {
            const bool last = (t == nt - 2);
            const char* a1 = cA + (size_t)(t + 1) * kstep;
            const char* a2 = last ? nA : cA + (size_t)(t + 2) * kstep; const char* b2 = last ? nB : cB + (size_t)(t + 2) * kstep;
            const char* a3 = a2 + kstep; const char* b3 = b2 + kstep;
            unsigned q00 = c00, q01 = c01, q10 = c10, q11 = c11;
            if (Sched::GATHER) { if (last) { q00 = otab[0]; q01 = otab[512]; q10 = otab[1024]; q11 = otab[1536]; } }
            const bool pre = RELAX && t == 0 && ui > 0;
            const bool rlx = pre && prev_full;
            PG_LDB(B0, 0, 0); PG_LDB(B1, 0, 1); PG_SCHED; PG_LDA(At, 0, 0); if (!pre) PG_STAGE2(PG_SA(1, 1), a1, c10, c11);
            if (rlx) wait_vm<8 + Epi::NVM>(); else PG_WAIT_V(8);
            PG_WAIT_L(0); PG_BAR; PG_MMA(0, 0, At, B0); PG_MMA(0, 1, At, B1); PG_BAR; PG_SCHED;
            PG_LDA(At, 0, 1); PG_STAGEB(PG_SB(0, 0), b2); PG_STAGEB(PG_SB(0, 1), b2 + hstepB); PG_STAGE2(PG_SA(0, 0), a2, q00, q01);
            if (rlx) wait_vm<8 + Epi::NVM>(); else PG_WAIT_V(8);
            PG_WAIT_L(0); PG_BAR; PG_MMA(1, 0, At, B0); PG_MMA(1, 1, At, B1); PG_BAR; PG_SCHED;
            PG_LDB(B0, 1, 0); PG_LDB(B1, 1, 1); PG_SCHED; PG_LDA(At, 1, 0); PG_STAGE2(PG_SA(0, 1), a2, q10, q11);
            if (rlx) wait_vm<8 + Epi::NVM>(); else PG_WAIT_V(8);
            PG_WAIT_L(0); PG_BAR; PG_MMA(0, 0, At, B0); PG_MMA(0, 1, At, B1); PG_BAR; PG_SCHED;
            PG_LDA(At, 1, 1); PG_STAGEB(PG_SB(1, 0), b3); PG_STAGEB(PG_SB(1, 1), b3 + hstepB); PG_STAGE2(PG_SA(1, 0), a3, q00, q01);
            PG_WAIT_V(8); PG_WAIT_L(0); PG_BAR; PG_MMA(1, 0, At, B0); PG_MMA(1, 1, At, B1); PG_BAR; PG_SCHED;
        }
        if constexpr (ALIGN_EPI) { if (wr == 0) PG_BAR; }
        if (RELAX && has_next) PG_STAGE2(PG_SA(1, 1), nA + kstep, c10, c11);
        E(acc, cur, wr, wc, fr, fq);
        prev_full = E.full(cur);
        if (!has_next) break;
#pragma unroll
        for (int a = 0; a < 2; ++a)
#pragma unroll
            for (int b = 0; b < 2; ++b)
#pragma unroll
                for (int m = 0; m < 4; ++m)
#pragma unroll
                    for (int n = 0; n < 2; ++n) acc[a][b][m][n] = (f32x4){0.f, 0.f, 0.f, 0.f};
        cur = nxt; cA = nA; cB = nB; ++ui;
        if (Sched::GATHER) { c00 = otab[0]; c01 = otab[512]; c10 = otab[1024]; c11 = otab[1536]; }
        if constexpr (ALIGN_EPI) { if (wr == 1) PG_BAR; }
    }
    PG_WAIT_V(0);
    if constexpr (!ALIGN_EPI) { if (wr == 0) PG_BAR; }
    PG_BAR;
#undef PG_SA
#undef PG_SB
#undef PG_STAGE2
#undef PG_STAGEB
#undef PG_LDA
#undef PG_LDB
#undef PG_MMA
#undef PG_WAIT_V
#undef PG_WAIT_L
#undef PG_BAR
#undef PG_SCHED
}
}
constexpr size_t MiB = 1u << 20;
constexpr size_t al256(size_t x) { return (x + 255) & ~(size_t)255; }
constexpr size_t WS_CTL = 0, CTL_ZERO_BYTES = 2 * MiB;
constexpr size_t WS_MODS = 1 * MiB;
constexpr size_t WS_X = 2 * MiB;
constexpr size_t WS_Z2 = WS_X + (size_t)T * D * 4;
constexpr size_t WS_DYN = al256(WS_Z2 + (size_t)DEPTH * SE * 64 * 4);
constexpr size_t WS_WIN = WS_DYN;
constexpr size_t WS_PJ = WS_WIN + (size_t)DIN * D * 2;
constexpr size_t WS_WO = WS_PJ + (size_t)3 * D * DH * 2;
constexpr size_t WS_RT = WS_WO + (size_t)D * D * 2;
constexpr size_t WS_SD = WS_RT + (size_t)2 * NE * D * 2;
constexpr size_t WS_GC = al256(WS_SD + (size_t)256 * 4097 * 16);
constexpr size_t WS_HMH = WS_GC + (size_t)DH * 512 * 4;
constexpr size_t WS_LIST = WS_HMH + (size_t)T * D * 2;
constexpr size_t WS_P = WS_LIST + (size_t)2 * NE * TH * 8;
constexpr size_t P_BYTES = (size_t)T * DIN * 2;
constexpr size_t WS_SLOT = WS_P;
constexpr size_t WS_W13 = WS_SLOT + (size_t)TH * 9 * D * 2;
constexpr size_t WS_W2 = WS_W13 + (size_t)65 * 512 * D * 2;
constexpr size_t WS_H = WS_W2 + (size_t)65 * D * DEXP * 2;
static_assert(WS_H + (size_t)(MAXT_H + SH_T) * 256 * DEXP * 2 <= WS_P + P_BYTES, "MoE overlay fits the P region");
constexpr size_t WS_ZT = WS_P + P_BYTES;
constexpr size_t WS_VT = WS_ZT + (size_t)B * DH * SE * 2;
constexpr size_t WS_SCR = WS_ZT;
static_assert((size_t)256 * 32 * 512 * 16 <= (size_t)2 * B * DH * SE * 2, "scratch fits ZT|VT");
constexpr size_t WS_VHT = WS_VT + (size_t)B * DH * SE * 2;
constexpr size_t WS_Y = WS_VHT + (size_t)B * DH * SE * 2;
constexpr size_t WS_END = WS_Y + (size_t)T * 1536 * 2;
static_assert((size_t)(MAXT_H + SH_T) * 256 * DEXP * 2 <= (size_t)T * 1536 * 2, "half 1's H fits the Y region");
constexpr int CW_BAR = 4096;
constexpr int CW_CNT = 16384;
constexpr int CW_DBG = 32768;

struct In {
    const GAS float *x, *c, *ctx, *c_ctx, *w_ada, *b_ada, *w_in, *hy_conv_w, *hy_conv_b, *hy_w1, *hy_b1, *hy_w2, *hy_b2, *hy_w3, *hy_sin_freq, *hy_bias_d,
        *hy_proj, *sc_conv_w, *sc_proj, *na_rpb, *na_proj, *w_o, *ln1_g, *ln1_b, *ln2_g, *ln2_b, *moe_router, *moe_bias, *moe_w1, *moe_w3, *moe_w2, *sh_w1, *sh_w3, *sh_w2;
};
struct Args { In in; GAS float* out; unsigned char* ws; int ph_lo, ph_hi, use_bar, flags; };

typedef const __attribute__((address_space(4))) In& CIN;
#define INP(name) ((const float*)(in.name))
typedef const __attribute__((address_space(4))) Args* CArgsP;
struct Frame {
    LAS unsigned char* lds;
    int tid, lane, wave, vcu, G, bid, dry;
    GAS unsigned char* ws;
};
__device__ __forceinline__ int mod_row(int row) { const int b = row / SE, ii = row - b * SE; return ii < S ? b : 8; }

struct TrItem { const float* W; int K, N; f16* WT; int row_off, row_mul, item; };
__device__ __forceinline__ void tr_load(const TrItem& q, f32x4 (&t)[8], int lane) {
    const int nblk = q.N / 32, kb = q.item / nblk, nb = q.item % nblk, k0 = 64 * kb, n0 = 32 * nb;
    const int kr = lane >> 3, c4 = (lane & 7) * 4;
#pragma unroll
    for (int i = 0; i < 8; ++i) t[i] = *(const f32x4*)(q.W + (size_t)(k0 + 8 * i + kr) * q.N + n0 + c4);
}
__device__ __forceinline__ void tr_store(const TrItem& q, const f32x4 (&t)[8], LAS float* scr, int lane) {
    const int nblk = q.N / 32, kb = q.item / nblk, nb = q.item % nblk, k0 = 64 * kb, n0 = 32 * nb;
    const int kr = lane >> 3, c4 = (lane & 7) * 4;
#pragma unroll
    for (int i = 0; i < 8; ++i) { LAS float* d = scr + (8 * i + kr) * 33 + c4; d[0] = t[i][0]; d[1] = t[i][1]; d[2] = t[i][2]; d[3] = t[i][3]; }
    LDS_WAIT(); asm volatile("" ::: "memory");
    const int c = lane & 7;
#pragma unroll
    for (int j = 0; j < 4; ++j) { const int n = (lane >> 3) + 8 * j; const LAS float* s = scr + (8 * c) * 33 + n;
        u32x4 o; o.x = pkh(s[0 * 33], s[1 * 33]); o.y = pkh(s[2 * 33], s[3 * 33]); o.z = pkh(s[4 * 33], s[5 * 33]); o.w = pkh(s[6 * 33], s[7 * 33]);
        *(u32x4*)(q.WT + (size_t)(q.row_off + (n0 + n) * q.row_mul) * q.K + k0 + 8 * c) = o; }
    LDS_WAIT(); asm volatile("" ::: "memory");
}
__device__ __forceinline__ TrItem mixer_item(Frame& F, CIN in, int l, int it) {
    constexpr int I_IN = (D / 64) * (DIN / 32), I_PJ = (DH / 64) * (D / 32);
    f16* win = (f16*)(F.ws + WS_WIN); f16* pj = (f16*)(F.ws + WS_PJ); f16* wo = (f16*)(F.ws + WS_WO);
    int r = it;
    if (r < I_IN) return TrItem{INP(w_in) + (size_t)l * D * DIN, D, DIN, win, 0, 1, r}; r -= I_IN;
    if (r < I_PJ) return TrItem{INP(hy_proj) + (size_t)l * DH * D, DH, D, pj, 0, 1, r}; r -= I_PJ;
    if (r < I_PJ) return TrItem{INP(sc_proj) + (size_t)l * DH * D, DH, D, pj, D, 1, r}; r -= I_PJ;
    if (r < I_PJ) return TrItem{INP(na_proj) + (size_t)l * DH * D, DH, D, pj, 2 * D, 1, r}; r -= I_PJ;
    return TrItem{INP(w_o) + (size_t)l * D * D, D, D, wo, 0, 1, r};
}
__device__ __forceinline__ void convert_mixer_weights(Frame& F, CIN in, int l) {
    LAS float* scr = (LAS float*)(F.lds + F.wave * 16384);
    const int gw = F.vcu * NWAVES + F.wave, NGW = F.G * NWAVES;
    constexpr int NIT = (D / 64) * (DIN / 32) + 3 * (DH / 64) * (D / 32) + (D / 64) * (D / 32);
    int it = gw; if (it >= NIT) return;
    f32x4 ta[8], tb[8];
    TrItem qa = mixer_item(F, in, l, it), qb = qa; tr_load(qa, ta, F.lane);
    for (;;) {
        const bool hb = it + NGW < NIT; if (hb) { qb = mixer_item(F, in, l, it + NGW); tr_load(qb, tb, F.lane); }
        tr_store(qa, ta, scr, F.lane); if (!hb) break; it += NGW;
        const bool ha = it + NGW < NIT; if (ha) { qa = mixer_item(F, in, l, it + NGW); tr_load(qa, ta, F.lane); }
        tr_store(qb, tb, scr, F.lane); if (!ha) break; it += NGW;
    }
}
__device__ __forceinline__ TrItem moe_item(Frame& F, CIN in, int l, int it) {
    constexpr int I_UP = (D / 64) * (DEXP / 32)  , I_DN = (DEXP / 64) * (D / 32)  , PER_E = 2 * I_UP + I_DN;
    f16* w13 = (f16*)(F.ws + WS_W13); f16* w2 = (f16*)(F.ws + WS_W2);
    const int e = it / PER_E; int r = it - e * PER_E;
    if (r < I_UP) return TrItem{e < NE ? INP(moe_w1) + ((size_t)l * NE + e) * D * DEXP : INP(sh_w1) + (size_t)l * D * DEXP, D, DEXP, w13 + (size_t)e * 512 * D, 0, 2, r}; r -= I_UP;
    if (r < I_UP) return TrItem{e < NE ? INP(moe_w3) + ((size_t)l * NE + e) * D * DEXP : INP(sh_w3) + (size_t)l * D * DEXP, D, DEXP, w13 + (size_t)e * 512 * D, 1, 2, r}; r -= I_UP;
    return TrItem{e < NE ? INP(moe_w2) + ((size_t)l * NE + e) * DEXP * D : INP(sh_w2) + (size_t)l * DEXP * D, DEXP, D, w2 + (size_t)e * D * DEXP, 0, 1, r};
}
__device__ __forceinline__ void convert_moe_weights(Frame& F, CIN in, int l) {
    LAS float* scr = (LAS float*)(F.lds + F.wave * 16384);
    const int gw = F.vcu * NWAVES + F.wave, NGW = F.G * NWAVES;
    constexpr int NIT = 65 * 384;
    int it = gw; if (it >= NIT) return;
    f32x4 ta[8], tb[8];
    TrItem qa = moe_item(F, in, l, it), qb = qa; tr_load(qa, ta, F.lane);
    for (;;) {
        const bool hb = it + NGW < NIT; if (hb) { qb = moe_item(F, in, l, it + NGW); tr_load(qb, tb, F.lane); }
        tr_store(qa, ta, scr, F.lane); if (!hb) break; it += NGW;
        const bool ha = it + NGW < NIT; if (ha) { qa = moe_item(F, in, l, it + NGW); tr_load(qa, ta, F.lane); }
        tr_store(qb, tb, scr, F.lane); if (!ha) break; it += NGW;
    }
}

struct MoeTab { int ptile[NE + 2]; };
__device__ __forceinline__ void moe_build_tab(Frame& F, const int* cnt, LAS int* tab) {
    if (F.tid < 64) {
        const int c = __hip_atomic_load(cnt + F.tid, __ATOMIC_RELAXED, __HIP_MEMORY_SCOPE_AGENT); int tl = (c + 255) >> 8; int inc = tl;
#pragma unroll
        for (int o = 1; o < 64; o <<= 1) { const int v = bpermi(F.lane - o, inc); if (F.lane >= o) inc += v; }
        tab[F.tid] = inc - tl; tab[128 + F.tid] = c;
        if (F.tid == 63) tab[64] = inc;
    }
    __syncthreads();
}
template <int NPN, bool UP>
struct MoeSched {
    static constexpr bool GATHER = UP;
    const LAS int* tab; int G, c, half; const unsigned long long* list; const char* Abase; const char* Bbase; int NT, lat_only;
    int sh_mode, NT_other;
    __device__ __forceinline__ bool next(int i, pg::Unit& u) const {
        const int SH = lat_only ? SH_T - 4 : SH_T;
        const int L = i * G + c; const int nun = (NT + (sh_mode == 2 ? 0 : (sh_mode == 1 ? 2 * SH : SH))) * NPN;
        if (L >= nun) return false;
        const int tile = L / NPN; u.pn = L - tile * NPN;
        int e;
        if (tile < NT) { e = 0;
#pragma unroll
            for (int s = 32; s >= 1; s >>= 1) { const int v = __builtin_amdgcn_readfirstlane(tab[(e + s) & 63]); if (e + s < NE && v <= tile) e += s; }
            u.pm = tile - __builtin_amdgcn_readfirstlane(tab[e]); int nr = __builtin_amdgcn_readfirstlane(tab[128 + e]) - u.pm * 256; u.nrows = nr > 256 ? 256 : nr;
        } else { e = NE; u.pm = tile - NT; u.nrows = 256;
            if (u.pm >= SH) { u.pm -= SH; u.nrows = 257; }
            if (lat_only) u.pm = (u.pm >> 4) * 17 + (u.pm & 15); }
        u.e = e;
        if (UP) { u.A = Abase; u.B = Bbase + ((size_t)e * 512 + (size_t)u.pn * 256) * D * 2; }
        else { u.A = Abase + (size_t)tile * 256 * DEXP * 2; u.B = Bbase + ((size_t)e * D + (size_t)u.pn * 256) * DEXP * 2; }
        u.aux0 = u.nrows == 257 ? NT_other + u.pm : tile;
        return true;
    }
    __device__ __forceinline__ int arow(const pg::Unit& u, int r) const {
        if (!UP) return r;
        if (u.e == NE) return (u.nrows == 257 ? (half ^ 1) : half) * TH + u.pm * 256 + r;
        int rr = u.pm * 256 + r; const int n = __builtin_amdgcn_readfirstlane(tab[128 + u.e]); if (rr >= n) rr = n - 1;
        const unsigned long long en = list[((size_t)half * NE + u.e) * TH + rr];
        return half * TH + (int)(en >> 36);
    }
};
struct EpiUp {
    static constexpr bool PERM = true; static constexpr int NVM = 0;
    __device__ __forceinline__ bool full(const pg::Unit&) const { return false; }
    f16* H; f16* Hother;
    __device__ __forceinline__ void operator()(const f32x4 (&acc)[2][2][4][2], const pg::Unit& u, int wr, int wc, int fr, int fq) const {
        f16* Hb = u.nrows == 257 ? Hother : H;
#pragma unroll
        for (int ai = 0; ai < 2; ++ai)
#pragma unroll
            for (int m = 0; m < 4; ++m) { const int r = ai * 128 + wr * 64 + m * 16 + fr; f16* rowp = Hb + ((size_t)u.aux0 * 256 + r) * DEXP + u.pn * 128;
#pragma unroll
                for (int bj = 0; bj < 2; ++bj) { const f32x4 v0 = acc[ai][bj][m][0], v1 = acc[ai][bj][m][1];
                    const float h0 = v0[0] * sigm(v0[0]) * v0[1], h1 = v0[2] * sigm(v0[2]) * v0[3], h2_ = v1[0] * sigm(v1[0]) * v1[1], h3 = v1[2] * sigm(v1[2]) * v1[3];
                    u32x2 w; w.x = pkh(h0, h1); w.y = pkh(h2_, h3);
                    *(u32x2*)(rowp + (wc * 64 + bj * 32 + 8 * fq) / 2) = w; }
                asm volatile("" ::: "memory"); }
    }
};
struct EpiDown {
    static constexpr bool PERM = true; static constexpr int NVM = 16;
    __device__ __forceinline__ bool full(const pg::Unit& u) const { return !dry && (u.e == NE || u.nrows == 256); }
    f16* SL; const unsigned long long* list; int half, dry;
    __device__ __forceinline__ void operator()(const f32x4 (&acc)[2][2][4][2], const pg::Unit& u, int wr, int wc, int fr, int fq) const {
        unsigned long long en[8];
        const unsigned long long* lp = list + ((size_t)half * NE + (u.e < NE ? u.e : 0)) * TH + u.pm * 256;
#pragma unroll
        for (int g = 0; g < 8; ++g) { const int r = (g >> 2) * 128 + wr * 64 + (g & 3) * 16 + fr; en[g] = (u.e < NE && r < u.nrows) ? lp[r] : 0ull; }
#pragma unroll
        for (int ai = 0; ai < 2; ++ai)
#pragma unroll
            for (int m = 0; m < 4; ++m) { const int r = ai * 128 + wr * 64 + m * 16 + fr;
                float w = 1.f; int srow = (u.pm * 256 + r) * 9 + 8; bool ok = true;
                if (u.e < NE) { ok = r < u.nrows; const unsigned long long e8 = en[ai * 4 + m]; w = __uint_as_float((unsigned)e8); const unsigned hi = (unsigned)(e8 >> 32); srow = (int)(hi >> 4) * 9 + (int)(hi & 15u); }
                if (ok) { f16* rowp = SL + (size_t)srow * D + u.pn * 256 + wc * 64 + 8 * fq;
#pragma unroll
                    for (int bj = 0; bj < 2; ++bj) { const f32x4 v0 = acc[ai][bj][m][0] * w, v1 = acc[ai][bj][m][1] * w;
                        u32x4 o; o.x = pkh(v0[0], v0[1]); o.y = pkh(v0[2], v0[3]); o.z = pkh(v1[0], v1[1]); o.w = pkh(v1[2], v1[3]);
                        if (!dry || o.x == 0x12345678u) __builtin_nontemporal_store(o, (u32x4*)(rowp + bj * 32)); } } }
    }
};
template <bool DO_LN>
__device__ __forceinline__ void ln1_rows(Frame& F, CIN in, int l) {
    const int gw = F.vcu * NWAVES + F.wave, NGW = F.G * NWAVES;
    float* X = (float*)(F.ws + WS_X); f16* HM = (f16*)(F.ws + WS_HMH);
    const float* mods = (const float*)(F.ws + WS_MODS) + (size_t)l * 9 * 6 * D;
    const f32x4* g4 = (const f32x4*)(INP(ln1_g) + l * D) + F.lane; const f32x4* b4 = (const f32x4*)(INP(ln1_b) + l * D) + F.lane;
    for (int row = gw; row < T; row += NGW) {
        f32x4* xr = (f32x4*)(X + (size_t)row * D) + F.lane;
        f32x4 v[4];
#pragma unroll
        for (int j = 0; j < 4; ++j) v[j] = xr[64 * j];
        if (DO_LN) {
            float s = 0.f;
#pragma unroll
            for (int j = 0; j < 4; ++j) s += (v[j].x + v[j].y) + (v[j].z + v[j].w);
            const float mean = wsum(s, F.lane) * (1.f / D); float s2 = 0.f;
#pragma unroll
            for (int j = 0; j < 4; ++j) { v[j] = v[j] - mean; s2 += (v[j].x * v[j].x + v[j].y * v[j].y) + (v[j].z * v[j].z + v[j].w * v[j].w); }
            const float rstd = 1.f / sqrtf(wsum(s2, F.lane) * (1.f / D) + LN_EPS);
#pragma unroll
            for (int j = 0; j < 4; ++j) { v[j] = v[j] * rstd * g4[64 * j] + b4[64 * j]; if (!F.dry) xr[64 * j] = v[j]; }
        }
        const float* m = mods + (size_t)mod_row(row) * 6 * D;
        const f32x4* sh = (const f32x4*)(m + 3 * D) + F.lane; const f32x4* sc = (const f32x4*)(m + 4 * D) + F.lane;
        u32x2* o8 = (u32x2*)(HM + (size_t)row * D) + F.lane;
#pragma unroll
        for (int j = 0; j < 4; ++j) { const f32x4 h = v[j] * (sc[64 * j] + 1.f) + sh[64 * j]; u32x2 w; w.x = pkh(h.x, h.y); w.y = pkh(h.z, h.w); if (!F.dry) o8[64 * j] = w; }
    }
}

__device__ __forceinline__ void router_phase(Frame& F, CIN in, int l) {
    const int gw = F.vcu * NWAVES + F.wave, NGW = F.G * NWAVES, lane = F.lane, fr = lane & 15, fq = lane >> 4;
    const float* X = (const float*)(F.ws + WS_X);
    const float* mods = (const float*)(F.ws + WS_MODS) + (size_t)l * 9 * 6 * D;
    const f16* rth = (const f16*)(F.ws + WS_RT); const f16* rtl = rth + NE * D;
    int* cntl = (int*)(F.ws + WS_CTL) + CW_CNT + l * 128;
    unsigned long long* list = (unsigned long long*)(F.ws + WS_LIST);
    LAS float* lgs = (LAS float*)(F.lds + F.wave * 4096);
    const float rb = INP(moe_bias)[l * NE + lane];
    for (int task = gw; task < T / 16; task += NGW) {
        const int row0 = task * 16;
        const float* m = mods + (size_t)mod_row(row0) * 6 * D;
        const float* xr = X + (size_t)(row0 + fr) * D + fq * 8;
        f32x4 acc[4];
#pragma unroll
        for (int nb = 0; nb < 4; ++nb) acc[nb] = (f32x4){0.f, 0.f, 0.f, 0.f};
#pragma unroll 2
        for (int s = 0; s < 32; ++s) {
            const int k = s * 32 + fq * 8;
            const f32x4 x0 = *(const f32x4*)(xr + s * 32), x1 = *(const f32x4*)(xr + s * 32 + 4);
            const f32x4 sc0 = *(const f32x4*)(m + 4 * D + k), sc1 = *(const f32x4*)(m + 4 * D + k + 4);
            const f32x4 sh0 = *(const f32x4*)(m + 3 * D + k), sh1 = *(const f32x4*)(m + 3 * D + k + 4);
            const f32x4 h0 = x0 * (sc0 + 1.f) + sh0, h1 = x1 * (sc1 + 1.f) + sh1;
            h8 ahi, alo;
#pragma unroll
            for (int j = 0; j < 4; ++j) { ahi[j] = (f16)h0[j]; alo[j] = (f16)(h0[j] - (float)ahi[j]); ahi[4 + j] = (f16)h1[j]; alo[4 + j] = (f16)(h1[j] - (float)ahi[4 + j]); }
#pragma unroll
            for (int nb = 0; nb < 4; ++nb) {
                const h8 bhi = *(const h8*)(rth + (size_t)(nb * 16 + fr) * D + k), blo = *(const h8*)(rtl + (size_t)(nb * 16 + fr) * D + k);
                acc[nb] = __builtin_amdgcn_mfma_f32_16x16x32_f16(ahi, bhi, acc[nb], 0, 0, 0);
                acc[nb] = __builtin_amdgcn_mfma_f32_16x16x32_f16(alo, bhi, acc[nb], 0, 0, 0);
                acc[nb] = __builtin_amdgcn_mfma_f32_16x16x32_f16(ahi, blo, acc[nb], 0, 0, 0);
            }
        }
#pragma unroll
        for (int nb = 0; nb < 4; ++nb)
#pragma unroll
            for (int i = 0; i < 4; ++i) lgs[(4 * fq + i) * 64 + nb * 16 + fr] = acc[nb][i];
        LDS_WAIT(); asm volatile("" ::: "memory");
        unsigned chosen_mask = 0u; float wv[16]; int kv[16];
#pragma unroll
        for (int t = 0; t < 16; ++t) {
            const float score = 1.f / (1.f + expf(-lgs[t * 64 + lane]));
            const float sel = score + rb;
            float m1 = sel;
            m1 = fmaxf(m1, SHX(m1, 1)); m1 = fmaxf(m1, SHX(m1, 2)); m1 = fmaxf(m1, SHX(m1, 4));
            const unsigned long long eq = __ballot(sel == m1);
            const int g = lane >> 3;
            const unsigned geq = (unsigned)((eq >> (g * 8)) & 0xffull);
            const int first = __ffs(geq) - 1;
            float s2 = ((lane & 7) == first) ? -3.0e38f : sel;
            s2 = fmaxf(s2, SHX(s2, 1)); s2 = fmaxf(s2, SHX(s2, 2)); s2 = fmaxf(s2, SHX(s2, 4));
            const float gs = m1 + s2;
            int grank = 0;
#pragma unroll
            for (int gg = 0; gg < 8; ++gg) { const float o = bperm(gg * 8, gs); grank += (o > gs || (o == gs && gg < g)) ? 1 : 0; }
            const bool gsel = grank < 4;
            const float val = gsel ? sel : -3.0e38f;
            int rank = 0;
            for (int j = 0; j < 64; ++j) { const float o = bperm(j, val); rank += (o > val || (o == val && j < lane)) ? 1 : 0; }
            const bool ch = gsel && rank < TOPK;
            const float tot = wsum(ch ? score : 0.f, lane);
            wv[t] = score / tot * 2.5f; kv[t] = rank;
            chosen_mask |= ch ? (1u << t) : 0u;
        }
        const int half = row0 >= TH ? 1 : 0;
        const int nch = __popc(chosen_mask);
        int base = 0;
        if (nch && !F.dry) base = atomicAdd(cntl + half * 64 + lane, nch);
        unsigned long long* lp = list + ((size_t)half * NE + lane) * TH;
        int pos = base;
#pragma unroll
        for (int t = 0; t < 16; ++t) if ((chosen_mask & (1u << t)) && !F.dry) {
            const unsigned tokh = (unsigned)(row0 + t - half * TH);
            lp[pos++] = ((unsigned long long)((tokh << 4) | (unsigned)kv[t]) << 32) | (unsigned long long)__float_as_uint(wv[t]);
        }
        LDS_WAIT(); asm volatile("" ::: "memory");
    }
}


constexpr int RL_PITCH = 1032;
constexpr int RL_LO = 16 * RL_PITCH * 2, RL_PART = 2 * RL_LO;
constexpr int RL_ENT = RL_PART + 32768, RL_MAXTASK = 18, RL_CNT = RL_ENT + RL_MAXTASK * 128 * 16, RL_BASE = RL_CNT + 512;
static_assert(RL_BASE + 512 <= 147456 - 1088, "router LDS map");
__device__ __forceinline__ void ln1_router_phase(Frame& F, CIN in, int l) {
    const int lane = F.lane, w = F.wave, fr = lane & 15, fq = lane >> 4;
    float* X = (float*)(F.ws + WS_X); f16* HM = (f16*)(F.ws + WS_HMH);
    const float* mods = (const float*)(F.ws + WS_MODS) + (size_t)l * 9 * 6 * D;
    const f32x4* g4 = (const f32x4*)(INP(ln1_g) + l * D) + lane; const f32x4* b4 = (const f32x4*)(INP(ln1_b) + l * D) + lane;
    int* cntl = (int*)(F.ws + WS_CTL) + CW_CNT + l * 128;
    unsigned long long* list = (unsigned long long*)(F.ws + WS_LIST);
    LAS f16* ahi = (LAS f16*)F.lds; LAS f16* alo = (LAS f16*)(F.lds + RL_LO); LAS float* part = (LAS float*)(F.lds + RL_PART);
    const f16* rth = (const f16*)(F.ws + WS_RT); const f16* rtl = rth + NE * D;
    h8 bh[4][4];
#pragma unroll
    for (int s = 0; s < 4; ++s)
#pragma unroll
        for (int nb = 0; nb < 4; ++nb) { const size_t o = (size_t)(nb * 16 + fr) * D + 128 * w + 32 * s + 8 * fq; bh[s][nb] = *(const h8*)(rth + o); }
    const float rb = INP(moe_bias)[l * NE + lane];
    if (F.tid < 128) ((LAS int*)(F.lds + RL_CNT))[F.tid] = 0;
    __syncthreads();
    int ti = 0;
    for (int task = F.bid; task < T / 16 && ti < RL_MAXTASK; task += F.G, ++ti) {
        const int row0 = task * 16;
        if (l == DEPTH - 1 && row0 % SE >= S) { --ti; continue; }
        const float* m = mods + (size_t)mod_row(row0) * 6 * D;
        f32x4 va[2][4], pg[4], pb[4], psh[4], psc[4];
#pragma unroll
        for (int j = 0; j < 4; ++j) {
            va[0][j] = ((const f32x4*)(X + (size_t)(row0 + 2 * w) * D) + lane)[64 * j]; va[1][j] = ((const f32x4*)(X + (size_t)(row0 + 2 * w + 1) * D) + lane)[64 * j];
            pg[j] = g4[64 * j]; pb[j] = b4[64 * j]; psh[j] = ((const f32x4*)(m + 3 * D) + lane)[64 * j]; psc[j] = ((const f32x4*)(m + 4 * D) + lane)[64 * j];
        }
        asm volatile("" ::: "memory");
#pragma unroll
        for (int rr = 0; rr < 2; ++rr) {
            const int lr = 2 * w + rr, row = row0 + lr;
            f32x4* xr = (f32x4*)(X + (size_t)row * D) + lane;
            f32x4 v[4]; float s = 0.f;
#pragma unroll
            for (int j = 0; j < 4; ++j) { v[j] = va[rr][j]; s += (v[j].x + v[j].y) + (v[j].z + v[j].w); }
            const float mean = wsum(s, lane) * (1.f / D); float s2 = 0.f;
#pragma unroll
            for (int j = 0; j < 4; ++j) { v[j] = v[j] - mean; s2 += (v[j].x * v[j].x + v[j].y * v[j].y) + (v[j].z * v[j].z + v[j].w * v[j].w); }
            const float rstd = 1.f / sqrtf(wsum(s2, lane) * (1.f / D) + LN_EPS);
            u32x2* o8 = (u32x2*)(HM + (size_t)row * D) + lane;
#pragma unroll
            for (int j = 0; j < 4; ++j) {
                v[j] = v[j] * rstd * pg[j] + pb[j];
                if (!F.dry) xr[64 * j] = v[j];
                const f32x4 h = v[j] * (psc[j] + 1.f) + psh[j];
                h4 hh, hl;
#pragma unroll
                for (int q = 0; q < 4; ++q) { hh[q] = (f16)h[q]; hl[q] = (f16)(h[q] - (float)hh[q]); }
                if (!F.dry) o8[64 * j] = __builtin_bit_cast(u32x2, hh);
                *(LAS h4*)(ahi + lr * RL_PITCH + 4 * lane + 256 * j) = hh; *(LAS h4*)(alo + lr * RL_PITCH + 4 * lane + 256 * j) = hl;
            }
        }
        __syncthreads();
        {
            h8 bl[4][4];
#pragma unroll
            for (int s = 0; s < 4; ++s)
#pragma unroll
                for (int nb = 0; nb < 4; ++nb) bl[s][nb] = *(const h8*)(rtl + (size_t)(nb * 16 + fr) * D + 128 * w + 32 * s + 8 * fq);
            f32x4 acc[4];
#pragma unroll
            for (int nb = 0; nb < 4; ++nb) acc[nb] = (f32x4){0.f, 0.f, 0.f, 0.f};
#pragma unroll
            for (int s = 0; s < 4; ++s) {
                const int k = 128 * w + 32 * s + 8 * fq;
                const h8 xh = *(const LAS h8*)(ahi + fr * RL_PITCH + k), xl = *(const LAS h8*)(alo + fr * RL_PITCH + k);
#pragma unroll
                for (int nb = 0; nb < 4; ++nb) {
                    acc[nb] = __builtin_amdgcn_mfma_f32_16x16x32_f16(xh, bh[s][nb], acc[nb], 0, 0, 0);
                    acc[nb] = __builtin_amdgcn_mfma_f32_16x16x32_f16(xl, bh[s][nb], acc[nb], 0, 0, 0);
                    acc[nb] = __builtin_amdgcn_mfma_f32_16x16x32_f16(xh, bl[s][nb], acc[nb], 0, 0, 0);
                }
            }
#pragma unroll
            for (int nb = 0; nb < 4; ++nb)
#pragma unroll
                for (int i = 0; i < 4; ++i) part[(w * 16 + 4 * fq + i) * 64 + nb * 16 + fr] = acc[nb][i];
        }
        __syncthreads();
        {
            unsigned chosen_mask = 0u; float wv[2]; int kv[2];
#pragma unroll
            for (int t = 0; t < 2; ++t) {
                const int lt = 2 * w + t;
                float lg = 0.f;
#pragma unroll
                for (int ww = 0; ww < 8; ++ww) lg += part[(ww * 16 + lt) * 64 + lane];
                const float score = 1.f / (1.f + expf(-lg));
                const float sel = score + rb;
                float m1 = sel;
                m1 = fmaxf(m1, SHX(m1, 1)); m1 = fmaxf(m1, SHX(m1, 2)); m1 = fmaxf(m1, SHX(m1, 4));
                const unsigned long long eq = __ballot(sel == m1);
                const int g = lane >> 3;
                const unsigned geq = (unsigned)((eq >> (g * 8)) & 0xffull);
                const int first = __ffs(geq) - 1;
                float s2 = ((lane & 7) == first) ? -3.0e38f : sel;
                s2 = fmaxf(s2, SHX(s2, 1)); s2 = fmaxf(s2, SHX(s2, 2)); s2 = fmaxf(s2, SHX(s2, 4));
                const float gs = m1 + s2;
                int grank = 0;
#pragma unroll
                for (int gg = 0; gg < 8; ++gg) { const float o = __int_as_float(__builtin_amdgcn_readlane(__float_as_int(gs), gg * 8)); grank += (o > gs || (o == gs && gg < g)) ? 1 : 0; }
                const bool gsel = grank < 4;
                const float val = gsel ? sel : -3.0e38f;
                int rank = 0;
#pragma unroll
                for (int j = 0; j < 64; ++j) { const float o = __int_as_float(__builtin_amdgcn_readlane(__float_as_int(val), j)); rank += (o > val || (o == val && j < lane)) ? 1 : 0; }
                const bool ch = gsel && rank < TOPK;
                const float tot = wsum(ch ? score : 0.f, lane);
                wv[t] = score / tot * 2.5f; kv[t] = rank;
                chosen_mask |= ch ? (1u << t) : 0u;
            }
            const int half = row0 >= TH ? 1 : 0;
#pragma unroll
            for (int t = 0; t < 2; ++t) if (chosen_mask & (1u << t)) {
                const unsigned lrank = (unsigned)__hip_atomic_fetch_add((LAS int*)(F.lds + RL_CNT) + half * 64 + lane, 1, __ATOMIC_RELAXED, __HIP_MEMORY_SCOPE_WORKGROUP);
                const unsigned tokh = (unsigned)(row0 + 2 * w + t - half * TH);
                u32x4 en; en.x = __float_as_uint(wv[t]); en.y = (tokh << 4) | (unsigned)kv[t]; en.z = (unsigned)(half * 64 + lane); en.w = lrank;
                ((LAS u32x4*)(F.lds + RL_ENT))[(ti * 16 + 2 * w + t) * 8 + kv[t]] = en;
            }
        }
        __syncthreads();
    }
    const int ntask = ti;
    if (F.tid < 128) {
        const int n = ((LAS int*)(F.lds + RL_CNT))[F.tid];
        ((LAS int*)(F.lds + RL_BASE))[F.tid] = (n && !F.dry) ? atomicAdd(cntl + F.tid, n) : 0;
    }
    __syncthreads();
    for (int idx = F.tid; idx < ntask * 128; idx += NTHR) {
        const u32x4 en = ((const LAS u32x4*)(F.lds + RL_ENT))[idx];
        const int he = (int)en.z; const int pos = ((const LAS int*)(F.lds + RL_BASE))[he] + (int)en.w;
        if (!F.dry) list[(size_t)he * TH + pos] = ((unsigned long long)en.y << 32) | (unsigned long long)en.x;
    }
    __syncthreads();
}
__device__ __forceinline__ void convert_router(Frame& F, CIN in, int l) {
    f16* rth = (f16*)(F.ws + WS_RT); f16* rtl = rth + NE * D;
    const float* rw = INP(moe_router) + (size_t)l * D * NE;
    for (int i = (F.vcu * NTHR + F.tid); i < NE * D; i += F.G * NTHR) { const int k = i / NE, n = i % NE; const float wgt = rw[i]; const f16 h = (f16)wgt; rth[n * D + k] = h; rtl[n * D + k] = (f16)(wgt - (float)h); }
}

__device__ __forceinline__ void moe_up_phase(Frame& F, int l, int half, int Gs, int cs) {
    LAS int* tab = (LAS int*)(F.lds + pg::STAGE_BYTES);
    const int* cnt = (const int*)(F.ws + WS_CTL) + CW_CNT + l * 128 + half * 64;
    const int lat_only = l == DEPTH - 1;
    int nt_other = 0;
    if (!lat_only && half == 0) { moe_build_tab(F, cnt + 64, tab); nt_other = __builtin_amdgcn_readfirstlane(tab[64]); __syncthreads(); }
    moe_build_tab(F, cnt, tab);
    MoeSched<2, true> Sc; Sc.tab = tab; Sc.G = Gs; Sc.c = cs; Sc.half = half; Sc.list = (const unsigned long long*)(F.ws + WS_LIST);
    Sc.Abase = (const char*)(F.ws + WS_HMH); Sc.Bbase = (const char*)(F.ws + WS_W13); Sc.NT = __builtin_amdgcn_readfirstlane(tab[64]); Sc.lat_only = lat_only;
    Sc.sh_mode = lat_only ? 0 : (half == 0 ? 1 : 2); Sc.NT_other = nt_other;
    EpiUp E; E.H = (f16*)(F.ws + (half ? WS_Y : WS_H)); E.Hother = (f16*)(F.ws + (half ? WS_H : WS_Y));
    pg::gemm_phase<EpiUp, MoeSched<2, true>, true>(F.lds, F.wave, D, D, D, Sc, E);
}
__device__ __forceinline__ void moe_down_phase(Frame& F, int l, int half, int Gs, int cs) {
    LAS int* tab = (LAS int*)(F.lds + pg::STAGE_BYTES);
    const int* cnt = (const int*)(F.ws + WS_CTL) + CW_CNT + l * 128 + half * 64;
    moe_build_tab(F, cnt, tab);
    MoeSched<4, false> Sc; Sc.tab = tab; Sc.G = Gs; Sc.c = cs; Sc.half = half; Sc.list = (const unsigned long long*)(F.ws + WS_LIST);
    Sc.Abase = (const char*)(F.ws + (half ? WS_Y : WS_H)); Sc.Bbase = (const char*)(F.ws + WS_W2); Sc.NT = __builtin_amdgcn_readfirstlane(tab[64]); Sc.lat_only = l == DEPTH - 1; Sc.sh_mode = 0; Sc.NT_other = 0;
    EpiDown E; E.SL = (f16*)(F.ws + WS_SLOT); E.list = Sc.list; E.half = half; E.dry = F.dry;
    pg::gemm_phase<EpiDown, MoeSched<4, false>, true>(F.lds, F.wave, DEXP, DEXP, DEXP, Sc, E);
}
__device__ __forceinline__ void ln2_rows(Frame& F, CIN in, float* out, int l, int half) {
    const int gw = F.vcu * NWAVES + F.wave, NGW = F.G * NWAVES;
    float* X = (float*)(F.ws + WS_X); f16* HM = (f16*)(F.ws + WS_HMH); const f16* SL = (const f16*)(F.ws + WS_SLOT);
    const float* mods = (const float*)(F.ws + WS_MODS) + (size_t)l * 9 * 6 * D;
    const f32x4* g4 = (const f32x4*)(INP(ln2_g) + l * D) + F.lane; const f32x4* b4 = (const f32x4*)(INP(ln2_b) + l * D) + F.lane;
    f32x4 gL[4], bL[4];
#pragma unroll
    for (int j = 0; j < 4; ++j) { gL[j] = g4[64 * j]; bL[j] = b4[64 * j]; }
    for (int th = gw; th < TH; th += NGW) {
        const int row = half * TH + th;
        if (l == DEPTH - 1 && row % SE >= S) continue;
        const float* m = mods + (size_t)mod_row(row) * 6 * D;
        f32x4* xr = (f32x4*)(X + (size_t)row * D) + F.lane;
        const f32x4* gt = (const f32x4*)(m + 5 * D) + F.lane;
        f32x4 v[4]; float s = 0.f;
        h4 q[4][9]; f32x4 xv[4], gv[4], shv[4], scv[4];
        const float* mn = mods + (size_t)9 * 6 * D + (size_t)mod_row(row) * 6 * D;
#pragma unroll
        for (int j = 0; j < 4; ++j) {
#pragma unroll
            for (int k = 0; k < 9; ++k) q[j][k] = *((const h4*)(SL + ((size_t)th * 9 + k) * D) + F.lane + 64 * j);
            xv[j] = xr[64 * j]; gv[j] = gt[64 * j];
            if (l + 1 < DEPTH) { shv[j] = ((const f32x4*)(mn) + F.lane)[64 * j]; scv[j] = ((const f32x4*)(mn + D) + F.lane)[64 * j]; }
        }
        asm volatile("" ::: "memory");
#pragma unroll
        for (int j = 0; j < 4; ++j) {
            f32x4 f = (f32x4){0.f, 0.f, 0.f, 0.f};
#pragma unroll
            for (int k = 0; k < 9; ++k) f += (f32x4){(float)q[j][k][0], (float)q[j][k][1], (float)q[j][k][2], (float)q[j][k][3]};
            v[j] = xv[j] * ALPHA + gv[j] * f; s += (v[j].x + v[j].y) + (v[j].z + v[j].w);
        }
        const float mean = wsum(s, F.lane) * (1.f / D); float s2 = 0.f;
#pragma unroll
        for (int j = 0; j < 4; ++j) { v[j] = v[j] - mean; s2 += (v[j].x * v[j].x + v[j].y * v[j].y) + (v[j].z * v[j].z + v[j].w * v[j].w); }
        const float rstd = 1.f / sqrtf(wsum(s2, F.lane) * (1.f / D) + LN_EPS);
#pragma unroll
        for (int j = 0; j < 4; ++j) { v[j] = v[j] * rstd * gL[j] + bL[j]; if (!F.dry) xr[64 * j] = v[j]; }
        if (l + 1 < DEPTH) {
            u32x2* o8 = (u32x2*)(HM + (size_t)row * D) + F.lane;
#pragma unroll
            for (int j = 0; j < 4; ++j) { const f32x4 h = v[j] * (scv[j] + 1.f) + shv[j]; u32x2 w; w.x = pkh(h.x, h.y); w.y = pkh(h.z, h.w); if (!F.dry) o8[64 * j] = w; }
        } else {
            const int b = row / SE, ii = row - b * SE;
            if (ii < S) { f32x4* o = (f32x4*)(out + ((size_t)b * S + ii) * D) + F.lane;
#pragma unroll
                for (int j = 0; j < 4; ++j) if (!F.dry) o[64 * j] = v[j]; }
        }
    }
}
#ifndef FFT_HD
#define FFT_HD __host__ __device__ __forceinline__
#endif
namespace fft {
constexpr int N = 8192, LOGN = 13, NPAD = N + N / 8;
FFT_HD int pidx(int i) { return i + (i >> 3); }
FFT_HD int brev(int k) { return (int)(__builtin_bitreverse32((unsigned)k) >> (32 - LOGN)); }
typedef float c2 __attribute__((ext_vector_type(2)));
FFT_HD c2 cmul(c2 a, c2 b) { return c2{a.x * b.x - a.y * b.y, a.x * b.y + a.y * b.x}; }
FFT_HD c2 cmulc(c2 a, c2 b) { return c2{a.x * b.x + a.y * b.y, a.y * b.x - a.x * b.y}; }
FFT_HD c2 tw(float frac) {
#if defined(__HIP_DEVICE_COMPILE__)
    return c2{__builtin_amdgcn_cosf(frac), -__builtin_amdgcn_sinf(frac)};
#else
    return c2{(float)cos(6.283185307179586 * (double)frac), (float)-sin(6.283185307179586 * (double)frac)};
#endif
}
template <int LOG, bool INV, class BP, class TP>
FFT_HD void pass_group(BP buf, TP tab, int h2, int gidx) {
    constexpr int R = 1 << LOG;
    const int hi = gidx / h2, lo = gidx - hi * h2, base = hi * (R * h2) + lo;
    c2 x[R];
#pragma unroll
    for (int m = 0; m < R; ++m) x[m] = buf[pidx(base + m * h2)];
    if (!INV) {
#pragma unroll
        for (int q = 0; q < LOG; ++q) { const int mq = R >> (q + 1); const int sc = N / (2 * mq * h2);
#pragma unroll
            for (int m = 0; m < R; ++m) if ((m & mq) == 0) { const c2 w = tab[pidx(((m % mq) * h2 + lo) * sc)]; const c2 a = x[m], b = x[m + mq];
                x[m] = c2{a.x + b.x, a.y + b.y}; x[m + mq] = cmul(c2{a.x - b.x, a.y - b.y}, w); } }
    } else {
#pragma unroll
        for (int q = LOG - 1; q >= 0; --q) { const int mq = R >> (q + 1); const int sc = N / (2 * mq * h2);
#pragma unroll
            for (int m = 0; m < R; ++m) if ((m & mq) == 0) { const c2 w = tab[pidx(((m % mq) * h2 + lo) * sc)]; const c2 a = x[m], t = cmulc(x[m + mq], w);
                x[m] = c2{a.x + t.x, a.y + t.y}; x[m + mq] = c2{a.x - t.x, a.y - t.y}; } }
    }
#pragma unroll
    for (int m = 0; m < R; ++m) buf[pidx(base + m * h2)] = x[m];
}
}
__device__ __forceinline__ void pro_mods(Frame& F, CIN in) {
    const int gw = F.vcu * NWAVES + F.wave, NGW = F.G * NWAVES, lane = F.lane;
    float* mods = (float*)(F.ws + WS_MODS);
    for (int task = gw; task < DEPTH * 96 * 16; task += NGW) {
        const int l = task / 1536, r0 = task - l * 1536, jb = r0 >> 4, kc = r0 & 15, col = jb * 64 + lane, k = kc * 64 + lane;
        float cv[9];
#pragma unroll
        for (int r = 0; r < 9; ++r) { const float v = r < 8 ? INP(c)[r * D + k] : INP(c_ctx)[k]; cv[r] = v / (1.f + expf(-v)); }
        float acc[9];
#pragma unroll
        for (int r = 0; r < 9; ++r) acc[r] = 0.f;
        const float* w = INP(w_ada) + ((size_t)l * D + kc * 64) * 6 * D + col;
#pragma unroll 4
        for (int kk = 0; kk < 64; ++kk) { const float wv = w[(size_t)kk * 6 * D];
#pragma unroll
            for (int r = 0; r < 9; ++r) acc[r] += __shfl(cv[r], kk) * wv; }
        const float bb = kc == 0 ? INP(b_ada)[l * 6 * D + col] : 0.f;
#pragma unroll
        for (int r = 0; r < 9; ++r) if (!F.dry) atomicAdd(&mods[((size_t)l * 9 + r) * 6 * D + col], acc[r] + bb);
    }
}
__device__ __forceinline__ void pro_init_x(Frame& F, CIN in) {
    const int gw = F.vcu * NWAVES + F.wave, NGW = F.G * NWAVES;
    float* X = (float*)(F.ws + WS_X);
    for (int row = gw; row < T; row += NGW) {
        const int b = row / SE, ii = row - b * SE;
        const f32x4* src = (const f32x4*)(ii < S ? INP(x) + ((size_t)b * S + ii) * D : INP(ctx) + ((size_t)b * CL + (ii - S)) * D) + F.lane;
        f32x4* dst = (f32x4*)(X + (size_t)row * D) + F.lane;
        f32x4 t4[4];
#pragma unroll
        for (int j = 0; j < 4; ++j) t4[j] = src[64 * j];
#pragma unroll
        for (int j = 0; j < 4; ++j) dst[64 * j] = t4[j];
    }
}
__device__ __forceinline__ void pro_z2(Frame& F, CIN in) {
    const int gw = F.vcu * NWAVES + F.wave, NGW = F.G * NWAVES, lane = F.lane;
    float* Z2 = (float*)(F.ws + WS_Z2);
    for (int task = gw; task < DEPTH * SE; task += NGW) {
        const int l = task / SE, ti = task - l * SE, L = ti < S ? S : CL, t = ti < S ? ti : ti - S;
        const float* w1 = INP(hy_w1) + l * 33 * 64; const float* w2 = INP(hy_w2) + l * 4096; const float* sf = INP(hy_sin_freq) + l * 128;
        const double PI2 = 6.283185307179586476925;
        const float tt = (float)((double)t / (double)(L - 1));
        const float ang = (float)(PI2 / (double)L) * (float)t;
        float a = INP(hy_b1)[l * 64 + lane];
        a += tt * w1[lane];
        for (int j = 0; j < 16; ++j) {
            const float band = (float)(1e-4 + (double)j * ((15.0 - 1e-4) / 15.0));
            const float arg = band * ang;
            a += cosf(arg) * w1[(1 + j) * 64 + lane];
            a += -sinf(arg) * w1[(17 + j) * 64 + lane];
        }
        const float z1 = sinf(sf[lane] * a);
        float a2 = INP(hy_b2)[l * 64 + lane];
        for (int i = 0; i < 64; ++i) a2 += __shfl(z1, i) * w2[i * 64 + lane];
        Z2[(size_t)task * 64 + lane] = sinf(sf[64 + lane] * a2);
    }
}
__device__ __forceinline__ void init_mod1_rows(Frame& F, CIN in) {
    const int gw = F.vcu * NWAVES + F.wave, NGW = F.G * NWAVES;
    float* X = (float*)(F.ws + WS_X); f16* HM = (f16*)(F.ws + WS_HMH);
    const float* mods = (const float*)(F.ws + WS_MODS);
    for (int row = gw; row < T; row += NGW) {
        const int b = row / SE, ii = row - b * SE;
        const f32x4* src = (const f32x4*)(ii < S ? INP(x) + ((size_t)b * S + ii) * D : INP(ctx) + ((size_t)b * CL + (ii - S)) * D) + F.lane;
        const float* m = mods + (size_t)(ii < S ? b : 8) * 6 * D;
        const f32x4* sh = (const f32x4*)(m) + F.lane; const f32x4* sc = (const f32x4*)(m + D) + F.lane;
        f32x4* dst = (f32x4*)(X + (size_t)row * D) + F.lane; u32x2* o8 = (u32x2*)(HM + (size_t)row * D) + F.lane;
        f32x4 xv[4], sv[4], cv[4];
#pragma unroll
        for (int j = 0; j < 4; ++j) { xv[j] = src[64 * j]; sv[j] = sh[64 * j]; cv[j] = sc[64 * j]; }
#pragma unroll
        for (int j = 0; j < 4; ++j) { dst[64 * j] = xv[j]; const f32x4 h = xv[j] * (cv[j] + 1.f) + sv[j]; u32x2 w; w.x = pkh(h.x, h.y); w.y = pkh(h.z, h.w); o8[64 * j] = w; }
    }
}
__device__ __forceinline__ void mod1_rows(Frame& F, int l) {
    const int gw = F.vcu * NWAVES + F.wave, NGW = F.G * NWAVES;
    const float* X = (const float*)(F.ws + WS_X); f16* HM = (f16*)(F.ws + WS_HMH);
    const float* mods = (const float*)(F.ws + WS_MODS) + (size_t)l * 9 * 6 * D;
    for (int row = gw; row < T; row += NGW) {
        const f32x4* xr = (const f32x4*)(X + (size_t)row * D) + F.lane;
        const float* m = mods + (size_t)mod_row(row) * 6 * D;
        const f32x4* sh = (const f32x4*)(m) + F.lane; const f32x4* sc = (const f32x4*)(m + D) + F.lane;
        u32x2* o8 = (u32x2*)(HM + (size_t)row * D) + F.lane;
        f32x4 xv[4], sv[4], cv[4];
#pragma unroll
        for (int j = 0; j < 4; ++j) { xv[j] = xr[64 * j]; sv[j] = sh[64 * j]; cv[j] = sc[64 * j]; }
#pragma unroll
        for (int j = 0; j < 4; ++j) { const f32x4 h = xv[j] * (cv[j] + 1.f) + sv[j]; u32x2 w; w.x = pkh(h.x, h.y); w.y = pkh(h.z, h.w); o8[64 * j] = w; }
    }
}

typedef LAS fft::c2* LBuf;
#define FFT_OPQ(t) asm volatile("" : "+v"(t))
typedef const LAS fft::c2* LTab;
constexpr int LDS_FFT_TAB = fft::NPAD * 8, LDS_FFT_END = LDS_FFT_TAB + (fft::N / 2 + fft::N / 16) * 8;
__device__ __forceinline__ void fft_fill_tab(LAS unsigned char* lds, int tid) {
    LAS fft::c2* tab = (LAS fft::c2*)(lds + LDS_FFT_TAB);
    for (int i = tid; i < fft::N / 2; i += NTHR) tab[fft::pidx(i)] = fft::tw((float)i * (1.0f / (float)fft::N));
    __syncthreads();
}
__device__ __forceinline__ void fft_fwd(LBuf buf, int tid) {
    LTab tab = (LTab)((const LAS unsigned char*)buf + LDS_FFT_TAB);
    FFT_OPQ(tid); fft::pass_group<4, false>(buf, tab, 512, tid); __syncthreads();
    FFT_OPQ(tid); fft::pass_group<3, false>(buf, tab, 64, tid); FFT_OPQ(tid); fft::pass_group<3, false>(buf, tab, 64, tid + 512); __syncthreads();
    FFT_OPQ(tid); fft::pass_group<3, false>(buf, tab, 8, tid); FFT_OPQ(tid); fft::pass_group<3, false>(buf, tab, 8, tid + 512); __syncthreads();
    FFT_OPQ(tid); fft::pass_group<3, false>(buf, tab, 1, tid); FFT_OPQ(tid); fft::pass_group<3, false>(buf, tab, 1, tid + 512); __syncthreads();
}
__device__ __forceinline__ void fft_inv(LBuf buf, int tid) {
    LTab tab = (LTab)((const LAS unsigned char*)buf + LDS_FFT_TAB);
    FFT_OPQ(tid); fft::pass_group<3, true>(buf, tab, 1, tid); FFT_OPQ(tid); fft::pass_group<3, true>(buf, tab, 1, tid + 512); __syncthreads();
    FFT_OPQ(tid); fft::pass_group<3, true>(buf, tab, 8, tid); FFT_OPQ(tid); fft::pass_group<3, true>(buf, tab, 8, tid + 512); __syncthreads();
    FFT_OPQ(tid); fft::pass_group<3, true>(buf, tab, 64, tid); FFT_OPQ(tid); fft::pass_group<3, true>(buf, tab, 64, tid + 512); __syncthreads();
    FFT_OPQ(tid); fft::pass_group<4, true>(buf, tab, 512, tid); __syncthreads();
}
__device__ __forceinline__ float hy_delta(int c) { const float la = -3.0701134573253944f  , st = (-15.350567286626972f + 3.0701134573253944f) / 511.0f; return fabsf(la + (float)c * st); }
__device__ __forceinline__ void filters_phase(Frame& F, CIN in, int l) {
    LBuf buf = (LBuf)F.lds;
    LAS float* w3s = (LAS float*)(F.lds + LDS_FFT_END);
    fft_fill_tab(F.lds, F.tid);
    const float* Z2 = (const float*)(F.ws + WS_Z2) + (size_t)l * SE * 64;
    const float* w3 = INP(hy_w3) + (size_t)l * 64 * 1024;
    f32x4* SD = (f32x4*)(F.ws + WS_SD);
    for (int p = F.bid; p < 256; p += F.G) {
        int tid = F.tid; asm volatile("" : "+v"(tid));
        const int ca = 2 * p, cb = 2 * p + 1;
        __syncthreads();
        if (tid < 256) { const int j = tid & 63, which = tid >> 6; const int col = (which & 1 ? cb : ca) + (which >> 1 ? 512 : 0); w3s[which * 64 + j] = w3[j * 1024 + col]; }
        __syncthreads();
        const float da = hy_delta(ca), db = hy_delta(cb);
        for (int i = 0; i < 8; ++i) {
            const int t = tid + 512 * i;
            const f32x4* zr = (const f32x4*)(Z2 + (size_t)t * 64);
            float fa = 0.f, fb = 0.f, ba = 0.f, bb = 0.f;
#pragma unroll 4
            for (int j4 = 0; j4 < 16; ++j4) { const f32x4 z = zr[j4];
#pragma unroll
                for (int u = 0; u < 4; ++u) { const int j = 4 * j4 + u; fa += z[u] * w3s[j]; fb += z[u] * w3s[64 + j]; ba += z[u] * w3s[128 + j]; bb += z[u] * w3s[192 + j]; } }
            const float tt = (float)t * (1.0f / (float)(S - 1));
            const float ea = expf(-tt * da), eb = expf(-tt * db);
            buf[fft::pidx(t)] = fft::c2{fa * ea, fb * eb};
            if (t == 0) { const float zf = (float)(tid >> 16); buf[fft::pidx(S)] = fft::c2{zf, zf}; } else buf[fft::pidx(2 * S - t)] = fft::c2{ba * ea, bb * eb};
        }
        __syncthreads();
        fft_fwd(buf, tid);
        for (int j = tid; j <= S; j += NTHR) {
            const int pos = j < S ? 2 * j : 1, k = fft::brev(pos);
            const fft::c2 Xk = buf[fft::pidx(pos)], Xp = buf[fft::pidx(fft::brev((fft::N - k) & (fft::N - 1)))];
            const float gar = 0.5f * (Xk.x + Xp.x), gai = 0.5f * (Xk.y - Xp.y);
            const float ur = Xk.x - Xp.x, ui = Xk.y + Xp.y;
            const float gbr = 0.5f * ui, gbi = -0.5f * ur;
            SD[(size_t)p * 4097 + j] = (f32x4){0.5f * (gar + gbr), 0.5f * (gai + gbi), 0.5f * (gar - gbr), 0.5f * (gai - gbi)};
        }
    }
    __syncthreads();
    const int gw = F.vcu * NWAVES + F.wave, NGW = F.G * NWAVES, lane = F.lane;
    float* GC = (float*)(F.ws + WS_GC);
    const float* Z2c = Z2 + (size_t)S * 64;
    for (int task = gw; task < CL * 16; task += NGW) {
        const int t = task >> 4, col = (task & 15) * 64 + lane;
        const float* zr = Z2c + (size_t)t * 64;
        float a = 0.f;
#pragma unroll 8
        for (int j = 0; j < 64; ++j) a += zr[j] * w3[j * 1024 + col];
        const int c = col & 511;
        const float tt = (float)t * (1.0f / (float)(CL - 1));
        const float v = a * expf(-tt * hy_delta(c));
        if (col < 512) GC[(size_t)c * 512 + 256 + t] = v; else if (t >= 1) GC[(size_t)c * 512 + 256 - t] = v;
    }
}

__device__ __forceinline__ void transpose_phase(Frame& F, CIN in, int l) {
    LAS f16* tile = (LAS f16*)F.lds;
    const f16* P = (const f16*)(F.ws + WS_P);
    f16* ZT = (f16*)(F.ws + WS_ZT); f16* VT = (f16*)(F.ws + WS_VT);
    const float* cw = INP(hy_conv_w) + l * 3 * 1536; const float* cbias = INP(hy_conv_b) + l * 1536;
    const int tid = F.tid, t = tid >> 3, cg = tid & 7;
    for (int task = F.bid; task < B * 68 * 4; task += F.G) {
        const int q = task & 3, r0 = task >> 2, tl = r0 % 68, b = r0 / 68;
        const int i = tl * 64 + t, lo = i < S ? 0 : S, hi = i < S ? S : SE;
        const f16* prow = P + ((size_t)b * SE + i) * DIN;
        const bool hasp = i - 1 >= lo, hasn = i + 1 < hi;
        h8 outv[4];
        if (q < 2) {
            h8 cur[4][2], prv[4][2], nxt[4][2];
#pragma unroll
            for (int u = 0; u < 4; ++u)
#pragma unroll
                for (int part = 0; part < 2; ++part) { const int col = 512 * (part + 1) + (4 * q + u) * 64 + cg * 8;
                    cur[u][part] = *(const h8*)(prow + col);
#pragma unroll
                    for (int j = 0; j < 8; ++j) { prv[u][part][j] = (f16)0.f; nxt[u][part][j] = (f16)0.f; }
                    if (hasp) prv[u][part] = *(const h8*)(prow - DIN + col);
                    if (hasn) nxt[u][part] = *(const h8*)(prow + DIN + col); }
#pragma unroll
            for (int u = 0; u < 4; ++u) { float z[8];
#pragma unroll
                for (int part = 0; part < 2; ++part) { const int col = 512 * (part + 1) + (4 * q + u) * 64 + cg * 8;
#pragma unroll
                    for (int j = 0; j < 8; ++j) { const float uu = (float)prv[u][part][j] * cw[col + j] + (float)cur[u][part][j] * cw[1536 + col + j] + (float)nxt[u][part][j] * cw[3072 + col + j] + cbias[col + j];
                        z[j] = part == 0 ? uu : z[j] * uu; } }
#pragma unroll
                for (int j = 0; j < 8; ++j) outv[u][j] = (f16)z[j]; }
        } else {
#pragma unroll
            for (int u = 0; u < 4; ++u) outv[u] = *(const h8*)(prow + OFF_NA + 1024 + (4 * (q - 2) + u) * 64 + cg * 8);
        }
        __syncthreads();
#pragma unroll
        for (int u = 0; u < 4; ++u)
#pragma unroll
            for (int j = 0; j < 8; ++j) tile[u * 4608 + (cg * 8 + j) * 72 + t] = outv[u][j];
        __syncthreads();
        {
            const int ch = tid >> 3, part = tid & 7;
#pragma unroll
            for (int u = 0; u < 4; ++u) {
                const h8 v = *(const LAS h8*)(tile + u * 4608 + ch * 72 + part * 8);
                const int cb = q < 2 ? 4 * q + u : 4 * (q - 2) + u;
                f16* dst = (q < 2 ? ZT : VT) + ((size_t)b * DH + cb * 64 + ch) * SE + tl * 64 + part * 8;
                *(h8*)dst = v; }
        }
    }
    __syncthreads();
}

__device__ __forceinline__ void fftconv_tasks(Frame& F, CIN in, int l, int pflags) {
    LBuf buf = (LBuf)F.lds;
    f16* ZT = (f16*)(F.ws + WS_ZT); const f16* VHT = (const f16*)(F.ws + WS_VHT);
    const f32x4* SD = (const f32x4*)(F.ws + WS_SD);
    const float* bd = INP(hy_bias_d) + l * DH;
    const float* cwl = INP(hy_conv_w) + l * 3 * 1536; const float* cbl = INP(hy_conv_b) + l * 1536;
    fft_fill_tab(F.lds, F.tid);
    for (int task = F.bid; task < B * 256; task += F.G) {
        int tid = F.tid; asm volatile("" : "+v"(tid));
        const int b = task & 7, p = task >> 3;
        f16* za = ZT + ((size_t)b * DH + 2 * p) * SE; f16* zb = za + SE;
        const f16* ha = VHT + ((size_t)b * DH + 2 * p) * SE; const f16* hb = ha + SE;
        const int t0 = tid * 8;
        h8 va, vb;
        {
            const h8 xa = *(const h8*)(za + t0), xb = *(const h8*)(zb + t0), wa = *(const h8*)(ha + t0), wb = *(const h8*)(hb + t0);
            const bool hp = t0 > 0, hn = t0 + 8 < S;
            const f16 zf = (f16)0.f;
            const f16 xap = hp ? za[t0 - 1] : zf, xan = hn ? za[t0 + 8] : zf, xbp = hp ? zb[t0 - 1] : zf, xbn = hn ? zb[t0 + 8] : zf;
            const f16 wap = hp ? ha[t0 - 1] : zf, wan = hn ? ha[t0 + 8] : zf, wbp = hp ? hb[t0 - 1] : zf, wbn = hn ? hb[t0 + 8] : zf;
            const int ca = 2 * p, cbb = 2 * p + 1;
            const float x1a0 = cwl[512 + ca], x1a1 = cwl[1536 + 512 + ca], x1a2 = cwl[3072 + 512 + ca], x1ab = cbl[512 + ca];
            const float x1b0 = cwl[512 + cbb], x1b1 = cwl[1536 + 512 + cbb], x1b2 = cwl[3072 + 512 + cbb], x1bb = cbl[512 + cbb];
            const float vha0 = cwl[1024 + ca], vha1 = cwl[1536 + 1024 + ca], vha2 = cwl[3072 + 1024 + ca], vhab = cbl[1024 + ca];
            const float vhb0 = cwl[1024 + cbb], vhb1 = cwl[1536 + 1024 + cbb], vhb2 = cwl[3072 + 1024 + cbb], vhbb = cbl[1024 + cbb];
#pragma unroll
            for (int j = 0; j < 8; ++j) {
                const float xa_m = (float)(j == 0 ? xap : xa[j == 0 ? 0 : j - 1]), xa_p = (float)(j == 7 ? xan : xa[j == 7 ? 7 : j + 1]);
                const float xb_m = (float)(j == 0 ? xbp : xb[j == 0 ? 0 : j - 1]), xb_p = (float)(j == 7 ? xbn : xb[j == 7 ? 7 : j + 1]);
                const float wa_m = (float)(j == 0 ? wap : wa[j == 0 ? 0 : j - 1]), wa_p = (float)(j == 7 ? wan : wa[j == 7 ? 7 : j + 1]);
                const float wb_m = (float)(j == 0 ? wbp : wb[j == 0 ? 0 : j - 1]), wb_p = (float)(j == 7 ? wbn : wb[j == 7 ? 7 : j + 1]);
                const float ua = xa_m * x1a0 + (float)xa[j] * x1a1 + xa_p * x1a2 + x1ab, ub = xb_m * x1b0 + (float)xb[j] * x1b1 + xb_p * x1b2 + x1bb;
                const float ya = wa_m * vha0 + (float)wa[j] * vha1 + wa_p * vha2 + vhab, yb = wb_m * vhb0 + (float)wb[j] * vhb1 + wb_p * vhb2 + vhbb;
                va[j] = (f16)(ua * ya); vb[j] = (f16)(ub * yb);
            }
        }
        f32x4 sdv[8];
#pragma unroll
        for (int i = 0; i < 8; ++i) sdv[i] = SD[(size_t)p * 4097 + tid + NTHR * i];
        __syncthreads();
#pragma unroll
        for (int j = 0; j < 8; ++j) { buf[fft::pidx(t0 + j)] = fft::c2{(float)va[j], (float)vb[j]}; buf[fft::pidx(S + t0 + j)] = fft::c2{0.f, 0.f}; }
        __syncthreads();
        if (!(pflags & 128)) fft_fwd(buf, tid);
#pragma unroll
        for (int i = 0; i < 9; ++i) {
            if (i < 8 || tid == 0) {
                const int pos = i < 8 ? 2 * (tid + NTHR * i) : 1, k = fft::brev(pos);
                const int pa = fft::pidx(pos), pp = fft::pidx(fft::brev((fft::N - k) & (fft::N - 1)));
                const fft::c2 Xk = buf[pa], Xp = buf[pp]; const f32x4 sd = i < 8 ? sdv[i < 8 ? i : 0] : SD[(size_t)p * 4097 + S];
                const fft::c2 Sv{sd[0], sd[1]}, Dv{sd[2], sd[3]};
                const fft::c2 t1 = fft::cmul(Xk, Sv), t2 = fft::cmul(fft::c2{Xp.x, -Xp.y}, Dv);
                const fft::c2 u1 = fft::cmulc(Xp, Sv), u2 = fft::cmulc(fft::c2{Xk.x, -Xk.y}, Dv);
                buf[pa] = fft::c2{t1.x + t2.x, t1.y + t2.y};
                if (pp != pa) buf[pp] = fft::c2{u1.x + u2.x, u1.y + u2.y};
            }
        }
        __syncthreads();
        if (!(pflags & 256)) fft_inv(buf, tid);
        const float ba = bd[2 * p], bb = bd[2 * p + 1];
        h8 oa, ob;
#pragma unroll
        for (int j = 0; j < 8; ++j) { const fft::c2 y = buf[fft::pidx(t0 + j)]; oa[j] = (f16)(y.x * (1.f / fft::N) + (float)va[j] * ba); ob[j] = (f16)(y.y * (1.f / fft::N) + (float)vb[j] * bb); }
        if (!F.dry) { *(h8*)(za + t0) = oa; *(h8*)(zb + t0) = ob; }
    }
    __syncthreads();
}
__device__ __forceinline__ void ctxconv_tasks(Frame& F, CIN in, int l) {
    const int gw = F.vcu * NWAVES + F.wave, NGW = F.G * NWAVES, lane = F.lane;
    f16* ZT = (f16*)(F.ws + WS_ZT); const f16* VHT = (const f16*)(F.ws + WS_VHT);
    const float* GC = (const float*)(F.ws + WS_GC);
    const float* cwl = INP(hy_conv_w) + l * 3 * 1536; const float* cbl = INP(hy_conv_b) + l * 1536;
    for (int task = gw; task < B * DH; task += NGW) {
        const int c = task & (DH - 1);
        f16* zp = ZT + (size_t)task * SE + S; const f16* hp = VHT + (size_t)task * SE + S;
        float zv[4], acc[4];
        {
            const float xw0 = cwl[512 + c], xw1 = cwl[1536 + 512 + c], xw2 = cwl[3072 + 512 + c], xbb = cbl[512 + c];
            const float vw0 = cwl[1024 + c], vw1 = cwl[1536 + 1024 + c], vw2 = cwl[3072 + 1024 + c], vbb = cbl[1024 + c];
#pragma unroll
            for (int j = 0; j < 4; ++j) { const int t = lane + 64 * j;
                const float xm = t > 0 ? (float)zp[t - 1] : 0.f, x0 = (float)zp[t], xp = t + 1 < CL ? (float)zp[t + 1] : 0.f;
                const float vm = t > 0 ? (float)hp[t - 1] : 0.f, v0 = (float)hp[t], vp = t + 1 < CL ? (float)hp[t + 1] : 0.f;
                zv[j] = (float)(f16)((xm * xw0 + x0 * xw1 + xp * xw2 + xbb) * (vm * vw0 + v0 * vw1 + vp * vw2 + vbb)); acc[j] = 0.f; }
        }
        const float* g = GC + (size_t)c * 512 + 256 + lane;
#pragma unroll
        for (int sj = 0; sj < 4; ++sj)
            for (int s0 = 0; s0 < 64; ++s0) { const float zs = bperm(s0, zv[sj]); const int s = sj * 64 + s0;
#pragma unroll
                for (int j = 0; j < 4; ++j) acc[j] += g[64 * j - s] * zs; }
        const float bdv = INP(hy_bias_d)[l * DH + c];
#pragma unroll
        for (int j = 0; j < 4; ++j) if (!F.dry) zp[lane + 64 * j] = (f16)(acc[j] + zv[j] * bdv);
    }
}
constexpr int AT_KP = 72, AT_VP = 264;
constexpr int AT_VOFF = 256 * AT_KP * 2;
constexpr int AT_RPB = AT_VOFF + 64 * AT_VP * 2;
template <bool LOCAL>
__device__ __forceinline__ void attn_wtask(Frame& F, const float* rpb_l, int b, int h, int r, int n, int qrow0, int pf = 0) {
    const int lane = lane_id(), fr = lane & 15, fq = lane >> 4;
    const f16* P = (const f16*)(F.ws + WS_P); const f16* VT = (const f16*)(F.ws + WS_VT); f16* Y = (f16*)(F.ws + WS_Y);
    const LAS f16* Kc = (const LAS f16*)F.lds; const LAS f16* VcT = (const LAS f16*)(F.lds + AT_VOFF);
    const int rs = r - 4 < 0 ? 0 : (r - 4 > 56 ? 56 : r - 4);
    const int kb = n == 0 ? 0 : (n == 1 ? 8 : (n == 2 ? 24 : 32));
    const f16* Pb = P + (size_t)b * SE * DIN;
    const f16* qp = Pb + (size_t)(qrow0 + fr) * DIN + OFF_NA + h * 64 + fq * 8;
    const h8 bq0 = *(const h8*)qp, bq1 = *(const h8*)(qp + 32);
    const char* kub = (const char*)(Pb + OFF_NA + 512 + h * 64);
    const unsigned klo = (unsigned)fq * 16u;
    const f16* vbase = VT + ((size_t)b * DH + h * 64 + fr) * SE + 8 * fq;
    const int ko = 8 * (fr >> 2) + (fr & 3);
    const int qc = 16 * n + fr; const int cs = qc - 8 < 0 ? 0 : (qc - 8 > 48 ? 48 : qc - 8);
    float mrun = -3.0e38f, lsum = 0.f;
    f32x4 o[4];
#pragma unroll
    for (int d = 0; d < 4; ++d) o[d] = (f32x4){0.f, 0.f, 0.f, 0.f};
    constexpr int NCH = LOCAL ? 2 : 1;
#pragma unroll
    for (int ch = 0; ch < NCH; ++ch) {
        if (LOCAL && ((ch == 0 && (pf & 8192)) || (ch == 1 && (pf & 16384)))) continue;
        const bool loc = LOCAL && ch == 0;
        f32x4 st[16];
        if (loc) {
            h8 kf[3][8];
#pragma unroll
            for (int g0 = 0; g0 < 2; ++g0)
#pragma unroll
                for (int q = 0; q < 4; ++q) { const int tl = 4 * g0 + q; const char* kp = kub + ((unsigned)((rs + (tl >> 1)) * 64 + kb + 4 * (tl & 1) + ko) * (unsigned)(DIN * 2) + klo); kf[g0][2 * q] = *(const h8*)kp; kf[g0][2 * q + 1] = *(const h8*)(kp + 64); }
#pragma unroll
            for (int g = 0; g < 4; ++g) {
                if (g + 2 < 4) {
#pragma unroll
                    for (int q = 0; q < 4; ++q) { const int tl = 4 * (g + 2) + q; const char* kp = kub + ((unsigned)((rs + (tl >> 1)) * 64 + kb + 4 * (tl & 1) + ko) * (unsigned)(DIN * 2) + klo);
                        kf[(g + 2) % 3][2 * q] = *(const h8*)kp; kf[(g + 2) % 3][2 * q + 1] = *(const h8*)(kp + 64); }
                }
                asm volatile("" ::: "memory");
#pragma unroll
                for (int q = 0; q < 4; ++q) { f32x4 acc = (f32x4){0.f, 0.f, 0.f, 0.f};
                    acc = __builtin_amdgcn_mfma_f32_16x16x32_f16(kf[g % 3][2 * q], bq0, acc, 0, 0, 0);
                    acc = __builtin_amdgcn_mfma_f32_16x16x32_f16(kf[g % 3][2 * q + 1], bq1, acc, 0, 0, 0);
                    st[4 * g + q] = acc; }
            }
        } else {
#pragma unroll
            for (int tl = 0; tl < 16; ++tl) {
                const LAS f16* kp = Kc + (32 * (tl >> 1) + 4 * (tl & 1) + ko) * AT_KP + fq * 8;
                const h8 a0 = *(const LAS h8*)kp, a1 = *(const LAS h8*)(kp + 32);
                f32x4 acc = (f32x4){0.f, 0.f, 0.f, 0.f};
                acc = __builtin_amdgcn_mfma_f32_16x16x32_f16(a0, bq0, acc, 0, 0, 0);
                acc = __builtin_amdgcn_mfma_f32_16x16x32_f16(a1, bq1, acc, 0, 0, 0);
                st[tl] = acc;
                if ((tl & 3) == 3) asm volatile("" ::: "memory");
            }
        }
        h8 vf[4][4];
        if (loc) {
#pragma unroll
            for (int pre = 0; pre < 3; ++pre)
#pragma unroll
                for (int d = 0; d < 4; ++d) vf[pre][d] = *(const h8*)(vbase + (size_t)d * 16 * SE + (rs + pre) * 64 + kb);
        }
        float mx = -3.0e38f;
        if (loc) {
            const LAS float* rp = (const LAS float*)(F.lds + AT_RPB) + h * 15 * 32;
            const int cbase = kb + 8 * fq - qc + 15;
#pragma unroll
            for (int sp = 0; sp < 8; ++sp) {
                const LAS float* rrow = rp + (rs + sp - r + 7) * 32;
                float bz[8];
#pragma unroll
                for (int e = 0; e < 8; ++e) { int ci = cbase + e; ci = ci < 0 ? 0 : (ci > 30 ? 30 : ci); bz[e] = rrow[ci]; }
#pragma unroll
                for (int e = 0; e < 8; ++e) { const int kcol = kb + 8 * fq + e; const bool ok = kcol >= cs && kcol < cs + 16;
                    const float sv = ok ? st[2 * sp + (e >> 2)][e & 3] * 0.125f + bz[e] : -1.0e30f;
                    st[2 * sp + (e >> 2)][e & 3] = sv; mx = fmaxf(mx, sv); }
            }
        } else {
#pragma unroll
            for (int tl = 0; tl < 16; ++tl)
#pragma unroll
                for (int i = 0; i < 4; ++i) { const float sv = st[tl][i] * 0.125f; st[tl][i] = sv; mx = fmaxf(mx, sv); }
        }
        mx = fmaxf(mx, SHX(mx, 16)); mx = fmaxf(mx, SHX(mx, 32));
        const float mnew = fmaxf(mrun, mx), alpha = __expf(mrun - mnew);
        mrun = mnew;
        float ps = 0.f;
#pragma unroll
        for (int tl = 0; tl < 16; ++tl)
#pragma unroll
            for (int i = 0; i < 4; ++i) { const float pv = __expf(st[tl][i] - mnew); st[tl][i] = pv; ps += pv; }
        ps += SHX(ps, 16); ps += SHX(ps, 32);
        lsum = lsum * alpha + ps;
        if (ch > 0) {
#pragma unroll
            for (int i = 0; i < 4; ++i) { const float al = bperm(4 * fq + i, alpha);
#pragma unroll
                for (int d = 0; d < 4; ++d) o[d][i] *= al; }
        }
        if (loc) {
#pragma unroll
            for (int sp = 0; sp < 8; ++sp) {
                if (sp + 3 < 8) {
#pragma unroll
                    for (int d = 0; d < 4; ++d) vf[(sp + 3) & 3][d] = *(const h8*)(vbase + (size_t)d * 16 * SE + (rs + sp + 3) * 64 + kb);
                }
                asm volatile("" ::: "memory");
                h8 pa;
#pragma unroll
                for (int i = 0; i < 4; ++i) { pa[i] = (f16)st[2 * sp][i]; pa[4 + i] = (f16)st[2 * sp + 1][i]; }
#pragma unroll
                for (int d = 0; d < 4; ++d) o[d] = __builtin_amdgcn_mfma_f32_16x16x32_f16(pa, vf[sp & 3][d], o[d], 0, 0, 0);
            }
        } else {
#pragma unroll
            for (int sp = 0; sp < 8; ++sp) {
                h8 pa;
#pragma unroll
                for (int i = 0; i < 4; ++i) { pa[i] = (f16)st[2 * sp][i]; pa[4 + i] = (f16)st[2 * sp + 1][i]; }
#pragma unroll
                for (int d = 0; d < 4; ++d) {
                    const h8 bv = *(const LAS h8*)(VcT + (16 * d + fr) * AT_VP + 32 * sp + 8 * fq);
                    o[d] = __builtin_amdgcn_mfma_f32_16x16x32_f16(pa, bv, o[d], 0, 0, 0);
                }
                if (sp & 1) asm volatile("" ::: "memory");
            }
        }
    }
    const float inv = 1.f / lsum;
    f16* yb = Y + ((size_t)b * SE + qrow0) * 1536 + 1024 + h * 64 + fr;
#pragma unroll
    for (int i = 0; i < 4; ++i) { const float sc = bperm(4 * fq + i, inv);
#pragma unroll
        for (int d = 0; d < 4; ++d) yb[(size_t)(4 * fq + i) * 1536 + 16 * d] = (f16)(o[d][i] * sc); }
}
__device__ __forceinline__ void attn_tasks(Frame& F, CIN in, int l, int pf) {
    const float* rpb_l = INP(na_rpb) + (size_t)l * NHEAD * 15 * 31;
    const f16* P = (const f16*)(F.ws + WS_P); const f16* VT = (const f16*)(F.ws + WS_VT);
    LAS f16* Kc = (LAS f16*)F.lds; LAS f16* VcT = (LAS f16*)(F.lds + AT_VOFF);
    constexpr int NBT = 64 * 34;
    { LAS float* rp = (LAS float*)(F.lds + AT_RPB); __syncthreads();
      for (int i = F.tid; i < NHEAD * 15 * 31; i += NTHR) { const int hh = i / 465, rem = i - hh * 465, ri = rem / 31, ci = rem - ri * 31; rp[(hh * 15 + ri) * 32 + ci] = rpb_l[i]; } }
    const int t_lo = (int)(((long)F.bid * NBT) / F.G), t_hi = (int)(((long)(F.bid + 1) * NBT) / F.G);
    int staged = -1;
    __syncthreads();
    for (int bt = t_lo; bt < t_hi; ++bt) {
        const int bh = bt / 34, j = bt - bh * 34, b = bh >> 3, h = bh & 7;
        if (bh != staged) {
            __syncthreads();
            const int tid = F.wave * 64 + lane_id();
            h8 tk[4], tv[4];
#pragma unroll
            for (int i = 0; i < 4; ++i) { const int idx = tid + NTHR * i, key = idx >> 3, part = idx & 7;
                tk[i] = *(const h8*)(P + ((size_t)b * SE + S + key) * DIN + OFF_NA + 512 + h * 64 + part * 8); }
#pragma unroll
            for (int i = 0; i < 4; ++i) { const int idx = tid + NTHR * i, d = idx >> 5, part = idx & 31;
                tv[i] = *(const h8*)(VT + ((size_t)b * DH + h * 64 + d) * SE + S + part * 8); }
#pragma unroll
            for (int i = 0; i < 4; ++i) { const int idx = tid + NTHR * i; *(LAS h8*)(Kc + (idx >> 3) * AT_KP + (idx & 7) * 8) = tk[i]; *(LAS h8*)(VcT + (idx >> 5) * AT_VP + (idx & 31) * 8) = tv[i]; }
            staged = bh;
            __syncthreads();
        }
        const int w = F.wave;
        if (j < 32) { const int r = 2 * j + (w >> 2), n = w & 3; attn_wtask<true>(F, rpb_l, b, h, r, n, r * 64 + 16 * n, pf); }
        else if (l + 1 < DEPTH) { const int qb = (j - 32) * 8 + w; attn_wtask<false>(F, rpb_l, b, h, 0, 0, S + 16 * qb); }
    }
    __syncthreads();
}

__device__ __forceinline__ void ymix_phase(Frame& F, CIN in, int l) {
    LAS f16* tile = (LAS f16*)F.lds;
    const f16* P = (const f16*)(F.ws + WS_P); const f16* ZT = (const f16*)(F.ws + WS_ZT); f16* Y = (f16*)(F.ws + WS_Y);
    const float* cw = INP(hy_conv_w) + l * 3 * 1536; const float* cbias = INP(hy_conv_b) + l * 1536; const float* scw = INP(sc_conv_w) + l * 3 * DH;
    const int tid = F.tid;
    {
        const int c0 = (tid & 63) * 8, rsub = tid >> 6;
        float w0[8], w1[8], w2[8];
#pragma unroll
        for (int j = 0; j < 8; ++j) { w0[j] = scw[c0 + j]; w1[j] = scw[512 + c0 + j]; w2[j] = scw[1024 + c0 + j]; }
        const int rows_per = (T + F.G - 1) / F.G, rbeg = F.bid * rows_per, rend = rbeg + rows_per < T ? rbeg + rows_per : T;
        for (int row = rbeg + rsub; row < rend; row += 8) {
            const int b = row / SE, i = row - b * SE, lo = i < S ? 0 : S, hi = i < S ? S : SE;
            const f16* ps = P + (size_t)row * DIN + OFF_SC + c0;
            const h8 bg = *(const h8*)ps, c1 = *(const h8*)(ps + 512), x1 = *(const h8*)(ps + 1024);
            h8 c0v, x0v, c2v, x2v;
#pragma unroll
            for (int j = 0; j < 8; ++j) { c0v[j] = (f16)0.f; x0v[j] = (f16)0.f; c2v[j] = (f16)0.f; x2v[j] = (f16)0.f; }
            if (i - 1 >= lo) { c0v = *(const h8*)(ps - DIN + 512); x0v = *(const h8*)(ps - DIN + 1024); }
            if (i + 1 < hi) { c2v = *(const h8*)(ps + DIN + 512); x2v = *(const h8*)(ps + DIN + 1024); }
            h8 o;
#pragma unroll
            for (int j = 0; j < 8; ++j) { const float v = (float)c0v[j] * (float)x0v[j] * w0[j] + (float)c1[j] * (float)x1[j] * w1[j] + (float)c2v[j] * (float)x2v[j] * w2[j];
                o[j] = (f16)((float)bg[j] * v); }
            *(h8*)(Y + (size_t)row * 1536 + 512 + c0) = o;
        }
    }
    const int t = tid >> 3, cg = tid & 7;
    for (int task = F.bid; task < B * 68 * 2; task += F.G) {
        const int q = task & 1, r0 = task >> 1, tl = r0 % 68, b = r0 / 68;
        const int i = tl * 64 + t, lo = i < S ? 0 : S, hi = i < S ? S : SE;
        const f16* prow = P + ((size_t)b * SE + i) * DIN;
        f16* yrow = Y + ((size_t)b * SE + i) * 1536;
        const bool hasp = i - 1 >= lo, hasn = i + 1 < hi;
        h8 yt[4], cur[4], prv[4], nxt[4];
        { const int ch = tid >> 3, part = tid & 7;
#pragma unroll
          for (int u = 0; u < 4; ++u) yt[u] = *(const h8*)(ZT + ((size_t)b * DH + (4 * q + u) * 64 + ch) * SE + tl * 64 + part * 8); }
#pragma unroll
        for (int u = 0; u < 4; ++u) { const int c0 = (4 * q + u) * 64 + cg * 8;
            cur[u] = *(const h8*)(prow + c0);
#pragma unroll
            for (int j = 0; j < 8; ++j) { prv[u][j] = (f16)0.f; nxt[u][j] = (f16)0.f; }
            if (hasp) prv[u] = *(const h8*)(prow - DIN + c0);
            if (hasn) nxt[u] = *(const h8*)(prow + DIN + c0); }
        __syncthreads();
        { const int ch = tid >> 3, part = tid & 7;
#pragma unroll
          for (int u = 0; u < 4; ++u) *(LAS h8*)(tile + u * 4608 + ch * 72 + part * 8) = yt[u]; }
        __syncthreads();
#pragma unroll
        for (int u = 0; u < 4; ++u) { const int c0 = (4 * q + u) * 64 + cg * 8; h8 o;
#pragma unroll
            for (int j = 0; j < 8; ++j) { const float x0 = (float)prv[u][j] * cw[c0 + j] + (float)cur[u][j] * cw[1536 + c0 + j] + (float)nxt[u][j] * cw[3072 + c0 + j] + cbias[c0 + j];
                o[j] = (f16)(x0 * (float)tile[u * 4608 + (cg * 8 + j) * 72 + t]); }
            *(h8*)(yrow + c0) = o; }
    }
    __syncthreads();
}

struct TileOrder {
    int nM, nN, nwg, G, c;
    __device__ __forceinline__ void init(int M, int N, int G_, int c_) { nM = M / 256; nN = N / 256; nwg = nM * nN; G = G_; c = c_; }
    __device__ __forceinline__ bool tile(int i, int& pm, int& pn) const {
        const long L = (long)i * G + c; if (L >= nwg) return false;
        int wgid = (int)L; { const int q = nwg / 8, r = nwg % 8, xcd = wgid % 8, off = wgid / 8; wgid = (xcd < r ? xcd * (q + 1) : r * (q + 1) + (xcd - r) * q) + off; }
        const int nig = 8 * nN, gid = wgid / nig, fm = gid * 8, gsz = (nM - fm) < 8 ? (nM - fm) : 8;
        pm = fm + ((wgid % nig) % gsz); pn = (wgid % nig) / gsz; return true;
    }
};
template <int SUB>
struct DenseSched {
    static constexpr bool GATHER = false;
    TileOrder O; const char* A; const char* Bm; int lda, ldb; size_t a_sub, b_sub; int lat_only;
    __device__ __forceinline__ bool next(int i, pg::Unit& u) const {
        const int ti = i / SUB, s = i - ti * SUB; int pm, pn;
        if (!O.tile(ti, pm, pn)) return false;
        if (lat_only) pm = (pm >> 4) * 17 + (pm & 15);
        u.pm = pm; u.pn = pn; u.e = s; u.nrows = 256; u.aux0 = 0;
        u.A = A + (size_t)pm * 256 * lda * 2 + s * a_sub; u.B = Bm + (size_t)pn * 256 * ldb * 2 + s * b_sub;
        return true;
    }
    __device__ __forceinline__ int arow(const pg::Unit&, int r) const { return r; }
};
struct EpiInproj {
    static constexpr bool PERM = true; static constexpr int NVM = 16;
    __device__ __forceinline__ bool full(const pg::Unit&) const { return !dry; }
    f16* O; f16* X1T; f16* VHT; f16* VT; int dry;
    __device__ __forceinline__ void operator()(const f32x4 (&acc)[2][2][4][2], const pg::Unit& u, int wr, int wc, int fr, int fq) const {
        const int pn = u.pn;
        f16* tb = (pn == 2 || pn == 3) ? X1T : ((pn == 4 || pn == 5) ? VHT : ((pn == 16 || pn == 17) ? VT : nullptr));
        if (tb == nullptr) {
#pragma unroll
            for (int ai = 0; ai < 2; ++ai)
#pragma unroll
                for (int m = 0; m < 4; ++m) { f16* rowp = O + (size_t)(u.pm * 256 + ai * 128 + wr * 64 + m * 16 + fr) * DIN + pn * 256 + wc * 64 + 8 * fq;
#pragma unroll
                    for (int bj = 0; bj < 2; ++bj) { const f32x4 v0 = acc[ai][bj][m][0], v1 = acc[ai][bj][m][1];
                        u32x4 o; o.x = pkh(v0[0], v0[1]); o.y = pkh(v0[2], v0[3]); o.z = pkh(v1[0], v1[1]); o.w = pkh(v1[2], v1[3]);
                        if (!dry || o.x == 0x12345678u) *(u32x4*)(rowp + bj * 32) = o; } }
        } else {
            const int row_t = u.pm * 256, b = row_t / SE, i0 = row_t - b * SE;
            const int ch0 = (pn & 1) * 256 + wc * 64 + 8 * fq;
            f16* cb = tb + ((size_t)b * DH + ch0) * SE + i0 + wr * 64 + fr;
#pragma unroll
            for (int bj = 0; bj < 2; ++bj)
#pragma unroll
                for (int e = 0; e < 8; ++e) { f16* cp = cb + (size_t)(bj * 32 + e) * SE;
#pragma unroll
                    for (int ai = 0; ai < 2; ++ai)
#pragma unroll
                        for (int m = 0; m < 4; ++m) if (!dry) cp[ai * 128 + m * 16] = (f16)acc[ai][bj][m][e >> 2][e & 3]; }
        }
    }
};
struct EpiBranch {
    static constexpr bool PERM = true; static constexpr int NVM = 16;
    __device__ __forceinline__ bool full(const pg::Unit&) const { return pf == 0; }
    const f16* P; f16* MG; u32x4* scr; int tid, pf;
    __device__ __forceinline__ void operator()(const f32x4 (&acc)[2][2][4][2], const pg::Unit& u, int wr, int wc, int fr, int fq) const {
        const int br = (pf & 512) ? 2 : u.e;
        const int col0 = u.pn * 256 + wc * 64 + 8 * fq;
        const size_t row0 = (size_t)(u.pm * 256 + wr * 64 + fr);
        const f16* gp = P + row0 * DIN + OFF_GATE + br * D + col0;
        f16* mp = MG + row0 * D + col0;
        u32x4* sp = scr + tid;
        h8 G[2][2]; u32x4 Sv[2][2];
        if (!(pf & 1024)) { G[0][0] = *(const h8*)gp; G[0][1] = *(const h8*)(gp + 32); } else { G[0][0] = __builtin_bit_cast(h8, (u32x4){(unsigned)fr, 0u, 0u, 0u}); G[0][1] = G[0][0]; G[1][0] = G[0][0]; G[1][1] = G[0][0]; }
        if (br == 1 || (br == 2 && !(pf & 512))) { Sv[0][0] = sp[0]; Sv[0][1] = sp[NTHR]; }
#pragma unroll
        for (int g = 0; g < 8; ++g) {
            const int ai = g >> 2, m = g & 3, cb = g & 1, nb = cb ^ 1;
            const f16* gpn = gp + ((m == 3 ? (size_t)(128 - 48) : (size_t)16) * DIN); u32x4* spn = sp + 2 * NTHR;
            if (g < 7) {
                if (!(pf & 1024)) { G[nb][0] = *(const h8*)gpn; G[nb][1] = *(const h8*)(gpn + 32); }
                if (br == 1 || (br == 2 && !(pf & 512))) { Sv[nb][0] = spn[0]; Sv[nb][1] = spn[NTHR]; }
            }
            asm volatile("" ::: "memory");
#pragma unroll
            for (int bj = 0; bj < 2; ++bj) {
                const h8 gg = G[cb][bj];
                f32x4 v0 = acc[ai][bj][m][0], v1 = acc[ai][bj][m][1];
#pragma unroll
                for (int j = 0; j < 4; ++j) { v0[j] *= sigm((float)gg[j]); v1[j] *= sigm((float)gg[4 + j]); }
                if (br == 1 || (br == 2 && !(pf & 512))) { const h8 pv = __builtin_bit_cast(h8, Sv[cb][bj]);
#pragma unroll
                    for (int j = 0; j < 4; ++j) { v0[j] += (float)pv[j]; v1[j] += (float)pv[4 + j]; } }
                u32x4 o; o.x = pkh(v0[0], v0[1]); o.y = pkh(v0[2], v0[3]); o.z = pkh(v1[0], v1[1]); o.w = pkh(v1[2], v1[3]);
                if (br < 2) sp[(size_t)bj * NTHR] = o; else if (!(pf & 2048)) *(u32x4*)(mp + bj * 32) = o;
            }
            gp = gpn; sp = spn; mp += (m == 3 ? (size_t)(128 - 48) : (size_t)16) * D;
            asm volatile("" : "+v"(gp), "+v"(mp), "+v"(sp) :: "memory");
        }
    }
};
struct EpiOut {
    static constexpr bool PERM = false; static constexpr int NVM = 32;
    __device__ __forceinline__ bool full(const pg::Unit&) const { return !dry; }
    float* X; const float* mods_l; int dry;
    __device__ __forceinline__ void operator()(const f32x4 (&acc)[2][2][4][2], const pg::Unit& u, int wr, int wc, int fr, int fq) const {
        const int row_t = u.pm * 256;
        const float* gt = mods_l + (size_t)mod_row(row_t) * 6 * D + 2 * D + u.pn * 256 + wc * 32 + 4 * fq;
        f32x4 gv[2][2];
#pragma unroll
        for (int bj = 0; bj < 2; ++bj)
#pragma unroll
            for (int n = 0; n < 2; ++n) gv[bj][n] = *(const f32x4*)(gt + bj * 128 + n * 16);
        float* xp = X + (size_t)(row_t + wr * 64 + fr) * D + u.pn * 256 + wc * 32 + 4 * fq;
        f32x4 Xv[2][4];
#pragma unroll
        for (int q = 0; q < 4; ++q) Xv[0][q] = *(const f32x4*)(xp + (q >> 1) * 128 + (q & 1) * 16);
#pragma unroll
        for (int g = 0; g < 8; ++g) {
            const int ai = g >> 2, m = g & 3, cb = g & 1, nb = cb ^ 1;
            float* xpn = xp + (m == 3 ? (size_t)(128 - 48) : (size_t)16) * D;
            if (g < 7) {
#pragma unroll
                for (int q = 0; q < 4; ++q) Xv[nb][q] = *(const f32x4*)(xpn + (q >> 1) * 128 + (q & 1) * 16);
            }
            asm volatile("" ::: "memory");
#pragma unroll
            for (int bj = 0; bj < 2; ++bj)
#pragma unroll
                for (int n = 0; n < 2; ++n) { const f32x4 nv_ = Xv[cb][bj * 2 + n] * ALPHA + gv[bj][n] * acc[ai][bj][m][n]; if (!dry) *(f32x4*)(xp + bj * 128 + n * 16) = nv_; }
            xp = xpn;
            asm volatile("" : "+v"(xp) :: "memory");
        }
    }
};
__device__ __forceinline__ void inproj_phase(Frame& F) {
    DenseSched<1> Sc; Sc.lat_only = 0; Sc.O.init(T, DIN, F.G, F.bid); Sc.A = (const char*)(F.ws + WS_HMH); Sc.Bm = (const char*)(F.ws + WS_WIN); Sc.lda = D; Sc.ldb = D; Sc.a_sub = 0; Sc.b_sub = 0;
    EpiInproj E; E.O = (f16*)(F.ws + WS_P); E.X1T = (f16*)(F.ws + WS_ZT); E.VHT = (f16*)(F.ws + WS_VHT); E.VT = (f16*)(F.ws + WS_VT); E.dry = F.dry;
    pg::gemm_phase<EpiInproj, DenseSched<1>, false>(F.lds, F.wave, D, D, D, Sc, E);
}
__device__ __forceinline__ void branch_phase(Frame& F, int lat_only, int pf) {
    DenseSched<3> Sc; Sc.lat_only = lat_only; Sc.O.init(lat_only ? B * S : T, D, F.G, F.bid); Sc.A = (const char*)(F.ws + WS_Y); Sc.Bm = (const char*)(F.ws + WS_PJ); Sc.lda = 1536; Sc.ldb = DH; Sc.a_sub = (size_t)DH * 2; Sc.b_sub = (size_t)D * DH * 2;
    EpiBranch E; E.P = (const f16*)(F.ws + WS_P); E.MG = (f16*)(F.ws + WS_HMH); E.scr = (u32x4*)(F.ws + WS_SCR) + (size_t)F.bid * 16 * NTHR; E.tid = F.tid; E.pf = pf;
    pg::gemm_phase<EpiBranch, DenseSched<3>, true>(F.lds, F.wave, DH, 1536, DH, Sc, E);
}
__device__ __forceinline__ void outproj_phase(Frame& F, int l) {
    const int lat_only = l == DEPTH - 1;
    DenseSched<1> Sc; Sc.lat_only = lat_only; Sc.O.init(lat_only ? B * S : T, D, F.G, F.bid); Sc.A = (const char*)(F.ws + WS_HMH); Sc.Bm = (const char*)(F.ws + WS_WO); Sc.lda = D; Sc.ldb = D; Sc.a_sub = 0; Sc.b_sub = 0;
    EpiOut E; E.X = (float*)(F.ws + WS_X); E.mods_l = (const float*)(F.ws + WS_MODS) + (size_t)l * 9 * 6 * D; E.dry = F.dry;
    pg::gemm_phase<EpiOut, DenseSched<1>, false>(F.lds, F.wave, D, D, D, Sc, E);
}
constexpr int LDS_TAB_OFF = pg::STAGE_BYTES;
constexpr int LDS_MISC_OFF = LDS_TAB_OFF + 1024;
constexpr int LDS_BYTES = 147456;
constexpr int NPH_L = 13, NPHASE = 2 + NPH_L * DEPTH;
constexpr int FLAG_HYB_MOE = 1;
constexpr int FLAG_HYB_MIX = 2;
constexpr int FLAG_DRY = 4;

template <class P> __device__ __forceinline__ P launder_uniform(P p) {
    unsigned long long v = (unsigned long long)p; unsigned lo = (unsigned)v, hi = (unsigned)(v >> 32);
    unsigned vlo, vhi;
    asm volatile("v_mov_b32 %0, %2\n\tv_mov_b32 %1, %3" : "=&v"(vlo), "=&v"(vhi) : "s"(lo), "s"(hi));
    lo = __builtin_amdgcn_readfirstlane(vlo); hi = __builtin_amdgcn_readfirstlane(vhi);
    return (P)(((unsigned long long)hi << 32) | lo);
}
typedef unsigned* gu32p;
__device__ __forceinline__ int launder_int(int v) { int o; asm volatile("v_mov_b32 %0, %1" : "=v"(o) : "s"(v)); return __builtin_amdgcn_readfirstlane(o); }
__device__ __forceinline__ void launder(Frame& F, CArgsP& ap) { F.lane = lane_id(); asm volatile("" : "+v"(F.lane)); ap = launder_uniform((CArgsP)__builtin_amdgcn_kernarg_segment_ptr()); F.ws = (GAS unsigned char*)ap->ws; F.G = launder_int(F.G); F.bid = launder_int(F.bid); F.vcu = launder_int(F.vcu); F.wave = launder_int(F.wave); F.dry = launder_int(F.dry); F.tid = F.wave * 64 + F.lane; }
#ifndef MOE_SPLIT_NUM
#define MOE_SPLIT_NUM 144
#endif
#ifndef PROBE_REP
#define PROBE_REP -1
#endif
#ifndef PROBE_SLO
#define PROBE_SLO -1
#define PROBE_SHI -1
#endif
#define REP(k, ...) do { __VA_ARGS__; if (PROBE_REP == (k)) { __syncthreads(); __VA_ARGS__; } } while (0)
__global__ void __launch_bounds__(NTHR, 2) fwd(Args a_unused) {
    CArgsP ap = (CArgsP)__builtin_amdgcn_kernarg_segment_ptr();
    extern __shared__ __attribute__((aligned(16))) unsigned char lds_raw[];
    Frame F;
    F.lds = (LAS unsigned char*)lds_raw;
    F.tid = threadIdx.x; F.lane = F.tid & 63; F.wave = __builtin_amdgcn_readfirstlane(F.tid >> 6);
    F.G = gridDim.x; F.bid = blockIdx.x; { const int bx = blockIdx.x; F.vcu = (F.G % 8 == 0) ? (bx % 8) * (F.G / 8) + bx / 8 : bx; }
    F.ws = (GAS unsigned char*)ap->ws; F.dry = (ap->flags & FLAG_DRY) ? 1 : 0;
    for (int u = F.tid; u < (1024 + 64) / 4; u += NTHR) ((LAS unsigned*)(F.lds + LDS_TAB_OFF))[u] = 0u;
    __syncthreads();
    XcdBarrier bar; bar.bar = (unsigned*)(F.ws + WS_CTL) + CW_BAR; bar.x = 0; bar.st = nullptr;
    if (ap->use_bar) bar = xcd_barrier_post((unsigned*)(F.ws + WS_CTL) + CW_BAR, (volatile LAS unsigned*)(F.lds + LDS_MISC_OFF + 32), F.tid);
#define IN(k) (launder(F, ap), ap->ph_lo <= (k) && (k) < ap->ph_hi)
#define SEAM(k) do { if (IN(k) && IN((k) + 1)) { bar.bar = (unsigned*)((unsigned char*)F.ws + WS_CTL) + CW_BAR; bar.x = (unsigned)launder_int((int)bar.x); xcd_barrier(bar, F.tid); if (PROBE_REP == 99) xcd_barrier(bar, F.tid); } } while (0)
    if (IN(0)) { pro_mods(F, ap->in); pro_z2(F, ap->in); convert_mixer_weights(F, ap->in, 0); }
    SEAM(0);
    if (IN(1)) { filters_phase(F, ap->in, 0); init_mod1_rows(F, ap->in); }
    SEAM(1);
    unsigned long long tacc = 0ull, tst = 0ull;
#define ST_B(k) do { if (PROBE_SLO == (k)) tst = __builtin_amdgcn_s_memrealtime(); } while (0)
#define ST_E(k) do { if (PROBE_SHI == (k)) tacc += __builtin_amdgcn_s_memrealtime() - tst; } while (0)
    for (int l = 0; l < DEPTH; ++l) {
        const int pb = 2 + NPH_L * l;
        ST_B(0); if (IN(pb + 0)) REP(0, inproj_phase(F));
        SEAM(pb + 0); ST_E(0);
        ST_B(2); if (IN(pb + 2)) { if (!(ap->flags & 8)) { fftconv_tasks(F, ap->in, l, ap->flags); launder(F, ap); if (l + 1 < DEPTH && !(ap->flags & 4096)) ctxconv_tasks(F, ap->in, l); launder(F, ap); } if (!(ap->flags & 16)) REP(2, attn_tasks(F, ap->in, l, F.dry ? ap->flags : 0)); }
        SEAM(pb + 2); ST_E(2);
        ST_B(3); if (IN(pb + 3)) REP(3, ymix_phase(F, ap->in, l));
        SEAM(pb + 3); ST_E(3);
        ST_B(4); if (IN(pb + 4)) REP(4, branch_phase(F, l == DEPTH - 1, F.dry ? ap->flags : 0));
        SEAM(pb + 4); ST_E(4);
        ST_B(5); if (IN(pb + 5)) { convert_router(F, ap->in, l); outproj_phase(F, l); }
        SEAM(pb + 5); ST_E(5);
        ST_B(6); if (IN(pb + 6)) { if (!(ap->flags & 64)) ln1_router_phase(F, ap->in, l); __syncthreads(); if (!(ap->flags & 32)) convert_moe_weights(F, ap->in, l); }
        SEAM(pb + 6); ST_E(6);
        ST_B(8); if (IN(pb + 8)) moe_up_phase(F, l, 0, F.G, F.bid);
        SEAM(pb + 8); ST_E(8);
        ST_B(9); if (IN(pb + 9)) moe_down_phase(F, l, 0, F.G, F.bid);
        SEAM(pb + 9); ST_E(9);
        ST_B(10); if (IN(pb + 10)) { ln2_rows(F, ap->in, (float*)ap->out, l, 0); launder(F, ap); moe_up_phase(F, l, 1, F.G, F.bid); }
        SEAM(pb + 10); ST_E(10);
        ST_B(11); if (IN(pb + 11)) moe_down_phase(F, l, 1, F.G, F.bid);
        SEAM(pb + 11); ST_E(11);
        ST_B(12); if (IN(pb + 12)) {
            if (!(ap->flags & FLAG_HYB_MIX)) ln2_rows(F, ap->in, (float*)ap->out, l, 1);
            if (l + 1 < DEPTH && !(ap->flags & FLAG_HYB_MOE)) {
                __syncthreads(); convert_mixer_weights(F, ap->in, l + 1); __syncthreads(); filters_phase(F, ap->in, l + 1);
                if (ap->flags & FLAG_HYB_MIX) mod1_rows(F, l + 1);
            }
        }
        SEAM(pb + 12); ST_E(12);
    }
    if (PROBE_SLO >= 0) {
        gu32p dbg = (gu32p)((unsigned*)(F.ws + WS_CTL) + CW_DBG);
        bar.bar = (unsigned*)((unsigned char*)F.ws + WS_CTL) + CW_BAR; xcd_barrier(bar, F.tid);
        if (F.bid == 0 && F.tid == 0) __hip_atomic_store((unsigned*)dbg, (unsigned)tacc, __ATOMIC_RELAXED, __HIP_MEMORY_SCOPE_AGENT);
        xcd_barrier(bar, F.tid);
        const unsigned tv = __hip_atomic_load((unsigned*)dbg, __ATOMIC_RELAXED, __HIP_MEMORY_SCOPE_AGENT);
        const float v = sqrtf((float)tv * (1.0f / 100000.0f));
        float* o = (float*)ap->out;
        for (size_t i = (size_t)F.bid * NTHR + F.tid; i < (size_t)B * S * D; i += (size_t)F.G * NTHR) o[i] = v;
    }
#undef IN
#undef SEAM
}

static int g_grid = 0;
static bool setup_grid() {
    if (g_grid) return g_grid > 0;
    int dev = 0, cus = 0, per_cu = 0;
    if (hipGetDevice(&dev) != hipSuccess || hipDeviceGetAttribute(&cus, hipDeviceAttributeMultiprocessorCount, dev) != hipSuccess) { g_grid = -1; return false; }
    if (hipFuncSetAttribute((const void*)fwd, hipFuncAttributeMaxDynamicSharedMemorySize, LDS_BYTES) != hipSuccess) { fprintf(stderr, "hipFuncSetAttribute failed\n"); g_grid = -1; return false; }
    if (hipOccupancyMaxActiveBlocksPerMultiprocessor(&per_cu, (const void*)fwd, NTHR, LDS_BYTES) != hipSuccess || per_cu < 1) { fprintf(stderr, "occupancy query: %d\n", per_cu); (void)hipGetLastError(); g_grid = -1; return false; }
    g_grid = cus;
    return true;
}
static void launch_phases(const Args& base, int lo, int hi, int use_bar, hipStream_t st) {
    Args a = base; a.ph_lo = lo; a.ph_hi = hi; a.use_bar = use_bar;
    hipLaunchKernelGGL(fwd, dim3(g_grid), dim3(NTHR), LDS_BYTES, st, a);
}
}
#ifndef PROBE_XFLAGS
#define PROBE_XFLAGS 0
#endif
#ifndef PROBE_PH
#define PROBE_PH -1
#endif
#ifndef HYB
#define HYB 1
#endif
#ifndef GAS
#define GAS __attribute__((address_space(1)))
#endif
extern "C" void kernel_launch(void* const* d_in, const int* in_sizes, int n_in, void* d_out, int out_size, void* d_ws, size_t ws_size, hipStream_t stream) {
    if (n_in != 34 || ws_size < fk::WS_END + (size_t)64 * fk::MiB) { fprintf(stderr, "kernel_launch: unexpected inputs / workspace (%d, %zu)\n", n_in, ws_size); return; }
    nv::In in{};
    { const float** f = (const float**)&in; for (int i = 0; i < 34; ++i) f[i] = (const float*)d_in[i]; }
    fk::Args a{};
    { const float** f = (const float**)&a.in; for (int i = 0; i < 34; ++i) f[i] = (const float*)d_in[i]; }
    a.out = (GAS float*)d_out; a.ws = (unsigned char*)d_ws;
    if (!fk::setup_grid()) return;
    (void)hipMemsetAsync((char*)d_ws + fk::WS_CTL, 0, fk::CTL_ZERO_BYTES, stream);
    nv::Ctx c = nv::make_ctx((unsigned char*)d_ws, fk::WS_DYN);
#if HYB == 0
    nv::prologue(in, c, stream);
    for (int l = 0; l < 4; ++l) { nv::mixer_layer(in, c, l, stream); nv::moe_layer(in, c, l, stream); }
    nv::finalize(c, (float*)d_out, stream);
#elif HYB == 1
    a.flags = fk::FLAG_HYB_MOE;
    nv::prologue(in, c, stream);
    for (int l = 0; l < 4; ++l) {
        nv::mixer_layer(in, c, l, stream);
        const int pb = 2 + fk::NPH_L * l;
        for (int p = pb + 6; p <= pb + 12; ++p) fk::launch_phases(a, p, p + 1, 0, stream);
    }
#elif HYB == 2
    a.flags = fk::FLAG_HYB_MIX;
    fk::launch_phases(a, 0, 1, 0, stream); fk::launch_phases(a, 1, 2, 0, stream);
    for (int l = 0; l < 4; ++l) {
        const int pb = 2 + fk::NPH_L * l;
        for (int p = pb; p <= pb + 6; ++p) fk::launch_phases(a, p, p + 1, 0, stream);
        nv::moe_layer(in, c, l, stream);
        if (l < 3) fk::launch_phases(a, pb + 12, pb + 13, 0, stream);
    }
    nv::finalize(c, (float*)d_out, stream);
#elif HYB == 3
    for (int p = 0; p < fk::NPHASE; ++p) fk::launch_phases(a, p, p + 1, 0, stream);
#elif HYB == 5
    for (int p = 0; p < fk::NPHASE; ++p) {
        const bool hit = (PROBE_PH >= 100) ? (p == PROBE_PH - 100) : (p >= 2 && (p - 2) % fk::NPH_L == PROBE_PH);
        if (hit) { fk::Args d = a; d.flags |= fk::FLAG_DRY | PROBE_XFLAGS; fk::launch_phases(d, p, p + 1, 0, stream); }
        fk::launch_phases(a, p, p + 1, 0, stream);
    }
#elif HYB == 4
    fk::launch_phases(a, 0, fk::NPHASE, 1, stream);
#endif
}
```

```cpp
#define HYB 4
#define PROBE_REP -1
#define PROBE_SLO -1
#define PROBE_SHI -1
#define PROBE_PH -1
#define PROBE_XFLAGS 0

#include <hip/hip_runtime.h>
#include <cstdio>
#include <cstdint>
namespace nv {
constexpr int B = 8, S = 4096, CL = 256, SE = S + CL, T = B * SE, D = 1024, DEPTH = 4;
constexpr int DH = 512, DIN = 7680, OFF_SC = 1536, OFF_NA = 3072, OFF_GATE = 4608;
constexpr int NE = 64, TOPK = 8, DEXP = 256;
constexpr int GRIDW = 64, NHEAD = 8, HDIM = 64;
constexpr float LN_EPS = 1e-5f;
constexpr float ALPHA = 1.681792830507429f;

__device__ __forceinline__ float sigmoidf_(float x) { return 1.f / (1.f + expf(-x)); }
__device__ __forceinline__ float siluf_(float x) { return x / (1.f + expf(-x)); }
__device__ __forceinline__ float wsum(float v) {
#pragma unroll
    for (int o = 1; o < 64; o <<= 1) v += __shfl_xor(v, o);
    return v;
}
__device__ __forceinline__ float wmax(float v) {
#pragma unroll
    for (int o = 1; o < 64; o <<= 1) v = fmaxf(v, __shfl_xor(v, o));
    return v;
}

__global__ void k_cond(const float* c, const float* c_ctx, float* cond) {
    int i = blockIdx.x * blockDim.x + threadIdx.x;
    if (i < 9 * D) { float v = i < 8 * D ? c[i] : c_ctx[i - 8 * D]; cond[i] = siluf_(v); }
}
__global__ void k_mods(const float* cond, const float* w_ada, const float* b_ada, float* mods) {
    int j = blockIdx.x * blockDim.x + threadIdx.x;
    if (j >= DEPTH * 6 * D) return;
    int l = j / (6 * D), col = j % (6 * D);
    float acc[9];
#pragma unroll
    for (int r = 0; r < 9; ++r) acc[r] = 0.f;
    const float* w = w_ada + (size_t)l * D * 6 * D + col;
    for (int k = 0; k < D; ++k) { float wv = w[(size_t)k * 6 * D];
#pragma unroll
        for (int r = 0; r < 9; ++r) acc[r] += cond[r * D + k] * wv; }
    float bb = b_ada[l * 6 * D + col];
#pragma unroll
    for (int r = 0; r < 9; ++r) mods[((size_t)l * 9 + r) * 6 * D + col] = acc[r] + bb;
}
__global__ void k_init_x(const float* x, const float* ctx, float* X) {
    size_t i = (size_t)blockIdx.x * blockDim.x + threadIdx.x;
    if (i >= (size_t)T * D) return;
    int row = (int)(i / D), d = (int)(i % D), b = row / SE, ii = row % SE;
    X[i] = ii < S ? x[((size_t)b * S + ii) * D + d] : ctx[((size_t)b * CL + (ii - S)) * D + d];
}
__global__ void k_modulate(const float* X, const float* mods_l, float* HM, int which) {
    size_t i = (size_t)blockIdx.x * blockDim.x + threadIdx.x;
    if (i >= (size_t)T * D) return;
    int row = (int)(i / D), d = (int)(i % D), b = row / SE, ii = row % SE, mb = ii < S ? b : 8;
    const float* m = mods_l + (size_t)mb * 6 * D;
    HM[i] = X[i] * (1.f + m[(which + 1) * D + d]) + m[which * D + d];
}
struct GemmP { const float* A; int lda; const int* gidx; const float* Bm; int ldb; float* C; int ldc; int M; const int* Mdev; int N, K; int mode;
               const int* sidx; const float* sw; long long eB, eG; const int* coff; const int* aoff; };
__global__ void __launch_bounds__(256) k_gemm(GemmP p) {
    __shared__ float As[16][68];
    __shared__ float Bs[16][64];
    const int z = blockIdx.z;
    const int M = p.Mdev ? p.Mdev[z] : p.M;
    const int row0 = blockIdx.y * 64, col0 = blockIdx.x * 64;
    if (row0 >= M) return;
    const float* A = p.A; const float* Bm = p.Bm + (size_t)z * p.eB;
    const int* gidx = p.gidx ? p.gidx + (size_t)z * p.eG : nullptr;
    const int* sidx = p.sidx ? p.sidx + (size_t)z * p.eG : nullptr;
    const float* sw = p.sw ? p.sw + (size_t)z * p.eG : nullptr;
    const int crow_off = p.coff ? p.coff[z] : 0;
    const int arow_off = p.aoff ? p.aoff[z] : 0;
    float* C = p.C;
    const int tid = threadIdx.x, tx = tid & 15, ty = tid >> 4;
    const int ar = tid >> 2, ak = (tid & 3) * 4;
    const int bk = tid >> 4, bn = (tid & 15) * 4;
    int arow = row0 + ar; if (arow >= M) arow = M - 1;
    const size_t asrc = gidx ? (size_t)gidx[arow] : (size_t)(arow_off + arow);
    const float* ap = A + asrc * p.lda + ak;
    const float* bp = Bm + (size_t)bk * p.ldb + col0 + bn;
    float acc[4][4];
#pragma unroll
    for (int i = 0; i < 4; ++i)
#pragma unroll
        for (int j = 0; j < 4; ++j) acc[i][j] = 0.f;
    for (int k0 = 0; k0 < p.K; k0 += 16) {
        float4 av = *(const float4*)(ap + k0);
        float4 bv = *(const float4*)(bp + (size_t)k0 * p.ldb);
        As[ak + 0][ar] = av.x; As[ak + 1][ar] = av.y; As[ak + 2][ar] = av.z; As[ak + 3][ar] = av.w;
        *(float4*)&Bs[bk][bn] = bv;
        __syncthreads();
#pragma unroll
        for (int kk = 0; kk < 16; ++kk) {
            float4 a4 = *(const float4*)&As[kk][ty * 4];
            float4 b4 = *(const float4*)&Bs[kk][tx * 4];
            float a[4] = {a4.x, a4.y, a4.z, a4.w}, b[4] = {b4.x, b4.y, b4.z, b4.w};
#pragma unroll
            for (int i = 0; i < 4; ++i)
#pragma unroll
                for (int j = 0; j < 4; ++j) acc[i][j] += a[i] * b[j];
        }
        __syncthreads();
    }
#pragma unroll
    for (int i = 0; i < 4; ++i) {
        int r = row0 + ty * 4 + i; if (r >= M) continue;
        if (p.mode == 0) {
            float* cp = C + (size_t)(crow_off + r) * p.ldc + col0 + tx * 4;
            *(float4*)cp = make_float4(acc[i][0], acc[i][1], acc[i][2], acc[i][3]);
        } else {
            int tok = sidx[r]; float w = sw[r];
            float* cp = C + (size_t)tok * p.ldc + col0 + tx * 4;
#pragma unroll
            for (int j = 0; j < 4; ++j) atomicAdd(cp + j, w * acc[i][j]);
        }
    }
}
static void gemm(hipStream_t st, const float* A, int lda, const float* Bm, int ldb, float* C, int ldc, int M, int N, int K) {
    GemmP p{}; p.A = A; p.lda = lda; p.Bm = Bm; p.ldb = ldb; p.C = C; p.ldc = ldc; p.M = M; p.N = N; p.K = K; p.mode = 0;
    hipLaunchKernelGGL(k_gemm, dim3(N / 64, (M + 63) / 64, 1), dim3(256), 0, st, p);
}

__global__ void k_hy_z2(const float* w1, const float* b1, const float* w2, const float* b2, const float* sf, int L, float* z2tab) {
    const int t = blockIdx.x * (blockDim.x / 64) + (threadIdx.x >> 6), lane = threadIdx.x & 63;
    if (t >= L) return;
    const double PI2 = 6.283185307179586476925;
    float tt = (float)((double)t / (double)(L - 1));
    float ang = (float)(PI2 / (double)L) * (float)t;
    float a = b1[lane];
    a += tt * w1[0 * 64 + lane];
    for (int j = 0; j < 16; ++j) {
        float band = (float)(1e-4 + (double)j * ((15.0 - 1e-4) / 15.0));
        float arg = band * ang;
        a += cosf(arg) * w1[(1 + j) * 64 + lane];
        a += -sinf(arg) * w1[(17 + j) * 64 + lane];
    }
    float z1 = sinf(sf[lane] * a);
    float a2 = b2[lane];
    for (int i = 0; i < 64; ++i) a2 += __shfl(z1, i) * w2[i * 64 + lane];
    z2tab[(size_t)t * 64 + lane] = sinf(sf[64 + lane] * a2);
}
__global__ void k_hy_filt(const float* z2tab, const float* w3, int L, float* hf, float* hb) {
    int i = blockIdx.x * blockDim.x + threadIdx.x;
    if (i >= L * DH) return;
    int t = i / DH, c = i % DH;
    float af = 0.f, ab = 0.f;
    for (int j = 0; j < 64; ++j) { float z = z2tab[(size_t)t * 64 + j]; af += z * w3[j * 1024 + c]; ab += z * w3[j * 1024 + 512 + c]; }
    const double la = log(1e-2) / 1.5, lb = log(1e-2) / 0.3;
    float delta = fabsf((float)(la + (double)c * ((lb - la) / 511.0)));
    float tt = (float)((double)t / (double)(L - 1));
    float dec = expf(-tt * delta);
    hf[i] = af * dec; hb[i] = ab * dec;
}
__global__ void k_hy_conv(const float* PB, const float* cw, const float* cb, float* UC) {
    int idx = blockIdx.x * blockDim.x + threadIdx.x;
    if (idx >= SE * 1536) return;
    int i = idx / 1536, c = idx % 1536;
    int lo = i < S ? 0 : S, hi = i < S ? S : SE;
    float v = PB[(size_t)i * DIN + c] * cw[1536 + c];
    if (i - 1 >= lo) v += PB[(size_t)(i - 1) * DIN + c] * cw[c];
    if (i + 1 < hi) v += PB[(size_t)(i + 1) * DIN + c] * cw[2 * 1536 + c];
    UC[idx] = v + cb[c];
}
__global__ void k_hy_z(const float* UC, float* Z) {
    int idx = blockIdx.x * blockDim.x + threadIdx.x;
    if (idx >= SE * DH) return;
    int i = idx / DH, c = idx % DH;
    Z[idx] = UC[(size_t)i * 1536 + 1024 + c] * UC[(size_t)i * 1536 + 512 + c];
}
__global__ void k_hy_long(const float* Z, const float* UC, const float* hf, const float* hb, const float* hfc, const float* hbc, const float* bias_d, float* YHY) {
    int idx = blockIdx.x * blockDim.x + threadIdx.x;
    if (idx >= SE * DH) return;
    int i = idx / DH, c = idx % DH;
    int lo = i < S ? 0 : S, L = i < S ? S : CL;
    const float* f = i < S ? hf : hfc; const float* g = i < S ? hb : hbc;
    int t = i - lo;
    float acc = 0.f;
    for (int s = 0; s <= t; ++s) acc += f[(size_t)(t - s) * DH + c] * Z[(size_t)(lo + s) * DH + c];
    for (int s = t + 1; s < L; ++s) acc += g[(size_t)(s - t) * DH + c] * Z[(size_t)(lo + s) * DH + c];
    float z = Z[idx];
    YHY[idx] = UC[(size_t)i * 1536 + c] * (acc + z * bias_d[c]);
}
__global__ void k_sconv(const float* PB, const float* cw, float* YSC) {
    int idx = blockIdx.x * blockDim.x + threadIdx.x;
    if (idx >= SE * DH) return;
    int i = idx / DH, c = idx % DH;
    int lo = i < S ? 0 : S, hi = i < S ? S : SE;
    const float* p = PB + OFF_SC;
    float v = p[(size_t)i * DIN + 512 + c] * p[(size_t)i * DIN + 1024 + c] * cw[512 + c];
    if (i - 1 >= lo) v += p[(size_t)(i - 1) * DIN + 512 + c] * p[(size_t)(i - 1) * DIN + 1024 + c] * cw[c];
    if (i + 1 < hi) v += p[(size_t)(i + 1) * DIN + 512 + c] * p[(size_t)(i + 1) * DIN + 1024 + c] * cw[1024 + c];
    YSC[idx] = p[(size_t)i * DIN + c] * v;
}
__global__ void k_attn(const float* PB, const float* rpb, float* YAT) {
    const int wt = blockIdx.x * (blockDim.x / 64) + (threadIdx.x >> 6), lane = threadIdx.x & 63;
    if (wt >= SE * NHEAD) return;
    const int i = wt / NHEAD, h = wt % NHEAD;
    const float* Q = PB + OFF_NA + h * HDIM; const float* Kp = PB + OFF_NA + 512 + h * HDIM; const float* V = PB + OFF_NA + 1024 + h * HDIM;
    const float q = Q[(size_t)i * DIN + lane];
    float m = -3.0e38f, l = 0.f, o = 0.f;
    if (i < S) {
        const int r = i / GRIDW, qc = i % GRIDW;
        int rs = r - 4; rs = rs < 0 ? 0 : (rs > 56 ? 56 : rs);
        int cs = qc - 8; cs = cs < 0 ? 0 : (cs > 48 ? 48 : cs);
        for (int j = 0; j < 8; ++j) for (int kc = cs; kc < cs + 16; ++kc) {
            const int kt = (rs + j) * GRIDW + kc;
            float s = wsum(q * Kp[(size_t)kt * DIN + lane]) * 0.125f + rpb[(h * 15 + (rs + j - r + 7)) * 31 + (kc - qc + 15)];
            float mn = fmaxf(m, s), a = expf(m - mn), pp = expf(s - mn);
            l = l * a + pp; o = o * a + pp * V[(size_t)kt * DIN + lane]; m = mn;
        }
    }
    for (int kt = S; kt < SE; ++kt) {
        float s = wsum(q * Kp[(size_t)kt * DIN + lane]) * 0.125f;
        float mn = fmaxf(m, s), a = expf(m - mn), pp = expf(s - mn);
        l = l * a + pp; o = o * a + pp * V[(size_t)kt * DIN + lane]; m = mn;
    }
    YAT[(size_t)i * DH + h * HDIM + lane] = o / l;
}
__global__ void k_merge(const float* PB, const float* T0, const float* T1, const float* T2, float* MG) {
    int idx = blockIdx.x * blockDim.x + threadIdx.x;
    if (idx >= SE * D) return;
    int i = idx / D, c = idx % D;
    const float* g = PB + (size_t)i * DIN + OFF_GATE;
    MG[idx] = sigmoidf_(g[c]) * T0[idx] + sigmoidf_(g[D + c]) * T1[idx] + sigmoidf_(g[2 * D + c]) * T2[idx];
}
__global__ void k_res_ln(float* X, const float* O, const float* mods_l, int gate_idx, const float* lg, const float* lb, int row0, int n) {
    const int w = blockIdx.x * (blockDim.x / 64) + (threadIdx.x >> 6), lane = threadIdx.x & 63;
    if (w >= n) return;
    const int row = row0 + w, b = row / SE, ii = row % SE, mb = ii < S ? b : 8;
    const float* gt = mods_l + (size_t)mb * 6 * D + gate_idx * D;
    float v[16]; float s = 0.f;
#pragma unroll
    for (int j = 0; j < 16; ++j) { int d = lane + 64 * j; v[j] = ALPHA * X[(size_t)row * D + d] + gt[d] * O[(size_t)w * D + d]; s += v[j]; }
    const float mu = wsum(s) * (1.f / D); float q = 0.f;
#pragma unroll
    for (int j = 0; j < 16; ++j) { v[j] -= mu; q += v[j] * v[j]; }
    const float rstd = rsqrtf(wsum(q) * (1.f / D) + LN_EPS);
#pragma unroll
    for (int j = 0; j < 16; ++j) { int d = lane + 64 * j; X[(size_t)row * D + d] = v[j] * rstd * lg[d] + lb[d]; }
}
__global__ void k_route(const float* logits, const float* rbias, int* cnt, int* ltok, float* lw) {
    const int tok = blockIdx.x * (blockDim.x / 64) + (threadIdx.x >> 6), lane = threadIdx.x & 63;
    if (tok >= T) return;
    const float score = sigmoidf_(logits[(size_t)tok * NE + lane]);
    const float sel = score + rbias[lane];
    float m1 = sel;
    m1 = fmaxf(m1, __shfl_xor(m1, 1)); m1 = fmaxf(m1, __shfl_xor(m1, 2)); m1 = fmaxf(m1, __shfl_xor(m1, 4));
    unsigned long long eq = __ballot(sel == m1);
    const int g = lane >> 3;
    const unsigned geq = (unsigned)((eq >> (g * 8)) & 0xffull);
    const int first = __ffs(geq) - 1;
    float s2 = ((lane & 7) == first) ? -3.0e38f : sel;
    s2 = fmaxf(s2, __shfl_xor(s2, 1)); s2 = fmaxf(s2, __shfl_xor(s2, 2)); s2 = fmaxf(s2, __shfl_xor(s2, 4));
    const float gs = m1 + s2;
    int grank = 0;
    for (int gg = 0; gg < 8; ++gg) { float o = __shfl(gs, gg * 8); if (o > gs || (o == gs && gg < g)) ++grank; }
    const bool gsel = grank < 4;
    const float val = gsel ? sel : -3.0e38f;
    int rank = 0;
    for (int j = 0; j < 64; ++j) { float o = __shfl(val, j); if (o > val || (o == val && j < lane)) ++rank; }
    const bool chosen = gsel && rank < TOPK;
    const float tot = wsum(chosen ? score : 0.f);
    if (chosen) {
        const float w = score / tot * 2.5f;
        int pos = atomicAdd(&cnt[lane], 1);
        ltok[(size_t)lane * T + pos] = tok; lw[(size_t)lane * T + pos] = w;
    }
}
__global__ void k_prefix(const int* cnt, int* off) { if (threadIdx.x == 0) { int a = 0; for (int e = 0; e < NE; ++e) { off[e] = a; a += cnt[e]; } } }
__global__ void k_swiglu(const float* U1, const float* U3, float* H, size_t n) {
    size_t i = (size_t)blockIdx.x * blockDim.x + threadIdx.x;
    if (i < n) H[i] = siluf_(U1[i]) * U3[i];
}
__global__ void k_final(const float* X, float* out) {
    size_t i = (size_t)blockIdx.x * blockDim.x + threadIdx.x;
    if (i >= (size_t)B * S * D) return;
    int d = (int)(i % D); size_t r = i / D; int b = (int)(r / S), t = (int)(r % S);
    out[i] = X[((size_t)b * SE + t) * D + d];
}

struct In {
    const float *x, *c, *ctx, *c_ctx, *w_ada, *b_ada, *w_in, *hy_conv_w, *hy_conv_b, *hy_w1, *hy_b1, *hy_w2, *hy_b2, *hy_w3, *hy_sin_freq, *hy_bias_d,
        *hy_proj, *sc_conv_w, *sc_proj, *na_rpb, *na_proj, *w_o, *ln1_g, *ln1_b, *ln2_g, *ln2_b, *moe_router, *moe_bias, *moe_w1, *moe_w3, *moe_w2, *sh_w1, *sh_w3, *sh_w2;
};


struct Ctx {
    float *X, *HM, *cond, *mods, *MIX, *PB, *UC, *Z, *YB, *T0, *T1, *T2, *MG, *OB, *z2a, *z2c, *hf, *hb, *hfc, *hbc, *logits, *lw, *U1, *U3, *F, *YHY, *YSC, *YAT;
    int *cnt, *off, *ltok;
};
static Ctx make_ctx(unsigned char* ws, size_t dyn_off) {
    Ctx c{};
    c.X = (float*)(ws + (size_t)2 * 1024 * 1024); c.mods = (float*)(ws + (size_t)1024 * 1024); c.cond = (float*)(ws + (size_t)256 * 1024);
    size_t o = dyn_off; auto alloc = [&](size_t bytes) { size_t r = o; o += (bytes + 255) & ~(size_t)255; return (void*)(ws + r); };
    c.HM = (float*)alloc((size_t)T * D * 4);
    c.MIX = (float*)alloc((size_t)SE * 16384 * 4);
    c.PB = c.MIX; c.UC = c.PB + (size_t)SE * DIN; c.Z = c.UC + (size_t)SE * 1536; c.YB = c.Z + (size_t)SE * DH;
    c.T0 = c.YB + (size_t)SE * 1536; c.T1 = c.T0 + (size_t)SE * D; c.T2 = c.T1 + (size_t)SE * D; c.MG = c.T2 + (size_t)SE * D; c.OB = c.MG + (size_t)SE * D;
    c.z2a = (float*)alloc((size_t)S * 64 * 4); c.z2c = (float*)alloc((size_t)CL * 64 * 4);
    c.hf = (float*)alloc((size_t)S * DH * 4); c.hb = (float*)alloc((size_t)S * DH * 4);
    c.hfc = (float*)alloc((size_t)CL * DH * 4); c.hbc = (float*)alloc((size_t)CL * DH * 4);
    c.logits = (float*)alloc((size_t)T * NE * 4);
    c.cnt = (int*)alloc(256); c.off = (int*)alloc(256);
    c.ltok = (int*)alloc((size_t)NE * T * 4); c.lw = (float*)alloc((size_t)NE * T * 4);
    c.U1 = (float*)alloc((size_t)T * TOPK * DEXP * 4);
    c.U3 = c.MIX; c.F = c.MIX + (size_t)32 * 1024 * 1024;
    c.YHY = c.YB; c.YSC = c.YB + (size_t)SE * DH; c.YAT = c.YB + 2 * (size_t)SE * DH;
    return c;
}
static void prologue(const In& in, const Ctx& c, hipStream_t st) {
    hipLaunchKernelGGL(k_cond, dim3((9 * D + 255) / 256), dim3(256), 0, st, in.c, in.c_ctx, c.cond);
    hipLaunchKernelGGL(k_mods, dim3(DEPTH * 6 * D / 256), dim3(256), 0, st, c.cond, in.w_ada, in.b_ada, c.mods);
    hipLaunchKernelGGL(k_init_x, dim3((unsigned)(((size_t)T * D + 255) / 256)), dim3(256), 0, st, in.x, in.ctx, c.X);
}
static void mixer_layer(const In& in, const Ctx& c, int l, hipStream_t st) {
    const unsigned gTD = (unsigned)(((size_t)T * D + 255) / 256);
    const float* ml = c.mods + (size_t)l * 9 * 6 * D;
    hipLaunchKernelGGL(k_hy_z2, dim3(S / 4), dim3(256), 0, st, in.hy_w1 + l * 33 * 64, in.hy_b1 + l * 64, in.hy_w2 + l * 4096, in.hy_b2 + l * 64, in.hy_sin_freq + l * 128, S, c.z2a);
    hipLaunchKernelGGL(k_hy_z2, dim3(CL / 4), dim3(256), 0, st, in.hy_w1 + l * 33 * 64, in.hy_b1 + l * 64, in.hy_w2 + l * 4096, in.hy_b2 + l * 64, in.hy_sin_freq + l * 128, CL, c.z2c);
    hipLaunchKernelGGL(k_hy_filt, dim3(S * DH / 256), dim3(256), 0, st, c.z2a, in.hy_w3 + (size_t)l * 64 * 1024, S, c.hf, c.hb);
    hipLaunchKernelGGL(k_hy_filt, dim3(CL * DH / 256), dim3(256), 0, st, c.z2c, in.hy_w3 + (size_t)l * 64 * 1024, CL, c.hfc, c.hbc);
    hipLaunchKernelGGL(k_modulate, dim3(gTD), dim3(256), 0, st, c.X, ml, c.HM, 0);
    for (int b = 0; b < B; ++b) {
        gemm(st, c.HM + (size_t)b * SE * D, D, in.w_in + (size_t)l * D * DIN, DIN, c.PB, DIN, SE, DIN, D);
        hipLaunchKernelGGL(k_hy_conv, dim3(SE * 1536 / 256), dim3(256), 0, st, c.PB, in.hy_conv_w + l * 3 * 1536, in.hy_conv_b + l * 1536, c.UC);
        hipLaunchKernelGGL(k_hy_z, dim3(SE * DH / 256), dim3(256), 0, st, c.UC, c.Z);
        hipLaunchKernelGGL(k_hy_long, dim3(SE * DH / 256), dim3(256), 0, st, c.Z, c.UC, c.hf, c.hb, c.hfc, c.hbc, in.hy_bias_d + l * DH, c.YHY);
        hipLaunchKernelGGL(k_sconv, dim3(SE * DH / 256), dim3(256), 0, st, c.PB, in.sc_conv_w + l * 3 * DH, c.YSC);
        hipLaunchKernelGGL(k_attn, dim3(SE * NHEAD / 4), dim3(256), 0, st, c.PB, in.na_rpb + l * NHEAD * 15 * 31, c.YAT);
        gemm(st, c.YHY, DH, in.hy_proj + (size_t)l * DH * D, D, c.T0, D, SE, D, DH);
        gemm(st, c.YSC, DH, in.sc_proj + (size_t)l * DH * D, D, c.T1, D, SE, D, DH);
        gemm(st, c.YAT, DH, in.na_proj + (size_t)l * DH * D, D, c.T2, D, SE, D, DH);
        hipLaunchKernelGGL(k_merge, dim3(SE * D / 256), dim3(256), 0, st, c.PB, c.T0, c.T1, c.T2, c.MG);
        gemm(st, c.MG, D, in.w_o + (size_t)l * D * D, D, c.OB, D, SE, D, D);
        hipLaunchKernelGGL(k_res_ln, dim3(SE / 4), dim3(256), 0, st, c.X, c.OB, ml, 2, in.ln1_g + l * D, in.ln1_b + l * D, b * SE, SE);
    }
}
static void moe_layer(const In& in, const Ctx& c, int l, hipStream_t st) {
    const unsigned gTD = (unsigned)(((size_t)T * D + 255) / 256);
    const float* ml = c.mods + (size_t)l * 9 * 6 * D;
    hipLaunchKernelGGL(k_modulate, dim3(gTD), dim3(256), 0, st, c.X, ml, c.HM, 3);
    gemm(st, c.HM, D, in.moe_router + (size_t)l * D * NE, NE, c.logits, NE, T, NE, D);
    (void)hipMemsetAsync(c.cnt, 0, 256, st);
    hipLaunchKernelGGL(k_route, dim3(T / 4), dim3(256), 0, st, c.logits, in.moe_bias + l * NE, c.cnt, c.ltok, c.lw);
    hipLaunchKernelGGL(k_prefix, dim3(1), dim3(64), 0, st, c.cnt, c.off);
    {
        GemmP p{}; p.A = c.HM; p.lda = D; p.gidx = c.ltok; p.eG = T; p.ldb = DEXP; p.ldc = DEXP; p.Mdev = c.cnt; p.N = DEXP; p.K = D; p.mode = 0; p.eB = (long long)D * DEXP; p.coff = c.off;
        p.Bm = in.moe_w1 + (size_t)l * NE * D * DEXP; p.C = c.U1;
        hipLaunchKernelGGL(k_gemm, dim3(DEXP / 64, T / 64, NE), dim3(256), 0, st, p);
        p.Bm = in.moe_w3 + (size_t)l * NE * D * DEXP; p.C = c.U3;
        hipLaunchKernelGGL(k_gemm, dim3(DEXP / 64, T / 64, NE), dim3(256), 0, st, p);
    }
    hipLaunchKernelGGL(k_swiglu, dim3((unsigned)(((size_t)T * TOPK * DEXP + 255) / 256)), dim3(256), 0, st, c.U1, c.U3, c.U1, (size_t)T * TOPK * DEXP);
    {
        float* V1 = c.U3; float* V3 = c.U3 + (size_t)T * DEXP;
        gemm(st, c.HM, D, in.sh_w1 + (size_t)l * D * DEXP, DEXP, V1, DEXP, T, DEXP, D);
        gemm(st, c.HM, D, in.sh_w3 + (size_t)l * D * DEXP, DEXP, V3, DEXP, T, DEXP, D);
        hipLaunchKernelGGL(k_swiglu, dim3((unsigned)(((size_t)T * DEXP + 255) / 256)), dim3(256), 0, st, V1, V3, V1, (size_t)T * DEXP);
        gemm(st, V1, DEXP, in.sh_w2 + (size_t)l * DEXP * D, D, c.F, D, T, D, DEXP);
    }
    {
        GemmP p{}; p.A = c.U1; p.lda = DEXP; p.aoff = c.off; p.sidx = c.ltok; p.sw = c.lw; p.eG = T; p.Bm = in.moe_w2 + (size_t)l * NE * DEXP * D; p.ldb = D; p.C = c.F; p.ldc = D; p.Mdev = c.cnt; p.N = D; p.K = DEXP; p.mode = 1;
        p.eB = (long long)DEXP * D;
        hipLaunchKernelGGL(k_gemm, dim3(D / 64, T / 64, NE), dim3(256), 0, st, p);
    }
    hipLaunchKernelGGL(k_res_ln, dim3(T / 4), dim3(256), 0, st, c.X, c.F, ml, 5, in.ln2_g + l * D, in.ln2_b + l * D, 0, T);
}
static void finalize(const Ctx& c, float* out, hipStream_t st) {
    hipLaunchKernelGGL(k_final, dim3((unsigned)(((size_t)B * S * D + 255) / 256)), dim3(256), 0, st, c.X, out);
}
}
namespace fk {
#define LAS __attribute__((address_space(3)))
#define GAS __attribute__((address_space(1)))
typedef _Float16 f16;
typedef _Float16 h8 __attribute__((ext_vector_type(8)));
typedef _Float16 h4 __attribute__((ext_vector_type(4)));
typedef _Float16 h2 __attribute__((ext_vector_type(2)));
typedef float f32x4 __attribute__((ext_vector_type(4)));
typedef float f32x2 __attribute__((ext_vector_type(2)));
typedef unsigned u32x4 __attribute__((ext_vector_type(4)));
typedef unsigned u32x2 __attribute__((ext_vector_type(2)));

constexpr int B = 8, S = 4096, CL = 256, SE = S + CL, T = B * SE, D = 1024, DEPTH = 4;
constexpr int DH = 512, DIN = 7680, OFF_SC = 1536, OFF_NA = 3072, OFF_GATE = 4608;
constexpr int NE = 64, TOPK = 8, DEXP = 256;
constexpr int GRIDW = 64, NHEAD = 8, HDIM = 64;
constexpr float LN_EPS = 1e-5f;
constexpr float ALPHA = 1.681792830507429f;
constexpr int NWAVES = 8, NTHR = 512;
constexpr int TH = T / 2;
constexpr int MAXT_H = TH * TOPK / 256 + NE;
constexpr int SH_T = TH / 256;

__device__ __forceinline__ unsigned pkh(float a, float b) { f32x2 v = {a, b}; h2 h = __builtin_convertvector(v, h2); return __builtin_bit_cast(unsigned, h); }
__device__ __forceinline__ float sigm(float x) { return __builtin_amdgcn_rcpf(1.f + __expf(-x)); }
__device__ __forceinline__ float bperm(int src, float v) { return __int_as_float(__builtin_amdgcn_ds_bpermute(src << 2, __float_as_int(v))); }
__device__ __forceinline__ int bpermi(int src, int v) { return __builtin_amdgcn_ds_bpermute(src << 2, v); }
#define SHX(v, o) bperm(lane ^ (o), (v))
__device__ __forceinline__ float wsum(float v, int lane) {
#pragma unroll
    for (int o = 1; o < 64; o <<= 1) v += SHX(v, o);
    return v;
}
__device__ __forceinline__ int lane_id() { int v; asm volatile("v_mbcnt_lo_u32_b32 %0, -1, 0\n\tv_mbcnt_hi_u32_b32 %0, -1, %0" : "=v"(v)); return v; }
#define LDS_WAIT() asm volatile("s_waitcnt lgkmcnt(0)" ::: "memory")
#define VM_WAIT() asm volatile("s_waitcnt vmcnt(0)" ::: "memory")

#define XB_TMO      128
#define XB_XCNT(j)  (256  + 64 * (j))
#define XB_XSUB(j)  (1280 + 64 * (j))
#define XB_XGEN(j)  (2304 + 64 * (j))
#define XB_TOP      3328
#define XB_TOPGEN   3392
#define XCD_BAR_WORDS 3456
#define XB_SPIN_CAP (1u << 18)
__device__ __forceinline__ unsigned xb_ld(unsigned* p)              { return __hip_atomic_load(p, __ATOMIC_RELAXED, __HIP_MEMORY_SCOPE_AGENT); }
__device__ __forceinline__ unsigned xb_add(unsigned* p, unsigned v) { return __hip_atomic_fetch_add(p, v, __ATOMIC_RELAXED, __HIP_MEMORY_SCOPE_AGENT); }
__device__ __forceinline__ unsigned xb_xcc_id() { return (unsigned)__builtin_amdgcn_s_getreg((3 << 11) | 20) & 0xFu; }
#define XB_SPIN(cond, bar) do { unsigned _sp = 0; while (cond) { __builtin_amdgcn_s_sleep(1); \
    if ((++_sp & 255u) == 0u) { if (xb_ld(&(bar)[XB_TMO])) break; if (_sp > XB_SPIN_CAP) { atomicAdd(&(bar)[XB_TMO], 1u); break; } } } } while (0)
struct XcdBarrier { unsigned* bar; unsigned x; volatile LAS unsigned* st; };
__device__ __forceinline__ XcdBarrier xcd_barrier_post(unsigned* bar, volatile LAS unsigned* st, int tid) {
    XcdBarrier b; b.bar = bar; b.x = xb_xcc_id(); b.st = st;
    if (tid == 0) (void)xb_add(&bar[XB_XCNT(b.x)], 1u);
    return b;
}
__device__ __forceinline__ void xcd_barrier_complete(unsigned* bar, unsigned x, unsigned& nloc, unsigned& nx) {
    const unsigned G = gridDim.x * gridDim.y * gridDim.z;
    unsigned sum, cnt, mine, sp = 0u;
    for (;;) {
        sum = 0u; cnt = 0u; mine = 0u;
#pragma unroll
        for (unsigned j = 0; j < 16; ++j) { const unsigned c = xb_ld(&bar[XB_XCNT(j)]); sum += c; cnt += (c > 0u) ? 1u : 0u; mine = (j == x) ? c : mine; }
        if (sum == G) break;
        __builtin_amdgcn_s_sleep(1);
        if ((++sp & 255u) == 0u) { if (xb_ld(&bar[XB_TMO])) break; if (sp > XB_SPIN_CAP) { atomicAdd(&bar[XB_TMO], 1u); break; } }
    }
    nloc = mine > 0u ? mine : 1u; nx = cnt > 0u ? cnt : 1u;
}
__device__ __forceinline__ void xcd_barrier(const XcdBarrier& b, int tid) {
    asm volatile("s_waitcnt vmcnt(0)" ::: "memory");
    __syncthreads();
    if (tid == 0) {
        unsigned* bar = b.bar;
        __builtin_amdgcn_s_waitcnt(0);
        unsigned nloc = b.st[0], nx = b.st[1];
        if (nloc == 0u) { xcd_barrier_complete(bar, b.x, nloc, nx); b.st[0] = nloc; b.st[1] = nx; }
        const unsigned old = xb_add(&bar[XB_XSUB(b.x)], 1u);
        const unsigned gen = old / nloc;
        if (old + 1u == (gen + 1u) * nloc) {
            __builtin_amdgcn_fence(__ATOMIC_RELEASE, "agent");
            asm volatile("s_waitcnt vmcnt(0)" ::: "memory");
            const unsigned og = xb_add(&bar[XB_TOP], 1u);
            const unsigned tg = og / nx;
            if (og + 1u == (tg + 1u) * nx) xb_add(&bar[XB_TOPGEN], 1u);
            else XB_SPIN(xb_ld(&bar[XB_TOPGEN]) == tg, bar);
            __builtin_amdgcn_fence(__ATOMIC_ACQUIRE, "agent");
            xb_add(&bar[XB_XGEN(b.x)], 1u);
            asm volatile("s_waitcnt vmcnt(0)" ::: "memory");
        } else {
            XB_SPIN(xb_ld(&bar[XB_XGEN(b.x)]) == gen, bar);
            __builtin_amdgcn_fence(__ATOMIC_ACQUIRE, "agent");
            asm volatile("s_waitcnt vmcnt(0)" ::: "memory");
        }
    }
    __syncthreads();
}

namespace pg {
constexpr int BM = 256, BK = 64, HALF = 128, HTB = HALF * BK * 2, STAGE_BYTES = 8 * HTB;
__host__ __device__ __forceinline__ int lds_byte(int r, int c) { const int st = (r >> 4) * 2 + (c >> 5), rr = r & 15, cc = c & 31, ob = rr * 64 + cc * 2; return st * 1024 + (ob ^ (((ob >> 9) & 1) << 5)); }
__host__ __device__ __forceinline__ void stage_rc(int b, int& R, int& C) { const int st = b / 1024, sb = b % 1024, swz = sb ^ (((sb >> 9) & 1) << 5); R = (st >> 1) * 16 + swz / 64; C = (st & 1) * 32 + (swz % 64) / 2; }
__host__ __device__ __forceinline__ int perm32(int rho) { const int n = rho >> 4, i = rho & 15; return 8 * (i >> 2) + 4 * n + (i & 3); }

struct Unit { const char* A; const char* B; int pm, pn, e, nrows, aux0; };

template <int N> __device__ __forceinline__ void wait_vm() { asm volatile("s_waitcnt vmcnt(%0)" :: "n"(N) : "memory"); }
template <class Epi, class Sched, bool ALIGN_EPI>
__device__ __forceinline__ void gemm_phase(LAS unsigned char* lds, const int wave, const int K, const int lda, const int ldb, const Sched& S, const Epi& E) {
    int tid_ = wave * 64 + lane_id(); asm volatile("" : "+v"(tid_));
    const int tid = tid_, wid = __builtin_amdgcn_readfirstlane(tid >> 6), lane = tid & 63, wr = wid >> 2, wc = wid & 3, fr = lane & 15, fq = lane >> 4;
    const int nt = K / BK;
    int sR[2], sC[2];
    unsigned voffB[2];
#pragma unroll
    for (int i = 0; i < 2; ++i) { int R, C; stage_rc(tid * 16 + i * 8192, R, C); sR[i] = R; sC[i] = C; const int Rb = Epi::PERM ? (64 * (R >> 5) + perm32(R & 31)) : R;
        voffB[i] = (unsigned)(Rb * ldb + C) * 2u; }
    const size_t kstep = (size_t)(BK * 2);
    const size_t hstepB = (size_t)(Epi::PERM ? 32 : HALF) * ldb * 2;
    const unsigned ldsw = (unsigned)wid * 1024u;
    const int aoff = lds_byte(wr * 64 + fr, fq * 8), boff = lds_byte(wc * 32 + fr, fq * 8);
#define PG_SA(b, h) (((b) * 2 + (h)) * HTB)
#define PG_SB(b, h) ((4 + (b) * 2 + (h)) * HTB)
#define PG_STAGE2(bufoff, gbase, o0, o1) do { \
        __builtin_amdgcn_global_load_lds((const unsigned*)((const char*)(gbase) + (o0)), (LAS unsigned*)(lds + (bufoff) + ldsw), 16, 0, 0); \
        __builtin_amdgcn_global_load_lds((const unsigned*)((const char*)(gbase) + (o1)), (LAS unsigned*)(lds + (bufoff) + ldsw + 8192), 16, 0, 0); } while (0)
#define PG_STAGEB(bufoff, gbase) PG_STAGE2(bufoff, gbase, voffB[0], voffB[1])
#define PG_LDA(dst, b, h) do { _Pragma("unroll") for (int m = 0; m < 4; ++m) _Pragma("unroll") for (int k = 0; k < 2; ++k) dst[m][k] = *(const LAS h8*)(lds + PG_SA(b, h) + aoff + m * 2048 + k * 1024); } while (0)
#define PG_LDB(dst, b, h) do { _Pragma("unroll") for (int n = 0; n < 2; ++n) _Pragma("unroll") for (int k = 0; k < 2; ++k) dst[n][k] = *(const LAS h8*)(lds + PG_SB(b, h) + boff + n * 2048 + k * 1024); } while (0)
#define PG_MMA(ai, bj, At, Bt) do { __builtin_amdgcn_s_setprio(1); _Pragma("unroll") for (int m = 0; m < 4; ++m) _Pragma("unroll") for (int n = 0; n < 2; ++n) _Pragma("unroll") for (int k = 0; k < 2; ++k) \
        acc[ai][bj][m][n] = __builtin_amdgcn_mfma_f32_16x16x32_f16(Bt[n][k], At[m][k], acc[ai][bj][m][n], 0, 0, 0); __builtin_amdgcn_s_setprio(0); } while (0)
#define PG_WAIT_V(n) asm volatile("s_waitcnt vmcnt(" #n ")" ::: "memory")
#define PG_WAIT_L(n) asm volatile("s_waitcnt lgkmcnt(" #n ")" ::: "memory")
#define PG_BAR __builtin_amdgcn_s_barrier()
#define PG_SCHED __builtin_amdgcn_sched_barrier(0)
    constexpr bool RELAX = !Sched::GATHER && Epi::NVM > 0;
    bool prev_full = false;
    Unit cur, nxt; int ui = 0;
    if (!S.next(0, cur)) return;
    unsigned c00, c01, c10, c11;
    LAS unsigned* otab = (LAS unsigned*)(lds + STAGE_BYTES + 2048) + tid;
    { c00 = (unsigned)(S.arow(cur, sR[0]) * lda + sC[0]) * 2u; c01 = (unsigned)(S.arow(cur, sR[1]) * lda + sC[1]) * 2u;
      c10 = (unsigned)(S.arow(cur, HALF + sR[0]) * lda + sC[0]) * 2u; c11 = (unsigned)(S.arow(cur, HALF + sR[1]) * lda + sC[1]) * 2u; }
    f32x4 acc[2][2][4][2];
#pragma unroll
    for (int a = 0; a < 2; ++a)
#pragma unroll
        for (int b = 0; b < 2; ++b)
#pragma unroll
            for (int m = 0; m < 4; ++m)
#pragma unroll
                for (int n = 0; n < 2; ++n) acc[a][b][m][n] = (f32x4){0.f, 0.f, 0.f, 0.f};
    h8 At[4][2], B0[2][2], B1[2][2];
    const char* cA = cur.A; const char* cB = cur.B;
    PG_STAGEB(PG_SB(0, 0), cB); PG_STAGEB(PG_SB(0, 1), cB + hstepB); PG_STAGE2(PG_SA(0, 0), cA, c00, c01); PG_STAGE2(PG_SA(0, 1), cA, c10, c11);
    if (wr == 1) PG_BAR;
    PG_WAIT_V(2); PG_BAR;
    PG_STAGEB(PG_SB(1, 0), cB + kstep); PG_STAGE2(PG_SA(1, 0), cA + kstep, c00, c01); PG_STAGEB(PG_SB(1, 1), cB + hstepB + kstep);
    PG_WAIT_V(6); PG_BAR;
    for (;;) {
        const bool has_next = S.next(ui + 1, nxt);
        const char* nA = has_next ? nxt.A : cA; const char* nB = has_next ? nxt.B : cB;
        if (Sched::GATHER) {
            if (has_next) { otab[0] = (unsigned)(S.arow(nxt, sR[0]) * lda + sC[0]) * 2u; otab[512] = (unsigned)(S.arow(nxt, sR[1]) * lda + sC[1]) * 2u;
                            otab[1024] = (unsigned)(S.arow(nxt, HALF + sR[0]) * lda + sC[0]) * 2u; otab[1536] = (unsigned)(S.arow(nxt, HALF + sR[1]) * lda + sC[1]) * 2u; }
            else { otab[0] = c00; otab[512] = c01; otab[1024] = c10; otab[1536] = c11; }
        }
#pragma unroll 1
        for (int t = 0; t < nt; t += 2) {
            const bool last = (t == nt - 2);
            const char* a1 = cA + (size_t)(t + 1) * kstep;
            const char* a2 = last ? nA : cA + (size_t)(t + 2) * kstep; const char* b2 = last ? nB : cB + (size_t)(t + 2) * kstep;
            const char* a3 = a2 + kstep; const char* b3 = b2 + kstep;
            unsigned q00 = c00, q01 = c01, q10 = c10, q11 = c11;
            if (Sched::GATHER) { if (last) { q00 = otab[0]; q01 = otab[512]; q10 = otab[1024]; q11 = otab[1536]; } }
            const bool pre = RELAX && t == 0 && ui > 0;
            const bool rlx = pre && prev_full;
            PG_LDB(B0, 0, 0); PG_LDB(B1, 0, 1); PG_SCHED; PG_LDA(At, 0, 0); if (!pre) PG_STAGE2(PG_SA(1, 1), a1, c10, c11);
            if (rlx) wait_vm<8 + Epi::NVM>(); else PG_WAIT_V(8);
            PG_WAIT_L(0); PG_BAR; PG_MMA(0, 0, At, B0); PG_MMA(0, 1, At, B1); PG_BAR; PG_SCHED;
            PG_LDA(At, 0, 1); PG_STAGEB(PG_SB(0, 0), b2); PG_STAGEB(PG_SB(0, 1), b2 + hstepB); PG_STAGE2(PG_SA(0, 0), a2, q00, q01);
            if (rlx) wait_vm<8 + Epi::NVM>(); else PG_WAIT_V(8);
            PG_WAIT_L(0); PG_BAR; PG_MMA(1, 0, At, B0); PG_MMA(1, 1, At, B1); PG_BAR; PG_SCHED;
            PG_LDB(B0, 1, 0); PG_LDB(B1, 1, 1); PG_SCHED; PG_LDA(At, 1, 0); PG_STAGE2(PG_SA(0, 1), a2, q10, q11);
            if (rlx) wait_vm<8 + Epi::NVM>(); else PG_WAIT_V(8);
            PG_WAIT_L(0); PG_BAR; PG_MMA(0, 0, At, B0); PG_MMA(0, 1, At, B1); PG_BAR; PG_SCHED;
            PG_LDA(At, 1, 1); PG_STAGEB(PG_SB(1, 0), b3); PG_STAGEB(PG_SB(1, 1), b3 + hstepB); PG_STAGE2(PG_SA(1, 0), a3, q00, q01);
            PG_WAIT_V(8); PG_WAIT_L(0); PG_BAR; PG_MMA(1, 0, At, B0); PG_MMA(1, 1, At, B1); PG_BAR; PG_SCHED;
        }
        if constexpr (ALIGN_EPI) { if (wr == 0) PG_BAR; }
        if (RELAX && has_next) PG_STAGE2(PG_SA(1, 1), nA + kstep, c10, c11);
        E(acc, cur, wr, wc, fr, fq);
        prev_full = E.full(cur);
        if (!has_next) break;
#pragma unroll
        for (int a = 0; a < 2; ++a)
#pragma unroll
            for (int b = 0; b < 2; ++b)
#pragma unroll
                for (int m = 0; m < 4; ++m)
#pragma unroll
                    for (int n = 0; n < 2; ++n) acc[a][b][m][n] = (f32x4){0.f, 0.f, 0.f, 0.f};
        cur = nxt; cA = nA; cB = nB; ++ui;
        if (Sched::GATHER) { c00 = otab[0]; c01 = otab[512]; c10 = otab[1024]; c11 = otab[1536]; }
        if constexpr (ALIGN_EPI) { if (wr == 1) PG_BAR; }
    }
    PG_WAIT_V(0);
    if constexpr (!ALIGN_EPI) { if (wr == 0) PG_BAR; }
    PG_BAR;
#undef PG_SA
#undef PG_SB
#undef PG_STAGE2
#undef PG_STAGEB
#undef PG_LDA
#undef PG_LDB
#undef PG_MMA
#undef PG_WAIT_V
#undef PG_WAIT_L
#undef PG_BAR
#undef PG_SCHED
}
}
constexpr size_t MiB = 1u << 20;
constexpr size_t al256(size_t x) { return (x + 255) & ~(size_t)255; }
constexpr size_t WS_CTL = 0, CTL_ZERO_BYTES = 2 * MiB;
constexpr size_t WS_MODS = 1 * MiB;
constexpr size_t WS_X = 2 * MiB;
constexpr size_t WS_Z2 = WS_X + (size_t)T * D * 4;
constexpr size_t WS_DYN = al256(WS_Z2 + (size_t)DEPTH * SE * 64 * 4);
constexpr size_t WS_WIN = WS_DYN;
constexpr size_t WS_PJ = WS_WIN + (size_t)DIN * D * 2;
constexpr size_t WS_WO = WS_PJ + (size_t)3 * D * DH * 2;
constexpr size_t WS_RT = WS_WO + (size_t)D * D * 2;
constexpr size_t WS_SD = WS_RT + (size_t)2 * NE * D * 2;
constexpr size_t WS_GC = al256(WS_SD + (size_t)256 * 4097 * 16);
constexpr size_t WS_HMH = WS_GC + (size_t)DH * 512 * 4;
constexpr size_t WS_LIST = WS_HMH + (size_t)T * D * 2;
constexpr size_t WS_P = WS_LIST + (size_t)2 * NE * TH * 8;
constexpr size_t P_BYTES = (size_t)T * DIN * 2;
constexpr size_t WS_SLOT = WS_P;
constexpr size_t WS_W13 = WS_SLOT + (size_t)TH * 9 * D * 2;
constexpr size_t WS_W2 = WS_W13 + (size_t)65 * 512 * D * 2;
constexpr size_t WS_H = WS_W2 + (size_t)65 * D * DEXP * 2;
static_assert(WS_H + (size_t)(MAXT_H + SH_T) * 256 * DEXP * 2 <= WS_P + P_BYTES, "MoE overlay fits the P region");
constexpr size_t WS_ZT = WS_P + P_BYTES;
constexpr size_t WS_VT = WS_ZT + (size_t)B * DH * SE * 2;
constexpr size_t WS_SCR = WS_ZT;
static_assert((size_t)256 * 32 * 512 * 16 <= (size_t)2 * B * DH * SE * 2, "scratch fits ZT|VT");
constexpr size_t WS_VHT = WS_VT + (size_t)B * DH * SE * 2;
constexpr size_t WS_Y = WS_VHT + (size_t)B * DH * SE * 2;
constexpr size_t WS_END = WS_Y + (size_t)T * 1536 * 2;
static_assert((size_t)(MAXT_H + SH_T) * 256 * DEXP * 2 <= (size_t)T * 1536 * 2, "half 1's H fits the Y region");
constexpr int CW_BAR = 4096;
constexpr int CW_CNT = 16384;
constexpr int CW_DBG = 32768;

struct In {
    const GAS float *x, *c, *ctx, *c_ctx, *w_ada, *b_ada, *w_in, *hy_conv_w, *hy_conv_b, *hy_w1, *hy_b1, *hy_w2, *hy_b2, *hy_w3, *hy_sin_freq, *hy_bias_d,
        *hy_proj, *sc_conv_w, *sc_proj, *na_rpb, *na_proj, *w_o, *ln1_g, *ln1_b, *ln2_g, *ln2_b, *moe_router, *moe_bias, *moe_w1, *moe_w3, *moe_w2, *sh_w1, *sh_w3, *sh_w2;
};
struct Args { In in; GAS float* out; unsigned char* ws; int ph_lo, ph_hi, use_bar, flags; };

typedef const __attribute__((address_space(4))) In& CIN;
#define INP(name) ((const float*)(in.name))
typedef const __attribute__((address_space(4))) Args* CArgsP;
struct Frame {
    LAS unsigned char* lds;
    int tid, lane, wave, vcu, G, bid, dry;
    GAS unsigned char* ws;
};
__device__ __forceinline__ int mod_row(int row) { const int b = row / SE, ii = row - b * SE; return ii < S ? b : 8; }

struct TrItem { const float* W; int K, N; f16* WT; int row_off, row_mul, item; };
__device__ __forceinline__ void tr_load(const TrItem& q, f32x4 (&t)[8], int lane) {
    const int nblk = q.N / 32, kb = q.item / nblk, nb = q.item % nblk, k0 = 64 * kb, n0 = 32 * nb;
    const int kr = lane >> 3, c4 = (lane & 7) * 4;
#pragma unroll
    for (int i = 0; i < 8; ++i) t[i] = *(const f32x4*)(q.W + (size_t)(k0 + 8 * i + kr) * q.N + n0 + c4);
}
__device__ __forceinline__ void tr_store(const TrItem& q, const f32x4 (&t)[8], LAS float* scr, int lane) {
    const int nblk = q.N / 32, kb = q.item / nblk, nb = q.item % nblk, k0 = 64 * kb, n0 = 32 * nb;
    const int kr = lane >> 3, c4 = (lane & 7) * 4;
#pragma unroll
    for (int i = 0; i < 8; ++i) { LAS float* d = scr + (8 * i + kr) * 33 + c4; d[0] = t[i][0]; d[1] = t[i][1]; d[2] = t[i][2]; d[3] = t[i][3]; }
    LDS_WAIT(); asm volatile("" ::: "memory");
    const int c = lane & 7;
#pragma unroll
    for (int j = 0; j < 4; ++j) { const int n = (lane >> 3) + 8 * j; const LAS float* s = scr + (8 * c) * 33 + n;
        u32x4 o; o.x = pkh(s[0 * 33], s[1 * 33]); o.y = pkh(s[2 * 33], s[3 * 33]); o.z = pkh(s[4 * 33], s[5 * 33]); o.w = pkh(s[6 * 33], s[7 * 33]);
        *(u32x4*)(q.WT + (size_t)(q.row_off + (n0 + n) * q.row_mul) * q.K + k0 + 8 * c) = o; }
    LDS_WAIT(); asm volatile("" ::: "memory");
}
__device__ __forceinline__ TrItem mixer_item(Frame& F, CIN in, int l, int it) {
    constexpr int I_IN = (D / 64) * (DIN / 32), I_PJ = (DH / 64) * (D / 32);
    f16* win = (f16*)(F.ws + WS_WIN); f16* pj = (f16*)(F.ws + WS_PJ); f16* wo = (f16*)(F.ws + WS_WO);
    int r = it;
    if (r < I_IN) return TrItem{INP(w_in) + (size_t)l * D * DIN, D, DIN, win, 0, 1, r}; r -= I_IN;
    if (r < I_PJ) return TrItem{INP(hy_proj) + (size_t)l * DH * D, DH, D, pj, 0, 1, r}; r -= I_PJ;
    if (r < I_PJ) return TrItem{INP(sc_proj) + (size_t)l * DH * D, DH, D, pj, D, 1, r}; r -= I_PJ;
    if (r < I_PJ) return TrItem{INP(na_proj) + (size_t)l * DH * D, DH, D, pj, 2 * D, 1, r}; r -= I_PJ;
    return TrItem{INP(w_o) + (size_t)l * D * D, D, D, wo, 0, 1, r};
}
__device__ __forceinline__ void convert_mixer_weights(Frame& F, CIN in, int l) {
    LAS float* scr = (LAS float*)(F.lds + F.wave * 16384);
    const int gw = F.vcu * NWAVES + F.wave, NGW = F.G * NWAVES;
    constexpr int NIT = (D / 64) * (DIN / 32) + 3 * (DH / 64) * (D / 32) + (D / 64) * (D / 32);
    int it = gw; if (it >= NIT) return;
    f32x4 ta[8], tb[8];
    TrItem qa = mixer_item(F, in, l, it), qb = qa; tr_load(qa, ta, F.lane);
    for (;;) {
        const bool hb = it + NGW < NIT; if (hb) { qb = mixer_item(F, in, l, it + NGW); tr_load(qb, tb, F.lane); }
        tr_store(qa, ta, scr, F.lane); if (!hb) break; it += NGW;
        const bool ha = it + NGW < NIT; if (ha) { qa = mixer_item(F, in, l, it + NGW); tr_load(qa, ta, F.lane); }
        tr_store(qb, tb, scr, F.lane); if (!ha) break; it += NGW;
    }
}
__device__ __forceinline__ TrItem moe_item(Frame& F, CIN in, int l, int it) {
    constexpr int I_UP = (D / 64) * (DEXP / 32)  , I_DN = (DEXP / 64) * (D / 32)  , PER_E = 2 * I_UP + I_DN;
    f16* w13 = (f16*)(F.ws + WS_W13); f16* w2 = (f16*)(F.ws + WS_W2);
    const int e = it / PER_E; int r = it - e * PER_E;
    if (r < I_UP) return TrItem{e < NE ? INP(moe_w1) + ((size_t)l * NE + e) * D * DEXP : INP(sh_w1) + (size_t)l * D * DEXP, D, DEXP, w13 + (size_t)e * 512 * D, 0, 2, r}; r -= I_UP;
    if (r < I_UP) return TrItem{e < NE ? INP(moe_w3) + ((size_t)l * NE + e) * D * DEXP : INP(sh_w3) + (size_t)l * D * DEXP, D, DEXP, w13 + (size_t)e * 512 * D, 1, 2, r}; r -= I_UP;
    return TrItem{e < NE ? INP(moe_w2) + ((size_t)l * NE + e) * DEXP * D : INP(sh_w2) + (size_t)l * DEXP * D, DEXP, D, w2 + (size_t)e * D * DEXP, 0, 1, r};
}
__device__ __forceinline__ void convert_moe_weights(Frame& F, CIN in, int l) {
    LAS float* scr = (LAS float*)(F.lds + F.wave * 16384);
    const int gw = F.vcu * NWAVES + F.wave, NGW = F.G * NWAVES;
    constexpr int NIT = 65 * 384;
    int it = gw; if (it >= NIT) return;
    f32x4 ta[8], tb[8];
    TrItem qa = moe_item(F, in, l, it), qb = qa; tr_load(qa, ta, F.lane);
    for (;;) {
        const bool hb = it + NGW < NIT; if (hb) { qb = moe_item(F, in, l, it + NGW); tr_load(qb, tb, F.lane); }
        tr_store(qa, ta, scr, F.lane); if (!hb) break; it += NGW;
        const bool ha = it + NGW < NIT; if (ha) { qa = moe_item(F, in, l, it + NGW); tr_load(qa, ta, F.lane); }
        tr_store(qb, tb, scr, F.lane); if (!ha) break; it += NGW;
    }
}

struct MoeTab { int ptile[NE + 2]; };
__device__ __forceinline__ void moe_build_tab(Frame& F, const int* cnt, LAS int* tab) {
    if (F.tid < 64) {
        const int c = __hip_atomic_load(cnt + F.tid, __ATOMIC_RELAXED, __HIP_MEMORY_SCOPE_AGENT); int tl = (c + 255) >> 8; int inc = tl;
#pragma unroll
        for (int o = 1; o < 64; o <<= 1) { const int v = bpermi(F.lane - o, inc); if (F.lane >= o) inc += v; }
        tab[F.tid] = inc - tl; tab[128 + F.tid] = c;
        if (F.tid == 63) tab[64] = inc;
    }
    __syncthreads();
}
template <int NPN, bool UP>
struct MoeSched {
    static constexpr bool GATHER = UP;
    const LAS int* tab; int G, c, half; const unsigned long long* list; const char* Abase; const char* Bbase; int NT, lat_only;
    int sh_mode, NT_other;
    __device__ __forceinline__ bool next(int i, pg::Unit& u) const {
        const int SH = lat_only ? SH_T - 4 : SH_T;
        const int L = i * G + c; const int nun = (NT + (sh_mode == 2 ? 0 : (sh_mode == 1 ? 2 * SH : SH))) * NPN;
        if (L >= nun) return false;
        const int tile = L / NPN; u.pn = L - tile * NPN;
        int e;
        if (tile < NT) { e = 0;
#pragma unroll
            for (int s = 32; s >= 1; s >>= 1) { const int v = __builtin_amdgcn_readfirstlane(tab[(e + s) & 63]); if (e + s < NE && v <= tile) e += s; }
            u.pm = tile - __builtin_amdgcn_readfirstlane(tab[e]); int nr = __builtin_amdgcn_readfirstlane(tab[128 + e]) - u.pm * 256; u.nrows = nr > 256 ? 256 : nr;
        } else { e = NE; u.pm = tile - NT; u.nrows = 256;
            if (u.pm >= SH) { u.pm -= SH; u.nrows = 257; }
            if (lat_only) u.pm = (u.pm >> 4) * 17 + (u.pm & 15); }
        u.e = e;
        if (UP) { u.A = Abase; u.B = Bbase + ((size_t)e * 512 + (size_t)u.pn * 256) * D * 2; }
        else { u.A = Abase + (size_t)tile * 256 * DEXP * 2; u.B = Bbase + ((size_t)e * D + (size_t)u.pn * 256) * DEXP * 2; }
        u.aux0 = u.nrows == 257 ? NT_other + u.pm : tile;
        return true;
    }
    __device__ __forceinline__ int arow(const pg::Unit& u, int r) const {
        if (!UP) return r;
        if (u.e == NE) return (u.nrows == 257 ? (half ^ 1) : half) * TH + u.pm * 256 + r;
        int rr = u.pm * 256 + r; const int n = __builtin_amdgcn_readfirstlane(tab[128 + u.e]); if (rr >= n) rr = n - 1;
        const unsigned long long en = list[((size_t)half * NE + u.e) * TH + rr];
        return half * TH + (int)(en >> 36);
    }
};
struct EpiUp {
    static constexpr bool PERM = true; static constexpr int NVM = 0;
    __device__ __forceinline__ bool full(const pg::Unit&) const { return false; }
    f16* H; f16* Hother;
    __device__ __forceinline__ void operator()(const f32x4 (&acc)[2][2][4][2], const pg::Unit& u, int wr, int wc, int fr, int fq) const {
        f16* Hb = u.nrows == 257 ? Hother : H;
#pragma unroll
        for (int ai = 0; ai < 2; ++ai)
#pragma unroll
            for (int m = 0; m < 4; ++m) { const int r = ai * 128 + wr * 64 + m * 16 + fr; f16* rowp = Hb + ((size_t)u.aux0 * 256 + r) * DEXP + u.pn * 128;
#pragma unroll
                for (int bj = 0; bj < 2; ++bj) { const f32x4 v0 = acc[ai][bj][m][0], v1 = acc[ai][bj][m][1];
                    const float h0 = v0[0] * sigm(v0[0]) * v0[1], h1 = v0[2] * sigm(v0[2]) * v0[3], h2_ = v1[0] * sigm(v1[0]) * v1[1], h3 = v1[2] * sigm(v1[2]) * v1[3];
                    u32x2 w; w.x = pkh(h0, h1); w.y = pkh(h2_, h3);
                    *(u32x2*)(rowp + (wc * 64 + bj * 32 + 8 * fq) / 2) = w; }
                asm volatile("" ::: "memory"); }
    }
};
struct EpiDown {
    static constexpr bool PERM = true; static constexpr int NVM = 16;
    __device__ __forceinline__ bool full(const pg::Unit& u) const { return !dry && (u.e == NE || u.nrows == 256); }
    f16* SL; const unsigned long long* list; int half, dry;
    __device__ __forceinline__ void operator()(const f32x4 (&acc)[2][2][4][2], const pg::Unit& u, int wr, int wc, int fr, int fq) const {
        unsigned long long en[8];
        const unsigned long long* lp = list + ((size_t)half * NE + (u.e < NE ? u.e : 0)) * TH + u.pm * 256;
#pragma unroll
        for (int g = 0; g < 8; ++g) { const int r = (g >> 2) * 128 + wr * 64 + (g & 3) * 16 + fr; en[g] = (u.e < NE && r < u.nrows) ? lp[r] : 0ull; }
#pragma unroll
        for (int ai = 0; ai < 2; ++ai)
#pragma unroll
            for (int m = 0; m < 4; ++m) { const int r = ai * 128 + wr * 64 + m * 16 + fr;
                float w = 1.f; int srow = (u.pm * 256 + r) * 9 + 8; bool ok = true;
                if (u.e < NE) { ok = r < u.nrows; const unsigned long long e8 = en[ai * 4 + m]; w = __uint_as_float((unsigned)e8); const unsigned hi = (unsigned)(e8 >> 32); srow = (int)(hi >> 4) * 9 + (int)(hi & 15u); }
                if (ok) { f16* rowp = SL + (size_t)srow * D + u.pn * 256 + wc * 64 + 8 * fq;
#pragma unroll
                    for (int bj = 0; bj < 2; ++bj) { const f32x4 v0 = acc[ai][bj][m][0] * w, v1 = acc[ai][bj][m][1] * w;
                        u32x4 o; o.x = pkh(v0[0], v0[1]); o.y = pkh(v0[2], v0[3]); o.z = pkh(v1[0], v1[1]); o.w = pkh(v1[2], v1[3]);
                        if (!dry || o.x == 0x12345678u) __builtin_nontemporal_store(o, (u32x4*)(rowp + bj * 32)); } } }
    }
};
template <bool DO_LN>
__device__ __forceinline__ void ln1_rows(Frame& F, CIN in, int l) {
    const int gw = F.vcu * NWAVES + F.wave, NGW = F.G * NWAVES;
    float* X = (float*)(F.ws + WS_X); f16* HM = (f16*)(F.ws + WS_HMH);
    const float* mods = (const float*)(F.ws + WS_MODS) + (size_t)l * 9 * 6 * D;
    const f32x4* g4 = (const f32x4*)(INP(ln1_g) + l * D) + F.lane; const f32x4* b4 = (const f32x4*)(INP(ln1_b) + l * D) + F.lane;
    for (int row = gw; row < T; row += NGW) {
        f32x4* xr = (f32x4*)(X + (size_t)row * D) + F.lane;
        f32x4 v[4];
#pragma unroll
        for (int j = 0; j < 4; ++j) v[j] = xr[64 * j];
        if (DO_LN) {
            float s = 0.f;
#pragma unroll
            for (int j = 0; j < 4; ++j) s += (v[j].x + v[j].y) + (v[j].z + v[j].w);
            const float mean = wsum(s, F.lane) * (1.f / D); float s2 = 0.f;
#pragma unroll
            for (int j = 0; j < 4; ++j) { v[j] = v[j] - mean; s2 += (v[j].x * v[j].x + v[j].y * v[j].y) + (v[j].z * v[j].z + v[j].w * v[j].w); }
            const float rstd = 1.f / sqrtf(wsum(s2, F.lane) * (1.f / D) + LN_EPS);
#pragma unroll
            for (int j = 0; j < 4; ++j) { v[j] = v[j] * rstd * g4[64 * j] + b4[64 * j]; if (!F.dry) xr[64 * j] = v[j]; }
        }
        const float* m = mods + (size_t)mod_row(row) * 6 * D;
        const f32x4* sh = (const f32x4*)(m + 3 * D) + F.lane; const f32x4* sc = (const f32x4*)(m + 4 * D) + F.lane;
        u32x2* o8 = (u32x2*)(HM + (size_t)row * D) + F.lane;
#pragma unroll
        for (int j = 0; j < 4; ++j) { const f32x4 h = v[j] * (sc[64 * j] + 1.f) + sh[64 * j]; u32x2 w; w.x = pkh(h.x, h.y); w.y = pkh(h.z, h.w); if (!F.dry) o8[64 * j] = w; }
    }
}

__device__ __forceinline__ void router_phase(Frame& F, CIN in, int l) {
    const int gw = F.vcu * NWAVES + F.wave, NGW = F.G * NWAVES, lane = F.lane, fr = lane & 15, fq = lane >> 4;
    const float* X = (const float*)(F.ws + WS_X);
    const float* mods = (const float*)(F.ws + WS_MODS) + (size_t)l * 9 * 6 * D;
    const f16* rth = (const f16*)(F.ws + WS_RT); const f16* rtl = rth + NE * D;
    int* cntl = (int*)(F.ws + WS_CTL) + CW_CNT + l * 128;
    unsigned long long* list = (unsigned long long*)(F.ws + WS_LIST);
    LAS float* lgs = (LAS float*)(F.lds + F.wave * 4096);
    const float rb = INP(moe_bias)[l * NE + lane];
    for (int task = gw; task < T / 16; task += NGW) {
        const int row0 = task * 16;
        const float* m = mods + (size_t)mod_row(row0) * 6 * D;
        const float* xr = X + (size_t)(row0 + fr) * D + fq * 8;
        f32x4 acc[4];
#pragma unroll
        for (int nb = 0; nb < 4; ++nb) acc[nb] = (f32x4){0.f, 0.f, 0.f, 0.f};
#pragma unroll 2
        for (int s = 0; s < 32; ++s) {
            const int k = s * 32 + fq * 8;
            const f32x4 x0 = *(const f32x4*)(xr + s * 32), x1 = *(const f32x4*)(xr + s * 32 + 4);
            const f32x4 sc0 = *(const f32x4*)(m + 4 * D + k), sc1 = *(const f32x4*)(m + 4 * D + k + 4);
            const f32x4 sh0 = *(const f32x4*)(m + 3 * D + k), sh1 = *(const f32x4*)(m + 3 * D + k + 4);
            const f32x4 h0 = x0 * (sc0 + 1.f) + sh0, h1 = x1 * (sc1 + 1.f) + sh1;
            h8 ahi, alo;
#pragma unroll
            for (int j = 0; j < 4; ++j) { ahi[j] = (f16)h0[j]; alo[j] = (f16)(h0[j] - (float)ahi[j]); ahi[4 + j] = (f16)h1[j]; alo[4 + j] = (f16)(h1[j] - (float)ahi[4 + j]); }
#pragma unroll
            for (int nb = 0; nb < 4; ++nb) {
                const h8 bhi = *(const h8*)(rth + (size_t)(nb * 16 + fr) * D + k), blo = *(const h8*)(rtl + (size_t)(nb * 16 + fr) * D + k);
                acc[nb] = __builtin_amdgcn_mfma_f32_16x16x32_f16(ahi, bhi, acc[nb], 0, 0, 0);
                acc[nb] = __builtin_amdgcn_mfma_f32_16x16x32_f16(alo, bhi, acc[nb], 0, 0, 0);
                acc[nb] = __builtin_amdgcn_mfma_f32_16x16x32_f16(ahi, blo, acc[nb], 0, 0, 0);
            }
        }
#pragma unroll
        for (int nb = 0; nb < 4; ++nb)
#pragma unroll
            for (int i = 0; i < 4; ++i) lgs[(4 * fq + i) * 64 + nb * 16 + fr] = acc[nb][i];
        LDS_WAIT(); asm volatile("" ::: "memory");
        unsigned chosen_mask = 0u; float wv[16]; int kv[16];
#pragma unroll
        for (int t = 0; t < 16; ++t) {
            const float score = 1.f / (1.f + expf(-lgs[t * 64 + lane]));
            const float sel = score + rb;
            float m1 = sel;
            m1 = fmaxf(m1, SHX(m1, 1)); m1 = fmaxf(m1, SHX(m1, 2)); m1 = fmaxf(m1, SHX(m1, 4));
            const unsigned long long eq = __ballot(sel == m1);
            const int g = lane >> 3;
            const unsigned geq = (unsigned)((eq >> (g * 8)) & 0xffull);
            const int first = __ffs(geq) - 1;
            float s2 = ((lane & 7) == first) ? -3.0e38f : sel;
            s2 = fmaxf(s2, SHX(s2, 1)); s2 = fmaxf(s2, SHX(s2, 2)); s2 = fmaxf(s2, SHX(s2, 4));
            const float gs = m1 + s2;
            int grank = 0;
#pragma unroll
            for (int gg = 0; gg < 8; ++gg) { const float o = bperm(gg * 8, gs); grank += (o > gs || (o == gs && gg < g)) ? 1 : 0; }
            const bool gsel = grank < 4;
            const float val = gsel ? sel : -3.0e38f;
            int rank = 0;
            for (int j = 0; j < 64; ++j) { const float o = bperm(j, val); rank += (o > val || (o == val && j < lane)) ? 1 : 0; }
            const bool ch = gsel && rank < TOPK;
            const float tot = wsum(ch ? score : 0.f, lane);
            wv[t] = score / tot * 2.5f; kv[t] = rank;
            chosen_mask |= ch ? (1u << t) : 0u;
        }
        const int half = row0 >= TH ? 1 : 0;
        const int nch = __popc(chosen_mask);
        int base = 0;
        if (nch && !F.dry) base = atomicAdd(cntl + half * 64 + lane, nch);
        unsigned long long* lp = list + ((size_t)half * NE + lane) * TH;
        int pos = base;
#pragma unroll
        for (int t = 0; t < 16; ++t) if ((chosen_mask & (1u << t)) && !F.dry) {
            const unsigned tokh = (unsigned)(row0 + t - half * TH);
            lp[pos++] = ((unsigned long long)((tokh << 4) | (unsigned)kv[t]) << 32) | (unsigned long long)__float_as_uint(wv[t]);
        }
        LDS_WAIT(); asm volatile("" ::: "memory");
    }
}


constexpr int RL_PITCH = 1032;
constexpr int RL_LO = 16 * RL_PITCH * 2, RL_PART = 2 * RL_LO;
constexpr int RL_ENT = RL_PART + 32768, RL_MAXTASK = 18, RL_CNT = RL_ENT + RL_MAXTASK * 128 * 16, RL_BASE = RL_CNT + 512;
static_assert(RL_BASE + 512 <= 147456 - 1088, "router LDS map");
__device__ __forceinline__ void ln1_router_phase(Frame& F, CIN in, int l) {
    const int lane = F.lane, w = F.wave, fr = lane & 15, fq = lane >> 4;
    float* X = (float*)(F.ws + WS_X); f16* HM = (f16*)(F.ws + WS_HMH);
    const float* mods = (const float*)(F.ws + WS_MODS) + (size_t)l * 9 * 6 * D;
    const f32x4* g4 = (const f32x4*)(INP(ln1_g) + l * D) + lane; const f32x4* b4 = (const f32x4*)(INP(ln1_b) + l * D) + lane;
    int* cntl = (int*)(F.ws + WS_CTL) + CW_CNT + l * 128;
    unsigned long long* list = (unsigned long long*)(F.ws + WS_LIST);
    LAS f16* ahi = (LAS f16*)F.lds; LAS f16* alo = (LAS f16*)(F.lds + RL_LO); LAS float* part = (LAS float*)(F.lds + RL_PART);
    const f16* rth = (const f16*)(F.ws + WS_RT); const f16* rtl = rth + NE * D;
    h8 bh[4][4];
#pragma unroll
    for (int s = 0; s < 4; ++s)
#pragma unroll
        for (int nb = 0; nb < 4; ++nb) { const size_t o = (size_t)(nb * 16 + fr) * D + 128 * w + 32 * s + 8 * fq; bh[s][nb] = *(const h8*)(rth + o); }
    const float rb = INP(moe_bias)[l * NE + lane];
    if (F.tid < 128) ((LAS int*)(F.lds + RL_CNT))[F.tid] = 0;
    __syncthreads();
    int ti = 0;
    for (int task = F.bid; task < T / 16 && ti < RL_MAXTASK; task += F.G, ++ti) {
        const int row0 = task * 16;
        if (l == DEPTH - 1 && row0 % SE >= S) { --ti; continue; }
        const float* m = mods + (size_t)mod_row(row0) * 6 * D;
        f32x4 va[2][4], pg[4], pb[4], psh[4], psc[4];
#pragma unroll
        for (int j = 0; j < 4; ++j) {
            va[0][j] = ((const f32x4*)(X + (size_t)(row0 + 2 * w) * D) + lane)[64 * j]; va[1][j] = ((const f32x4*)(X + (size_t)(row0 + 2 * w + 1) * D) + lane)[64 * j];
            pg[j] = g4[64 * j]; pb[j] = b4[64 * j]; psh[j] = ((const f32x4*)(m + 3 * D) + lane)[64 * j]; psc[j] = ((const f32x4*)(m + 4 * D) + lane)[64 * j];
        }
        asm volatile("" ::: "memory");
#pragma unroll
        for (int rr = 0; rr < 2; ++rr) {
            const int lr = 2 * w + rr, row = row0 + lr;
            f32x4* xr = (f32x4*)(X + (size_t)row * D) + lane;
            f32x4 v[4]; float s = 0.f;
#pragma unroll
            for (int j = 0; j < 4; ++j) { v[j] = va[rr][j]; s += (v[j].x + v[j].y) + (v[j].z + v[j].w); }
            const float mean = wsum(s, lane) * (1.f / D); float s2 = 0.f;
#pragma unroll
            for (int j = 0; j < 4; ++j) { v[j] = v[j] - mean; s2 += (v[j].x * v[j].x + v[j].y * v[j].y) + (v[j].z * v[j].z + v[j].w * v[j].w); }
            const float rstd = 1.f / sqrtf(wsum(s2, lane) * (1.f / D) + LN_EPS);
            u32x2* o8 = (u32x2*)(HM + (size_t)row * D) + lane;
#pragma unroll
            for (int j = 0; j < 4; ++j) {
                v[j] = v[j] * rstd * pg[j] + pb[j];
                if (!F.dry) xr[64 * j] = v[j];
                const f32x4 h = v[j] * (psc[j] + 1.f) + psh[j];
                h4 hh, hl;
#pragma unroll
                for (int q = 0; q < 4; ++q) { hh[q] = (f16)h[q]; hl[q] = (f16)(h[q] - (float)hh[q]); }
                if (!F.dry) o8[64 * j] = __builtin_bit_cast(u32x2, hh);
                *(LAS h4*)(ahi + lr * RL_PITCH + 4 * lane + 256 * j) = hh; *(LAS h4*)(alo + lr * RL_PITCH + 4 * lane + 256 * j) = hl;
            }
        }
        __syncthreads();
        {
            h8 bl[4][4];
#pragma unroll
            for (int s = 0; s < 4; ++s)
#pragma unroll
                for (int nb = 0; nb < 4; ++nb) bl[s][nb] = *(const h8*)(rtl + (size_t)(nb * 16 + fr) * D + 128 * w + 32 * s + 8 * fq);
            f32x4 acc[4];
#pragma unroll
            for (int nb = 0; nb < 4; ++nb) acc[nb] = (f32x4){0.f, 0.f, 0.f, 0.f};
#pragma unroll
            for (int s = 0; s < 4; ++s) {
                const int k = 128 * w + 32 * s + 8 * fq;
                const h8 xh = *(const LAS h8*)(ahi + fr * RL_PITCH + k), xl = *(const LAS h8*)(alo + fr * RL_PITCH + k);
#pragma unroll
                for (int nb = 0; nb < 4; ++nb) {
                    acc[nb] = __builtin_amdgcn_mfma_f32_16x16x32_f16(xh, bh[s][nb], acc[nb], 0, 0, 0);
                    acc[nb] = __builtin_amdgcn_mfma_f32_16x16x32_f16(xl, bh[s][nb], acc[nb], 0, 0, 0);
                    acc[nb] = __builtin_amdgcn_mfma_f32_16x16x32_f16(xh, bl[s][nb], acc[nb], 0, 0, 0);
                }
            }
#pragma unroll
            for (int nb = 0; nb < 4; ++nb)
#pragma unroll
                for (int i = 0; i < 4; ++i) part[(w * 16 + 4 * fq + i) * 64 + nb * 16 + fr] = acc[nb][i];
        }
        __syncthreads();
        {
            unsigned chosen_mask = 0u; float wv[2]; int kv[2];
#pragma unroll
            for (int t = 0; t < 2; ++t) {
                const int lt = 2 * w + t;
                float lg = 0.f;
#pragma unroll
                for (int ww = 0; ww < 8; ++ww) lg += part[(ww * 16 + lt) * 64 + lane];
                const float score = 1.f / (1.f + expf(-lg));
                const float sel = score + rb;
                float m1 = sel;
                m1 = fmaxf(m1, SHX(m1, 1)); m1 = fmaxf(m1, SHX(m1, 2)); m1 = fmaxf(m1, SHX(m1, 4));
                const unsigned long long eq = __ballot(sel == m1);
                const int g = lane >> 3;
                const unsigned geq = (unsigned)((eq >> (g * 8)) & 0xffull);
                const int first = __ffs(geq) - 1;
                float s2 = ((lane & 7) == first) ? -3.0e38f : sel;
                s2 = fmaxf(s2, SHX(s2, 1)); s2 = fmaxf(s2, SHX(s2, 2)); s2 = fmaxf(s2, SHX(s2, 4));
                const float gs = m1 + s2;
                int grank = 0;
#pragma unroll
                for (int gg = 0; gg < 8; ++gg) { const float o = __int_as_float(__builtin_amdgcn_readlane(__float_as_int(gs), gg * 8)); grank += (o > gs || (o == gs && gg < g)) ? 1 : 0; }
                const bool gsel = grank < 4;
                const float val = gsel ? sel : -3.0e38f;
                int rank = 0;
#pragma unroll
                for (int j = 0; j < 64; ++j) { const float o = __int_as_float(__builtin_amdgcn_readlane(__float_as_int(val), j)); rank += (o > val || (o == val && j < lane)) ? 1 : 0; }
                const bool ch = gsel && rank < TOPK;
                const float tot = wsum(ch ? score : 0.f, lane);
                wv[t] = score / tot * 2.5f; kv[t] = rank;
                chosen_mask |= ch ? (1u << t) : 0u;
            }
            const int half = row0 >= TH ? 1 : 0;
#pragma unroll
            for (int t = 0; t < 2; ++t) if (chosen_mask & (1u << t)) {
                const unsigned lrank = (unsigned)__hip_atomic_fetch_add((LAS int*)(F.lds + RL_CNT) + half * 64 + lane, 1, __ATOMIC_RELAXED, __HIP_MEMORY_SCOPE_WORKGROUP);
                const unsigned tokh = (unsigned)(row0 + 2 * w + t - half * TH);
                u32x4 en; en.x = __float_as_uint(wv[t]); en.y = (tokh << 4) | (unsigned)kv[t]; en.z = (unsigned)(half * 64 + lane); en.w = lrank;
                ((LAS u32x4*)(F.lds + RL_ENT))[(ti * 16 + 2 * w + t) * 8 + kv[t]] = en;
            }
        }
        __syncthreads();
    }
    const int ntask = ti;
    if (F.tid < 128) {
        const int n = ((LAS int*)(F.lds + RL_CNT))[F.tid];
        ((LAS int*)(F.lds + RL_BASE))[F.tid] = (n && !F.dry) ? atomicAdd(cntl + F.tid, n) : 0;
    }
    __syncthreads();
    for (int idx = F.tid; idx < ntask * 128; idx += NTHR) {
        const u32x4 en = ((const LAS u32x4*)(F.lds + RL_ENT))[idx];
        const int he = (int)en.z; const int pos = ((const LAS int*)(F.lds + RL_BASE))[he] + (int)en.w;
        if (!F.dry) list[(size_t)he * TH + pos] = ((unsigned long long)en.y << 32) | (unsigned long long)en.x;
    }
    __syncthreads();
}
__device__ __forceinline__ void convert_router(Frame& F, CIN in, int l) {
    f16* rth = (f16*)(F.ws + WS_RT); f16* rtl = rth + NE * D;
    const float* rw = INP(moe_router) + (size_t)l * D * NE;
    for (int i = (F.vcu * NTHR + F.tid); i < NE * D; i += F.G * NTHR) { const int k = i / NE, n = i % NE; const float wgt = rw[i]; const f16 h = (f16)wgt; rth[n * D + k] = h; rtl[n * D + k] = (f16)(wgt - (float)h); }
}

__device__ __forceinline__ void moe_up_phase(Frame& F, int l, int half, int Gs, int cs) {
    LAS int* tab = (LAS int*)(F.lds + pg::STAGE_BYTES);
    const int* cnt = (const int*)(F.ws + WS_CTL) + CW_CNT + l * 128 + half * 64;
    const int lat_only = l == DEPTH - 1;
    int nt_other = 0;
    if (!lat_only && half == 0) { moe_build_tab(F, cnt + 64, tab); nt_other = __builtin_amdgcn_readfirstlane(tab[64]); __syncthreads(); }
    moe_build_tab(F, cnt, tab);
    MoeSched<2, true> Sc; Sc.tab = tab; Sc.G = Gs; Sc.c = cs; Sc.half = half; Sc.list = (const unsigned long long*)(F.ws + WS_LIST);
    Sc.Abase = (const char*)(F.ws + WS_HMH); Sc.Bbase = (const char*)(F.ws + WS_W13); Sc.NT = __builtin_amdgcn_readfirstlane(tab[64]); Sc.lat_only = lat_only;
    Sc.sh_mode = lat_only ? 0 : (half == 0 ? 1 : 2); Sc.NT_other = nt_other;
    EpiUp E; E.H = (f16*)(F.ws + (half ? WS_Y : WS_H)); E.Hother = (f16*)(F.ws + (half ? WS_H : WS_Y));
    pg::gemm_phase<EpiUp, MoeSched<2, true>, true>(F.lds, F.wave, D, D, D, Sc, E);
}
__device__ __forceinline__ void moe_down_phase(Frame& F, int l, int half, int Gs, int cs) {
    LAS int* tab = (LAS int*)(F.lds + pg::STAGE_BYTES);
    const int* cnt = (const int*)(F.ws + WS_CTL) + CW_CNT + l * 128 + half * 64;
    moe_build_tab(F, cnt, tab);
    MoeSched<4, false> Sc; Sc.tab = tab; Sc.G = Gs; Sc.c = cs; Sc.half = half; Sc.list = (const unsigned long long*)(F.ws + WS_LIST);
    Sc.Abase = (const char*)(F.ws + (half ? WS_Y : WS_H)); Sc.Bbase = (const char*)(F.ws + WS_W2); Sc.NT = __builtin_amdgcn_readfirstlane(tab[64]); Sc.lat_only = l == DEPTH - 1; Sc.sh_mode = 0; Sc.NT_other = 0;
    EpiDown E; E.SL = (f16*)(F.ws + WS_SLOT); E.list = Sc.list; E.half = half; E.dry = F.dry;
    pg::gemm_phase<EpiDown, MoeSched<4, false>, true>(F.lds, F.wave, DEXP, DEXP, DEXP, Sc, E);
}
__device__ __forceinline__ void ln2_rows(Frame& F, CIN in, float* out, int l, int half) {
    const int gw = F.vcu * NWAVES + F.wave, NGW = F.G * NWAVES;
    float* X = (float*)(F.ws + WS_X); f16* HM = (f16*)(F.ws + WS_HMH); const f16* SL = (const f16*)(F.ws + WS_SLOT);
    const float* mods = (const float*)(F.ws + WS_MODS) + (size_t)l * 9 * 6 * D;
    const f32x4* g4 = (const f32x4*)(INP(ln2_g) + l * D) + F.lane; const f32x4* b4 = (const f32x4*)(INP(ln2_b) + l * D) + F.lane;
    f32x4 gL[4], bL[4];
#pragma unroll
    for (int j = 0; j < 4; ++j) { gL[j] = g4[64 * j]; bL[j] = b4[64 * j]; }
    for (int th = gw; th < TH; th += NGW) {
        const int row = half * TH + th;
        if (l == DEPTH - 1 && row % SE >= S) continue;
        const float* m = mods + (size_t)mod_row(row) * 6 * D;
        f32x4* xr = (f32x4*)(X + (size_t)row * D) + F.lane;
        const f32x4* gt = (const f32x4*)(m + 5 * D) + F.lane;
        f32x4 v[4]; float s = 0.f;
        h4 q[4][9]; f32x4 xv[4], gv[4], shv[4], scv[4];
        const float* mn = mods + (size_t)9 * 6 * D + (size_t)mod_row(row) * 6 * D;
#pragma unroll
        for (int j = 0; j < 4; ++j) {
#pragma unroll
            for (int k = 0; k < 9; ++k) q[j][k] = *((const h4*)(SL + ((size_t)th * 9 + k) * D) + F.lane + 64 * j);
            xv[j] = xr[64 * j]; gv[j] = gt[64 * j];
            if (l + 1 < DEPTH) { shv[j] = ((const f32x4*)(mn) + F.lane)[64 * j]; scv[j] = ((const f32x4*)(mn + D) + F.lane)[64 * j]; }
        }
        asm volatile("" ::: "memory");
#pragma unroll
        for (int j = 0; j < 4; ++j) {
            f32x4 f = (f32x4){0.f, 0.f, 0.f, 0.f};
#pragma unroll
            for (int k = 0; k < 9; ++k) f += (f32x4){(float)q[j][k][0], (float)q[j][k][1], (float)q[j][k][2], (float)q[j][k][3]};
            v[j] = xv[j] * ALPHA + gv[j] * f; s += (v[j].x + v[j].y) + (v[j].z + v[j].w);
        }
        const float mean = wsum(s, F.lane) * (1.f / D); float s2 = 0.f;
#pragma unroll
        for (int j = 0; j < 4; ++j) { v[j] = v[j] - mean; s2 += (v[j].x * v[j].x + v[j].y * v[j].y) + (v[j].z * v[j].z + v[j].w * v[j].w); }
        const float rstd = 1.f / sqrtf(wsum(s2, F.lane) * (1.f / D) + LN_EPS);
#pragma unroll
        for (int j = 0; j < 4; ++j) { v[j] = v[j] * rstd * gL[j] + bL[j]; if (!F.dry) xr[64 * j] = v[j]; }
        if (l + 1 < DEPTH) {
            u32x2* o8 = (u32x2*)(HM + (size_t)row * D) + F.lane;
#pragma unroll
            for (int j = 0; j < 4; ++j) { const f32x4 h = v[j] * (scv[j] + 1.f) + shv[j]; u32x2 w; w.x = pkh(h.x, h.y); w.y = pkh(h.z, h.w); if (!F.dry) o8[64 * j] = w; }
        } else {
            const int b = row / SE, ii = row - b * SE;
            if (ii < S) { f32x4* o = (f32x4*)(out + ((size_t)b * S + ii) * D) + F.lane;
#pragma unroll
                for (int j = 0; j < 4; ++j) if (!F.dry) o[64 * j] = v[j]; }
        }
    }
}
#ifndef FFT_HD
#define FFT_HD __host__ __device__ __forceinline__
#endif
namespace fft {
constexpr int N = 8192, LOGN = 13, NPAD = N + N / 8;
FFT_HD int pidx(int i) { return i + (i >> 3); }
FFT_HD int brev(int k) { return (int)(__builtin_bitreverse32((unsigned)k) >> (32 - LOGN)); }
typedef float c2 __attribute__((ext_vector_type(2)));
FFT_HD c2 cmul(c2 a, c2 b) { return c2{a.x * b.x - a.y * b.y, a.x * b.y + a.y * b.x}; }
FFT_HD c2 cmulc(c2 a, c2 b) { return c2{a.x * b.x + a.y * b.y, a.y * b.x - a.x * b.y}; }
FFT_HD c2 tw(float frac) {
#if defined(__HIP_DEVICE_COMPILE__)
    return c2{__builtin_amdgcn_cosf(frac), -__builtin_amdgcn_sinf(frac)};
#else
    return c2{(float)cos(6.283185307179586 * (double)frac), (float)-sin(6.283185307179586 * (double)frac)};
#endif
}
template <int LOG, bool INV, class BP, class TP, bool HALF = false>
FFT_HD void pass_group(BP buf, TP tab, int h2, int gidx) {
    constexpr int R = 1 << LOG;
    const int hi = gidx / h2, lo = gidx - hi * h2, base = hi * (R * h2) + lo;
    c2 x[R];
#pragma unroll
    for (int m = 0; m < R; ++m) { if (HALF && !INV && m >= R / 2) x[m] = c2{0.f, 0.f}; else x[m] = buf[pidx(base + m * h2)]; }
    if (!INV) {
#pragma unroll
        for (int q = 0; q < LOG; ++q) { const int mq = R >> (q + 1); const int sc = N / (2 * mq * h2);
#pragma unroll
            for (int m = 0; m < R; ++m) if ((m & mq) == 0) { const c2 w = tab[pidx(((m % mq) * h2 + lo) * sc)]; const c2 a = x[m], b = x[m + mq];
                x[m] = c2{a.x + b.x, a.y + b.y}; x[m + mq] = cmul(c2{a.x - b.x, a.y - b.y}, w); } }
    } else {
#pragma unroll
        for (int q = LOG - 1; q >= 0; --q) { const int mq = R >> (q + 1); const int sc = N / (2 * mq * h2);
#pragma unroll
            for (int m = 0; m < R; ++m) if ((m & mq) == 0) { const c2 w = tab[pidx(((m % mq) * h2 + lo) * sc)]; const c2 a = x[m], t = cmulc(x[m + mq], w);
                x[m] = c2{a.x + t.x, a.y + t.y}; x[m + mq] = c2{a.x - t.x, a.y - t.y}; } }
    }
#pragma unroll
    for (int m = 0; m < R; ++m) if (!(HALF && INV && m >= R / 2)) buf[pidx(base + m * h2)] = x[m];
}
}
__device__ __forceinline__ void pro_mods(Frame& F, CIN in) {
    const int gw = F.vcu * NWAVES + F.wave, NGW = F.G * NWAVES, lane = F.lane;
    float* mods = (float*)(F.ws + WS_MODS);
    for (int task = gw; task < DEPTH * 96 * 16; task += NGW) {
        const int l = task / 1536, r0 = task - l * 1536, jb = r0 >> 4, kc = r0 & 15, col = jb * 64 + lane, k = kc * 64 + lane;
        float cv[9];
#pragma unroll
        for (int r = 0; r < 9; ++r) { const float v = r < 8 ? INP(c)[r * D + k] : INP(c_ctx)[k]; cv[r] = v / (1.f + expf(-v)); }
        float acc[9];
#pragma unroll
        for (int r = 0; r < 9; ++r) acc[r] = 0.f;
        const float* w = INP(w_ada) + ((size_t)l * D + kc * 64) * 6 * D + col;
#pragma unroll 4
        for (int kk = 0; kk < 64; ++kk) { const float wv = w[(size_t)kk * 6 * D];
#pragma unroll
            for (int r = 0; r < 9; ++r) acc[r] += __shfl(cv[r], kk) * wv; }
        const float bb = kc == 0 ? INP(b_ada)[l * 6 * D + col] : 0.f;
#pragma unroll
        for (int r = 0; r < 9; ++r) if (!F.dry) atomicAdd(&mods[((size_t)l * 9 + r) * 6 * D + col], acc[r] + bb);
    }
}
__device__ __forceinline__ void pro_init_x(Frame& F, CIN in) {
    const int gw = F.vcu * NWAVES + F.wave, NGW = F.G * NWAVES;
    float* X = (float*)(F.ws + WS_X);
    for (int row = gw; row < T; row += NGW) {
        const int b = row / SE, ii = row - b * SE;
        const f32x4* src = (const f32x4*)(ii < S ? INP(x) + ((size_t)b * S + ii) * D : INP(ctx) + ((size_t)b * CL + (ii - S)) * D) + F.lane;
        f32x4* dst = (f32x4*)(X + (size_t)row * D) + F.lane;
        f32x4 t4[4];
#pragma unroll
        for (int j = 0; j < 4; ++j) t4[j] = src[64 * j];
#pragma unroll
        for (int j = 0; j < 4; ++j) dst[64 * j] = t4[j];
    }
}
__device__ __forceinline__ void pro_z2(Frame& F, CIN in) {
    const int gw = F.vcu * NWAVES + F.wave, NGW = F.G * NWAVES, lane = F.lane;
    float* Z2 = (float*)(F.ws + WS_Z2);
    for (int task = gw; task < DEPTH * SE; task += NGW) {
        const int l = task / SE, ti = task - l * SE, L = ti < S ? S : CL, t = ti < S ? ti : ti - S;
        const float* w1 = INP(hy_w1) + l * 33 * 64; const float* w2 = INP(hy_w2) + l * 4096; const float* sf = INP(hy_sin_freq) + l * 128;
        const double PI2 = 6.283185307179586476925;
        const float tt = (float)((double)t / (double)(L - 1));
        const float ang = (float)(PI2 / (double)L) * (float)t;
        float a = INP(hy_b1)[l * 64 + lane];
        a += tt * w1[lane];
        for (int j = 0; j < 16; ++j) {
            const float band = (float)(1e-4 + (double)j * ((15.0 - 1e-4) / 15.0));
            const float arg = band * ang;
            a += cosf(arg) * w1[(1 + j) * 64 + lane];
            a += -sinf(arg) * w1[(17 + j) * 64 + lane];
        }
        const float z1 = sinf(sf[lane] * a);
        float a2 = INP(hy_b2)[l * 64 + lane];
        for (int i = 0; i < 64; ++i) a2 += __shfl(z1, i) * w2[i * 64 + lane];
        Z2[(size_t)task * 64 + lane] = sinf(sf[64 + lane] * a2);
    }
}
__device__ __forceinline__ void init_mod1_rows(Frame& F, CIN in) {
    const int gw = F.vcu * NWAVES + F.wave, NGW = F.G * NWAVES;
    float* X = (float*)(F.ws + WS_X); f16* HM = (f16*)(F.ws + WS_HMH);
    const float* mods = (const float*)(F.ws + WS_MODS);
    for (int row = gw; row < T; row += NGW) {
        const int b = row / SE, ii = row - b * SE;
        const f32x4* src = (const f32x4*)(ii < S ? INP(x) + ((size_t)b * S + ii) * D : INP(ctx) + ((size_t)b * CL + (ii - S)) * D) + F.lane;
        const float* m = mods + (size_t)(ii < S ? b : 8) * 6 * D;
        const f32x4* sh = (const f32x4*)(m) + F.lane; const f32x4* sc = (const f32x4*)(m + D) + F.lane;
        f32x4* dst = (f32x4*)(X + (size_t)row * D) + F.lane; u32x2* o8 = (u32x2*)(HM + (size_t)row * D) + F.lane;
        f32x4 xv[4], sv[4], cv[4];
#pragma unroll
        for (int j = 0; j < 4; ++j) { xv[j] = src[64 * j]; sv[j] = sh[64 * j]; cv[j] = sc[64 * j]; }
#pragma unroll
        for (int j = 0; j < 4; ++j) { dst[64 * j] = xv[j]; const f32x4 h = xv[j] * (cv[j] + 1.f) + sv[j]; u32x2 w; w.x = pkh(h.x, h.y); w.y = pkh(h.z, h.w); o8[64 * j] = w; }
    }
}
__device__ __forceinline__ void mod1_rows(Frame& F, int l) {
    const int gw = F.vcu * NWAVES + F.wave, NGW = F.G * NWAVES;
    const float* X = (const float*)(F.ws + WS_X); f16* HM = (f16*)(F.ws + WS_HMH);
    const float* mods = (const float*)(F.ws + WS_MODS) + (size_t)l * 9 * 6 * D;
    for (int row = gw; row < T; row += NGW) {
        const f32x4* xr = (const f32x4*)(X + (size_t)row * D) + F.lane;
        const float* m = mods + (size_t)mod_row(row) * 6 * D;
        const f32x4* sh = (const f32x4*)(m) + F.lane; const f32x4* sc = (const f32x4*)(m + D) + F.lane;
        u32x2* o8 = (u32x2*)(HM + (size_t)row * D) + F.lane;
        f32x4 xv[4], sv[4], cv[4];
#pragma unroll
        for (int j = 0; j < 4; ++j) { xv[j] = xr[64 * j]; sv[j] = sh[64 * j]; cv[j] = sc[64 * j]; }
#pragma unroll
        for (int j = 0; j < 4; ++j) { const f32x4 h = xv[j] * (cv[j] + 1.f) + sv[j]; u32x2 w; w.x = pkh(h.x, h.y); w.y = pkh(h.z, h.w); o8[64 * j] = w; }
    }
}

typedef LAS fft::c2* LBuf;
#define FFT_OPQ(t) asm volatile("" : "+v"(t))
typedef const LAS fft::c2* LTab;
constexpr int LDS_FFT_TAB = fft::NPAD * 8, LDS_FFT_END = LDS_FFT_TAB + (fft::N / 2 + fft::N / 16) * 8;
__device__ __forceinline__ void fft_fill_tab(LAS unsigned char* lds, int tid) {
    LAS fft::c2* tab = (LAS fft::c2*)(lds + LDS_FFT_TAB);
    for (int i = tid; i < fft::N / 2; i += NTHR) tab[fft::pidx(i)] = fft::tw((float)i * (1.0f / (float)fft::N));
    __syncthreads();
}
template <bool ZERO_UPPER>
__device__ __forceinline__ void fft_fwd(LBuf buf, int tid) {
    LTab tab = (LTab)((const LAS unsigned char*)buf + LDS_FFT_TAB);
    FFT_OPQ(tid); fft::pass_group<4, false, LBuf, LTab, ZERO_UPPER>(buf, tab, 512, tid); __syncthreads();
    FFT_OPQ(tid); fft::pass_group<3, false>(buf, tab, 64, tid); FFT_OPQ(tid); fft::pass_group<3, false>(buf, tab, 64, tid + 512); __syncthreads();
    FFT_OPQ(tid); fft::pass_group<3, false>(buf, tab, 8, tid); FFT_OPQ(tid); fft::pass_group<3, false>(buf, tab, 8, tid + 512); __syncthreads();
    FFT_OPQ(tid); fft::pass_group<3, false>(buf, tab, 1, tid); FFT_OPQ(tid); fft::pass_group<3, false>(buf, tab, 1, tid + 512); __syncthreads();
}
__device__ __forceinline__ void fft_inv(LBuf buf, int tid) {
    LTab tab = (LTab)((const LAS unsigned char*)buf + LDS_FFT_TAB);
    FFT_OPQ(tid); fft::pass_group<3, true>(buf, tab, 1, tid); FFT_OPQ(tid); fft::pass_group<3, true>(buf, tab, 1, tid + 512); __syncthreads();
    FFT_OPQ(tid); fft::pass_group<3, true>(buf, tab, 8, tid); FFT_OPQ(tid); fft::pass_group<3, true>(buf, tab, 8, tid + 512); __syncthreads();
    FFT_OPQ(tid); fft::pass_group<3, true>(buf, tab, 64, tid); FFT_OPQ(tid); fft::pass_group<3, true>(buf, tab, 64, tid + 512); __syncthreads();
    FFT_OPQ(tid); fft::pass_group<4, true, LBuf, LTab, true>(buf, tab, 512, tid); __syncthreads();
}
__device__ __forceinline__ float hy_delta(int c) { const float la = -3.0701134573253944f  , st = (-15.350567286626972f + 3.0701134573253944f) / 511.0f; return fabsf(la + (float)c * st); }
__device__ __forceinline__ void filters_phase(Frame& F, CIN in, int l) {
    LBuf buf = (LBuf)F.lds;
    LAS float* w3s = (LAS float*)(F.lds + LDS_FFT_END);
    fft_fill_tab(F.lds, F.tid);
    const float* Z2 = (const float*)(F.ws + WS_Z2) + (size_t)l * SE * 64;
    const float* w3 = INP(hy_w3) + (size_t)l * 64 * 1024;
    f32x4* SD = (f32x4*)(F.ws + WS_SD);
    for (int p = F.bid; p < 256; p += F.G) {
        int tid = F.tid; asm volatile("" : "+v"(tid));
        const int ca = 2 * p, cb = 2 * p + 1;
        __syncthreads();
        if (tid < 256) { const int j = tid & 63, which = tid >> 6; const int col = (which & 1 ? cb : ca) + (which >> 1 ? 512 : 0); w3s[which * 64 + j] = w3[j * 1024 + col]; }
        __syncthreads();
        const float da = hy_delta(ca), db = hy_delta(cb);
        for (int i = 0; i < 8; ++i) {
            const int t = tid + 512 * i;
            const f32x4* zr = (const f32x4*)(Z2 + (size_t)t * 64);
            float fa = 0.f, fb = 0.f, ba = 0.f, bb = 0.f;
#pragma unroll 4
            for (int j4 = 0; j4 < 16; ++j4) { const f32x4 z = zr[j4];
#pragma unroll
                for (int u = 0; u < 4; ++u) { const int j = 4 * j4 + u; fa += z[u] * w3s[j]; fb += z[u] * w3s[64 + j]; ba += z[u] * w3s[128 + j]; bb += z[u] * w3s[192 + j]; } }
            const float tt = (float)t * (1.0f / (float)(S - 1));
            const float ea = expf(-tt * da), eb = expf(-tt * db);
            buf[fft::pidx(t)] = fft::c2{fa * ea, fb * eb};
            if (t == 0) { const float zf = (float)(tid >> 16); buf[fft::pidx(S)] = fft::c2{zf, zf}; } else buf[fft::pidx(2 * S - t)] = fft::c2{ba * ea, bb * eb};
        }
        __syncthreads();
        fft_fwd<false>(buf, tid);
        for (int j = tid; j <= S; j += NTHR) {
            const int pos = j < S ? 2 * j : 1, k = fft::brev(pos);
            const fft::c2 Xk = buf[fft::pidx(pos)], Xp = buf[fft::pidx(fft::brev((fft::N - k) & (fft::N - 1)))];
            const float gar = 0.5f * (Xk.x + Xp.x), gai = 0.5f * (Xk.y - Xp.y);
            const float ur = Xk.x - Xp.x, ui = Xk.y + Xp.y;
            const float gbr = 0.5f * ui, gbi = -0.5f * ur;
            SD[(size_t)p * 4097 + j] = (f32x4){0.5f * (gar + gbr), 0.5f * (gai + gbi), 0.5f * (gar - gbr), 0.5f * (gai - gbi)};
        }
    }
    __syncthreads();
    const int gw = F.vcu * NWAVES + F.wave, NGW = F.G * NWAVES, lane = F.lane;
    float* GC = (float*)(F.ws + WS_GC);
    const float* Z2c = Z2 + (size_t)S * 64;
    for (int task = gw; task < CL * 16; task += NGW) {
        const int t = task >> 4, col = (task & 15) * 64 + lane;
        const float* zr = Z2c + (size_t)t * 64;
        float a = 0.f;
#pragma unroll 8
        for (int j = 0; j < 64; ++j) a += zr[j] * w3[j * 1024 + col];
        const int c = col & 511;
        const float tt = (float)t * (1.0f / (float)(CL - 1));
        const float v = a * expf(-tt * hy_delta(c));
        if (col < 512) GC[(size_t)c * 512 + 256 + t] = v; else if (t >= 1) GC[(size_t)c * 512 + 256 - t] = v;
    }
}

__device__ __forceinline__ void transpose_phase(Frame& F, CIN in, int l) {
    LAS f16* tile = (LAS f16*)F.lds;
    const f16* P = (const f16*)(F.ws + WS_P);
    f16* ZT = (f16*)(F.ws + WS_ZT); f16* VT = (f16*)(F.ws + WS_VT);
    const float* cw = INP(hy_conv_w) + l * 3 * 1536; const float* cbias = INP(hy_conv_b) + l * 1536;
    const int tid = F.tid, t = tid >> 3, cg = tid & 7;
    for (int task = F.bid; task < B * 68 * 4; task += F.G) {
        const int q = task & 3, r0 = task >> 2, tl = r0 % 68, b = r0 / 68;
        const int i = tl * 64 + t, lo = i < S ? 0 : S, hi = i < S ? S : SE;
        const f16* prow = P + ((size_t)b * SE + i) * DIN;
        const bool hasp = i - 1 >= lo, hasn = i + 1 < hi;
        h8 outv[4];
        if (q < 2) {
            h8 cur[4][2], prv[4][2], nxt[4][2];
#pragma unroll
            for (int u = 0; u < 4; ++u)
#pragma unroll
                for (int part = 0; part < 2; ++part) { const int col = 512 * (part + 1) + (4 * q + u) * 64 + cg * 8;
                    cur[u][part] = *(const h8*)(prow + col);
#pragma unroll
                    for (int j = 0; j < 8; ++j) { prv[u][part][j] = (f16)0.f; nxt[u][part][j] = (f16)0.f; }
                    if (hasp) prv[u][part] = *(const h8*)(prow - DIN + col);
                    if (hasn) nxt[u][part] = *(const h8*)(prow + DIN + col); }
#pragma unroll
            for (int u = 0; u < 4; ++u) { float z[8];
#pragma unroll
                for (int part = 0; part < 2; ++part) { const int col = 512 * (part + 1) + (4 * q + u) * 64 + cg * 8;
#pragma unroll
                    for (int j = 0; j < 8; ++j) { const float uu = (float)prv[u][part][j] * cw[col + j] + (float)cur[u][part][j] * cw[1536 + col + j] + (float)nxt[u][part][j] * cw[3072 + col + j] + cbias[col + j];
                        z[j] = part == 0 ? uu : z[j] * uu; } }
#pragma unroll
                for (int j = 0; j < 8; ++j) outv[u][j] = (f16)z[j]; }
        } else {
#pragma unroll
            for (int u = 0; u < 4; ++u) outv[u] = *(const h8*)(prow + OFF_NA + 1024 + (4 * (q - 2) + u) * 64 + cg * 8);
        }
        __syncthreads();
#pragma unroll
        for (int u = 0; u < 4; ++u)
#pragma unroll
            for (int j = 0; j < 8; ++j) tile[u * 4608 + (cg * 8 + j) * 72 + t] = outv[u][j];
        __syncthreads();
        {
            const int ch = tid >> 3, part = tid & 7;
#pragma unroll
            for (int u = 0; u < 4; ++u) {
                const h8 v = *(const LAS h8*)(tile + u * 4608 + ch * 72 + part * 8);
                const int cb = q < 2 ? 4 * q + u : 4 * (q - 2) + u;
                f16* dst = (q < 2 ? ZT : VT) + ((size_t)b * DH + cb * 64 + ch) * SE + tl * 64 + part * 8;
                *(h8*)dst = v; }
        }
    }
    __syncthreads();
}

__device__ __forceinline__ void fftconv_tasks(Frame& F, CIN in, int l, int pflags) {
    LBuf buf = (LBuf)F.lds;
    f16* ZT = (f16*)(F.ws + WS_ZT); const f16* VHT = (const f16*)(F.ws + WS_VHT);
    const f32x4* SD = (const f32x4*)(F.ws + WS_SD);
    const float* bd = INP(hy_bias_d) + l * DH;
    const float* cwl = INP(hy_conv_w) + l * 3 * 1536; const float* cbl = INP(hy_conv_b) + l * 1536;
    fft_fill_tab(F.lds, F.tid);
    for (int task = F.bid; task < B * 256; task += F.G) {
        int tid = F.tid; asm volatile("" : "+v"(tid));
        const int b = task & 7, p = task >> 3;
        f16* za = ZT + ((size_t)b * DH + 2 * p) * SE; f16* zb = za + SE;
        const f16* ha = VHT + ((size_t)b * DH + 2 * p) * SE; const f16* hb = ha + SE;
        const int t0 = tid * 8;
        h8 va, vb;
        {
            const h8 xa = *(const h8*)(za + t0), xb = *(const h8*)(zb + t0), wa = *(const h8*)(ha + t0), wb = *(const h8*)(hb + t0);
            const bool hp = t0 > 0, hn = t0 + 8 < S;
            const f16 zf = (f16)0.f;
            const f16 xap = hp ? za[t0 - 1] : zf, xan = hn ? za[t0 + 8] : zf, xbp = hp ? zb[t0 - 1] : zf, xbn = hn ? zb[t0 + 8] : zf;
            const f16 wap = hp ? ha[t0 - 1] : zf, wan = hn ? ha[t0 + 8] : zf, wbp = hp ? hb[t0 - 1] : zf, wbn = hn ? hb[t0 + 8] : zf;
            const int ca = 2 * p, cbb = 2 * p + 1;
            const float x1a0 = cwl[512 + ca], x1a1 = cwl[1536 + 512 + ca], x1a2 = cwl[3072 + 512 + ca], x1ab = cbl[512 + ca];
            const float x1b0 = cwl[512 + cbb], x1b1 = cwl[1536 + 512 + cbb], x1b2 = cwl[3072 + 512 + cbb], x1bb = cbl[512 + cbb];
            const float vha0 = cwl[1024 + ca], vha1 = cwl[1536 + 1024 + ca], vha2 = cwl[3072 + 1024 + ca], vhab = cbl[1024 + ca];
            const float vhb0 = cwl[1024 + cbb], vhb1 = cwl[1536 + 1024 + cbb], vhb2 = cwl[3072 + 1024 + cbb], vhbb = cbl[1024 + cbb];
#pragma unroll
            for (int j = 0; j < 8; ++j) {
                const float xa_m = (float)(j == 0 ? xap : xa[j == 0 ? 0 : j - 1]), xa_p = (float)(j == 7 ? xan : xa[j == 7 ? 7 : j + 1]);
                const float xb_m = (float)(j == 0 ? xbp : xb[j == 0 ? 0 : j - 1]), xb_p = (float)(j == 7 ? xbn : xb[j == 7 ? 7 : j + 1]);
                const float wa_m = (float)(j == 0 ? wap : wa[j == 0 ? 0 : j - 1]), wa_p = (float)(j == 7 ? wan : wa[j == 7 ? 7 : j + 1]);
                const float wb_m = (float)(j == 0 ? wbp : wb[j == 0 ? 0 : j - 1]), wb_p = (float)(j == 7 ? wbn : wb[j == 7 ? 7 : j + 1]);
                const float ua = xa_m * x1a0 + (float)xa[j] * x1a1 + xa_p * x1a2 + x1ab, ub = xb_m * x1b0 + (float)xb[j] * x1b1 + xb_p * x1b2 + x1bb;
                const float ya = wa_m * vha0 + (float)wa[j] * vha1 + wa_p * vha2 + vhab, yb = wb_m * vhb0 + (float)wb[j] * vhb1 + wb_p * vhb2 + vhbb;
                va[j] = (f16)(ua * ya); vb[j] = (f16)(ub * yb);
            }
        }
        f32x4 sdv[8];
#pragma unroll
        for (int i = 0; i < 8; ++i) sdv[i] = SD[(size_t)p * 4097 + tid + NTHR * i];
        __syncthreads();
#pragma unroll
        for (int j = 0; j < 8; ++j) buf[fft::pidx(t0 + j)] = fft::c2{(float)va[j], (float)vb[j]};
        __syncthreads();
        if (!(pflags & 128)) fft_fwd<true>(buf, tid);
#pragma unroll
        for (int i = 0; i < 9; ++i) {
            if (i < 8 || tid == 0) {
                const int pos = i < 8 ? 2 * (tid + NTHR * i) : 1, k = fft::brev(pos);
                const int pa = fft::pidx(pos), pp = fft::pidx(fft::brev((fft::N - k) & (fft::N - 1)));
                const fft::c2 Xk = buf[pa], Xp = buf[pp]; const f32x4 sd = i < 8 ? sdv[i < 8 ? i : 0] : SD[(size_t)p * 4097 + S];
                const fft::c2 Sv{sd[0], sd[1]}, Dv{sd[2], sd[3]};
                const fft::c2 t1 = fft::cmul(Xk, Sv), t2 = fft::cmul(fft::c2{Xp.x, -Xp.y}, Dv);
                const fft::c2 u1 = fft::cmulc(Xp, Sv), u2 = fft::cmulc(fft::c2{Xk.x, -Xk.y}, Dv);
                buf[pa] = fft::c2{t1.x + t2.x, t1.y + t2.y};
                if (pp != pa) buf[pp] = fft::c2{u1.x + u2.x, u1.y + u2.y};
            }
        }
        __syncthreads();
        if (!(pflags & 256)) fft_inv(buf, tid);
        const float ba = bd[2 * p], bb = bd[2 * p + 1];
        h8 oa, ob;
#pragma unroll
        for (int j = 0; j < 8; ++j) { const fft::c2 y = buf[fft::pidx(t0 + j)]; oa[j] = (f16)(y.x * (1.f / fft::N) + (float)va[j] * ba); ob[j] = (f16)(y.y * (1.f / fft::N) + (float)vb[j] * bb); }
        if (!F.dry) { *(h8*)(za + t0) = oa; *(h8*)(zb + t0) = ob; }
    }
    __syncthreads();
}
__device__ __forceinline__ void ctxconv_tasks(Frame& F, CIN in, int l) {
    const int gw = F.vcu * NWAVES + F.wave, NGW = F.G * NWAVES, lane = F.lane;
    f16* ZT = (f16*)(F.ws + WS_ZT); const f16* VHT = (const f16*)(F.ws + WS_VHT);
    const float* GC = (const float*)(F.ws + WS_GC);
    const float* cwl = INP(hy_conv_w) + l * 3 * 1536; const float* cbl = INP(hy_conv_b) + l * 1536;
    for (int task = gw; task < B * DH; task += NGW) {
        const int c = task & (DH - 1);
        f16* zp = ZT + (size_t)task * SE + S; const f16* hp = VHT + (size_t)task * SE + S;
        float zv[4], acc[4];
        {
            const float xw0 = cwl[512 + c], xw1 = cwl[1536 + 512 + c], xw2 = cwl[3072 + 512 + c], xbb = cbl[512 + c];
            const float vw0 = cwl[1024 + c], vw1 = cwl[1536 + 1024 + c], vw2 = cwl[3072 + 1024 + c], vbb = cbl[1024 + c];
#pragma unroll
            for (int j = 0; j < 4; ++j) { const int t = lane + 64 * j;
                const float xm = t > 0 ? (float)zp[t - 1] : 0.f, x0 = (float)zp[t], xp = t + 1 < CL ? (float)zp[t + 1] : 0.f;
                const float vm = t > 0 ? (float)hp[t - 1] : 0.f, v0 = (float)hp[t], vp = t + 1 < CL ? (float)hp[t + 1] : 0.f;
                zv[j] = (float)(f16)((xm * xw0 + x0 * xw1 + xp * xw2 + xbb) * (vm * vw0 + v0 * vw1 + vp * vw2 + vbb)); acc[j] = 0.f; }
        }
        const float* g = GC + (size_t)c * 512 + 256 + lane;
#pragma unroll
        for (int sj = 0; sj < 4; ++sj)
            for (int s0 = 0; s0 < 64; ++s0) { const float zs = bperm(s0, zv[sj]); const int s = sj * 64 + s0;
#pragma unroll
                for (int j = 0; j < 4; ++j) acc[j] += g[64 * j - s] * zs; }
        const float bdv = INP(hy_bias_d)[l * DH + c];
#pragma unroll
        for (int j = 0; j < 4; ++j) if (!F.dry) zp[lane + 64 * j] = (f16)(acc[j] + zv[j] * bdv);
    }
}
constexpr int AT_KP = 72, AT_VP = 264;
constexpr int AT_VOFF = 256 * AT_KP * 2;
constexpr int AT_RPB = AT_VOFF + 64 * AT_VP * 2;
template <bool LOCAL>
__device__ __forceinline__ void attn_wtask(Frame& F, const float* rpb_l, int b, int h, int r, int n, int qrow0, int pf = 0) {
    const int lane = lane_id(), fr = lane & 15, fq = lane >> 4;
    const f16* P = (const f16*)(F.ws + WS_P); const f16* VT = (const f16*)(F.ws + WS_VT); f16* Y = (f16*)(F.ws + WS_Y);
    const LAS f16* Kc = (const LAS f16*)F.lds; const LAS f16* VcT = (const LAS f16*)(F.lds + AT_VOFF);
    const int rs = r - 4 < 0 ? 0 : (r - 4 > 56 ? 56 : r - 4);
    const int kb = n == 0 ? 0 : (n == 1 ? 8 : (n == 2 ? 24 : 32));
    const f16* Pb = P + (size_t)b * SE * DIN;
    const f16* qp = Pb + (size_t)(qrow0 + fr) * DIN + OFF_NA + h * 64 + fq * 8;
    const h8 bq0 = *(const h8*)qp, bq1 = *(const h8*)(qp + 32);
    const char* kub = (const char*)(Pb + OFF_NA + 512 + h * 64);
    const unsigned klo = (unsigned)fq * 16u;
    const f16* vbase = VT + ((size_t)b * DH + h * 64 + fr) * SE + 8 * fq;
    const int ko = 8 * (fr >> 2) + (fr & 3);
    const int qc = 16 * n + fr; const int cs = qc - 8 < 0 ? 0 : (qc - 8 > 48 ? 48 : qc - 8);
    float mrun = -3.0e38f, lsum = 0.f;
    f32x4 o[4];
#pragma unroll
    for (int d = 0; d < 4; ++d) o[d] = (f32x4){0.f, 0.f, 0.f, 0.f};
    constexpr int NCH = LOCAL ? 2 : 1;
#pragma unroll
    for (int ch = 0; ch < NCH; ++ch) {
        if (LOCAL && ((ch == 0 && (pf & 8192)) || (ch == 1 && (pf & 16384)))) continue;
        const bool loc = LOCAL && ch == 0;
        f32x4 st[16];
        if (loc) {
            h8 kf[3][8];
#pragma unroll
            for (int g0 = 0; g0 < 2; ++g0)
#pragma unroll
                for (int q = 0; q < 4; ++q) { const int tl = 4 * g0 + q; const char* kp = kub + ((unsigned)((rs + (tl >> 1)) * 64 + kb + 4 * (tl & 1) + ko) * (unsigned)(DIN * 2) + klo); kf[g0][2 * q] = *(const h8*)kp; kf[g0][2 * q + 1] = *(const h8*)(kp + 64); }
#pragma unroll
            for (int g = 0; g < 4; ++g) {
                if (g + 2 < 4) {
#pragma unroll
                    for (int q = 0; q < 4; ++q) { const int tl = 4 * (g + 2) + q; const char* kp = kub + ((unsigned)((rs + (tl >> 1)) * 64 + kb + 4 * (tl & 1) + ko) * (unsigned)(DIN * 2) + klo);
                        kf[(g + 2) % 3][2 * q] = *(const h8*)kp; kf[(g + 2) % 3][2 * q + 1] = *(const h8*)(kp + 64); }
                }
                asm volatile("" ::: "memory");
#pragma unroll
                for (int q = 0; q < 4; ++q) { f32x4 acc = (f32x4){0.f, 0.f, 0.f, 0.f};
                    acc = __builtin_amdgcn_mfma_f32_16x16x32_f16(kf[g % 3][2 * q], bq0, acc, 0, 0, 0);
                    acc = __builtin_amdgcn_mfma_f32_16x16x32_f16(kf[g % 3][2 * q + 1], bq1, acc, 0, 0, 0);
                    st[4 * g + q] = acc; }
            }
        } else {
#pragma unroll
            for (int tl = 0; tl < 16; ++tl) {
                const LAS f16* kp = Kc + (32 * (tl >> 1) + 4 * (tl & 1) + ko) * AT_KP + fq * 8;
                const h8 a0 = *(const LAS h8*)kp, a1 = *(const LAS h8*)(kp + 32);
                f32x4 acc = (f32x4){0.f, 0.f, 0.f, 0.f};
                acc = __builtin_amdgcn_mfma_f32_16x16x32_f16(a0, bq0, acc, 0, 0, 0);
                acc = __builtin_amdgcn_mfma_f32_16x16x32_f16(a1, bq1, acc, 0, 0, 0);
                st[tl] = acc;
                if ((tl & 3) == 3) asm volatile("" ::: "memory");
            }
        }
        h8 vf[4][4];
        if (loc) {
#pragma unroll
            for (int pre = 0; pre < 3; ++pre)
#pragma unroll
                for (int d = 0; d < 4; ++d) vf[pre][d] = *(const h8*)(vbase + (size_t)d * 16 * SE + (rs + pre) * 64 + kb);
        }
        float mx = -3.0e38f;
        if (loc) {
            const LAS float* rp = (const LAS float*)(F.lds + AT_RPB) + h * 15 * 32;
            const int cbase = kb + 8 * fq - qc + 15;
#pragma unroll
            for (int sp = 0; sp < 8; ++sp) {
                const LAS float* rrow = rp + (rs + sp - r + 7) * 32;
                float bz[8];
#pragma unroll
                for (int e = 0; e < 8; ++e) { int ci = cbase + e; ci = ci < 0 ? 0 : (ci > 30 ? 30 : ci); bz[e] = rrow[ci]; }
#pragma unroll
                for (int e = 0; e < 8; ++e) { const int kcol = kb + 8 * fq + e; const bool ok = kcol >= cs && kcol < cs + 16;
                    const float sv = ok ? st[2 * sp + (e >> 2)][e & 3] * 0.125f + bz[e] : -1.0e30f;
                    st[2 * sp + (e >> 2)][e & 3] = sv; mx = fmaxf(mx, sv); }
            }
        } else {
#pragma unroll
            for (int tl = 0; tl < 16; ++tl)
#pragma unroll
                for (int i = 0; i < 4; ++i) { const float sv = st[tl][i] * 0.125f; st[tl][i] = sv; mx = fmaxf(mx, sv); }
        }
        mx = fmaxf(mx, SHX(mx, 16)); mx = fmaxf(mx, SHX(mx, 32));
        const float mnew = fmaxf(mrun, mx), alpha = __expf(mrun - mnew);
        mrun = mnew;
        float ps = 0.f;
#pragma unroll
        for (int tl = 0; tl < 16; ++tl)
#pragma unroll
            for (int i = 0; i < 4; ++i) { const float pv = __expf(st[tl][i] - mnew); st[tl][i] = pv; ps += pv; }
        ps += SHX(ps, 16); ps += SHX(ps, 32);
        lsum = lsum * alpha + ps;
        if (ch > 0) {
#pragma unroll
            for (int i = 0; i < 4; ++i) { const float al = bperm(4 * fq + i, alpha);
#pragma unroll
                for (int d = 0; d < 4; ++d) o[d][i] *= al; }
        }
        if (loc) {
#pragma unroll
            for (int sp = 0; sp < 8; ++sp) {
                if (sp + 3 < 8) {
#pragma unroll
                    for (int d = 0; d < 4; ++d) vf[(sp + 3) & 3][d] = *(const h8*)(vbase + (size_t)d * 16 * SE + (rs + sp + 3) * 64 + kb);
                }
                asm volatile("" ::: "memory");
                h8 pa;
#pragma unroll
                for (int i = 0; i < 4; ++i) { pa[i] = (f16)st[2 * sp][i]; pa[4 + i] = (f16)st[2 * sp + 1][i]; }
#pragma unroll
                for (int d = 0; d < 4; ++d) o[d] = __builtin_amdgcn_mfma_f32_16x16x32_f16(pa, vf[sp & 3][d], o[d], 0, 0, 0);
            }
        } else {
#pragma unroll
            for (int sp = 0; sp < 8; ++sp) {
                h8 pa;
#pragma unroll
                for (int i = 0; i < 4; ++i) { pa[i] = (f16)st[2 * sp][i]; pa[4 + i] = (f16)st[2 * sp + 1][i]; }
#pragma unroll
                for (int d = 0; d < 4; ++d) {
                    const h8 bv = *(const LAS h8*)(VcT + (16 * d + fr) * AT_VP + 32 * sp + 8 * fq);
                    o[d] = __builtin_amdgcn_mfma_f32_16x16x32_f16(pa, bv, o[d], 0, 0, 0);
                }
                if (sp & 1) asm volatile("" ::: "memory");
            }
        }
    }
    const float inv = 1.f / lsum;
    f16* yb = Y + ((size_t)b * SE + qrow0) * 1536 + 1024 + h * 64 + fr;
#pragma unroll
    for (int i = 0; i < 4; ++i) { const float sc = bperm(4 * fq + i, inv);
#pragma unroll
        for (int d = 0; d < 4; ++d) yb[(size_t)(4 * fq + i) * 1536 + 16 * d] = (f16)(o[d][i] * sc); }
}
__device__ __forceinline__ void attn_tasks(Frame& F, CIN in, int l, int pf) {
    const float* rpb_l = INP(na_rpb) + (size_t)l * NHEAD * 15 * 31;
    const f16* P = (const f16*)(F.ws + WS_P); const f16* VT = (const f16*)(F.ws + WS_VT);
    LAS f16* Kc = (LAS f16*)F.lds; LAS f16* VcT = (LAS f16*)(F.lds + AT_VOFF);
    constexpr int NBT = 64 * 34;
    { LAS float* rp = (LAS float*)(F.lds + AT_RPB); __syncthreads();
      for (int i = F.tid; i < NHEAD * 15 * 31; i += NTHR) { const int hh = i / 465, rem = i - hh * 465, ri = rem / 31, ci = rem - ri * 31; rp[(hh * 15 + ri) * 32 + ci] = rpb_l[i]; } }
    const int t_lo = (int)(((long)F.bid * NBT) / F.G), t_hi = (int)(((long)(F.bid + 1) * NBT) / F.G);
    int staged = -1;
    __syncthreads();
    for (int bt = t_lo; bt < t_hi; ++bt) {
        const int bh = bt / 34, j = bt - bh * 34, b = bh >> 3, h = bh & 7;
        if (bh != staged) {
            __syncthreads();
            const int tid = F.wave * 64 + lane_id();
            h8 tk[4], tv[4];
#pragma unroll
            for (int i = 0; i < 4; ++i) { const int idx = tid + NTHR * i, key = idx >> 3, part = idx & 7;
                tk[i] = *(const h8*)(P + ((size_t)b * SE + S + key) * DIN + OFF_NA + 512 + h * 64 + part * 8); }
#pragma unroll
            for (int i = 0; i < 4; ++i) { const int idx = tid + NTHR * i, d = idx >> 5, part = idx & 31;
                tv[i] = *(const h8*)(VT + ((size_t)b * DH + h * 64 + d) * SE + S + part * 8); }
#pragma unroll
            for (int i = 0; i < 4; ++i) { const int idx = tid + NTHR * i; *(LAS h8*)(Kc + (idx >> 3) * AT_KP + (idx & 7) * 8) = tk[i]; *(LAS h8*)(VcT + (idx >> 5) * AT_VP + (idx & 31) * 8) = tv[i]; }
            staged = bh;
            __syncthreads();
        }
        const int w = F.wave;
        if (j < 32) { const int r = 2 * j + (w >> 2), n = w & 3; attn_wtask<true>(F, rpb_l, b, h, r, n, r * 64 + 16 * n, pf); }
        else if (l + 1 < DEPTH) { const int qb = (j - 32) * 8 + w; attn_wtask<false>(F, rpb_l, b, h, 0, 0, S + 16 * qb); }
    }
    __syncthreads();
}

__device__ __forceinline__ void ymix_phase(Frame& F, CIN in, int l) {
    LAS f16* tile = (LAS f16*)F.lds;
    const f16* P = (const f16*)(F.ws + WS_P); const f16* ZT = (const f16*)(F.ws + WS_ZT); f16* Y = (f16*)(F.ws + WS_Y);
    const float* cw = INP(hy_conv_w) + l * 3 * 1536; const float* cbias = INP(hy_conv_b) + l * 1536; const float* scw = INP(sc_conv_w) + l * 3 * DH;
    const int tid = F.tid;
    {
        const int c0 = (tid & 63) * 8, rsub = tid >> 6;
        float w0[8], w1[8], w2[8];
#pragma unroll
        for (int j = 0; j < 8; ++j) { w0[j] = scw[c0 + j]; w1[j] = scw[512 + c0 + j]; w2[j] = scw[1024 + c0 + j]; }
        const int rows_per = (T + F.G - 1) / F.G, rbeg = F.bid * rows_per, rend = rbeg + rows_per < T ? rbeg + rows_per : T;
        for (int row = rbeg + rsub; row < rend; row += 8) {
            const int b = row / SE, i = row - b * SE, lo = i < S ? 0 : S, hi = i < S ? S : SE;
            const f16* ps = P + (size_t)row * DIN + OFF_SC + c0;
            const h8 bg = *(const h8*)ps, c1 = *(const h8*)(ps + 512), x1 = *(const h8*)(ps + 1024);
            h8 c0v, x0v, c2v, x2v;
#pragma unroll
            for (int j = 0; j < 8; ++j) { c0v[j] = (f16)0.f; x0v[j] = (f16)0.f; c2v[j] = (f16)0.f; x2v[j] = (f16)0.f; }
            if (i - 1 >= lo) { c0v = *(const h8*)(ps - DIN + 512); x0v = *(const h8*)(ps - DIN + 1024); }
            if (i + 1 < hi) { c2v = *(const h8*)(ps + DIN + 512); x2v = *(const h8*)(ps + DIN + 1024); }
            h8 o;
#pragma unroll
            for (int j = 0; j < 8; ++j) { const float v = (float)c0v[j] * (float)x0v[j] * w0[j] + (float)c1[j] * (float)x1[j] * w1[j] + (float)c2v[j] * (float)x2v[j] * w2[j];
                o[j] = (f16)((float)bg[j] * v); }
            *(h8*)(Y + (size_t)row * 1536 + 512 + c0) = o;
        }
    }
    const int t = tid >> 3, cg = tid & 7;
    for (int task = F.bid; task < B * 68 * 2; task += F.G) {
        const int q = task & 1, r0 = task >> 1, tl = r0 % 68, b = r0 / 68;
        const int i = tl * 64 + t, lo = i < S ? 0 : S, hi = i < S ? S : SE;
        const f16* prow = P + ((size_t)b * SE + i) * DIN;
        f16* yrow = Y + ((size_t)b * SE + i) * 1536;
        const bool hasp = i - 1 >= lo, hasn = i + 1 < hi;
        h8 yt[4], cur[4], prv[4], nxt[4];
        { const int ch = tid >> 3, part = tid & 7;
#pragma unroll
          for (int u = 0; u < 4; ++u) yt[u] = *(const h8*)(ZT + ((size_t)b * DH + (4 * q + u) * 64 + ch) * SE + tl * 64 + part * 8); }
#pragma unroll
        for (int u = 0; u < 4; ++u) { const int c0 = (4 * q + u) * 64 + cg * 8;
            cur[u] = *(const h8*)(prow + c0);
#pragma unroll
            for (int j = 0; j < 8; ++j) { prv[u][j] = (f16)0.f; nxt[u][j] = (f16)0.f; }
            if (hasp) prv[u] = *(const h8*)(prow - DIN + c0);
            if (hasn) nxt[u] = *(const h8*)(prow + DIN + c0); }
        __syncthreads();
        { const int ch = tid >> 3, part = tid & 7;
#pragma unroll
          for (int u = 0; u < 4; ++u) *(LAS h8*)(tile + u * 4608 + ch * 72 + part * 8) = yt[u]; }
        __syncthreads();
#pragma unroll
        for (int u = 0; u < 4; ++u) { const int c0 = (4 * q + u) * 64 + cg * 8; h8 o;
#pragma unroll
            for (int j = 0; j < 8; ++j) { const float x0 = (float)prv[u][j] * cw[c0 + j] + (float)cur[u][j] * cw[1536 + c0 + j] + (float)nxt[u][j] * cw[3072 + c0 + j] + cbias[c0 + j];
                o[j] = (f16)(x0 * (float)tile[u * 4608 + (cg * 8 + j) * 72 + t]); }
            *(h8*)(yrow + c0) = o; }
    }
    __syncthreads();
}

struct TileOrder {
    int nM, nN, nwg, G, c;
    __device__ __forceinline__ void init(int M, int N, int G_, int c_) { nM = M / 256; nN = N / 256; nwg = nM * nN; G = G_; c = c_; }
    __device__ __forceinline__ bool tile(int i, int& pm, int& pn) const {
        const long L = (long)i * G + c; if (L >= nwg) return false;
        int wgid = (int)L; { const int q = nwg / 8, r = nwg % 8, xcd = wgid % 8, off = wgid / 8; wgid = (xcd < r ? xcd * (q + 1) : r * (q + 1) + (xcd - r) * q) + off; }
        const int nig = 8 * nN, gid = wgid / nig, fm = gid * 8, gsz = (nM - fm) < 8 ? (nM - fm) : 8;
        pm = fm + ((wgid % nig) % gsz); pn = (wgid % nig) / gsz; return true;
    }
};
template <int SUB>
struct DenseSched {
    static constexpr bool GATHER = false;
    TileOrder O; const char* A; const char* Bm; int lda, ldb; size_t a_sub, b_sub; int lat_only;
    __device__ __forceinline__ bool next(int i, pg::Unit& u) const {
        const int ti = i / SUB, s = i - ti * SUB; int pm, pn;
        if (!O.tile(ti, pm, pn)) return false;
        if (lat_only) pm = (pm >> 4) * 17 + (pm & 15);
        u.pm = pm; u.pn = pn; u.e = s; u.nrows = 256; u.aux0 = 0;
        u.A = A + (size_t)pm * 256 * lda * 2 + s * a_sub; u.B = Bm + (size_t)pn * 256 * ldb * 2 + s * b_sub;
        return true;
    }
    __device__ __forceinline__ int arow(const pg::Unit&, int r) const { return r; }
};
struct EpiInproj {
    static constexpr bool PERM = true; static constexpr int NVM = 16;
    __device__ __forceinline__ bool full(const pg::Unit&) const { return !dry; }
    f16* O; f16* X1T; f16* VHT; f16* VT; int dry;
    __device__ __forceinline__ void operator()(const f32x4 (&acc)[2][2][4][2], const pg::Unit& u, int wr, int wc, int fr, int fq) const {
        const int pn = u.pn;
        f16* tb = (pn == 2 || pn == 3) ? X1T : ((pn == 4 || pn == 5) ? VHT : ((pn == 16 || pn == 17) ? VT : nullptr));
        if (tb == nullptr) {
#pragma unroll
            for (int ai = 0; ai < 2; ++ai)
#pragma unroll
                for (int m = 0; m < 4; ++m) { f16* rowp = O + (size_t)(u.pm * 256 + ai * 128 + wr * 64 + m * 16 + fr) * DIN + pn * 256 + wc * 64 + 8 * fq;
#pragma unroll
                    for (int bj = 0; bj < 2; ++bj) { const f32x4 v0 = acc[ai][bj][m][0], v1 = acc[ai][bj][m][1];
                        u32x4 o; o.x = pkh(v0[0], v0[1]); o.y = pkh(v0[2], v0[3]); o.z = pkh(v1[0], v1[1]); o.w = pkh(v1[2], v1[3]);
                        if (!dry || o.x == 0x12345678u) *(u32x4*)(rowp + bj * 32) = o; } }
        } else {
            const int row_t = u.pm * 256, b = row_t / SE, i0 = row_t - b * SE;
            const int ch0 = (pn & 1) * 256 + wc * 64 + 8 * fq;
            f16* cb = tb + ((size_t)b * DH + ch0) * SE + i0 + wr * 64 + fr;
#pragma unroll
            for (int bj = 0; bj < 2; ++bj)
#pragma unroll
                for (int e = 0; e < 8; ++e) { f16* cp = cb + (size_t)(bj * 32 + e) * SE;
#pragma unroll
                    for (int ai = 0; ai < 2; ++ai)
#pragma unroll
                        for (int m = 0; m < 4; ++m) if (!dry) cp[ai * 128 + m * 16] = (f16)acc[ai][bj][m][e >> 2][e & 3]; }
        }
    }
};
struct EpiBranch {
    static constexpr bool PERM = true; static constexpr int NVM = 16;
    __device__ __forceinline__ bool full(const pg::Unit&) const { return pf == 0; }
    const f16* P; f16* MG; u32x4* scr; int tid, pf;
    __device__ __forceinline__ void operator()(const f32x4 (&acc)[2][2][4][2], const pg::Unit& u, int wr, int wc, int fr, int fq) const {
        const int br = (pf & 512) ? 2 : u.e;
        const int col0 = u.pn * 256 + wc * 64 + 8 * fq;
        const size_t row0 = (size_t)(u.pm * 256 + wr * 64 + fr);
        const f16* gp = P + row0 * DIN + OFF_GATE + br * D + col0;
        f16* mp = MG + row0 * D + col0;
        u32x4* sp = scr + tid;
        h8 G[2][2]; u32x4 Sv[2][2];
        if (!(pf & 1024)) { G[0][0] = *(const h8*)gp; G[0][1] = *(const h8*)(gp + 32); } else { G[0][0] = __builtin_bit_cast(h8, (u32x4){(unsigned)fr, 0u, 0u, 0u}); G[0][1] = G[0][0]; G[1][0] = G[0][0]; G[1][1] = G[0][0]; }
        if (br == 1 || (br == 2 && !(pf & 512))) { Sv[0][0] = sp[0]; Sv[0][1] = sp[NTHR]; }
#pragma unroll
        for (int g = 0; g < 8; ++g) {
            const int ai = g >> 2, m = g & 3, cb = g & 1, nb = cb ^ 1;
            const f16* gpn = gp + ((m == 3 ? (size_t)(128 - 48) : (size_t)16) * DIN); u32x4* spn = sp + 2 * NTHR;
            if (g < 7) {
                if (!(pf & 1024)) { G[nb][0] = *(const h8*)gpn; G[nb][1] = *(const h8*)(gpn + 32); }
                if (br == 1 || (br == 2 && !(pf & 512))) { Sv[nb][0] = spn[0]; Sv[nb][1] = spn[NTHR]; }
            }
            asm volatile("" ::: "memory");
#pragma unroll
            for (int bj = 0; bj < 2; ++bj) {
                const h8 gg = G[cb][bj];
                f32x4 v0 = acc[ai][bj][m][0], v1 = acc[ai][bj][m][1];
#pragma unroll
                for (int j = 0; j < 4; ++j) { v0[j] *= sigm((float)gg[j]); v1[j] *= sigm((float)gg[4 + j]); }
                if (br == 1 || (br == 2 && !(pf & 512))) { const h8 pv = __builtin_bit_cast(h8, Sv[cb][bj]);
#pragma unroll
                    for (int j = 0; j < 4; ++j) { v0[j] += (float)pv[j]; v1[j] += (float)pv[4 + j]; } }
                u32x4 o; o.x = pkh(v0[0], v0[1]); o.y = pkh(v0[2], v0[3]); o.z = pkh(v1[0], v1[1]); o.w = pkh(v1[2], v1[3]);
                if (br < 2) sp[(size_t)bj * NTHR] = o; else if (!(pf & 2048)) *(u32x4*)(mp + bj * 32) = o;
            }
            gp = gpn; sp = spn; mp += (m == 3 ? (size_t)(128 - 48) : (size_t)16) * D;
            asm volatile("" : "+v"(gp), "+v"(mp), "+v"(sp) :: "memory");
        }
    }
};
struct EpiOut {
    static constexpr bool PERM = false; static constexpr int NVM = 32;
    __device__ __forceinline__ bool full(const pg::Unit&) const { return !dry; }
    float* X; const float* mods_l; int dry;
    __device__ __forceinline__ void operator()(const f32x4 (&acc)[2][2][4][2], const pg::Unit& u, int wr, int wc, int fr, int fq) const {
        const int row_t = u.pm * 256;
        const float* gt = mods_l + (size_t)mod_row(row_t) * 6 * D + 2 * D + u.pn * 256 + wc * 32 + 4 * fq;
        f32x4 gv[2][2];
#pragma unroll
        for (int bj = 0; bj < 2; ++bj)
#pragma unroll
            for (int n = 0; n < 2; ++n) gv[bj][n] = *(const f32x4*)(gt + bj * 128 + n * 16);
        float* xp = X + (size_t)(row_t + wr * 64 + fr) * D + u.pn * 256 + wc * 32 + 4 * fq;
        f32x4 Xv[2][4];
#pragma unroll
        for (int q = 0; q < 4; ++q) Xv[0][q] = *(const f32x4*)(xp + (q >> 1) * 128 + (q & 1) * 16);
#pragma unroll
        for (int g = 0; g < 8; ++g) {
            const int ai = g >> 2, m = g & 3, cb = g & 1, nb = cb ^ 1;
            float* xpn = xp + (m == 3 ? (size_t)(128 - 48) : (size_t)16) * D;
            if (g < 7) {
#pragma unroll
                for (int q = 0; q < 4; ++q) Xv[nb][q] = *(const f32x4*)(xpn + (q >> 1) * 128 + (q & 1) * 16);
            }
            asm volatile("" ::: "memory");
#pragma unroll
            for (int bj = 0; bj < 2; ++bj)
#pragma unroll
                for (int n = 0; n < 2; ++n) { const f32x4 nv_ = Xv[cb][bj * 2 + n] * ALPHA + gv[bj][n] * acc[ai][bj][m][n]; if (!dry) *(f32x4*)(xp + bj * 128 + n * 16) = nv_; }
            xp = xpn;
            asm volatile("" : "+v"(xp) :: "memory");
        }
    }
};
__device__ __forceinline__ void inproj_phase(Frame& F) {
    DenseSched<1> Sc; Sc.lat_only = 0; Sc.O.init(T, DIN, F.G, F.bid); Sc.A = (const char*)(F.ws + WS_HMH); Sc.Bm = (const char*)(F.ws + WS_WIN); Sc.lda = D; Sc.ldb = D; Sc.a_sub = 0; Sc.b_sub = 0;
    EpiInproj E; E.O = (f16*)(F.ws + WS_P); E.X1T = (f16*)(F.ws + WS_ZT); E.VHT = (f16*)(F.ws + WS_VHT); E.VT = (f16*)(F.ws + WS_VT); E.dry = F.dry;
    pg::gemm_phase<EpiInproj, DenseSched<1>, false>(F.lds, F.wave, D, D, D, Sc, E);
}
__device__ __forceinline__ void branch_phase(Frame& F, int lat_only, int pf) {
    DenseSched<3> Sc; Sc.lat_only = lat_only; Sc.O.init(lat_only ? B * S : T, D, F.G, F.bid); Sc.A = (const char*)(F.ws + WS_Y); Sc.Bm = (const char*)(F.ws + WS_PJ); Sc.lda = 1536; Sc.ldb = DH; Sc.a_sub = (size_t)DH * 2; Sc.b_sub = (size_t)D * DH * 2;
    EpiBranch E; E.P = (const f16*)(F.ws + WS_P); E.MG = (f16*)(F.ws + WS_HMH); E.scr = (u32x4*)(F.ws + WS_SCR) + (size_t)F.bid * 16 * NTHR; E.tid = F.tid; E.pf = pf;
    pg::gemm_phase<EpiBranch, DenseSched<3>, true>(F.lds, F.wave, DH, 1536, DH, Sc, E);
}
__device__ __forceinline__ void outproj_phase(Frame& F, int l) {
    const int lat_only = l == DEPTH - 1;
    DenseSched<1> Sc; Sc.lat_only = lat_only; Sc.O.init(lat_only ? B * S : T, D, F.G, F.bid); Sc.A = (const char*)(F.ws + WS_HMH); Sc.Bm = (const char*)(F.ws + WS_WO); Sc.lda = D; Sc.ldb = D; Sc.a_sub = 0; Sc.b_sub = 0;
    EpiOut E; E.X = (float*)(F.ws + WS_X); E.mods_l = (const float*)(F.ws + WS_MODS) + (size_t)l * 9 * 6 * D; E.dry = F.dry;
    pg::gemm_phase<EpiOut, DenseSched<1>, false>(F.lds, F.wave, D, D, D, Sc, E);
}
constexpr int LDS_TAB_OFF = pg::STAGE_BYTES;
constexpr int LDS_MISC_OFF = LDS_TAB_OFF + 1024;
constexpr int LDS_BYTES = 147456;
constexpr int NPH_L = 13, NPHASE = 2 + NPH_L * DEPTH;
constexpr int FLAG_HYB_MOE = 1;
constexpr int FLAG_HYB_MIX = 2;
constexpr int FLAG_DRY = 4;

template <class P> __device__ __forceinline__ P launder_uniform(P p) {
    unsigned long long v = (unsigned long long)p; unsigned lo = (unsigned)v, hi = (unsigned)(v >> 32);
    unsigned vlo, vhi;
    asm volatile("v_mov_b32 %0, %2\n\tv_mov_b32 %1, %3" : "=&v"(vlo), "=&v"(vhi) : "s"(lo), "s"(hi));
    lo = __builtin_amdgcn_readfirstlane(vlo); hi = __builtin_amdgcn_readfirstlane(vhi);
    return (P)(((unsigned long long)hi << 32) | lo);
}
typedef unsigned* gu32p;
__device__ __forceinline__ int launder_int(int v) { int o; asm volatile("v_mov_b32 %0, %1" : "=v"(o) : "s"(v)); return __builtin_amdgcn_readfirstlane(o); }
__device__ __forceinline__ void launder(Frame& F, CArgsP& ap) { F.lane = lane_id(); asm volatile("" : "+v"(F.lane)); ap = launder_uniform((CArgsP)__builtin_amdgcn_kernarg_segment_ptr()); F.ws = (GAS unsigned char*)ap->ws; F.G = launder_int(F.G); F.bid = launder_int(F.bid); F.vcu = launder_int(F.vcu); F.wave = launder_int(F.wave); F.dry = launder_int(F.dry); F.tid = F.wave * 64 + F.lane; }
#ifndef MOE_SPLIT_NUM
#define MOE_SPLIT_NUM 144
#endif
#ifndef PROBE_REP
#define PROBE_REP -1
#endif
#ifndef PROBE_SLO
#define PROBE_SLO -1
#define PROBE_SHI -1
#endif
#define REP(k, ...) do { __VA_ARGS__; if (PROBE_REP == (k)) { __syncthreads(); __VA_ARGS__; } } while (0)
__global__ void __launch_bounds__(NTHR, 2) fwd(Args a_unused) {
    CArgsP ap = (CArgsP)__builtin_amdgcn_kernarg_segment_ptr();
    extern __shared__ __attribute__((aligned(16))) unsigned char lds_raw[];
    Frame F;
    F.lds = (LAS unsigned char*)lds_raw;
    F.tid = threadIdx.x; F.lane = F.tid & 63; F.wave = __builtin_amdgcn_readfirstlane(F.tid >> 6);
    F.G = gridDim.x; F.bid = blockIdx.x; { const int bx = blockIdx.x; F.vcu = (F.G % 8 == 0) ? (bx % 8) * (F.G / 8) + bx / 8 : bx; }
    F.ws = (GAS unsigned char*)ap->ws; F.dry = (ap->flags & FLAG_DRY) ? 1 : 0;
    for (int u = F.tid; u < (1024 + 64) / 4; u += NTHR) ((LAS unsigned*)(F.lds + LDS_TAB_OFF))[u] = 0u;
    __syncthreads();
    XcdBarrier bar; bar.bar = (unsigned*)(F.ws + WS_CTL) + CW_BAR; bar.x = 0; bar.st = nullptr;
    if (ap->use_bar) bar = xcd_barrier_post((unsigned*)(F.ws + WS_CTL) + CW_BAR, (volatile LAS unsigned*)(F.lds + LDS_MISC_OFF + 32), F.tid);
#define IN(k) (launder(F, ap), ap->ph_lo <= (k) && (k) < ap->ph_hi)
#define SEAM(k) do { if (IN(k) && IN((k) + 1)) { bar.bar = (unsigned*)((unsigned char*)F.ws + WS_CTL) + CW_BAR; bar.x = (unsigned)launder_int((int)bar.x); xcd_barrier(bar, F.tid); if (PROBE_REP == 99) xcd_barrier(bar, F.tid); } } while (0)
    if (IN(0)) { pro_mods(F, ap->in); pro_z2(F, ap->in); convert_mixer_weights(F, ap->in, 0); }
    SEAM(0);
    if (IN(1)) { filters_phase(F, ap->in, 0); init_mod1_rows(F, ap->in); }
    SEAM(1);
    unsigned long long tacc = 0ull, tst = 0ull;
#define ST_B(k) do { if (PROBE_SLO == (k)) tst = __builtin_amdgcn_s_memrealtime(); } while (0)
#define ST_E(k) do { if (PROBE_SHI == (k)) tacc += __builtin_amdgcn_s_memrealtime() - tst; } while (0)
    for (int l = 0; l < DEPTH; ++l) {
        const int pb = 2 + NPH_L * l;
        ST_B(0); if (IN(pb + 0)) REP(0, inproj_phase(F));
        SEAM(pb + 0); ST_E(0);
        ST_B(2); if (IN(pb + 2)) { if (!(ap->flags & 8)) { fftconv_tasks(F, ap->in, l, ap->flags); launder(F, ap); if (l + 1 < DEPTH && !(ap->flags & 4096)) ctxconv_tasks(F, ap->in, l); launder(F, ap); } if (!(ap->flags & 16)) REP(2, attn_tasks(F, ap->in, l, F.dry ? ap->flags : 0)); }
        SEAM(pb + 2); ST_E(2);
        ST_B(3); if (IN(pb + 3)) REP(3, ymix_phase(F, ap->in, l));
        SEAM(pb + 3); ST_E(3);
        ST_B(4); if (IN(pb + 4)) REP(4, branch_phase(F, l == DEPTH - 1, F.dry ? ap->flags : 0));
        SEAM(pb + 4); ST_E(4);
        ST_B(5); if (IN(pb + 5)) { convert_router(F, ap->in, l); outproj_phase(F, l); }
        SEAM(pb + 5); ST_E(5);
        ST_B(6); if (IN(pb + 6)) { if (!(ap->flags & 64)) ln1_router_phase(F, ap->in, l); __syncthreads(); if (!(ap->flags & 32)) convert_moe_weights(F, ap->in, l); }
        SEAM(pb + 6); ST_E(6);
        ST_B(8); if (IN(pb + 8)) moe_up_phase(F, l, 0, F.G, F.bid);
        SEAM(pb + 8); ST_E(8);
        ST_B(9); if (IN(pb + 9)) moe_down_phase(F, l, 0, F.G, F.bid);
        SEAM(pb + 9); ST_E(9);
        ST_B(10); if (IN(pb + 10)) { ln2_rows(F, ap->in, (float*)ap->out, l, 0); launder(F, ap); moe_up_phase(F, l, 1, F.G, F.bid); }
        SEAM(pb + 10); ST_E(10);
        ST_B(11); if (IN(pb + 11)) moe_down_phase(F, l, 1, F.G, F.bid);
        SEAM(pb + 11); ST_E(11);
        ST_B(12); if (IN(pb + 12)) {
            if (!(ap->flags & FLAG_HYB_MIX)) ln2_rows(F, ap->in, (float*)ap->out, l, 1);
            if (l + 1 < DEPTH && !(ap->flags & FLAG_HYB_MOE)) {
                __syncthreads(); convert_mixer_weights(F, ap->in, l + 1); __syncthreads(); filters_phase(F, ap->in, l + 1);
                if (ap->flags & FLAG_HYB_MIX) mod1_rows(F, l + 1);
            }
        }
        SEAM(pb + 12); ST_E(12);
    }
    if (PROBE_SLO >= 0) {
        gu32p dbg = (gu32p)((unsigned*)(F.ws + WS_CTL) + CW_DBG);
        bar.bar = (unsigned*)((unsigned char*)F.ws + WS_CTL) + CW_BAR; xcd_barrier(bar, F.tid);
        if (F.bid == 0 && F.tid == 0) __hip_atomic_store((unsigned*)dbg, (unsigned)tacc, __ATOMIC_RELAXED, __HIP_MEMORY_SCOPE_AGENT);
        xcd_barrier(bar, F.tid);
        const unsigned tv = __hip_atomic_load((unsigned*)dbg, __ATOMIC_RELAXED, __HIP_MEMORY_SCOPE_AGENT);
        const float v = sqrtf((float)tv * (1.0f / 100000.0f));
        float* o = (float*)ap->out;
        for (size_t i = (size_t)F.bid * NTHR + F.tid; i < (size_t)B * S * D; i += (size_t)F.G * NTHR) o[i] = v;
    }
#undef IN
#undef SEAM
}

static int g_grid = 0;
static bool setup_grid() {
    if (g_grid) return g_grid > 0;
    int dev = 0, cus = 0, per_cu = 0;
    if (hipGetDevice(&dev) != hipSuccess || hipDeviceGetAttribute(&cus, hipDeviceAttributeMultiprocessorCount, dev) != hipSuccess) { g_grid = -1; return false; }
    if (hipFuncSetAttribute((const void*)fwd, hipFuncAttributeMaxDynamicSharedMemorySize, LDS_BYTES) != hipSuccess) { fprintf(stderr, "hipFuncSetAttribute failed\n"); g_grid = -1; return false; }
    if (hipOccupancyMaxActiveBlocksPerMultiprocessor(&per_cu, (const void*)fwd, NTHR, LDS_BYTES) != hipSuccess || per_cu < 1) { fprintf(stderr, "occupancy query: %d\n", per_cu); (void)hipGetLastError(); g_grid = -1; return false; }
    g_grid = cus;
    return true;
}
static void launch_phases(const Args& base, int lo, int hi, int use_bar, hipStream_t st) {
    Args a = base; a.ph_lo = lo; a.ph_hi = hi; a.use_bar = use_bar;
    hipLaunchKernelGGL(fwd, dim3(g_grid), dim3(NTHR), LDS_BYTES, st, a);
}
}
#ifndef PROBE_XFLAGS
#define PROBE_XFLAGS 0
#endif
#ifndef PROBE_PH
#define PROBE_PH -1
#endif
#ifndef HYB
#define HYB 1
#endif
#ifndef GAS
#define GAS __attribute__((address_space(1)))
#endif
extern "C" void kernel_launch(void* const* d_in, const int* in_sizes, int n_in, void* d_out, int out_size, void* d_ws, size_t ws_size, hipStream_t stream) {
    if (n_in != 34 || ws_size < fk::WS_END + (size_t)64 * fk::MiB) { fprintf(stderr, "kernel_launch: unexpected inputs / workspace (%d, %zu)\n", n_in, ws_size); return; }
    nv::In in{};
    { const float** f = (const float**)&in; for (int i = 0; i < 34; ++i) f[i] = (const float*)d_in[i]; }
    fk::Args a{};
    { const float** f = (const float**)&a.in; for (int i = 0; i < 34; ++i) f[i] = (const float*)d_in[i]; }
    a.out = (GAS float*)d_out; a.ws = (unsigned char*)d_ws;
    if (!fk::setup_grid()) return;
    (void)hipMemsetAsync((char*)d_ws + fk::WS_CTL, 0, fk::CTL_ZERO_BYTES, stream);
    nv::Ctx c = nv::make_ctx((unsigned char*)d_ws, fk::WS_DYN);
#if HYB == 0
    nv::prologue(in, c, stream);
    for (int l = 0; l < 4; ++l) { nv::mixer_layer(in, c, l, stream); nv::moe_layer(in, c, l, stream); }
    nv::finalize(c, (float*)d_out, stream);
#elif HYB == 1
    a.flags = fk::FLAG_HYB_MOE;
    nv::prologue(in, c, stream);
    for (int l = 0; l < 4; ++l) {
        nv::mixer_layer(in, c, l, stream);
        const int pb = 2 + fk::NPH_L * l;
        for (int p = pb + 6; p <= pb + 12; ++p) fk::launch_phases(a, p, p + 1, 0, stream);
    }
#elif HYB == 2
    a.flags = fk::FLAG_HYB_MIX;
    fk::launch_phases(a, 0, 1, 0, stream); fk::launch_phases(a, 1, 2, 0, stream);
    for (int l = 0; l < 4; ++l) {
        const int pb = 2 + fk::NPH_L * l;
        for (int p = pb; p <= pb + 6; ++p) fk::launch_phases(a, p, p + 1, 0, stream);
        nv::moe_layer(in, c, l, stream);
        if (l < 3) fk::launch_phases(a, pb + 12, pb + 13, 0, stream);
    }
    nv::finalize(c, (float*)d_out, stream);
#elif HYB == 3
    for (int p = 0; p < fk::NPHASE; ++p) fk::launch_phases(a, p, p + 1, 0, stream);
#elif HYB == 5
    for (int p = 0; p < fk::NPHASE; ++p) {
        const bool hit = (PROBE_PH >= 100) ? (p == PROBE_PH - 100) : (p >= 2 && (p - 2) % fk::NPH_L == PROBE_PH);
        if (hit) { fk::Args d = a; d.flags |= fk::FLAG_DRY | PROBE_XFLAGS; fk::launch_phases(d, p, p + 1, 0, stream); }
        fk::launch_phases(a, p, p + 1, 0, stream);
    }
#elif HYB == 4
    fk::launch_phases(a, 0, fk::NPHASE, 1, stream);
#endif
}
```

```cpp
#define HYB 4
#define PROBE_REP -1
#define PROBE_SLO -1
#define PROBE_SHI -1
#define PROBE_PH -1
#define PROBE_XFLAGS 0

#include <hip/hip_runtime.h>
#include <cstdio>
#include <cstdint>
namespace nv {
constexpr int B = 8, S = 4096, CL = 256, SE = S + CL, T = B * SE, D = 1024, DEPTH = 4;
constexpr int DH = 512, DIN = 7680, OFF_SC = 1536, OFF_NA = 3072, OFF_GATE = 4608;
constexpr int NE = 64, TOPK = 8, DEXP = 256;
constexpr int GRIDW = 64, NHEAD = 8, HDIM = 64;
constexpr float LN_EPS = 1e-5f;
constexpr float ALPHA = 1.681792830507429f;

__device__ __forceinline__ float sigmoidf_(float x) { return 1.f / (1.f + expf(-x)); }
__device__ __forceinline__ float siluf_(float x) { return x / (1.f + expf(-x)); }
__device__ __forceinline__ float wsum(float v) {
#pragma unroll
    for (int o = 1; o < 64; o <<= 1) v += __shfl_xor(v, o);
    return v;
}
__device__ __forceinline__ float wmax(float v) {
#pragma unroll
    for (int o = 1; o < 64; o <<= 1) v = fmaxf(v, __shfl_xor(v, o));
    return v;
}

__global__ void k_cond(const float* c, const float* c_ctx, float* cond) {
    int i = blockIdx.x * blockDim.x + threadIdx.x;
    if (i < 9 * D) { float v = i < 8 * D ? c[i] : c_ctx[i - 8 * D]; cond[i] = siluf_(v); }
}
__global__ void k_mods(const float* cond, const float* w_ada, const float* b_ada, float* mods) {
    int j = blockIdx.x * blockDim.x + threadIdx.x;
    if (j >= DEPTH * 6 * D) return;
    int l = j / (6 * D), col = j % (6 * D);
    float acc[9];
#pragma unroll
    for (int r = 0; r < 9; ++r) acc[r] = 0.f;
    const float* w = w_ada + (size_t)l * D * 6 * D + col;
    for (int k = 0; k < D; ++k) { float wv = w[(size_t)k * 6 * D];
#pragma unroll
        for (int r = 0; r < 9; ++r) acc[r] += cond[r * D + k] * wv; }
    float bb = b_ada[l * 6 * D + col];
#pragma unroll
    for (int r = 0; r < 9; ++r) mods[((size_t)l * 9 + r) * 6 * D + col] = acc[r] + bb;
}
__global__ void k_init_x(const float* x, const float* ctx, float* X) {
    size_t i = (size_t)blockIdx.x * blockDim.x + threadIdx.x;
    if (i >= (size_t)T * D) return;
    int row = (int)(i / D), d = (int)(i % D), b = row / SE, ii = row % SE;
    X[i] = ii < S ? x[((size_t)b * S + ii) * D + d] : ctx[((size_t)b * CL + (ii - S)) * D + d];
}
__global__ void k_modulate(const float* X, const float* mods_l, float* HM, int which) {
    size_t i = (size_t)blockIdx.x * blockDim.x + threadIdx.x;
    if (i >= (size_t)T * D) return;
    int row = (int)(i / D), d = (int)(i % D), b = row / SE, ii = row % SE, mb = ii < S ? b : 8;
    const float* m = mods_l + (size_t)mb * 6 * D;
    HM[i] = X[i] * (1.f + m[(which + 1) * D + d]) + m[which * D + d];
}
struct GemmP { const float* A; int lda; const int* gidx; const float* Bm; int ldb; float* C; int ldc; int M; const int* Mdev; int N, K; int mode;
               const int* sidx; const float* sw; long long eB, eG; const int* coff; const int* aoff; };
__global__ void __launch_bounds__(256) k_gemm(GemmP p) {
    __shared__ float As[16][68];
    __shared__ float Bs[16][64];
    const int z = blockIdx.z;
    const int M = p.Mdev ? p.Mdev[z] : p.M;
    const int row0 = blockIdx.y * 64, col0 = blockIdx.x * 64;
    if (row0 >= M) return;
    const float* A = p.A; const float* Bm = p.Bm + (size_t)z * p.eB;
    const int* gidx = p.gidx ? p.gidx + (size_t)z * p.eG : nullptr;
    const int* sidx = p.sidx ? p.sidx + (size_t)z * p.eG : nullptr;
    const float* sw = p.sw ? p.sw + (size_t)z * p.eG : nullptr;
    const int crow_off = p.coff ? p.coff[z] : 0;
    const int arow_off = p.aoff ? p.aoff[z] : 0;
    float* C = p.C;
    const int tid = threadIdx.x, tx = tid & 15, ty = tid >> 4;
    const int ar = tid >> 2, ak = (tid & 3) * 4;
    const int bk = tid >> 4, bn = (tid & 15) * 4;
    int arow = row0 + ar; if (arow >= M) arow = M - 1;
    const size_t asrc = gidx ? (size_t)gidx[arow] : (size_t)(arow_off + arow);
    const float* ap = A + asrc * p.lda + ak;
    const float* bp = Bm + (size_t)bk * p.ldb + col0 + bn;
    float acc[4][4];
#pragma unroll
    for (int i = 0; i < 4; ++i)
#pragma unroll
        for (int j = 0; j < 4; ++j) acc[i][j] = 0.f;
    for (int k0 = 0; k0 < p.K; k0 += 16) {
        float4 av = *(const float4*)(ap + k0);
        float4 bv = *(const float4*)(bp + (size_t)k0 * p.ldb);
        As[ak + 0][ar] = av.x; As[ak + 1][ar] = av.y; As[ak + 2][ar] = av.z; As[ak + 3][ar] = av.w;
        *(float4*)&Bs[bk][bn] = bv;
        __syncthreads();
#pragma unroll
        for (int kk = 0; kk < 16; ++kk) {
            float4 a4 = *(const float4*)&As[kk][ty * 4];
            float4 b4 = *(const float4*)&Bs[kk][tx * 4];
            float a[4] = {a4.x, a4.y, a4.z, a4.w}, b[4] = {b4.x, b4.y, b4.z, b4.w};
#pragma unroll
            for (int i = 0; i < 4; ++i)
#pragma unroll
                for (int j = 0; j < 4; ++j) acc[i][j] += a[i] * b[j];
        }
        __syncthreads();
    }
#pragma unroll
    for (int i = 0; i < 4; ++i) {
        int r = row0 + ty * 4 + i; if (r >= M) continue;
        if (p.mode == 0) {
            float* cp = C + (size_t)(crow_off + r) * p.ldc + col0 + tx * 4;
            *(float4*)cp = make_float4(acc[i][0], acc[i][1], acc[i][2], acc[i][3]);
        } else {
            int tok = sidx[r]; float w = sw[r];
            float* cp = C + (size_t)tok * p.ldc + col0 + tx * 4;
#pragma unroll
            for (int j = 0; j < 4; ++j) atomicAdd(cp + j, w * acc[i][j]);
        }
    }
}
static void gemm(hipStream_t st, const float* A, int lda, const float* Bm, int ldb, float* C, int ldc, int M, int N, int K) {
    GemmP p{}; p.A = A; p.lda = lda; p.Bm = Bm; p.ldb = ldb; p.C = C; p.ldc = ldc; p.M = M; p.N = N; p.K = K; p.mode = 0;
    hipLaunchKernelGGL(k_gemm, dim3(N / 64, (M + 63) / 64, 1), dim3(256), 0, st, p);
}

__global__ void k_hy_z2(const float* w1, const float* b1, const float* w2, const float* b2, const float* sf, int L, float* z2tab) {
    const int t = blockIdx.x * (blockDim.x / 64) + (threadIdx.x >> 6), lane = threadIdx.x & 63;
    if (t >= L) return;
    const double PI2 = 6.283185307179586476925;
    float tt = (float)((double)t / (double)(L - 1));
    float ang = (float)(PI2 / (double)L) * (float)t;
    float a = b1[lane];
    a += tt * w1[0 * 64 + lane];
    for (int j = 0; j < 16; ++j) {
        float band = (float)(1e-4 + (double)j * ((15.0 - 1e-4) / 15.0));
        float arg = band * ang;
        a += cosf(arg) * w1[(1 + j) * 64 + lane];
        a += -sinf(arg) * w1[(17 + j) * 64 + lane];
    }
    float z1 = sinf(sf[lane] * a);
    float a2 = b2[lane];
    for (int i = 0; i < 64; ++i) a2 += __shfl(z1, i) * w2[i * 64 + lane];
    z2tab[(size_t)t * 64 + lane] = sinf(sf[64 + lane] * a2);
}
__global__ void k_hy_filt(const float* z2tab, const float* w3, int L, float* hf, float* hb) {
    int i = blockIdx.x * blockDim.x + threadIdx.x;
    if (i >= L * DH) return;
    int t = i / DH, c = i % DH;
    float af = 0.f, ab = 0.f;
    for (int j = 0; j < 64; ++j) { float z = z2tab[(size_t)t * 64 + j]; af += z * w3[j * 1024 + c]; ab += z * w3[j * 1024 + 512 + c]; }
    const double la = log(1e-2) / 1.5, lb = log(1e-2) / 0.3;
    float delta = fabsf((float)(la + (double)c * ((lb - la) / 511.0)));
    float tt = (float)((double)t / (double)(L - 1));
    float dec = expf(-tt * delta);
    hf[i] = af * dec; hb[i] = ab * dec;
}
__global__ void k_hy_conv(const float* PB, const float* cw, const float* cb, float* UC) {
    int idx = blockIdx.x * blockDim.x + threadIdx.x;
    if (idx >= SE * 1536) return;
    int i = idx / 1536, c = idx % 1536;
    int lo = i < S ? 0 : S, hi = i < S ? S : SE;
    float v = PB[(size_t)i * DIN + c] * cw[1536 + c];
    if (i - 1 >= lo) v += PB[(size_t)(i - 1) * DIN + c] * cw[c];
    if (i + 1 < hi) v += PB[(size_t)(i + 1) * DIN + c] * cw[2 * 1536 + c];
    UC[idx] = v + cb[c];
}
__global__ void k_hy_z(const float* UC, float* Z) {
    int idx = blockIdx.x * blockDim.x + threadIdx.x;
    if (idx >= SE * DH) return;
    int i = idx / DH, c = idx % DH;
    Z[idx] = UC[(size_t)i * 1536 + 1024 + c] * UC[(size_t)i * 1536 + 512 + c];
}
__global__ void k_hy_long(const float* Z, const float* UC, const float* hf, const float* hb, const float* hfc, const float* hbc, const float* bias_d, float* YHY) {
    int idx = blockIdx.x * blockDim.x + threadIdx.x;
    if (idx >= SE * DH) return;
    int i = idx / DH, c = idx % DH;
    int lo = i < S ? 0 : S, L = i < S ? S : CL;
    const float* f = i < S ? hf : hfc; const float* g = i < S ? hb : hbc;
    int t = i - lo;
    float acc = 0.f;
    for (int s = 0; s <= t; ++s) acc += f[(size_t)(t - s) * DH + c] * Z[(size_t)(lo + s) * DH + c];
    for (int s = t + 1; s < L; ++s) acc += g[(size_t)(s - t) * DH + c] * Z[(size_t)(lo + s) * DH + c];
    float z = Z[idx];
    YHY[idx] = UC[(size_t)i * 1536 + c] * (acc + z * bias_d[c]);
}
__global__ void k_sconv(const float* PB, const float* cw, float* YSC) {
    int idx = blockIdx.x * blockDim.x + threadIdx.x;
    if (idx >= SE * DH) return;
    int i = idx / DH, c = idx % DH;
    int lo = i < S ? 0 : S, hi = i < S ? S : SE;
    const float* p = PB + OFF_SC;
    float v = p[(size_t)i * DIN + 512 + c] * p[(size_t)i * DIN + 1024 + c] * cw[512 + c];
    if (i - 1 >= lo) v += p[(size_t)(i - 1) * DIN + 512 + c] * p[(size_t)(i - 1) * DIN + 1024 + c] * cw[c];
    if (i + 1 < hi) v += p[(size_t)(i + 1) * DIN + 512 + c] * p[(size_t)(i + 1) * DIN + 1024 + c] * cw[1024 + c];
    YSC[idx] = p[(size_t)i * DIN + c] * v;
}
__global__ void k_attn(const float* PB, const float* rpb, float* YAT) {
    const int wt = blockIdx.x * (blockDim.x / 64) + (threadIdx.x >> 6), lane = threadIdx.x & 63;
    if (wt >= SE * NHEAD) return;
    const int i = wt / NHEAD, h = wt % NHEAD;
    const float* Q = PB + OFF_NA + h * HDIM; const float* Kp = PB + OFF_NA + 512 + h * HDIM; const float* V = PB + OFF_NA + 1024 + h * HDIM;
    const float q = Q[(size_t)i * DIN + lane];
    float m = -3.0e38f, l = 0.f, o = 0.f;
    if (i < S) {
        const int r = i / GRIDW, qc = i % GRIDW;
        int rs = r - 4; rs = rs < 0 ? 0 : (rs > 56 ? 56 : rs);
        int cs = qc - 8; cs = cs < 0 ? 0 : (cs > 48 ? 48 : cs);
        for (int j = 0; j < 8; ++j) for (int kc = cs; kc < cs + 16; ++kc) {
            const int kt = (rs + j) * GRIDW + kc;
            float s = wsum(q * Kp[(size_t)kt * DIN + lane]) * 0.125f + rpb[(h * 15 + (rs + j - r + 7)) * 31 + (kc - qc + 15)];
            float mn = fmaxf(m, s), a = expf(m - mn), pp = expf(s - mn);
            l = l * a + pp; o = o * a + pp * V[(size_t)kt * DIN + lane]; m = mn;
        }
    }
    for (int kt = S; kt < SE; ++kt) {
        float s = wsum(q * Kp[(size_t)kt * DIN + lane]) * 0.125f;
        float mn = fmaxf(m, s), a = expf(m - mn), pp = expf(s - mn);
        l = l * a + pp; o = o * a + pp * V[(size_t)kt * DIN + lane]; m = mn;
    }
    YAT[(size_t)i * DH + h * HDIM + lane] = o / l;
}
__global__ void k_merge(const float* PB, const float* T0, const float* T1, const float* T2, float* MG) {
    int idx = blockIdx.x * blockDim.x + threadIdx.x;
    if (idx >= SE * D) return;
    int i = idx / D, c = idx % D;
    const float* g = PB + (size_t)i * DIN + OFF_GATE;
    MG[idx] = sigmoidf_(g[c]) * T0[idx] + sigmoidf_(g[D + c]) * T1[idx] + sigmoidf_(g[2 * D + c]) * T2[idx];
}
__global__ void k_res_ln(float* X, const float* O, const float* mods_l, int gate_idx, const float* lg, const float* lb, int row0, int n) {
    const int w = blockIdx.x * (blockDim.x / 64) + (threadIdx.x >> 6), lane = threadIdx.x & 63;
    if (w >= n) return;
    const int row = row0 + w, b = row / SE, ii = row % SE, mb = ii < S ? b : 8;
    const float* gt = mods_l + (size_t)mb * 6 * D + gate_idx * D;
    float v[16]; float s = 0.f;
#pragma unroll
    for (int j = 0; j < 16; ++j) { int d = lane + 64 * j; v[j] = ALPHA * X[(size_t)row * D + d] + gt[d] * O[(size_t)w * D + d]; s += v[j]; }
    const float mu = wsum(s) * (1.f / D); float q = 0.f;
#pragma unroll
    for (int j = 0; j < 16; ++j) { v[j] -= mu; q += v[j] * v[j]; }
    const float rstd = rsqrtf(wsum(q) * (1.f / D) + LN_EPS);
#pragma unroll
    for (int j = 0; j < 16; ++j) { int d = lane + 64 * j; X[(size_t)row * D + d] = v[j] * rstd * lg[d] + lb[d]; }
}
__global__ void k_route(const float* logits, const float* rbias, int* cnt, int* ltok, float* lw) {
    const int tok = blockIdx.x * (blockDim.x / 64) + (threadIdx.x >> 6), lane = threadIdx.x & 63;
    if (tok >= T) return;
    const float score = sigmoidf_(logits[(size_t)tok * NE + lane]);
    const float sel = score + rbias[lane];
    float m1 = sel;
    m1 = fmaxf(m1, __shfl_xor(m1, 1)); m1 = fmaxf(m1, __shfl_xor(m1, 2)); m1 = fmaxf(m1, __shfl_xor(m1, 4));
    unsigned long long eq = __ballot(sel == m1);
    const int g = lane >> 3;
    const unsigned geq = (unsigned)((eq >> (g * 8)) & 0xffull);
    const int first = __ffs(geq) - 1;
    float s2 = ((lane & 7) == first) ? -3.0e38f : sel;
    s2 = fmaxf(s2, __shfl_xor(s2, 1)); s2 = fmaxf(s2, __shfl_xor(s2, 2)); s2 = fmaxf(s2, __shfl_xor(s2, 4));
    const float gs = m1 + s2;
    int grank = 0;
    for (int gg = 0; gg < 8; ++gg) { float o = __shfl(gs, gg * 8); if (o > gs || (o == gs && gg < g)) ++grank; }
    const bool gsel = grank < 4;
    const float val = gsel ? sel : -3.0e38f;
    int rank = 0;
    for (int j = 0; j < 64; ++j) { float o = __shfl(val, j); if (o > val || (o == val && j < lane)) ++rank; }
    const bool chosen = gsel && rank < TOPK;
    const float tot = wsum(chosen ? score : 0.f);
    if (chosen) {
        const float w = score / tot * 2.5f;
        int pos = atomicAdd(&cnt[lane], 1);
        ltok[(size_t)lane * T + pos] = tok; lw[(size_t)lane * T + pos] = w;
    }
}
__global__ void k_prefix(const int* cnt, int* off) { if (threadIdx.x == 0) { int a = 0; for (int e = 0; e < NE; ++e) { off[e] = a; a += cnt[e]; } } }
__global__ void k_swiglu(const float* U1, const float* U3, float* H, size_t n) {
    size_t i = (size_t)blockIdx.x * blockDim.x + threadIdx.x;
    if (i < n) H[i] = siluf_(U1[i]) * U3[i];
}
__global__ void k_final(const float* X, float* out) {
    size_t i = (size_t)blockIdx.x * blockDim.x + threadIdx.x;
    if (i >= (size_t)B * S * D) return;
    int d = (int)(i % D); size_t r = i / D; int b = (int)(r / S), t = (int)(r % S);
    out[i] = X[((size_t)b * SE + t) * D + d];
}

struct In {
    const float *x, *c, *ctx, *c_ctx, *w_ada, *b_ada, *w_in, *hy_conv_w, *hy_conv_b, *hy_w1, *hy_b1, *hy_w2, *hy_b2, *hy_w3, *hy_sin_freq, *hy_bias_d,
        *hy_proj, *sc_conv_w, *sc_proj, *na_rpb, *na_proj, *w_o, *ln1_g, *ln1_b, *ln2_g, *ln2_b, *moe_router, *moe_bias, *moe_w1, *moe_w3, *moe_w2, *sh_w1, *sh_w3, *sh_w2;
};


struct Ctx {
    float *X, *HM, *cond, *mods, *MIX, *PB, *UC, *Z, *YB, *T0, *T1, *T2, *MG, *OB, *z2a, *z2c, *hf, *hb, *hfc, *hbc, *logits, *lw, *U1, *U3, *F, *YHY, *YSC, *YAT;
    int *cnt, *off, *ltok;
};
static Ctx make_ctx(unsigned char* ws, size_t dyn_off) {
    Ctx c{};
    c.X = (float*)(ws + (size_t)2 * 1024 * 1024); c.mods = (float*)(ws + (size_t)1024 * 1024); c.cond = (float*)(ws + (size_t)256 * 1024);
    size_t o = dyn_off; auto alloc = [&](size_t bytes) { size_t r = o; o += (bytes + 255) & ~(size_t)255; return (void*)(ws + r); };
    c.HM = (float*)alloc((size_t)T * D * 4);
    c.MIX = (float*)alloc((size_t)SE * 16384 * 4);
    c.PB = c.MIX; c.UC = c.PB + (size_t)SE * DIN; c.Z = c.UC + (size_t)SE * 1536; c.YB = c.Z + (size_t)SE * DH;
    c.T0 = c.YB + (size_t)SE * 1536; c.T1 = c.T0 + (size_t)SE * D; c.T2 = c.T1 + (size_t)SE * D; c.MG = c.T2 + (size_t)SE * D; c.OB = c.MG + (size_t)SE * D;
    c.z2a = (float*)alloc((size_t)S * 64 * 4); c.z2c = (float*)alloc((size_t)CL * 64 * 4);
    c.hf = (float*)alloc((size_t)S * DH * 4); c.hb = (float*)alloc((size_t)S * DH * 4);
    c.hfc = (float*)alloc((size_t)CL * DH * 4); c.hbc = (float*)alloc((size_t)CL * DH * 4);
    c.logits = (float*)alloc((size_t)T * NE * 4);
    c.cnt = (int*)alloc(256); c.off = (int*)alloc(256);
    c.ltok = (int*)alloc((size_t)NE * T * 4); c.lw = (float*)alloc((size_t)NE * T * 4);
    c.U1 = (float*)alloc((size_t)T * TOPK * DEXP * 4);
    c.U3 = c.MIX; c.F = c.MIX + (size_t)32 * 1024 * 1024;
    c.YHY = c.YB; c.YSC = c.YB + (size_t)SE * DH; c.YAT = c.YB + 2 * (size_t)SE * DH;
    return c;
}
static void prologue(const In& in, const Ctx& c, hipStream_t st) {
    hipLaunchKernelGGL(k_cond, dim3((9 * D + 255) / 256), dim3(256), 0, st, in.c, in.c_ctx, c.cond);
    hipLaunchKernelGGL(k_mods, dim3(DEPTH * 6 * D / 256), dim3(256), 0, st, c.cond, in.w_ada, in.b_ada, c.mods);
    hipLaunchKernelGGL(k_init_x, dim3((unsigned)(((size_t)T * D + 255) / 256)), dim3(256), 0, st, in.x, in.ctx, c.X);
}
static void mixer_layer(const In& in, const Ctx& c, int l, hipStream_t st) {
    const unsigned gTD = (unsigned)(((size_t)T * D + 255) / 256);
    const float* ml = c.mods + (size_t)l * 9 * 6 * D;
    hipLaunchKernelGGL(k_hy_z2, dim3(S / 4), dim3(256), 0, st, in.hy_w1 + l * 33 * 64, in.hy_b1 + l * 64, in.hy_w2 + l * 4096, in.hy_b2 + l * 64, in.hy_sin_freq + l * 128, S, c.z2a);
    hipLaunchKernelGGL(k_hy_z2, dim3(CL / 4), dim3(256), 0, st, in.hy_w1 + l * 33 * 64, in.hy_b1 + l * 64, in.hy_w2 + l * 4096, in.hy_b2 + l * 64, in.hy_sin_freq + l * 128, CL, c.z2c);
    hipLaunchKernelGGL(k_hy_filt, dim3(S * DH / 256), dim3(256), 0, st, c.z2a, in.hy_w3 + (size_t)l * 64 * 1024, S, c.hf, c.hb);
    hipLaunchKernelGGL(k_hy_filt, dim3(CL * DH / 256), dim3(256), 0, st, c.z2c, in.hy_w3 + (size_t)l * 64 * 1024, CL, c.hfc, c.hbc);
    hipLaunchKernelGGL(k_modulate, dim3(gTD), dim3(256), 0, st, c.X, ml, c.HM, 0);
    for (int b = 0; b < B; ++b) {
        gemm(st, c.HM + (size_t)b * SE * D, D, in.w_in + (size_t)l * D * DIN, DIN, c.PB, DIN, SE, DIN, D);
        hipLaunchKernelGGL(k_hy_conv, dim3(SE * 1536 / 256), dim3(256), 0, st, c.PB, in.hy_conv_w + l * 3 * 1536, in.hy_conv_b + l * 1536, c.UC);
        hipLaunchKernelGGL(k_hy_z, dim3(SE * DH / 256), dim3(256), 0, st, c.UC, c.Z);
        hipLaunchKernelGGL(k_hy_long, dim3(SE * DH / 256), dim3(256), 0, st, c.Z, c.UC, c.hf, c.hb, c.hfc, c.hbc, in.hy_bias_d + l * DH, c.YHY);
        hipLaunchKernelGGL(k_sconv, dim3(SE * DH / 256), dim3(256), 0, st, c.PB, in.sc_conv_w + l * 3 * DH, c.YSC);
        hipLaunchKernelGGL(k_attn, dim3(SE * NHEAD / 4), dim3(256), 0, st, c.PB, in.na_rpb + l * NHEAD * 15 * 31, c.YAT);
        gemm(st, c.YHY, DH, in.hy_proj + (size_t)l * DH * D, D, c.T0, D, SE, D, DH);
        gemm(st, c.YSC, DH, in.sc_proj + (size_t)l * DH * D, D, c.T1, D, SE, D, DH);
        gemm(st, c.YAT, DH, in.na_proj + (size_t)l * DH * D, D, c.T2, D, SE, D, DH);
        hipLaunchKernelGGL(k_merge, dim3(SE * D / 256), dim3(256), 0, st, c.PB, c.T0, c.T1, c.T2, c.MG);
        gemm(st, c.MG, D, in.w_o + (size_t)l * D * D, D, c.OB, D, SE, D, D);
        hipLaunchKernelGGL(k_res_ln, dim3(SE / 4), dim3(256), 0, st, c.X, c.OB, ml, 2, in.ln1_g + l * D, in.ln1_b + l * D, b * SE, SE);
    }
}
static void moe_layer(const In& in, const Ctx& c, int l, hipStream_t st) {
    const unsigned gTD = (unsigned)(((size_t)T * D + 255) / 256);
    const float* ml = c.mods + (size_t)l * 9 * 6 * D;
    hipLaunchKernelGGL(k_modulate, dim3(gTD), dim3(256), 0, st, c.X, ml, c.HM, 3);
    gemm(st, c.HM, D, in.moe_router + (size_t)l * D * NE, NE, c.logits, NE, T, NE, D);
    (void)hipMemsetAsync(c.cnt, 0, 256, st);
    hipLaunchKernelGGL(k_route, dim3(T / 4), dim3(256), 0, st, c.logits, in.moe_bias + l * NE, c.cnt, c.ltok, c.lw);
    hipLaunchKernelGGL(k_prefix, dim3(1), dim3(64), 0, st, c.cnt, c.off);
    {
        GemmP p{}; p.A = c.HM; p.lda = D; p.gidx = c.ltok; p.eG = T; p.ldb = DEXP; p.ldc = DEXP; p.Mdev = c.cnt; p.N = DEXP; p.K = D; p.mode = 0; p.eB = (long long)D * DEXP; p.coff = c.off;
        p.Bm = in.moe_w1 + (size_t)l * NE * D * DEXP; p.C = c.U1;
        hipLaunchKernelGGL(k_gemm, dim3(DEXP / 64, T / 64, NE), dim3(256), 0, st, p);
        p.Bm = in.moe_w3 + (size_t)l * NE * D * DEXP; p.C = c.U3;
        hipLaunchKernelGGL(k_gemm, dim3(DEXP / 64, T / 64, NE), dim3(256), 0, st, p);
    }
    hipLaunchKernelGGL(k_swiglu, dim3((unsigned)(((size_t)T * TOPK * DEXP + 255) / 256)), dim3(256), 0, st, c.U1, c.U3, c.U1, (size_t)T * TOPK * DEXP);
    {
        float* V1 = c.U3; float* V3 = c.U3 + (size_t)T * DEXP;
        gemm(st, c.HM, D, in.sh_w1 + (size_t)l * D * DEXP, DEXP, V1, DEXP, T, DEXP, D);
        gemm(st, c.HM, D, in.sh_w3 + (size_t)l * D * DEXP, DEXP, V3, DEXP, T, DEXP, D);
        hipLaunchKernelGGL(k_swiglu, dim3((unsigned)(((size_t)T * DEXP + 255) / 256)), dim3(256), 0, st, V1, V3, V1, (size_t)T * DEXP);
        gemm(st, V1, DEXP, in.sh_w2 + (size_t)l * DEXP * D, D, c.F, D, T, D, DEXP);
    }
    {
        GemmP p{}; p.A = c.U1; p.lda = DEXP; p.aoff = c.off; p.sidx = c.ltok; p.sw = c.lw; p.eG = T; p.Bm = in.moe_w2 + (size_t)l * NE * DEXP * D; p.ldb = D; p.C = c.F; p.ldc = D; p.Mdev = c.cnt; p.N = D; p.K = DEXP; p.mode = 1;
        p.eB = (long long)DEXP * D;
        hipLaunchKernelGGL(k_gemm, dim3(D / 64, T / 64, NE), dim3(256), 0, st, p);
    }
    hipLaunchKernelGGL(k_res_ln, dim3(T / 4), dim3(256), 0, st, c.X, c.F, ml, 5, in.ln2_g + l * D, in.ln2_b + l * D, 0, T);
}
static void finalize(const Ctx& c, float* out, hipStream_t st) {
    hipLaunchKernelGGL(k_final, dim3((unsigned)(((size_t)B * S * D + 255) / 256)), dim3(256), 0, st, c.X, out);
}
}
namespace fk {
#define LAS __attribute__((address_space(3)))
#define GAS __attribute__((address_space(1)))
typedef _Float16 f16;
typedef _Float16 h8 __attribute__((ext_vector_type(8)));
typedef _Float16 h4 __attribute__((ext_vector_type(4)));
typedef _Float16 h2 __attribute__((ext_vector_type(2)));
typedef float f32x4 __attribute__((ext_vector_type(4)));
typedef float f32x2 __attribute__((ext_vector_type(2)));
typedef unsigned u32x4 __attribute__((ext_vector_type(4)));
typedef unsigned u32x2 __attribute__((ext_vector_type(2)));

constexpr int B = 8, S = 4096, CL = 256, SE = S + CL, T = B * SE, D = 1024, DEPTH = 4;
constexpr int DH = 512, DIN = 7680, OFF_SC = 1536, OFF_NA = 3072, OFF_GATE = 4608;
constexpr int NE = 64, TOPK = 8, DEXP = 256;
constexpr int GRIDW = 64, NHEAD = 8, HDIM = 64;
constexpr float LN_EPS = 1e-5f;
constexpr float ALPHA = 1.681792830507429f;
constexpr int NWAVES = 8, NTHR = 512;
constexpr int TH = T / 2;
constexpr int MAXT_H = TH * TOPK / 256 + NE;
constexpr int SH_T = TH / 256;

__device__ __forceinline__ unsigned pkh(float a, float b) { f32x2 v = {a, b}; h2 h = __builtin_convertvector(v, h2); return __builtin_bit_cast(unsigned, h); }
__device__ __forceinline__ float sigm(float x) { return __builtin_amdgcn_rcpf(1.f + __expf(-x)); }
__device__ __forceinline__ float bperm(int src, float v) { return __int_as_float(__builtin_amdgcn_ds_bpermute(src << 2, __float_as_int(v))); }
__device__ __forceinline__ int bpermi(int src, int v) { return __builtin_amdgcn_ds_bpermute(src << 2, v); }
#define SHX(v, o) bperm(lane ^ (o), (v))
__device__ __forceinline__ float wsum(float v, int lane) {
#pragma unroll
    for (int o = 1; o < 64; o <<= 1) v += SHX(v, o);
    return v;
}
__device__ __forceinline__ int lane_id() { int v; asm volatile("v_mbcnt_lo_u32_b32 %0, -1, 0\n\tv_mbcnt_hi_u32_b32 %0, -1, %0" : "=v"(v)); return v; }
#define LDS_WAIT() asm volatile("s_waitcnt lgkmcnt(0)" ::: "memory")
#define VM_WAIT() asm volatile("s_waitcnt vmcnt(0)" ::: "memory")

#define XB_TMO      128
#define XB_XCNT(j)  (256  + 64 * (j))
#define XB_XSUB(j)  (1280 + 64 * (j))
#define XB_XGEN(j)  (2304 + 64 * (j))
#define XB_TOP      3328
#define XB_TOPGEN   3392
#define XCD_BAR_WORDS 3456
#define XB_SPIN_CAP (1u << 18)
__device__ __forceinline__ unsigned xb_ld(unsigned* p)              { return __hip_atomic_load(p, __ATOMIC_RELAXED, __HIP_MEMORY_SCOPE_AGENT); }
__device__ __forceinline__ unsigned xb_add(unsigned* p, unsigned v) { return __hip_atomic_fetch_add(p, v, __ATOMIC_RELAXED, __HIP_MEMORY_SCOPE_AGENT); }
__device__ __forceinline__ unsigned xb_xcc_id() { return (unsigned)__builtin_amdgcn_s_getreg((3 << 11) | 20) & 0xFu; }
#define XB_SPIN(cond, bar) do { unsigned _sp = 0; while (cond) { __builtin_amdgcn_s_sleep(1); \
    if ((++_sp & 255u) == 0u) { if (xb_ld(&(bar)[XB_TMO])) break; if (_sp > XB_SPIN_CAP) { atomicAdd(&(bar)[XB_TMO], 1u); break; } } } } while (0)
struct XcdBarrier { unsigned* bar; unsigned x; volatile LAS unsigned* st; };
__device__ __forceinline__ XcdBarrier xcd_barrier_post(unsigned* bar, volatile LAS unsigned* st, int tid) {
    XcdBarrier b; b.bar = bar; b.x = xb_xcc_id(); b.st = st;
    if (tid == 0) (void)xb_add(&bar[XB_XCNT(b.x)], 1u);
    return b;
}
__device__ __forceinline__ void xcd_barrier_complete(unsigned* bar, unsigned x, unsigned& nloc, unsigned& nx) {
    const unsigned G = gridDim.x * gridDim.y * gridDim.z;
    unsigned sum, cnt, mine, sp = 0u;
    for (;;) {
        sum = 0u; cnt = 0u; mine = 0u;
#pragma unroll
        for (unsigned j = 0; j < 16; ++j) { const unsigned c = xb_ld(&bar[XB_XCNT(j)]); sum += c; cnt += (c > 0u) ? 1u : 0u; mine = (j == x) ? c : mine; }
        if (sum == G) break;
        __builtin_amdgcn_s_sleep(1);
        if ((++sp & 255u) == 0u) { if (xb_ld(&bar[XB_TMO])) break; if (sp > XB_SPIN_CAP) { atomicAdd(&bar[XB_TMO], 1u); break; } }
    }
    nloc = mine > 0u ? mine : 1u; nx = cnt > 0u ? cnt : 1u;
}
__device__ __forceinline__ void xcd_barrier(const XcdBarrier& b, int tid) {
    asm volatile("s_waitcnt vmcnt(0)" ::: "memory");
    __syncthreads();
    if (tid == 0) {
        unsigned* bar = b.bar;
        __builtin_amdgcn_s_waitcnt(0);
        unsigned nloc = b.st[0], nx = b.st[1];
        if (nloc == 0u) { xcd_barrier_complete(bar, b.x, nloc, nx); b.st[0] = nloc; b.st[1] = nx; }
        const unsigned old = xb_add(&bar[XB_XSUB(b.x)], 1u);
        const unsigned gen = old / nloc;
        if (old + 1u == (gen + 1u) * nloc) {
            __builtin_amdgcn_fence(__ATOMIC_RELEASE, "agent");
            asm volatile("s_waitcnt vmcnt(0)" ::: "memory");
            const unsigned og = xb_add(&bar[XB_TOP], 1u);
            const unsigned tg = og / nx;
            if (og + 1u == (tg + 1u) * nx) xb_add(&bar[XB_TOPGEN], 1u);
            else XB_SPIN(xb_ld(&bar[XB_TOPGEN]) == tg, bar);
            __builtin_amdgcn_fence(__ATOMIC_ACQUIRE, "agent");
            xb_add(&bar[XB_XGEN(b.x)], 1u);
            asm volatile("s_waitcnt vmcnt(0)" ::: "memory");
        } else {
            XB_SPIN(xb_ld(&bar[XB_XGEN(b.x)]) == gen, bar);
            __builtin_amdgcn_fence(__ATOMIC_ACQUIRE, "agent");
            asm volatile("s_waitcnt vmcnt(0)" ::: "memory");
        }
    }
    __syncthreads();
}

namespace pg {
constexpr int BM = 256, BK = 64, HALF = 128, HTB = HALF * BK * 2, STAGE_BYTES = 8 * HTB;
__host__ __device__ __forceinline__ int lds_byte(int r, int c) { const int st = (r >> 4) * 2 + (c >> 5), rr = r & 15, cc = c & 31, ob = rr * 64 + cc * 2; return st * 1024 + (ob ^ (((ob >> 9) & 1) << 5)); }
__host__ __device__ __forceinline__ void stage_rc(int b, int& R, int& C) { const int st = b / 1024, sb = b % 1024, swz = sb ^ (((sb >> 9) & 1) << 5); R = (st >> 1) * 16 + swz / 64; C = (st & 1) * 32 + (swz % 64) / 2; }
__host__ __device__ __forceinline__ int perm32(int rho) { const int n = rho >> 4, i = rho & 15; return 8 * (i >> 2) + 4 * n + (i & 3); }

struct Unit { const char* A; const char* B; int pm, pn, e, nrows, aux0; };

template <int N> __device__ __forceinline__ void wait_vm() { asm volatile("s_waitcnt vmcnt(%0)" :: "n"(N) : "memory"); }
template <class Epi, class Sched, bool ALIGN_EPI>
__device__ __forceinline__ void gemm_phase(LAS unsigned char* lds, const int wave, const int K, const int lda, const int ldb, const Sched& S, const Epi& E) {
    int tid_ = wave * 64 + lane_id(); asm volatile("" : "+v"(tid_));
    const int tid = tid_, wid = __builtin_amdgcn_readfirstlane(tid >> 6), lane = tid & 63, wr = wid >> 2, wc = wid & 3, fr = lane & 15, fq = lane >> 4;
    const int nt = K / BK;
    int sR[2], sC[2];
    unsigned voffB[2];
#pragma unroll
    for (int i = 0; i < 2; ++i) { int R, C; stage_rc(tid * 16 + i * 8192, R, C); sR[i] = R; sC[i] = C; const int Rb = Epi::PERM ? (64 * (R >> 5) + perm32(R & 31)) : R;
        voffB[i] = (unsigned)(Rb * ldb + C) * 2u; }
    const size_t kstep = (size_t)(BK * 2);
    const size_t hstepB = (size_t)(Epi::PERM ? 32 : HALF) * ldb * 2;
    const unsigned ldsw = (unsigned)wid * 1024u;
    const int aoff = lds_byte(wr * 64 + fr, fq * 8), boff = lds_byte(wc * 32 + fr, fq * 8);
#define PG_SA(b, h) (((b) * 2 + (h)) * HTB)
#define PG_SB(b, h) ((4 + (b) * 2 + (h)) * HTB)
#define PG_STAGE2(bufoff, gbase, o0, o1) do { \
        __builtin_amdgcn_global_load_lds((const unsigned*)((const char*)(gbase) + (o0)), (LAS unsigned*)(lds + (bufoff) + ldsw), 16, 0, 0); \
        __builtin_amdgcn_global_load_lds((const unsigned*)((const char*)(gbase) + (o1)), (LAS unsigned*)(lds + (bufoff) + ldsw + 8192), 16, 0, 0); } while (0)
#define PG_STAGEB(bufoff, gbase) PG_STAGE2(bufoff, gbase, voffB[0], voffB[1])
#define PG_LDA(dst, b, h) do { _Pragma("unroll") for (int m = 0; m < 4; ++m) _Pragma("unroll") for (int k = 0; k < 2; ++k) dst[m][k] = *(const LAS h8*)(lds + PG_SA(b, h) + aoff + m * 2048 + k * 1024); } while (0)
#define PG_LDB(dst, b, h) do { _Pragma("unroll") for (int n = 0; n < 2; ++n) _Pragma("unroll") for (int k = 0; k < 2; ++k) dst[n][k] = *(const LAS h8*)(lds + PG_SB(b, h) + boff + n * 2048 + k * 1024); } while (0)
#define PG_MMA(ai, bj, At, Bt) do { __builtin_amdgcn_s_setprio(1); _Pragma("unroll") for (int m = 0; m < 4; ++m) _Pragma("unroll") for (int n = 0; n < 2; ++n) _Pragma("unroll") for (int k = 0; k < 2; ++k) \
        acc[ai][bj][m][n] = __builtin_amdgcn_mfma_f32_16x16x32_f16(Bt[n][k], At[m][k], acc[ai][bj][m][n], 0, 0, 0); __builtin_amdgcn_s_setprio(0); } while (0)
#define PG_WAIT_V(n) asm volatile("s_waitcnt vmcnt(" #n ")" ::: "memory")
#define PG_WAIT_L(n) asm volatile("s_waitcnt lgkmcnt(" #n ")" ::: "memory")
#define PG_BAR __builtin_amdgcn_s_barrier()
#define PG_SCHED __builtin_amdgcn_sched_barrier(0)
    constexpr bool RELAX = !Sched::GATHER && Epi::NVM > 0;
    bool prev_full = false;
    Unit cur, nxt; int ui = 0;
    if (!S.next(0, cur)) return;
    unsigned c00, c01, c10, c11;
    LAS unsigned* otab = (LAS unsigned*)(lds + STAGE_BYTES + 2048) + tid;
    { c00 = (unsigned)(S.arow(cur, sR[0]) * lda + sC[0]) * 2u; c01 = (unsigned)(S.arow(cur, sR[1]) * lda + sC[1]) * 2u;
      c10 = (unsigned)(S.arow(cur, HALF + sR[0]) * lda + sC[0]) * 2u; c11 = (unsigned)(S.arow(cur, HALF + sR[1]) * lda + sC[1]) * 2u; }
    f32x4 acc[2][2][4][2];
#pragma unroll
    for (int a = 0; a < 2; ++a)
#pragma unroll
        for (int b = 0; b < 2; ++b)
#pragma unroll
            for (int m = 0; m < 4; ++m)
#pragma unroll
                for (int n = 0; n < 2; ++n) acc[a][b][m][n] = (f32x4){0.f, 0.f, 0.f, 0.f};
    h8 At[4][2], B0[2][2], B1[2][2];
    const char* cA = cur.A; const char* cB = cur.B;
    PG_STAGEB(PG_SB(0, 0), cB); PG_STAGEB(PG_SB(0, 1), cB + hstepB); PG_STAGE2(PG_SA(0, 0), cA, c00, c01); PG_STAGE2(PG_SA(0, 1), cA, c10, c11);
    if (wr == 1) PG_BAR;
    PG_WAIT_V(2); PG_BAR;
    PG_STAGEB(PG_SB(1, 0), cB + kstep); PG_STAGE2(PG_SA(1, 0), cA + kstep, c00, c01); PG_STAGEB(PG_SB(1, 1), cB + hstepB + kstep);
    PG_WAIT_V(6); PG_BAR;
    for (;;) {
        const bool has_next = S.next(ui + 1, nxt);
        const char* nA = has_next ? nxt.A : cA; const char* nB = has_next ? nxt.B : cB;
        if (Sched::GATHER) {
            if (has_next) { otab[0] = (unsigned)(S.arow(nxt, sR[0]) * lda + sC[0]) * 2u; otab[512] = (unsigned)(S.arow(nxt, sR[1]) * lda + sC[1]) * 2u;
                            otab[1024] = (unsigned)(S.arow(nxt, HALF + sR[0]) * lda + sC[0]) * 2u; otab[1536] = (unsigned)(S.arow(nxt, HALF + sR[1]) * lda + sC[1]) * 2u; }
            else { otab[0] = c00; otab[512] = c01; otab[1024] = c10; otab[1536] = c11; }
        }
#pragma unroll 1
        for (int t = 0; t < nt; t += 2) {
            const bool last = (t == nt - 2);
            const char* a1 = cA + (size_t)(t + 1) * kstep;
            const char* a2 = last ? nA : cA + (size_t)(t + 2) * kstep; const char* b2 = last ? nB : cB + (size_t)(t + 2) * kstep;
            const char* a3 = a2 + kstep; const char* b3 = b2 + kstep;
            unsigned q00 = c00, q01 = c01, q10 = c10, q11 = c11;
            if (Sched::GATHER) { if (last) { q00 = otab[0]; q01 = otab[512]; q10 = otab[1024]; q11 = otab[1536]; } }
            const bool pre = RELAX && t == 0 && ui > 0;
            const bool rlx = pre && prev_full;
            PG_LDB(B0, 0, 0); PG_LDB(B1, 0, 1); PG_SCHED; PG_LDA(At, 0, 0); if (!pre) PG_STAGE2(PG_SA(1, 1), a1, c10, c11);
            if (rlx) wait_vm<8 + Epi::NVM>(); else PG_WAIT_V(8);
            PG_WAIT_L(0); PG_BAR; PG_MMA(0, 0, At, B0); PG_MMA(0, 1, At, B1); PG_BAR; PG_SCHED;
            PG_LDA(At, 0, 1); PG_STAGEB(PG_SB(0, 0), b2); PG_STAGEB(PG_SB(0, 1), b2 + hstepB); PG_STAGE2(PG_SA(0, 0), a2, q00, q01);
            if (rlx) wait_vm<8 + Epi::NVM>(); else PG_WAIT_V(8);
            PG_WAIT_L(0); PG_BAR; PG_MMA(1, 0, At, B0); PG_MMA(1, 1, At, B1); PG_BAR; PG_SCHED;
            PG_LDB(B0, 1, 0); PG_LDB(B1, 1, 1); PG_SCHED; PG_LDA(At, 1, 0); PG_STAGE2(PG_SA(0, 1), a2, q10, q11);
            if (rlx) wait_vm<8 + Epi::NVM>(); else PG_WAIT_V(8);
            PG_WAIT_L(0); PG_BAR; PG_MMA(0, 0, At, B0); PG_MMA(0, 1, At, B1); PG_BAR; PG_SCHED;
            PG_LDA(At, 1, 1); PG_STAGEB(PG_SB(1, 0), b3); PG_STAGEB(PG_SB(1, 1), b3 + hstepB); PG_STAGE2(PG_SA(1, 0), a3, q00, q01);
            PG_WAIT_V(8); PG_WAIT_L(0); PG_BAR; PG_MMA(1, 0, At, B0); PG_MMA(1, 1, At, B1); PG_BAR; PG_SCHED;
        }
        if constexpr (ALIGN_EPI) { if (wr == 0) PG_BAR; }
        if (RELAX && has_next) PG_STAGE2(PG_SA(1, 1), nA + kstep, c10, c11);
        E(acc, cur, wr, wc, fr, fq);
        prev_full = E.full(cur);
        if (!has_next) break;
#pragma unroll
        for (int a = 0; a < 2; ++a)
#pragma unroll
            for (int b = 0; b < 2; ++b)
#pragma unroll
                for (int m = 0; m < 4; ++m)
#pragma unroll
                    for (int n = 0; n < 2; ++n) acc[a][b][m][n] = (f32x4){0.f, 0.f, 0.f, 0.f};
        cur = nxt; cA = nA; cB = nB; ++ui;
        if (Sched::GATHER) { c00 = otab[0]; c01 = otab[512]; c10 = otab[1024]; c11 = otab[1536]; }
        if constexpr (ALIGN_EPI) { if (wr == 1) PG_BAR; }
    }
    PG_WAIT_V(0);
    if constexpr (!ALIGN_EPI) { if (wr == 0) PG_BAR; }
    PG_BAR;
#undef PG_SA
#undef PG_SB
#undef PG_STAGE2
#undef PG_STAGEB
#undef PG_LDA
#undef PG_LDB
#undef PG_MMA
#undef PG_WAIT_V
#undef PG_WAIT_L
#undef PG_BAR
#undef PG_SCHED
}
}
constexpr size_t MiB = 1u << 20;
constexpr size_t al256(size_t x) { return (x + 255) & ~(size_t)255; }
constexpr size_t WS_CTL = 0, CTL_ZERO_BYTES = 2 * MiB;
constexpr size_t WS_MODS = 1 * MiB;
constexpr size_t WS_X = 2 * MiB;
constexpr size_t WS_Z2 = WS_X + (size_t)T * D * 4;
constexpr size_t WS_DYN = al256(WS_Z2 + (size_t)DEPTH * SE * 64 * 4);
constexpr size_t WS_WIN = WS_DYN;
constexpr size_t WS_PJ = WS_WIN + (size_t)DIN * D * 2;
constexpr size_t WS_WO = WS_PJ + (size_t)3 * D * DH * 2;
constexpr size_t WS_RT = WS_WO + (size_t)D * D * 2;
constexpr size_t WS_SD = WS_RT + (size_t)2 * NE * D * 2;
constexpr size_t WS_GC = al256(WS_SD + (size_t)256 * 4097 * 16);
constexpr size_t WS_HMH = WS_GC + (size_t)DH * 512 * 4;
constexpr size_t WS_LIST = WS_HMH + (size_t)T * D * 2;
constexpr size_t WS_P = WS_LIST + (size_t)2 * NE * TH * 8;
constexpr size_t P_BYTES = (size_t)T * DIN * 2;
constexpr size_t WS_SLOT = WS_P;
constexpr size_t WS_SLSH = WS_SLOT + (size_t)TH * 8 * D;
constexpr float SLOT_SC = 64.f;
constexpr size_t WS_W13 = WS_SLOT + (size_t)TH * 9 * D * 2;
constexpr size_t WS_W2 = WS_W13 + (size_t)65 * 512 * D * 2;
constexpr size_t WS_H = WS_W2 + (size_t)65 * D * DEXP * 2;
static_assert(WS_H + (size_t)(MAXT_H + SH_T) * 256 * DEXP * 2 <= WS_P + P_BYTES, "MoE overlay fits the P region");
constexpr size_t WS_ZT = WS_P + P_BYTES;
constexpr size_t WS_VT = WS_ZT + (size_t)B * DH * SE * 2;
constexpr size_t WS_SCR = WS_ZT;
static_assert((size_t)256 * 32 * 512 * 16 <= (size_t)2 * B * DH * SE * 2, "scratch fits ZT|VT");
constexpr size_t WS_VHT = WS_VT + (size_t)B * DH * SE * 2;
constexpr size_t WS_Y = WS_VHT + (size_t)B * DH * SE * 2;
constexpr size_t WS_END = WS_Y + (size_t)T * 1536 * 2;
static_assert((size_t)(MAXT_H + SH_T) * 256 * DEXP * 2 <= (size_t)T * 1536 * 2, "half 1's H fits the Y region");
constexpr int CW_BAR = 4096;
constexpr int CW_CNT = 16384;
constexpr int CW_DBG = 32768;

struct In {
    const GAS float *x, *c, *ctx, *c_ctx, *w_ada, *b_ada, *w_in, *hy_conv_w, *hy_conv_b, *hy_w1, *hy_b1, *hy_w2, *hy_b2, *hy_w3, *hy_sin_freq, *hy_bias_d,
        *hy_proj, *sc_conv_w, *sc_proj, *na_rpb, *na_proj, *w_o, *ln1_g, *ln1_b, *ln2_g, *ln2_b, *moe_router, *moe_bias, *moe_w1, *moe_w3, *moe_w2, *sh_w1, *sh_w3, *sh_w2;
};
struct Args { In in; GAS float* out; unsigned char* ws; int ph_lo, ph_hi, use_bar, flags; };

typedef const __attribute__((address_space(4))) In& CIN;
#define INP(name) ((const float*)(in.name))
typedef const __attribute__((address_space(4))) Args* CArgsP;
struct Frame {
    LAS unsigned char* lds;
    int tid, lane, wave, vcu, G, bid, dry;
    GAS unsigned char* ws;
};
__device__ __forceinline__ int mod_row(int row) { const int b = row / SE, ii = row - b * SE; return ii < S ? b : 8; }

struct TrItem { const float* W; int K, N; f16* WT; int row_off, row_mul, item; };
__device__ __forceinline__ void tr_load(const TrItem& q, f32x4 (&t)[8], int lane) {
    const int nblk = q.N / 32, kb = q.item / nblk, nb = q.item % nblk, k0 = 64 * kb, n0 = 32 * nb;
    const int kr = lane >> 3, c4 = (lane & 7) * 4;
#pragma unroll
    for (int i = 0; i < 8; ++i) t[i] = *(const f32x4*)(q.W + (size_t)(k0 + 8 * i + kr) * q.N + n0 + c4);
}
__device__ __forceinline__ void tr_store(const TrItem& q, const f32x4 (&t)[8], LAS float* scr, int lane) {
    const int nblk = q.N / 32, kb = q.item / nblk, nb = q.item % nblk, k0 = 64 * kb, n0 = 32 * nb;
    const int kr = lane >> 3, c4 = (lane & 7) * 4;
#pragma unroll
    for (int i = 0; i < 8; ++i) { LAS float* d = scr + (8 * i + kr) * 33 + c4; d[0] = t[i][0]; d[1] = t[i][1]; d[2] = t[i][2]; d[3] = t[i][3]; }
    LDS_WAIT(); asm volatile("" ::: "memory");
    const int c = lane & 7;
#pragma unroll
    for (int j = 0; j < 4; ++j) { const int n = (lane >> 3) + 8 * j; const LAS float* s = scr + (8 * c) * 33 + n;
        u32x4 o; o.x = pkh(s[0 * 33], s[1 * 33]); o.y = pkh(s[2 * 33], s[3 * 33]); o.z = pkh(s[4 * 33], s[5 * 33]); o.w = pkh(s[6 * 33], s[7 * 33]);
        *(u32x4*)(q.WT + (size_t)(q.row_off + (n0 + n) * q.row_mul) * q.K + k0 + 8 * c) = o; }
    LDS_WAIT(); asm volatile("" ::: "memory");
}
__device__ __forceinline__ TrItem mixer_item(Frame& F, CIN in, int l, int it) {
    constexpr int I_IN = (D / 64) * (DIN / 32), I_PJ = (DH / 64) * (D / 32);
    f16* win = (f16*)(F.ws + WS_WIN); f16* pj = (f16*)(F.ws + WS_PJ); f16* wo = (f16*)(F.ws + WS_WO);
    int r = it;
    if (r < I_IN) return TrItem{INP(w_in) + (size_t)l * D * DIN, D, DIN, win, 0, 1, r}; r -= I_IN;
    if (r < I_PJ) return TrItem{INP(hy_proj) + (size_t)l * DH * D, DH, D, pj, 0, 1, r}; r -= I_PJ;
    if (r < I_PJ) return TrItem{INP(sc_proj) + (size_t)l * DH * D, DH, D, pj, D, 1, r}; r -= I_PJ;
    if (r < I_PJ) return TrItem{INP(na_proj) + (size_t)l * DH * D, DH, D, pj, 2 * D, 1, r}; r -= I_PJ;
    return TrItem{INP(w_o) + (size_t)l * D * D, D, D, wo, 0, 1, r};
}
__device__ __forceinline__ void convert_mixer_weights(Frame& F, CIN in, int l) {
    LAS float* scr = (LAS float*)(F.lds + F.wave * 16384);
    const int gw = F.vcu * NWAVES + F.wave, NGW = F.G * NWAVES;
    constexpr int NIT = (D / 64) * (DIN / 32) + 3 * (DH / 64) * (D / 32) + (D / 64) * (D / 32);
    int it = gw; if (it >= NIT) return;
    f32x4 ta[8], tb[8];
    TrItem qa = mixer_item(F, in, l, it), qb = qa; tr_load(qa, ta, F.lane);
    for (;;) {
        const bool hb = it + NGW < NIT; if (hb) { qb = mixer_item(F, in, l, it + NGW); tr_load(qb, tb, F.lane); }
        tr_store(qa, ta, scr, F.lane); if (!hb) break; it += NGW;
        const bool ha = it + NGW < NIT; if (ha) { qa = mixer_item(F, in, l, it + NGW); tr_load(qa, ta, F.lane); }
        tr_store(qb, tb, scr, F.lane); if (!ha) break; it += NGW;
    }
}
__device__ __forceinline__ TrItem moe_item(Frame& F, CIN in, int l, int it) {
    constexpr int I_UP = (D / 64) * (DEXP / 32)  , I_DN = (DEXP / 64) * (D / 32)  , PER_E = 2 * I_UP + I_DN;
    f16* w13 = (f16*)(F.ws + WS_W13); f16* w2 = (f16*)(F.ws + WS_W2);
    const int e = it / PER_E; int r = it - e * PER_E;
    if (r < I_UP) return TrItem{e < NE ? INP(moe_w1) + ((size_t)l * NE + e) * D * DEXP : INP(sh_w1) + (size_t)l * D * DEXP, D, DEXP, w13 + (size_t)e * 512 * D, 0, 2, r}; r -= I_UP;
    if (r < I_UP) return TrItem{e < NE ? INP(moe_w3) + ((size_t)l * NE + e) * D * DEXP : INP(sh_w3) + (size_t)l * D * DEXP, D, DEXP, w13 + (size_t)e * 512 * D, 1, 2, r}; r -= I_UP;
    return TrItem{e < NE ? INP(moe_w2) + ((size_t)l * NE + e) * DEXP * D : INP(sh_w2) + (size_t)l * DEXP * D, DEXP, D, w2 + (size_t)e * D * DEXP, 0, 1, r};
}
__device__ __forceinline__ void convert_moe_weights(Frame& F, CIN in, int l) {
    LAS float* scr = (LAS float*)(F.lds + F.wave * 16384);
    const int gw = F.vcu * NWAVES + F.wave, NGW = F.G * NWAVES;
    constexpr int NIT = 65 * 384;
    int it = gw; if (it >= NIT) return;
    f32x4 ta[8], tb[8];
    TrItem qa = moe_item(F, in, l, it), qb = qa; tr_load(qa, ta, F.lane);
    for (;;) {
        const bool hb = it + NGW < NIT; if (hb) { qb = moe_item(F, in, l, it + NGW); tr_load(qb, tb, F.lane); }
        tr_store(qa, ta, scr, F.lane); if (!hb) break; it += NGW;
        const bool ha = it + NGW < NIT; if (ha) { qa = moe_item(F, in, l, it + NGW); tr_load(qa, ta, F.lane); }
        tr_store(qb, tb, scr, F.lane); if (!ha) break; it += NGW;
    }
}

struct MoeTab { int ptile[NE + 2]; };
__device__ __forceinline__ void moe_build_tab(Frame& F, const int* cnt, LAS int* tab) {
    if (F.tid < 64) {
        const int c = __hip_atomic_load(cnt + F.tid, __ATOMIC_RELAXED, __HIP_MEMORY_SCOPE_AGENT); int tl = (c + 255) >> 8; int inc = tl;
#pragma unroll
        for (int o = 1; o < 64; o <<= 1) { const int v = bpermi(F.lane - o, inc); if (F.lane >= o) inc += v; }
        tab[F.tid] = inc - tl; tab[128 + F.tid] = c;
        if (F.tid == 63) tab[64] = inc;
    }
    __syncthreads();
}
template <int NPN, bool UP>
struct MoeSched {
    static constexpr bool GATHER = UP;
    const LAS int* tab; int G, c, half; const unsigned long long* list; const char* Abase; const char* Bbase; int NT, lat_only;
    int sh_mode, NT_other;
    __device__ __forceinline__ bool next(int i, pg::Unit& u) const {
        const int SH = lat_only ? SH_T - 4 : SH_T;
        const int L = i * G + c; const int nun = (NT + (sh_mode == 2 ? 0 : (sh_mode == 1 ? 2 * SH : SH))) * NPN;
        if (L >= nun) return false;
        const int tile = L / NPN; u.pn = L - tile * NPN;
        int e;
        if (tile < NT) { e = 0;
#pragma unroll
            for (int s = 32; s >= 1; s >>= 1) { const int v = __builtin_amdgcn_readfirstlane(tab[(e + s) & 63]); if (e + s < NE && v <= tile) e += s; }
            u.pm = tile - __builtin_amdgcn_readfirstlane(tab[e]); int nr = __builtin_amdgcn_readfirstlane(tab[128 + e]) - u.pm * 256; u.nrows = nr > 256 ? 256 : nr;
        } else { e = NE; u.pm = tile - NT; u.nrows = 256;
            if (u.pm >= SH) { u.pm -= SH; u.nrows = 257; }
            if (lat_only) u.pm = (u.pm >> 4) * 17 + (u.pm & 15); }
        u.e = e;
        if (UP) { u.A = Abase; u.B = Bbase + ((size_t)e * 512 + (size_t)u.pn * 256) * D * 2; }
        else { u.A = Abase + (size_t)tile * 256 * DEXP * 2; u.B = Bbase + ((size_t)e * D + (size_t)u.pn * 256) * DEXP * 2; }
        u.aux0 = u.nrows == 257 ? NT_other + u.pm : tile;
        return true;
    }
    __device__ __forceinline__ int arow(const pg::Unit& u, int r) const {
        if (!UP) return r;
        if (u.e == NE) return (u.nrows == 257 ? (half ^ 1) : half) * TH + u.pm * 256 + r;
        int rr = u.pm * 256 + r; const int n = __builtin_amdgcn_readfirstlane(tab[128 + u.e]); if (rr >= n) rr = n - 1;
        const unsigned long long en = list[((size_t)half * NE + u.e) * TH + rr];
        return half * TH + (int)(en >> 36);
    }
};
struct EpiUp {
    static constexpr bool PERM = true; static constexpr int NVM = 0;
    __device__ __forceinline__ bool full(const pg::Unit&) const { return false; }
    f16* H; f16* Hother;
    __device__ __forceinline__ void operator()(const f32x4 (&acc)[2][2][4][2], const pg::Unit& u, int wr, int wc, int fr, int fq) const {
        f16* Hb = u.nrows == 257 ? Hother : H;
#pragma unroll
        for (int ai = 0; ai < 2; ++ai)
#pragma unroll
            for (int m = 0; m < 4; ++m) { const int r = ai * 128 + wr * 64 + m * 16 + fr; f16* rowp = Hb + ((size_t)u.aux0 * 256 + r) * DEXP + u.pn * 128;
#pragma unroll
                for (int bj = 0; bj < 2; ++bj) { const f32x4 v0 = acc[ai][bj][m][0], v1 = acc[ai][bj][m][1];
                    const float h0 = v0[0] * sigm(v0[0]) * v0[1], h1 = v0[2] * sigm(v0[2]) * v0[3], h2_ = v1[0] * sigm(v1[0]) * v1[1], h3 = v1[2] * sigm(v1[2]) * v1[3];
                    u32x2 w; w.x = pkh(h0, h1); w.y = pkh(h2_, h3);
                    *(u32x2*)(rowp + (wc * 64 + bj * 32 + 8 * fq) / 2) = w; }
                asm volatile("" ::: "memory"); }
    }
};
struct EpiDown {
    static constexpr bool PERM = true; static constexpr int NVM = 16;
    __device__ __forceinline__ bool full(const pg::Unit& u) const { return !dry && (u.e == NE || u.nrows == 256); }
    f16* SL; f16* SH; const unsigned long long* list; int half, dry;
    __device__ __forceinline__ void operator()(const f32x4 (&acc)[2][2][4][2], const pg::Unit& u, int wr, int wc, int fr, int fq) const {
        unsigned long long en[8];
        const unsigned long long* lp = list + ((size_t)half * NE + (u.e < NE ? u.e : 0)) * TH + u.pm * 256;
#pragma unroll
        for (int g = 0; g < 8; ++g) { const int r = (g >> 2) * 128 + wr * 64 + (g & 3) * 16 + fr; en[g] = (u.e < NE && r < u.nrows) ? lp[r] : 0ull; }
#pragma unroll
        for (int ai = 0; ai < 2; ++ai)
#pragma unroll
            for (int m = 0; m < 4; ++m) { const int r = ai * 128 + wr * 64 + m * 16 + fr;
                float w = 1.f; int srow = u.pm * 256 + r; bool ok = true;
                if (u.e < NE) { ok = r < u.nrows; const unsigned long long e8 = en[ai * 4 + m]; w = __uint_as_float((unsigned)e8); const unsigned hi = (unsigned)(e8 >> 32); srow = (int)(hi >> 4) * 8 + (int)(hi & 15u); }
                if (ok) {
                    if (u.e < NE) {
                        unsigned char* rowp = (unsigned char*)SL + (size_t)srow * D + u.pn * 256 + wc * 64 + 8 * fq; w *= SLOT_SC;
#pragma unroll
                        for (int bj = 0; bj < 2; ++bj) { const f32x4 v0 = acc[ai][bj][m][0] * w, v1 = acc[ai][bj][m][1] * w;
                            int a = __builtin_amdgcn_cvt_pk_fp8_f32(v0[0], v0[1], 0, false); a = __builtin_amdgcn_cvt_pk_fp8_f32(v0[2], v0[3], a, true);
                            int b = __builtin_amdgcn_cvt_pk_fp8_f32(v1[0], v1[1], 0, false); b = __builtin_amdgcn_cvt_pk_fp8_f32(v1[2], v1[3], b, true);
                            u32x2 o; o.x = (unsigned)a; o.y = (unsigned)b;
                            if (!dry || o.x == 0x12345678u) __builtin_nontemporal_store(o, (u32x2*)(rowp + bj * 32)); }
                    } else {
                        f16* rowp = SH + (size_t)srow * D + u.pn * 256 + wc * 64 + 8 * fq;
#pragma unroll
                        for (int bj = 0; bj < 2; ++bj) { const f32x4 v0 = acc[ai][bj][m][0], v1 = acc[ai][bj][m][1];
                            u32x4 o; o.x = pkh(v0[0], v0[1]); o.y = pkh(v0[2], v0[3]); o.z = pkh(v1[0], v1[1]); o.w = pkh(v1[2], v1[3]);
                            if (!dry || o.x == 0x12345678u) __builtin_nontemporal_store(o, (u32x4*)(rowp + bj * 32)); } } } }
    }
};
template <bool DO_LN>
__device__ __forceinline__ void ln1_rows(Frame& F, CIN in, int l) {
    const int gw = F.vcu * NWAVES + F.wave, NGW = F.G * NWAVES;
    float* X = (float*)(F.ws + WS_X); f16* HM = (f16*)(F.ws + WS_HMH);
    const float* mods = (const float*)(F.ws + WS_MODS) + (size_t)l * 9 * 6 * D;
    const f32x4* g4 = (const f32x4*)(INP(ln1_g) + l * D) + F.lane; const f32x4* b4 = (const f32x4*)(INP(ln1_b) + l * D) + F.lane;
    for (int row = gw; row < T; row += NGW) {
        f32x4* xr = (f32x4*)(X + (size_t)row * D) + F.lane;
        f32x4 v[4];
#pragma unroll
        for (int j = 0; j < 4; ++j) v[j] = xr[64 * j];
        if (DO_LN) {
            float s = 0.f;
#pragma unroll
            for (int j = 0; j < 4; ++j) s += (v[j].x + v[j].y) + (v[j].z + v[j].w);
            const float mean = wsum(s, F.lane) * (1.f / D); float s2 = 0.f;
#pragma unroll
            for (int j = 0; j < 4; ++j) { v[j] = v[j] - mean; s2 += (v[j].x * v[j].x + v[j].y * v[j].y) + (v[j].z * v[j].z + v[j].w * v[j].w); }
            const float rstd = 1.f / sqrtf(wsum(s2, F.lane) * (1.f / D) + LN_EPS);
#pragma unroll
            for (int j = 0; j < 4; ++j) { v[j] = v[j] * rstd * g4[64 * j] + b4[64 * j]; if (!F.dry) xr[64 * j] = v[j]; }
        }
        const float* m = mods + (size_t)mod_row(row) * 6 * D;
        const f32x4* sh = (const f32x4*)(m + 3 * D) + F.lane; const f32x4* sc = (const f32x4*)(m + 4 * D) + F.lane;
        u32x2* o8 = (u32x2*)(HM + (size_t)row * D) + F.lane;
#pragma unroll
        for (int j = 0; j < 4; ++j) { const f32x4 h = v[j] * (sc[64 * j] + 1.f) + sh[64 * j]; u32x2 w; w.x = pkh(h.x, h.y); w.y = pkh(h.z, h.w); if (!F.dry) o8[64 * j] = w; }
    }
}

__device__ __forceinline__ void router_phase(Frame& F, CIN in, int l) {
    const int gw = F.vcu * NWAVES + F.wave, NGW = F.G * NWAVES, lane = F.lane, fr = lane & 15, fq = lane >> 4;
    const float* X = (const float*)(F.ws + WS_X);
    const float* mods = (const float*)(F.ws + WS_MODS) + (size_t)l * 9 * 6 * D;
    const f16* rth = (const f16*)(F.ws + WS_RT); const f16* rtl = rth + NE * D;
    int* cntl = (int*)(F.ws + WS_CTL) + CW_CNT + l * 128;
    unsigned long long* list = (unsigned long long*)(F.ws + WS_LIST);
    LAS float* lgs = (LAS float*)(F.lds + F.wave * 4096);
    const float rb = INP(moe_bias)[l * NE + lane];
    for (int task = gw; task < T / 16; task += NGW) {
        const int row0 = task * 16;
        const float* m = mods + (size_t)mod_row(row0) * 6 * D;
        const float* xr = X + (size_t)(row0 + fr) * D + fq * 8;
        f32x4 acc[4];
#pragma unroll
        for (int nb = 0; nb < 4; ++nb) acc[nb] = (f32x4){0.f, 0.f, 0.f, 0.f};
#pragma unroll 2
        for (int s = 0; s < 32; ++s) {
            const int k = s * 32 + fq * 8;
            const f32x4 x0 = *(const f32x4*)(xr + s * 32), x1 = *(const f32x4*)(xr + s * 32 + 4);
            const f32x4 sc0 = *(const f32x4*)(m + 4 * D + k), sc1 = *(const f32x4*)(m + 4 * D + k + 4);
            const f32x4 sh0 = *(const f32x4*)(m + 3 * D + k), sh1 = *(const f32x4*)(m + 3 * D + k + 4);
            const f32x4 h0 = x0 * (sc0 + 1.f) + sh0, h1 = x1 * (sc1 + 1.f) + sh1;
            h8 ahi, alo;
#pragma unroll
            for (int j = 0; j < 4; ++j) { ahi[j] = (f16)h0[j]; alo[j] = (f16)(h0[j] - (float)ahi[j]); ahi[4 + j] = (f16)h1[j]; alo[4 + j] = (f16)(h1[j] - (float)ahi[4 + j]); }
#pragma unroll
            for (int nb = 0; nb < 4; ++nb) {
                const h8 bhi = *(const h8*)(rth + (size_t)(nb * 16 + fr) * D + k), blo = *(const h8*)(rtl + (size_t)(nb * 16 + fr) * D + k);
                acc[nb] = __builtin_amdgcn_mfma_f32_16x16x32_f16(ahi, bhi, acc[nb], 0, 0, 0);
                acc[nb] = __builtin_amdgcn_mfma_f32_16x16x32_f16(alo, bhi, acc[nb], 0, 0, 0);
                acc[nb] = __builtin_amdgcn_mfma_f32_16x16x32_f16(ahi, blo, acc[nb], 0, 0, 0);
            }
        }
#pragma unroll
        for (int nb = 0; nb < 4; ++nb)
#pragma unroll
            for (int i = 0; i < 4; ++i) lgs[(4 * fq + i) * 64 + nb * 16 + fr] = acc[nb][i];
        LDS_WAIT(); asm volatile("" ::: "memory");
        unsigned chosen_mask = 0u; float wv[16]; int kv[16];
#pragma unroll
        for (int t = 0; t < 16; ++t) {
            const float score = 1.f / (1.f + expf(-lgs[t * 64 + lane]));
            const float sel = score + rb;
            float m1 = sel;
            m1 = fmaxf(m1, SHX(m1, 1)); m1 = fmaxf(m1, SHX(m1, 2)); m1 = fmaxf(m1, SHX(m1, 4));
            const unsigned long long eq = __ballot(sel == m1);
            const int g = lane >> 3;
            const unsigned geq = (unsigned)((eq >> (g * 8)) & 0xffull);
            const int first = __ffs(geq) - 1;
            float s2 = ((lane & 7) == first) ? -3.0e38f : sel;
            s2 = fmaxf(s2, SHX(s2, 1)); s2 = fmaxf(s2, SHX(s2, 2)); s2 = fmaxf(s2, SHX(s2, 4));
            const float gs = m1 + s2;
            int grank = 0;
#pragma unroll
            for (int gg = 0; gg < 8; ++gg) { const float o = bperm(gg * 8, gs); grank += (o > gs || (o == gs && gg < g)) ? 1 : 0; }
            const bool gsel = grank < 4;
            const float val = gsel ? sel : -3.0e38f;
            int rank = 0;
            for (int j = 0; j < 64; ++j) { const float o = bperm(j, val); rank += (o > val || (o == val && j < lane)) ? 1 : 0; }
            const bool ch = gsel && rank < TOPK;
            const float tot = wsum(ch ? score : 0.f, lane);
            wv[t] = score / tot * 2.5f; kv[t] = rank;
            chosen_mask |= ch ? (1u << t) : 0u;
        }
        const int half = row0 >= TH ? 1 : 0;
        const int nch = __popc(chosen_mask);
        int base = 0;
        if (nch && !F.dry) base = atomicAdd(cntl + half * 64 + lane, nch);
        unsigned long long* lp = list + ((size_t)half * NE + lane) * TH;
        int pos = base;
#pragma unroll
        for (int t = 0; t < 16; ++t) if ((chosen_mask & (1u << t)) && !F.dry) {
            const unsigned tokh = (unsigned)(row0 + t - half * TH);
            lp[pos++] = ((unsigned long long)((tokh << 4) | (unsigned)kv[t]) << 32) | (unsigned long long)__float_as_uint(wv[t]);
        }
        LDS_WAIT(); asm volatile("" ::: "memory");
    }
}


constexpr int RL_PITCH = 1032;
constexpr int RL_LO = 16 * RL_PITCH * 2, RL_PART = 2 * RL_LO;
constexpr int RL_ENT = RL_PART + 32768, RL_MAXTASK = 18, RL_CNT = RL_ENT + RL_MAXTASK * 128 * 16, RL_BASE = RL_CNT + 512;
static_assert(RL_BASE + 512 <= 147456 - 1088, "router LDS map");
__device__ __forceinline__ void ln1_router_phase(Frame& F, CIN in, int l) {
    const int lane = F.lane, w = F.wave, fr = lane & 15, fq = lane >> 4;
    float* X = (float*)(F.ws + WS_X); f16* HM = (f16*)(F.ws + WS_HMH);
    const float* mods = (const float*)(F.ws + WS_MODS) + (size_t)l * 9 * 6 * D;
    const f32x4* g4 = (const f32x4*)(INP(ln1_g) + l * D) + lane; const f32x4* b4 = (const f32x4*)(INP(ln1_b) + l * D) + lane;
    int* cntl = (int*)(F.ws + WS_CTL) + CW_CNT + l * 128;
    unsigned long long* list = (unsigned long long*)(F.ws + WS_LIST);
    LAS f16* ahi = (LAS f16*)F.lds; LAS f16* alo = (LAS f16*)(F.lds + RL_LO); LAS float* part = (LAS float*)(F.lds + RL_PART);
    const f16* rth = (const f16*)(F.ws + WS_RT); const f16* rtl = rth + NE * D;
    h8 bh[4][4];
#pragma unroll
    for (int s = 0; s < 4; ++s)
#pragma unroll
        for (int nb = 0; nb < 4; ++nb) { const size_t o = (size_t)(nb * 16 + fr) * D + 128 * w + 32 * s + 8 * fq; bh[s][nb] = *(const h8*)(rth + o); }
    const float rb = INP(moe_bias)[l * NE + lane];
    if (F.tid < 128) ((LAS int*)(F.lds + RL_CNT))[F.tid] = 0;
    __syncthreads();
    int ti = 0;
    for (int task = F.bid; task < T / 16 && ti < RL_MAXTASK; task += F.G, ++ti) {
        const int row0 = task * 16;
        if (l == DEPTH - 1 && row0 % SE >= S) { --ti; continue; }
        const float* m = mods + (size_t)mod_row(row0) * 6 * D;
        f32x4 va[2][4], pg[4], pb[4], psh[4], psc[4];
#pragma unroll
        for (int j = 0; j < 4; ++j) {
            va[0][j] = ((const f32x4*)(X + (size_t)(row0 + 2 * w) * D) + lane)[64 * j]; va[1][j] = ((const f32x4*)(X + (size_t)(row0 + 2 * w + 1) * D) + lane)[64 * j];
            pg[j] = g4[64 * j]; pb[j] = b4[64 * j]; psh[j] = ((const f32x4*)(m + 3 * D) + lane)[64 * j]; psc[j] = ((const f32x4*)(m + 4 * D) + lane)[64 * j];
        }
        asm volatile("" ::: "memory");
#pragma unroll
        for (int rr = 0; rr < 2; ++rr) {
            const int lr = 2 * w + rr, row = row0 + lr;
            f32x4* xr = (f32x4*)(X + (size_t)row * D) + lane;
            f32x4 v[4]; float s = 0.f;
#pragma unroll
            for (int j = 0; j < 4; ++j) { v[j] = va[rr][j]; s += (v[j].x + v[j].y) + (v[j].z + v[j].w); }
            const float mean = wsum(s, lane) * (1.f / D); float s2 = 0.f;
#pragma unroll
            for (int j = 0; j < 4; ++j) { v[j] = v[j] - mean; s2 += (v[j].x * v[j].x + v[j].y * v[j].y) + (v[j].z * v[j].z + v[j].w * v[j].w); }
            const float rstd = 1.f / sqrtf(wsum(s2, lane) * (1.f / D) + LN_EPS);
            u32x2* o8 = (u32x2*)(HM + (size_t)row * D) + lane;
#pragma unroll
            for (int j = 0; j < 4; ++j) {
                v[j] = v[j] * rstd * pg[j] + pb[j];
                if (!F.dry) xr[64 * j] = v[j];
                const f32x4 h = v[j] * (psc[j] + 1.f) + psh[j];
                h4 hh, hl;
#pragma unroll
                for (int q = 0; q < 4; ++q) { hh[q] = (f16)h[q]; hl[q] = (f16)(h[q] - (float)hh[q]); }
                if (!F.dry) o8[64 * j] = __builtin_bit_cast(u32x2, hh);
                *(LAS h4*)(ahi + lr * RL_PITCH + 4 * lane + 256 * j) = hh; *(LAS h4*)(alo + lr * RL_PITCH + 4 * lane + 256 * j) = hl;
            }
        }
        __syncthreads();
        {
            h8 bl[4][4];
#pragma unroll
            for (int s = 0; s < 4; ++s)
#pragma unroll
                for (int nb = 0; nb < 4; ++nb) bl[s][nb] = *(const h8*)(rtl + (size_t)(nb * 16 + fr) * D + 128 * w + 32 * s + 8 * fq);
            f32x4 acc[4];
#pragma unroll
            for (int nb = 0; nb < 4; ++nb) acc[nb] = (f32x4){0.f, 0.f, 0.f, 0.f};
#pragma unroll
            for (int s = 0; s < 4; ++s) {
                const int k = 128 * w + 32 * s + 8 * fq;
                const h8 xh = *(const LAS h8*)(ahi + fr * RL_PITCH + k), xl = *(const LAS h8*)(alo + fr * RL_PITCH + k);
#pragma unroll
                for (int nb = 0; nb < 4; ++nb) {
                    acc[nb] = __builtin_amdgcn_mfma_f32_16x16x32_f16(xh, bh[s][nb], acc[nb], 0, 0, 0);
                    acc[nb] = __builtin_amdgcn_mfma_f32_16x16x32_f16(xl, bh[s][nb], acc[nb], 0, 0, 0);
                    acc[nb] = __builtin_amdgcn_mfma_f32_16x16x32_f16(xh, bl[s][nb], acc[nb], 0, 0, 0);
                }
            }
#pragma unroll
            for (int nb = 0; nb < 4; ++nb)
#pragma unroll
                for (int i = 0; i < 4; ++i) part[(w * 16 + 4 * fq + i) * 64 + nb * 16 + fr] = acc[nb][i];
        }
        __syncthreads();
        {
            unsigned chosen_mask = 0u; float wv[2]; int kv[2];
#pragma unroll
            for (int t = 0; t < 2; ++t) {
                const int lt = 2 * w + t;
                float lg = 0.f;
#pragma unroll
                for (int ww = 0; ww < 8; ++ww) lg += part[(ww * 16 + lt) * 64 + lane];
                const float score = 1.f / (1.f + expf(-lg));
                const float sel = score + rb;
                float m1 = sel;
                m1 = fmaxf(m1, SHX(m1, 1)); m1 = fmaxf(m1, SHX(m1, 2)); m1 = fmaxf(m1, SHX(m1, 4));
                const unsigned long long eq = __ballot(sel == m1);
                const int g = lane >> 3;
                const unsigned geq = (unsigned)((eq >> (g * 8)) & 0xffull);
                const int first = __ffs(geq) - 1;
                float s2 = ((lane & 7) == first) ? -3.0e38f : sel;
                s2 = fmaxf(s2, SHX(s2, 1)); s2 = fmaxf(s2, SHX(s2, 2)); s2 = fmaxf(s2, SHX(s2, 4));
                const float gs = m1 + s2;
                int grank = 0;
#pragma unroll
                for (int gg = 0; gg < 8; ++gg) { const float o = __int_as_float(__builtin_amdgcn_readlane(__float_as_int(gs), gg * 8)); grank += (o > gs || (o == gs && gg < g)) ? 1 : 0; }
                const bool gsel = grank < 4;
                const float val = gsel ? sel : -3.0e38f;
                int rank = 0;
#pragma unroll
                for (int j = 0; j < 64; ++j) { const float o = __int_as_float(__builtin_amdgcn_readlane(__float_as_int(val), j)); rank += (o > val || (o == val && j < lane)) ? 1 : 0; }
                const bool ch = gsel && rank < TOPK;
                const float tot = wsum(ch ? score : 0.f, lane);
                wv[t] = score / tot * 2.5f; kv[t] = rank;
                chosen_mask |= ch ? (1u << t) : 0u;
            }
            const int half = row0 >= TH ? 1 : 0;
#pragma unroll
            for (int t = 0; t < 2; ++t) if (chosen_mask & (1u << t)) {
                const unsigned lrank = (unsigned)__hip_atomic_fetch_add((LAS int*)(F.lds + RL_CNT) + half * 64 + lane, 1, __ATOMIC_RELAXED, __HIP_MEMORY_SCOPE_WORKGROUP);
                const unsigned tokh = (unsigned)(row0 + 2 * w + t - half * TH);
                u32x4 en; en.x = __float_as_uint(wv[t]); en.y = (tokh << 4) | (unsigned)kv[t]; en.z = (unsigned)(half * 64 + lane); en.w = lrank;
                ((LAS u32x4*)(F.lds + RL_ENT))[(ti * 16 + 2 * w + t) * 8 + kv[t]] = en;
            }
        }
        __syncthreads();
    }
    const int ntask = ti;
    if (F.tid < 128) {
        const int n = ((LAS int*)(F.lds + RL_CNT))[F.tid];
        ((LAS int*)(F.lds + RL_BASE))[F.tid] = (n && !F.dry) ? atomicAdd(cntl + F.tid, n) : 0;
    }
    __syncthreads();
    for (int idx = F.tid; idx < ntask * 128; idx += NTHR) {
        const u32x4 en = ((const LAS u32x4*)(F.lds + RL_ENT))[idx];
        const int he = (int)en.z; const int pos = ((const LAS int*)(F.lds + RL_BASE))[he] + (int)en.w;
        if (!F.dry) list[(size_t)he * TH + pos] = ((unsigned long long)en.y << 32) | (unsigned long long)en.x;
    }
    __syncthreads();
}
__device__ __forceinline__ void convert_router(Frame& F, CIN in, int l) {
    f16* rth = (f16*)(F.ws + WS_RT); f16* rtl = rth + NE * D;
    const float* rw = INP(moe_router) + (size_t)l * D * NE;
    for (int i = (F.vcu * NTHR + F.tid); i < NE * D; i += F.G * NTHR) { const int k = i / NE, n = i % NE; const float wgt = rw[i]; const f16 h = (f16)wgt; rth[n * D + k] = h; rtl[n * D + k] = (f16)(wgt - (float)h); }
}

__device__ __forceinline__ void moe_up_phase(Frame& F, int l, int half, int Gs, int cs) {
    LAS int* tab = (LAS int*)(F.lds + pg::STAGE_BYTES);
    const int* cnt = (const int*)(F.ws + WS_CTL) + CW_CNT + l * 128 + half * 64;
    const int lat_only = l == DEPTH - 1;
    int nt_other = 0;
    if (!lat_only && half == 0) { moe_build_tab(F, cnt + 64, tab); nt_other = __builtin_amdgcn_readfirstlane(tab[64]); __syncthreads(); }
    moe_build_tab(F, cnt, tab);
    MoeSched<2, true> Sc; Sc.tab = tab; Sc.G = Gs; Sc.c = cs; Sc.half = half; Sc.list = (const unsigned long long*)(F.ws + WS_LIST);
    Sc.Abase = (const char*)(F.ws + WS_HMH); Sc.Bbase = (const char*)(F.ws + WS_W13); Sc.NT = __builtin_amdgcn_readfirstlane(tab[64]); Sc.lat_only = lat_only;
    Sc.sh_mode = lat_only ? 0 : (half == 0 ? 1 : 2); Sc.NT_other = nt_other;
    EpiUp E; E.H = (f16*)(F.ws + (half ? WS_Y : WS_H)); E.Hother = (f16*)(F.ws + (half ? WS_H : WS_Y));
    pg::gemm_phase<EpiUp, MoeSched<2, true>, true>(F.lds, F.wave, D, D, D, Sc, E);
}
__device__ __forceinline__ void moe_down_phase(Frame& F, int l, int half, int Gs, int cs) {
    LAS int* tab = (LAS int*)(F.lds + pg::STAGE_BYTES);
    const int* cnt = (const int*)(F.ws + WS_CTL) + CW_CNT + l * 128 + half * 64;
    moe_build_tab(F, cnt, tab);
    MoeSched<4, false> Sc; Sc.tab = tab; Sc.G = Gs; Sc.c = cs; Sc.half = half; Sc.list = (const unsigned long long*)(F.ws + WS_LIST);
    Sc.Abase = (const char*)(F.ws + (half ? WS_Y : WS_H)); Sc.Bbase = (const char*)(F.ws + WS_W2); Sc.NT = __builtin_amdgcn_readfirstlane(tab[64]); Sc.lat_only = l == DEPTH - 1; Sc.sh_mode = 0; Sc.NT_other = 0;
    EpiDown E; E.SL = (f16*)(F.ws + WS_SLOT); E.SH = (f16*)(F.ws + WS_SLSH); E.list = Sc.list; E.half = half; E.dry = F.dry;
    pg::gemm_phase<EpiDown, MoeSched<4, false>, true>(F.lds, F.wave, DEXP, DEXP, DEXP, Sc, E);
}
__device__ __forceinline__ void ln2_rows(Frame& F, CIN in, float* out, int l, int half) {
    const int gw = F.vcu * NWAVES + F.wave, NGW = F.G * NWAVES;
    float* X = (float*)(F.ws + WS_X); f16* HM = (f16*)(F.ws + WS_HMH); const unsigned char* SL8 = (const unsigned char*)(F.ws + WS_SLOT); const f16* SH = (const f16*)(F.ws + WS_SLSH);
    const float* mods = (const float*)(F.ws + WS_MODS) + (size_t)l * 9 * 6 * D;
    const f32x4* g4 = (const f32x4*)(INP(ln2_g) + l * D) + F.lane; const f32x4* b4 = (const f32x4*)(INP(ln2_b) + l * D) + F.lane;
    f32x4 gL[4], bL[4];
#pragma unroll
    for (int j = 0; j < 4; ++j) { gL[j] = g4[64 * j]; bL[j] = b4[64 * j]; }
    for (int th = gw; th < TH; th += NGW) {
        const int row = half * TH + th;
        if (l == DEPTH - 1 && row % SE >= S) continue;
        const float* m = mods + (size_t)mod_row(row) * 6 * D;
        f32x4* xr = (f32x4*)(X + (size_t)row * D) + F.lane;
        const f32x4* gt = (const f32x4*)(m + 5 * D) + F.lane;
        f32x4 v[4]; float s = 0.f;
        unsigned q[4][8]; h4 qs[4]; f32x4 xv[4], gv[4], shv[4], scv[4];
        const float* mn = mods + (size_t)9 * 6 * D + (size_t)mod_row(row) * 6 * D;
#pragma unroll
        for (int j = 0; j < 4; ++j) {
#pragma unroll
            for (int k = 0; k < 8; ++k) q[j][k] = *((const unsigned*)(SL8 + ((size_t)th * 8 + k) * D) + F.lane + 64 * j);
            qs[j] = *((const h4*)(SH + (size_t)th * D) + F.lane + 64 * j);
            xv[j] = xr[64 * j]; gv[j] = gt[64 * j];
            if (l + 1 < DEPTH) { shv[j] = ((const f32x4*)(mn) + F.lane)[64 * j]; scv[j] = ((const f32x4*)(mn + D) + F.lane)[64 * j]; }
        }
        asm volatile("" ::: "memory");
#pragma unroll
        for (int j = 0; j < 4; ++j) {
            f32x4 f = (f32x4){0.f, 0.f, 0.f, 0.f};
#pragma unroll
            for (int k = 0; k < 8; ++k) { const int w8 = (int)q[j][k]; f += (f32x4){__builtin_amdgcn_cvt_f32_fp8(w8, 0), __builtin_amdgcn_cvt_f32_fp8(w8, 1), __builtin_amdgcn_cvt_f32_fp8(w8, 2), __builtin_amdgcn_cvt_f32_fp8(w8, 3)}; }
            f = f * (1.f / SLOT_SC) + (f32x4){(float)qs[j][0], (float)qs[j][1], (float)qs[j][2], (float)qs[j][3]};
            v[j] = xv[j] * ALPHA + gv[j] * f; s += (v[j].x + v[j].y) + (v[j].z + v[j].w);
        }
        const float mean = wsum(s, F.lane) * (1.f / D); float s2 = 0.f;
#pragma unroll
        for (int j = 0; j < 4; ++j) { v[j] = v[j] - mean; s2 += (v[j].x * v[j].x + v[j].y * v[j].y) + (v[j].z * v[j].z + v[j].w * v[j].w); }
        const float rstd = 1.f / sqrtf(wsum(s2, F.lane) * (1.f / D) + LN_EPS);
#pragma unroll
        for (int j = 0; j < 4; ++j) { v[j] = v[j] * rstd * gL[j] + bL[j]; if (!F.dry) xr[64 * j] = v[j]; }
        if (l + 1 < DEPTH) {
            u32x2* o8 = (u32x2*)(HM + (size_t)row * D) + F.lane;
#pragma unroll
            for (int j = 0; j < 4; ++j) { const f32x4 h = v[j] * (scv[j] + 1.f) + shv[j]; u32x2 w; w.x = pkh(h.x, h.y); w.y = pkh(h.z, h.w); if (!F.dry) o8[64 * j] = w; }
        } else {
            const int b = row / SE, ii = row - b * SE;
            if (ii < S) { f32x4* o = (f32x4*)(out + ((size_t)b * S + ii) * D) + F.lane;
#pragma unroll
                for (int j = 0; j < 4; ++j) if (!F.dry) o[64 * j] = v[j]; }
        }
    }
}
#ifndef FFT_HD
#define FFT_HD __host__ __device__ __forceinline__
#endif
namespace fft {
constexpr int N = 8192, LOGN = 13, NPAD = N + N / 8;
FFT_HD int pidx(int i) { return i + (i >> 3); }
FFT_HD int brev(int k) { return (int)(__builtin_bitreverse32((unsigned)k) >> (32 - LOGN)); }
typedef float c2 __attribute__((ext_vector_type(2)));
FFT_HD c2 cmul(c2 a, c2 b) { return c2{a.x * b.x - a.y * b.y, a.x * b.y + a.y * b.x}; }
FFT_HD c2 cmulc(c2 a, c2 b) { return c2{a.x * b.x + a.y * b.y, a.y * b.x - a.x * b.y}; }
FFT_HD c2 tw(float frac) {
#if defined(__HIP_DEVICE_COMPILE__)
    return c2{__builtin_amdgcn_cosf(frac), -__builtin_amdgcn_sinf(frac)};
#else
    return c2{(float)cos(6.283185307179586 * (double)frac), (float)-sin(6.283185307179586 * (double)frac)};
#endif
}
template <int LOG, bool INV, class BP, class TP, bool HALF = false>
FFT_HD void pass_group(BP buf, TP tab, int h2, int gidx) {
    constexpr int R = 1 << LOG;
    const int hi = gidx / h2, lo = gidx - hi * h2, base = hi * (R * h2) + lo;
    c2 x[R];
#pragma unroll
    for (int m = 0; m < R; ++m) { if (HALF && !INV && m >= R / 2) x[m] = c2{0.f, 0.f}; else x[m] = buf[pidx(base + m * h2)]; }
    if (!INV) {
#pragma unroll
        for (int q = 0; q < LOG; ++q) { const int mq = R >> (q + 1); const int sc = N / (2 * mq * h2);
#pragma unroll
            for (int m = 0; m < R; ++m) if ((m & mq) == 0) { const c2 w = tab[pidx(((m % mq) * h2 + lo) * sc)]; const c2 a = x[m], b = x[m + mq];
                x[m] = c2{a.x + b.x, a.y + b.y}; x[m + mq] = cmul(c2{a.x - b.x, a.y - b.y}, w); } }
    } else {
#pragma unroll
        for (int q = LOG - 1; q >= 0; --q) { const int mq = R >> (q + 1); const int sc = N / (2 * mq * h2);
#pragma unroll
            for (int m = 0; m < R; ++m) if ((m & mq) == 0) { const c2 w = tab[pidx(((m % mq) * h2 + lo) * sc)]; const c2 a = x[m], t = cmulc(x[m + mq], w);
                x[m] = c2{a.x + t.x, a.y + t.y}; x[m + mq] = c2{a.x - t.x, a.y - t.y}; } }
    }
#pragma unroll
    for (int m = 0; m < R; ++m) if (!(HALF && INV && m >= R / 2)) buf[pidx(base + m * h2)] = x[m];
}
}
__device__ __forceinline__ void pro_mods(Frame& F, CIN in) {
    const int gw = F.vcu * NWAVES + F.wave, NGW = F.G * NWAVES, lane = F.lane;
    float* mods = (float*)(F.ws + WS_MODS);
    for (int task = gw; task < DEPTH * 96 * 16; task += NGW) {
        const int l = task / 1536, r0 = task - l * 1536, jb = r0 >> 4, kc = r0 & 15, col = jb * 64 + lane, k = kc * 64 + lane;
        float cv[9];
#pragma unroll
        for (int r = 0; r < 9; ++r) { const float v = r < 8 ? INP(c)[r * D + k] : INP(c_ctx)[k]; cv[r] = v / (1.f + expf(-v)); }
        float acc[9];
#pragma unroll
        for (int r = 0; r < 9; ++r) acc[r] = 0.f;
        const float* w = INP(w_ada) + ((size_t)l * D + kc * 64) * 6 * D + col;
#pragma unroll 4
        for (int kk = 0; kk < 64; ++kk) { const float wv = w[(size_t)kk * 6 * D];
#pragma unroll
            for (int r = 0; r < 9; ++r) acc[r] += __shfl(cv[r], kk) * wv; }
        const float bb = kc == 0 ? INP(b_ada)[l * 6 * D + col] : 0.f;
#pragma unroll
        for (int r = 0; r < 9; ++r) if (!F.dry) atomicAdd(&mods[((size_t)l * 9 + r) * 6 * D + col], acc[r] + bb);
    }
}
__device__ __forceinline__ void pro_init_x(Frame& F, CIN in) {
    const int gw = F.vcu * NWAVES + F.wave, NGW = F.G * NWAVES;
    float* X = (float*)(F.ws + WS_X);
    for (int row = gw; row < T; row += NGW) {
        const int b = row / SE, ii = row - b * SE;
        const f32x4* src = (const f32x4*)(ii < S ? INP(x) + ((size_t)b * S + ii) * D : INP(ctx) + ((size_t)b * CL + (ii - S)) * D) + F.lane;
        f32x4* dst = (f32x4*)(X + (size_t)row * D) + F.lane;
        f32x4 t4[4];
#pragma unroll
        for (int j = 0; j < 4; ++j) t4[j] = src[64 * j];
#pragma unroll
        for (int j = 0; j < 4; ++j) dst[64 * j] = t4[j];
    }
}
__device__ __forceinline__ void pro_z2(Frame& F, CIN in) {
    const int gw = F.vcu * NWAVES + F.wave, NGW = F.G * NWAVES, lane = F.lane;
    float* Z2 = (float*)(F.ws + WS_Z2);
    for (int task = gw; task < DEPTH * SE; task += NGW) {
        const int l = task / SE, ti = task - l * SE, L = ti < S ? S : CL, t = ti < S ? ti : ti - S;
        const float* w1 = INP(hy_w1) + l * 33 * 64; const float* w2 = INP(hy_w2) + l * 4096; const float* sf = INP(hy_sin_freq) + l * 128;
        const double PI2 = 6.283185307179586476925;
        const float tt = (float)((double)t / (double)(L - 1));
        const float ang = (float)(PI2 / (double)L) * (float)t;
        float a = INP(hy_b1)[l * 64 + lane];
        a += tt * w1[lane];
        for (int j = 0; j < 16; ++j) {
            const float band = (float)(1e-4 + (double)j * ((15.0 - 1e-4) / 15.0));
            const float arg = band * ang;
            a += cosf(arg) * w1[(1 + j) * 64 + lane];
            a += -sinf(arg) * w1[(17 + j) * 64 + lane];
        }
        const float z1 = sinf(sf[lane] * a);
        float a2 = INP(hy_b2)[l * 64 + lane];
        for (int i = 0; i < 64; ++i) a2 += __shfl(z1, i) * w2[i * 64 + lane];
        Z2[(size_t)task * 64 + lane] = sinf(sf[64 + lane] * a2);
    }
}
__device__ __forceinline__ void init_mod1_rows(Frame& F, CIN in) {
    const int gw = F.vcu * NWAVES + F.wave, NGW = F.G * NWAVES;
    float* X = (float*)(F.ws + WS_X); f16* HM = (f16*)(F.ws + WS_HMH);
    const float* mods = (const float*)(F.ws + WS_MODS);
    for (int row = gw; row < T; row += NGW) {
        const int b = row / SE, ii = row - b * SE;
        const f32x4* src = (const f32x4*)(ii < S ? INP(x) + ((size_t)b * S + ii) * D : INP(ctx) + ((size_t)b * CL + (ii - S)) * D) + F.lane;
        const float* m = mods + (size_t)(ii < S ? b : 8) * 6 * D;
        const f32x4* sh = (const f32x4*)(m) + F.lane; const f32x4* sc = (const f32x4*)(m + D) + F.lane;
        f32x4* dst = (f32x4*)(X + (size_t)row * D) + F.lane; u32x2* o8 = (u32x2*)(HM + (size_t)row * D) + F.lane;
        f32x4 xv[4], sv[4], cv[4];
#pragma unroll
        for (int j = 0; j < 4; ++j) { xv[j] = src[64 * j]; sv[j] = sh[64 * j]; cv[j] = sc[64 * j]; }
#pragma unroll
        for (int j = 0; j < 4; ++j) { dst[64 * j] = xv[j]; const f32x4 h = xv[j] * (cv[j] + 1.f) + sv[j]; u32x2 w; w.x = pkh(h.x, h.y); w.y = pkh(h.z, h.w); o8[64 * j] = w; }
    }
}
__device__ __forceinline__ void mod1_rows(Frame& F, int l) {
    const int gw = F.vcu * NWAVES + F.wave, NGW = F.G * NWAVES;
    const float* X = (const float*)(F.ws + WS_X); f16* HM = (f16*)(F.ws + WS_HMH);
    const float* mods = (const float*)(F.ws + WS_MODS) + (size_t)l * 9 * 6 * D;
    for (int row = gw; row < T; row += NGW) {
        const f32x4* xr = (const f32x4*)(X + (size_t)row * D) + F.lane;
        const float* m = mods + (size_t)mod_row(row) * 6 * D;
        const f32x4* sh = (const f32x4*)(m) + F.lane; const f32x4* sc = (const f32x4*)(m + D) + F.lane;
        u32x2* o8 = (u32x2*)(HM + (size_t)row * D) + F.lane;
        f32x4 xv[4], sv[4], cv[4];
#pragma unroll
        for (int j = 0; j < 4; ++j) { xv[j] = xr[64 * j]; sv[j] = sh[64 * j]; cv[j] = sc[64 * j]; }
#pragma unroll
        for (int j = 0; j < 4; ++j) { const f32x4 h = xv[j] * (cv[j] + 1.f) + sv[j]; u32x2 w; w.x = pkh(h.x, h.y); w.y = pkh(h.z, h.w); o8[64 * j] = w; }
    }
}

typedef LAS fft::c2* LBuf;
#define FFT_OPQ(t) asm volatile("" : "+v"(t))
typedef const LAS fft::c2* LTab;
constexpr int LDS_FFT_TAB = fft::NPAD * 8, LDS_FFT_END = LDS_FFT_TAB + (fft::N / 2 + fft::N / 16) * 8;
__device__ __forceinline__ void fft_fill_tab(LAS unsigned char* lds, int tid) {
    LAS fft::c2* tab = (LAS fft::c2*)(lds + LDS_FFT_TAB);
    for (int i = tid; i < fft::N / 2; i += NTHR) tab[fft::pidx(i)] = fft::tw((float)i * (1.0f / (float)fft::N));
    __syncthreads();
}
template <bool ZERO_UPPER>
__device__ __forceinline__ void fft_fwd(LBuf buf, int tid) {
    LTab tab = (LTab)((const LAS unsigned char*)buf + LDS_FFT_TAB);
    FFT_OPQ(tid); fft::pass_group<4, false, LBuf, LTab, ZERO_UPPER>(buf, tab, 512, tid); __syncthreads();
    FFT_OPQ(tid); fft::pass_group<3, false>(buf, tab, 64, tid); FFT_OPQ(tid); fft::pass_group<3, false>(buf, tab, 64, tid + 512); __syncthreads();
    FFT_OPQ(tid); fft::pass_group<3, false>(buf, tab, 8, tid); FFT_OPQ(tid); fft::pass_group<3, false>(buf, tab, 8, tid + 512); __syncthreads();
    FFT_OPQ(tid); fft::pass_group<3, false>(buf, tab, 1, tid); FFT_OPQ(tid); fft::pass_group<3, false>(buf, tab, 1, tid + 512); __syncthreads();
}
__device__ __forceinline__ void fft_inv(LBuf buf, int tid) {
    LTab tab = (LTab)((const LAS unsigned char*)buf + LDS_FFT_TAB);
    FFT_OPQ(tid); fft::pass_group<3, true>(buf, tab, 1, tid); FFT_OPQ(tid); fft::pass_group<3, true>(buf, tab, 1, tid + 512); __syncthreads();
    FFT_OPQ(tid); fft::pass_group<3, true>(buf, tab, 8, tid); FFT_OPQ(tid); fft::pass_group<3, true>(buf, tab, 8, tid + 512); __syncthreads();
    FFT_OPQ(tid); fft::pass_group<3, true>(buf, tab, 64, tid); FFT_OPQ(tid); fft::pass_group<3, true>(buf, tab, 64, tid + 512); __syncthreads();
    FFT_OPQ(tid); fft::pass_group<4, true, LBuf, LTab, true>(buf, tab, 512, tid); __syncthreads();
}
__device__ __forceinline__ float hy_delta(int c) { const float la = -3.0701134573253944f  , st = (-15.350567286626972f + 3.0701134573253944f) / 511.0f; return fabsf(la + (float)c * st); }
__device__ __forceinline__ void filters_phase(Frame& F, CIN in, int l) {
    LBuf buf = (LBuf)F.lds;
    LAS float* w3s = (LAS float*)(F.lds + LDS_FFT_END);
    fft_fill_tab(F.lds, F.tid);
    const float* Z2 = (const float*)(F.ws + WS_Z2) + (size_t)l * SE * 64;
    const float* w3 = INP(hy_w3) + (size_t)l * 64 * 1024;
    f32x4* SD = (f32x4*)(F.ws + WS_SD);
    for (int p = F.bid; p < 256; p += F.G) {
        int tid = F.tid; asm volatile("" : "+v"(tid));
        const int ca = 2 * p, cb = 2 * p + 1;
        __syncthreads();
        if (tid < 256) { const int j = tid & 63, which = tid >> 6; const int col = (which & 1 ? cb : ca) + (which >> 1 ? 512 : 0); w3s[which * 64 + j] = w3[j * 1024 + col]; }
        __syncthreads();
        const float da = hy_delta(ca), db = hy_delta(cb);
        for (int i = 0; i < 8; ++i) {
            const int t = tid + 512 * i;
            const f32x4* zr = (const f32x4*)(Z2 + (size_t)t * 64);
            float fa = 0.f, fb = 0.f, ba = 0.f, bb = 0.f;
#pragma unroll 4
            for (int j4 = 0; j4 < 16; ++j4) { const f32x4 z = zr[j4];
#pragma unroll
                for (int u = 0; u < 4; ++u) { const int j = 4 * j4 + u; fa += z[u] * w3s[j]; fb += z[u] * w3s[64 + j]; ba += z[u] * w3s[128 + j]; bb += z[u] * w3s[192 + j]; } }
            const float tt = (float)t * (1.0f / (float)(S - 1));
            const float ea = expf(-tt * da), eb = expf(-tt * db);
            buf[fft::pidx(t)] = fft::c2{fa * ea, fb * eb};
            if (t == 0) { const float zf = (float)(tid >> 16); buf[fft::pidx(S)] = fft::c2{zf, zf}; } else buf[fft::pidx(2 * S - t)] = fft::c2{ba * ea, bb * eb};
        }
        __syncthreads();
        fft_fwd<false>(buf, tid);
        for (int j = tid; j <= S; j += NTHR) {
            const int pos = j < S ? 2 * j : 1, k = fft::brev(pos);
            const fft::c2 Xk = buf[fft::pidx(pos)], Xp = buf[fft::pidx(fft::brev((fft::N - k) & (fft::N - 1)))];
            const float gar = 0.5f * (Xk.x + Xp.x), gai = 0.5f * (Xk.y - Xp.y);
            const float ur = Xk.x - Xp.x, ui = Xk.y + Xp.y;
            const float gbr = 0.5f * ui, gbi = -0.5f * ur;
            SD[(size_t)p * 4097 + j] = (f32x4){0.5f * (gar + gbr), 0.5f * (gai + gbi), 0.5f * (gar - gbr), 0.5f * (gai - gbi)};
        }
    }
    __syncthreads();
    const int gw = F.vcu * NWAVES + F.wave, NGW = F.G * NWAVES, lane = F.lane;
    float* GC = (float*)(F.ws + WS_GC);
    const float* Z2c = Z2 + (size_t)S * 64;
    for (int task = gw; task < CL * 16; task += NGW) {
        const int t = task >> 4, col = (task & 15) * 64 + lane;
        const float* zr = Z2c + (size_t)t * 64;
        float a = 0.f;
#pragma unroll 8
        for (int j = 0; j < 64; ++j) a += zr[j] * w3[j * 1024 + col];
        const int c = col & 511;
        const float tt = (float)t * (1.0f / (float)(CL - 1));
        const float v = a * expf(-tt * hy_delta(c));
        if (col < 512) GC[(size_t)c * 512 + 256 + t] = v; else if (t >= 1) GC[(size_t)c * 512 + 256 - t] = v;
    }
}

__device__ __forceinline__ void transpose_phase(Frame& F, CIN in, int l) {
    LAS f16* tile = (LAS f16*)F.lds;
    const f16* P = (const f16*)(F.ws + WS_P);
    f16* ZT = (f16*)(F.ws + WS_ZT); f16* VT = (f16*)(F.ws + WS_VT);
    const float* cw = INP(hy_conv_w) + l * 3 * 1536; const float* cbias = INP(hy_conv_b) + l * 1536;
    const int tid = F.tid, t = tid >> 3, cg = tid & 7;
    for (int task = F.bid; task < B * 68 * 4; task += F.G) {
        const int q = task & 3, r0 = task >> 2, tl = r0 % 68, b = r0 / 68;
        const int i = tl * 64 + t, lo = i < S ? 0 : S, hi = i < S ? S : SE;
        const f16* prow = P + ((size_t)b * SE + i) * DIN;
        const bool hasp = i - 1 >= lo, hasn = i + 1 < hi;
        h8 outv[4];
        if (q < 2) {
            h8 cur[4][2], prv[4][2], nxt[4][2];
#pragma unroll
            for (int u = 0; u < 4; ++u)
#pragma unroll
                for (int part = 0; part < 2; ++part) { const int col = 512 * (part + 1) + (4 * q + u) * 64 + cg * 8;
                    cur[u][part] = *(const h8*)(prow + col);
#pragma unroll
                    for (int j = 0; j < 8; ++j) { prv[u][part][j] = (f16)0.f; nxt[u][part][j] = (f16)0.f; }
                    if (hasp) prv[u][part] = *(const h8*)(prow - DIN + col);
                    if (hasn) nxt[u][part] = *(const h8*)(prow + DIN + col); }
#pragma unroll
            for (int u = 0; u < 4; ++u) { float z[8];
#pragma unroll
                for (int part = 0; part < 2; ++part) { const int col = 512 * (part + 1) + (4 * q + u) * 64 + cg * 8;
#pragma unroll
                    for (int j = 0; j < 8; ++j) { const float uu = (float)prv[u][part][j] * cw[col + j] + (float)cur[u][part][j] * cw[1536 + col + j] + (float)nxt[u][part][j] * cw[3072 + col + j] + cbias[col + j];
                        z[j] = part == 0 ? uu : z[j] * uu; } }
#pragma unroll
                for (int j = 0; j < 8; ++j) outv[u][j] = (f16)z[j]; }
        } else {
#pragma unroll
            for (int u = 0; u < 4; ++u) outv[u] = *(const h8*)(prow + OFF_NA + 1024 + (4 * (q - 2) + u) * 64 + cg * 8);
        }
        __syncthreads();
#pragma unroll
        for (int u = 0; u < 4; ++u)
#pragma unroll
            for (int j = 0; j < 8; ++j) tile[u * 4608 + (cg * 8 + j) * 72 + t] = outv[u][j];
        __syncthreads();
        {
            const int ch = tid >> 3, part = tid & 7;
#pragma unroll
            for (int u = 0; u < 4; ++u) {
                const h8 v = *(const LAS h8*)(tile + u * 4608 + ch * 72 + part * 8);
                const int cb = q < 2 ? 4 * q + u : 4 * (q - 2) + u;
                f16* dst = (q < 2 ? ZT : VT) + ((size_t)b * DH + cb * 64 + ch) * SE + tl * 64 + part * 8;
                *(h8*)dst = v; }
        }
    }
    __syncthreads();
}

__device__ __forceinline__ void fftconv_tasks(Frame& F, CIN in, int l, int pflags) {
    LBuf buf = (LBuf)F.lds;
    f16* ZT = (f16*)(F.ws + WS_ZT); const f16* VHT = (const f16*)(F.ws + WS_VHT);
    const f32x4* SD = (const f32x4*)(F.ws + WS_SD);
    const float* bd = INP(hy_bias_d) + l * DH;
    const float* cwl = INP(hy_conv_w) + l * 3 * 1536; const float* cbl = INP(hy_conv_b) + l * 1536;
    fft_fill_tab(F.lds, F.tid);
    for (int task = F.bid; task < B * 256; task += F.G) {
        int tid = F.tid; asm volatile("" : "+v"(tid));
        const int b = task & 7, p = task >> 3;
        f16* za = ZT + ((size_t)b * DH + 2 * p) * SE; f16* zb = za + SE;
        const f16* ha = VHT + ((size_t)b * DH + 2 * p) * SE; const f16* hb = ha + SE;
        const int t0 = tid * 8;
        h8 va, vb;
        {
            const h8 xa = *(const h8*)(za + t0), xb = *(const h8*)(zb + t0), wa = *(const h8*)(ha + t0), wb = *(const h8*)(hb + t0);
            const bool hp = t0 > 0, hn = t0 + 8 < S;
            const f16 zf = (f16)0.f;
            const f16 xap = hp ? za[t0 - 1] : zf, xan = hn ? za[t0 + 8] : zf, xbp = hp ? zb[t0 - 1] : zf, xbn = hn ? zb[t0 + 8] : zf;
            const f16 wap = hp ? ha[t0 - 1] : zf, wan = hn ? ha[t0 + 8] : zf, wbp = hp ? hb[t0 - 1] : zf, wbn = hn ? hb[t0 + 8] : zf;
            const int ca = 2 * p, cbb = 2 * p + 1;
            const float x1a0 = cwl[512 + ca], x1a1 = cwl[1536 + 512 + ca], x1a2 = cwl[3072 + 512 + ca], x1ab = cbl[512 + ca];
            const float x1b0 = cwl[512 + cbb], x1b1 = cwl[1536 + 512 + cbb], x1b2 = cwl[3072 + 512 + cbb], x1bb = cbl[512 + cbb];
            const float vha0 = cwl[1024 + ca], vha1 = cwl[1536 + 1024 + ca], vha2 = cwl[3072 + 1024 + ca], vhab = cbl[1024 + ca];
            const float vhb0 = cwl[1024 + cbb], vhb1 = cwl[1536 + 1024 + cbb], vhb2 = cwl[3072 + 1024 + cbb], vhbb = cbl[1024 + cbb];
#pragma unroll
            for (int j = 0; j < 8; ++j) {
                const float xa_m = (float)(j == 0 ? xap : xa[j == 0 ? 0 : j - 1]), xa_p = (float)(j == 7 ? xan : xa[j == 7 ? 7 : j + 1]);
                const float xb_m = (float)(j == 0 ? xbp : xb[j == 0 ? 0 : j - 1]), xb_p = (float)(j == 7 ? xbn : xb[j == 7 ? 7 : j + 1]);
                const float wa_m = (float)(j == 0 ? wap : wa[j == 0 ? 0 : j - 1]), wa_p = (float)(j == 7 ? wan : wa[j == 7 ? 7 : j + 1]);
                const float wb_m = (float)(j == 0 ? wbp : wb[j == 0 ? 0 : j - 1]), wb_p = (float)(j == 7 ? wbn : wb[j == 7 ? 7 : j + 1]);
                const float ua = xa_m * x1a0 + (float)xa[j] * x1a1 + xa_p * x1a2 + x1ab, ub = xb_m * x1b0 + (float)xb[j] * x1b1 + xb_p * x1b2 + x1bb;
                const float ya = wa_m * vha0 + (float)wa[j] * vha1 + wa_p * vha2 + vhab, yb = wb_m * vhb0 + (float)wb[j] * vhb1 + wb_p * vhb2 + vhbb;
                va[j] = (f16)(ua * ya); vb[j] = (f16)(ub * yb);
            }
        }
        f32x4 sdv[8];
#pragma unroll
        for (int i = 0; i < 8; ++i) sdv[i] = SD[(size_t)p * 4097 + tid + NTHR * i];
        __syncthreads();
#pragma unroll
        for (int j = 0; j < 8; ++j) buf[fft::pidx(t0 + j)] = fft::c2{(float)va[j], (float)vb[j]};
        __syncthreads();
        if (!(pflags & 128)) fft_fwd<true>(buf, tid);
#pragma unroll
        for (int i = 0; i < 9; ++i) {
            if (i < 8 || tid == 0) {
                const int pos = i < 8 ? 2 * (tid + NTHR * i) : 1, k = fft::brev(pos);
                const int pa = fft::pidx(pos), pp = fft::pidx(fft::brev((fft::N - k) & (fft::N - 1)));
                const fft::c2 Xk = buf[pa], Xp = buf[pp]; const f32x4 sd = i < 8 ? sdv[i < 8 ? i : 0] : SD[(size_t)p * 4097 + S];
                const fft::c2 Sv{sd[0], sd[1]}, Dv{sd[2], sd[3]};
                const fft::c2 t1 = fft::cmul(Xk, Sv), t2 = fft::cmul(fft::c2{Xp.x, -Xp.y}, Dv);
                const fft::c2 u1 = fft::cmulc(Xp, Sv), u2 = fft::cmulc(fft::c2{Xk.x, -Xk.y}, Dv);
                buf[pa] = fft::c2{t1.x + t2.x, t1.y + t2.y};
                if (pp != pa) buf[pp] = fft::c2{u1.x + u2.x, u1.y + u2.y};
            }
        }
        __syncthreads();
        if (!(pflags & 256)) fft_inv(buf, tid);
        const float ba = bd[2 * p], bb = bd[2 * p + 1];
        h8 oa, ob;
#pragma unroll
        for (int j = 0; j < 8; ++j) { const fft::c2 y = buf[fft::pidx(t0 + j)]; oa[j] = (f16)(y.x * (1.f / fft::N) + (float)va[j] * ba); ob[j] = (f16)(y.y * (1.f / fft::N) + (float)vb[j] * bb); }
        if (!F.dry) { *(h8*)(za + t0) = oa; *(h8*)(zb + t0) = ob; }
    }
    __syncthreads();
}
__device__ __forceinline__ void ctxconv_tasks(Frame& F, CIN in, int l) {
    const int gw = F.vcu * NWAVES + F.wave, NGW = F.G * NWAVES, lane = F.lane;
    f16* ZT = (f16*)(F.ws + WS_ZT); const f16* VHT = (const f16*)(F.ws + WS_VHT);
    const float* GC = (const float*)(F.ws + WS_GC);
    const float* cwl = INP(hy_conv_w) + l * 3 * 1536; const float* cbl = INP(hy_conv_b) + l * 1536;
    for (int task = gw; task < B * DH; task += NGW) {
        const int c = task & (DH - 1);
        f16* zp = ZT + (size_t)task * SE + S; const f16* hp = VHT + (size_t)task * SE + S;
        float zv[4], acc[4];
        {
            const float xw0 = cwl[512 + c], xw1 = cwl[1536 + 512 + c], xw2 = cwl[3072 + 512 + c], xbb = cbl[512 + c];
            const float vw0 = cwl[1024 + c], vw1 = cwl[1536 + 1024 + c], vw2 = cwl[3072 + 1024 + c], vbb = cbl[1024 + c];
#pragma unroll
            for (int j = 0; j < 4; ++j) { const int t = lane + 64 * j;
                const float xm = t > 0 ? (float)zp[t - 1] : 0.f, x0 = (float)zp[t], xp = t + 1 < CL ? (float)zp[t + 1] : 0.f;
                const float vm = t > 0 ? (float)hp[t - 1] : 0.f, v0 = (float)hp[t], vp = t + 1 < CL ? (float)hp[t + 1] : 0.f;
                zv[j] = (float)(f16)((xm * xw0 + x0 * xw1 + xp * xw2 + xbb) * (vm * vw0 + v0 * vw1 + vp * vw2 + vbb)); acc[j] = 0.f; }
        }
        const float* g = GC + (size_t)c * 512 + 256 + lane;
#pragma unroll
        for (int sj = 0; sj < 4; ++sj)
            for (int s0 = 0; s0 < 64; ++s0) { const float zs = bperm(s0, zv[sj]); const int s = sj * 64 + s0;
#pragma unroll
                for (int j = 0; j < 4; ++j) acc[j] += g[64 * j - s] * zs; }
        const float bdv = INP(hy_bias_d)[l * DH + c];
#pragma unroll
        for (int j = 0; j < 4; ++j) if (!F.dry) zp[lane + 64 * j] = (f16)(acc[j] + zv[j] * bdv);
    }
}
constexpr int AT_KP = 72, AT_VP = 264;
constexpr int AT_VOFF = 256 * AT_KP * 2;
constexpr int AT_RPB = AT_VOFF + 64 * AT_VP * 2;
template <bool LOCAL>
__device__ __forceinline__ void attn_wtask(Frame& F, const float* rpb_l, int b, int h, int r, int n, int qrow0, int pf = 0) {
    const int lane = lane_id(), fr = lane & 15, fq = lane >> 4;
    const f16* P = (const f16*)(F.ws + WS_P); const f16* VT = (const f16*)(F.ws + WS_VT); f16* Y = (f16*)(F.ws + WS_Y);
    const LAS f16* Kc = (const LAS f16*)F.lds; const LAS f16* VcT = (const LAS f16*)(F.lds + AT_VOFF);
    const int rs = r - 4 < 0 ? 0 : (r - 4 > 56 ? 56 : r - 4);
    const int kb = n == 0 ? 0 : (n == 1 ? 8 : (n == 2 ? 24 : 32));
    const f16* Pb = P + (size_t)b * SE * DIN;
    const f16* qp = Pb + (size_t)(qrow0 + fr) * DIN + OFF_NA + h * 64 + fq * 8;
    const h8 bq0 = *(const h8*)qp, bq1 = *(const h8*)(qp + 32);
    const char* kub = (const char*)(Pb + OFF_NA + 512 + h * 64);
    const unsigned klo = (unsigned)fq * 16u;
    const f16* vbase = VT + ((size_t)b * DH + h * 64 + fr) * SE + 8 * fq;
    const int ko = 8 * (fr >> 2) + (fr & 3);
    const int qc = 16 * n + fr; const int cs = qc - 8 < 0 ? 0 : (qc - 8 > 48 ? 48 : qc - 8);
    float mrun = -3.0e38f, lsum = 0.f;
    f32x4 o[4];
#pragma unroll
    for (int d = 0; d < 4; ++d) o[d] = (f32x4){0.f, 0.f, 0.f, 0.f};
    constexpr int NCH = LOCAL ? 2 : 1;
#pragma unroll
    for (int ch = 0; ch < NCH; ++ch) {
        if (LOCAL && ((ch == 0 && (pf & 8192)) || (ch == 1 && (pf & 16384)))) continue;
        const bool loc = LOCAL && ch == 0;
        f32x4 st[16];
        if (loc) {
            h8 kf[3][8];
#pragma unroll
            for (int g0 = 0; g0 < 2; ++g0)
#pragma unroll
                for (int q = 0; q < 4; ++q) { const int tl = 4 * g0 + q; const char* kp = kub + ((unsigned)((rs + (tl >> 1)) * 64 + kb + 4 * (tl & 1) + ko) * (unsigned)(DIN * 2) + klo); kf[g0][2 * q] = *(const h8*)kp; kf[g0][2 * q + 1] = *(const h8*)(kp + 64); }
#pragma unroll
            for (int g = 0; g < 4; ++g) {
                if (g + 2 < 4) {
#pragma unroll
                    for (int q = 0; q < 4; ++q) { const int tl = 4 * (g + 2) + q; const char* kp = kub + ((unsigned)((rs + (tl >> 1)) * 64 + kb + 4 * (tl & 1) + ko) * (unsigned)(DIN * 2) + klo);
                        kf[(g + 2) % 3][2 * q] = *(const h8*)kp; kf[(g + 2) % 3][2 * q + 1] = *(const h8*)(kp + 64); }
                }
                asm volatile("" ::: "memory");
#pragma unroll
                for (int q = 0; q < 4; ++q) { f32x4 acc = (f32x4){0.f, 0.f, 0.f, 0.f};
                    acc = __builtin_amdgcn_mfma_f32_16x16x32_f16(kf[g % 3][2 * q], bq0, acc, 0, 0, 0);
                    acc = __builtin_amdgcn_mfma_f32_16x16x32_f16(kf[g % 3][2 * q + 1], bq1, acc, 0, 0, 0);
                    st[4 * g + q] = acc; }
            }
        } else {
#pragma unroll
            for (int tl = 0; tl < 16; ++tl) {
                const LAS f16* kp = Kc + (32 * (tl >> 1) + 4 * (tl & 1) + ko) * AT_KP + fq * 8;
                const h8 a0 = *(const LAS h8*)kp, a1 = *(const LAS h8*)(kp + 32);
                f32x4 acc = (f32x4){0.f, 0.f, 0.f, 0.f};
                acc = __builtin_amdgcn_mfma_f32_16x16x32_f16(a0, bq0, acc, 0, 0, 0);
                acc = __builtin_amdgcn_mfma_f32_16x16x32_f16(a1, bq1, acc, 0, 0, 0);
                st[tl] = acc;
                if ((tl & 3) == 3) asm volatile("" ::: "memory");
            }
        }
        h8 vf[4][4];
        if (loc) {
#pragma unroll
            for (int pre = 0; pre < 3; ++pre)
#pragma unroll
                for (int d = 0; d < 4; ++d) vf[pre][d] = *(const h8*)(vbase + (size_t)d * 16 * SE + (rs + pre) * 64 + kb);
        }
        float mx = -3.0e38f;
        if (loc) {
            const LAS float* rp = (const LAS float*)(F.lds + AT_RPB) + h * 15 * 32;
            const int cbase = kb + 8 * fq - qc + 15;
#pragma unroll
            for (int sp = 0; sp < 8; ++sp) {
                const LAS float* rrow = rp + (rs + sp - r + 7) * 32;
                float bz[8];
#pragma unroll
                for (int e = 0; e < 8; ++e) { int ci = cbase + e; ci = ci < 0 ? 0 : (ci > 30 ? 30 : ci); bz[e] = rrow[ci]; }
#pragma unroll
                for (int e = 0; e < 8; ++e) { const int kcol = kb + 8 * fq + e; const bool ok = kcol >= cs && kcol < cs + 16;
                    const float sv = ok ? st[2 * sp + (e >> 2)][e & 3] * 0.125f + bz[e] : -1.0e30f;
                    st[2 * sp + (e >> 2)][e & 3] = sv; mx = fmaxf(mx, sv); }
            }
        } else {
#pragma unroll
            for (int tl = 0; tl < 16; ++tl)
#pragma unroll
                for (int i = 0; i < 4; ++i) { const float sv = st[tl][i] * 0.125f; st[tl][i] = sv; mx = fmaxf(mx, sv); }
        }
        mx = fmaxf(mx, SHX(mx, 16)); mx = fmaxf(mx, SHX(mx, 32));
        const float mnew = fmaxf(mrun, mx), alpha = __expf(mrun - mnew);
        mrun = mnew;
        float ps = 0.f;
#pragma unroll
        for (int tl = 0; tl < 16; ++tl)
#pragma unroll
            for (int i = 0; i < 4; ++i) { const float pv = __expf(st[tl][i] - mnew); st[tl][i] = pv; ps += pv; }
        ps += SHX(ps, 16); ps += SHX(ps, 32);
        lsum = lsum * alpha + ps;
        if (ch > 0) {
#pragma unroll
            for (int i = 0; i < 4; ++i) { const float al = bperm(4 * fq + i, alpha);
#pragma unroll
                for (int d = 0; d < 4; ++d) o[d][i] *= al; }
        }
        if (loc) {
#pragma unroll
            for (int sp = 0; sp < 8; ++sp) {
                if (sp + 3 < 8) {
#pragma unroll
                    for (int d = 0; d < 4; ++d) vf[(sp + 3) & 3][d] = *(const h8*)(vbase + (size_t)d * 16 * SE + (rs + sp + 3) * 64 + kb);
                }
                asm volatile("" ::: "memory");
                h8 pa;
#pragma unroll
                for (int i = 0; i < 4; ++i) { pa[i] = (f16)st[2 * sp][i]; pa[4 + i] = (f16)st[2 * sp + 1][i]; }
#pragma unroll
                for (int d = 0; d < 4; ++d) o[d] = __builtin_amdgcn_mfma_f32_16x16x32_f16(pa, vf[sp & 3][d], o[d], 0, 0, 0);
            }
        } else {
#pragma unroll
            for (int sp = 0; sp < 8; ++sp) {
                h8 pa;
#pragma unroll
                for (int i = 0; i < 4; ++i) { pa[i] = (f16)st[2 * sp][i]; pa[4 + i] = (f16)st[2 * sp + 1][i]; }
#pragma unroll
                for (int d = 0; d < 4; ++d) {
                    const h8 bv = *(const LAS h8*)(VcT + (16 * d + fr) * AT_VP + 32 * sp + 8 * fq);
                    o[d] = __builtin_amdgcn_mfma_f32_16x16x32_f16(pa, bv, o[d], 0, 0, 0);
                }
                if (sp & 1) asm volatile("" ::: "memory");
            }
        }
    }
    const float inv = 1.f / lsum;
    f16* yb = Y + ((size_t)b * SE + qrow0) * 1536 + 1024 + h * 64 + fr;
#pragma unroll
    for (int i = 0; i < 4; ++i) { const float sc = bperm(4 * fq + i, inv);
#pragma unroll
        for (int d = 0; d < 4; ++d) yb[(size_t)(4 * fq + i) * 1536 + 16 * d] = (f16)(o[d][i] * sc); }
}
__device__ __forceinline__ void attn_tasks(Frame& F, CIN in, int l, int pf) {
    const float* rpb_l = INP(na_rpb) + (size_t)l * NHEAD * 15 * 31;
    const f16* P = (const f16*)(F.ws + WS_P); const f16* VT = (const f16*)(F.ws + WS_VT);
    LAS f16* Kc = (LAS f16*)F.lds; LAS f16* VcT = (LAS f16*)(F.lds + AT_VOFF);
    constexpr int NBT = 64 * 34;
    { LAS float* rp = (LAS float*)(F.lds + AT_RPB); __syncthreads();
      for (int i = F.tid; i < NHEAD * 15 * 31; i += NTHR) { const int hh = i / 465, rem = i - hh * 465, ri = rem / 31, ci = rem - ri * 31; rp[(hh * 15 + ri) * 32 + ci] = rpb_l[i]; } }
    const int t_lo = (int)(((long)F.bid * NBT) / F.G), t_hi = (int)(((long)(F.bid + 1) * NBT) / F.G);
    int staged = -1;
    __syncthreads();
    for (int bt = t_lo; bt < t_hi; ++bt) {
        const int bh = bt / 34, j = bt - bh * 34, b = bh >> 3, h = bh & 7;
        if (bh != staged) {
            __syncthreads();
            const int tid = F.wave * 64 + lane_id();
            h8 tk[4], tv[4];
#pragma unroll
            for (int i = 0; i < 4; ++i) { const int idx = tid + NTHR * i, key = idx >> 3, part = idx & 7;
                tk[i] = *(const h8*)(P + ((size_t)b * SE + S + key) * DIN + OFF_NA + 512 + h * 64 + part * 8); }
#pragma unroll
            for (int i = 0; i < 4; ++i) { const int idx = tid + NTHR * i, d = idx >> 5, part = idx & 31;
                tv[i] = *(const h8*)(VT + ((size_t)b * DH + h * 64 + d) * SE + S + part * 8); }
#pragma unroll
            for (int i = 0; i < 4; ++i) { const int idx = tid + NTHR * i; *(LAS h8*)(Kc + (idx >> 3) * AT_KP + (idx & 7) * 8) = tk[i]; *(LAS h8*)(VcT + (idx >> 5) * AT_VP + (idx & 31) * 8) = tv[i]; }
            staged = bh;
            __syncthreads();
        }
        const int w = F.wave;
        if (j < 32) { const int r = 2 * j + (w >> 2), n = w & 3; attn_wtask<true>(F, rpb_l, b, h, r, n, r * 64 + 16 * n, pf); }
        else if (l + 1 < DEPTH) { const int qb = (j - 32) * 8 + w; attn_wtask<false>(F, rpb_l, b, h, 0, 0, S + 16 * qb); }
    }
    __syncthreads();
}

__device__ __forceinline__ void ymix_phase(Frame& F, CIN in, int l) {
    LAS f16* tile = (LAS f16*)F.lds;
    const f16* P = (const f16*)(F.ws + WS_P); const f16* ZT = (const f16*)(F.ws + WS_ZT); f16* Y = (f16*)(F.ws + WS_Y);
    const float* cw = INP(hy_conv_w) + l * 3 * 1536; const float* cbias = INP(hy_conv_b) + l * 1536; const float* scw = INP(sc_conv_w) + l * 3 * DH;
    const int tid = F.tid;
    {
        const int c0 = (tid & 63) * 8, rsub = tid >> 6;
        float w0[8], w1[8], w2[8];
#pragma unroll
        for (int j = 0; j < 8; ++j) { w0[j] = scw[c0 + j]; w1[j] = scw[512 + c0 + j]; w2[j] = scw[1024 + c0 + j]; }
        const int rows_per = (T + F.G - 1) / F.G, rbeg = F.bid * rows_per, rend = rbeg + rows_per < T ? rbeg + rows_per : T;
        for (int row = rbeg + rsub; row < rend; row += 8) {
            const int b = row / SE, i = row - b * SE, lo = i < S ? 0 : S, hi = i < S ? S : SE;
            const f16* ps = P + (size_t)row * DIN + OFF_SC + c0;
            const h8 bg = *(const h8*)ps, c1 = *(const h8*)(ps + 512), x1 = *(const h8*)(ps + 1024);
            h8 c0v, x0v, c2v, x2v;
#pragma unroll
            for (int j = 0; j < 8; ++j) { c0v[j] = (f16)0.f; x0v[j] = (f16)0.f; c2v[j] = (f16)0.f; x2v[j] = (f16)0.f; }
            if (i - 1 >= lo) { c0v = *(const h8*)(ps - DIN + 512); x0v = *(const h8*)(ps - DIN + 1024); }
            if (i + 1 < hi) { c2v = *(const h8*)(ps + DIN + 512); x2v = *(const h8*)(ps + DIN + 1024); }
            h8 o;
#pragma unroll
            for (int j = 0; j < 8; ++j) { const float v = (float)c0v[j] * (float)x0v[j] * w0[j] + (float)c1[j] * (float)x1[j] * w1[j] + (float)c2v[j] * (float)x2v[j] * w2[j];
                o[j] = (f16)((float)bg[j] * v); }
            *(h8*)(Y + (size_t)row * 1536 + 512 + c0) = o;
        }
    }
    const int t = tid >> 3, cg = tid & 7;
    for (int task = F.bid; task < B * 68 * 2; task += F.G) {
        const int q = task & 1, r0 = task >> 1, tl = r0 % 68, b = r0 / 68;
        const int i = tl * 64 + t, lo = i < S ? 0 : S, hi = i < S ? S : SE;
        const f16* prow = P + ((size_t)b * SE + i) * DIN;
        f16* yrow = Y + ((size_t)b * SE + i) * 1536;
        const bool hasp = i - 1 >= lo, hasn = i + 1 < hi;
        h8 yt[4], cur[4], prv[4], nxt[4];
        { const int ch = tid >> 3, part = tid & 7;
#pragma unroll
          for (int u = 0; u < 4; ++u) yt[u] = *(const h8*)(ZT + ((size_t)b * DH + (4 * q + u) * 64 + ch) * SE + tl * 64 + part * 8); }
#pragma unroll
        for (int u = 0; u < 4; ++u) { const int c0 = (4 * q + u) * 64 + cg * 8;
            cur[u] = *(const h8*)(prow + c0);
#pragma unroll
            for (int j = 0; j < 8; ++j) { prv[u][j] = (f16)0.f; nxt[u][j] = (f16)0.f; }
            if (hasp) prv[u] = *(const h8*)(prow - DIN + c0);
            if (hasn) nxt[u] = *(const h8*)(prow + DIN + c0); }
        __syncthreads();
        { const int ch = tid >> 3, part = tid & 7;
#pragma unroll
          for (int u = 0; u < 4; ++u) *(LAS h8*)(tile + u * 4608 + ch * 72 + part * 8) = yt[u]; }
        __syncthreads();
#pragma unroll
        for (int u = 0; u < 4; ++u) { const int c0 = (4 * q + u) * 64 + cg * 8; h8 o;
#pragma unroll
            for (int j = 0; j < 8; ++j) { const float x0 = (float)prv[u][j] * cw[c0 + j] + (float)cur[u][j] * cw[1536 + c0 + j] + (float)nxt[u][j] * cw[3072 + c0 + j] + cbias[c0 + j];
                o[j] = (f16)(x0 * (float)tile[u * 4608 + (cg * 8 + j) * 72 + t]); }
            *(h8*)(yrow + c0) = o; }
    }
    __syncthreads();
}

struct TileOrder {
    int nM, nN, nwg, G, c;
    __device__ __forceinline__ void init(int M, int N, int G_, int c_) { nM = M / 256; nN = N / 256; nwg = nM * nN; G = G_; c = c_; }
    __device__ __forceinline__ bool tile(int i, int& pm, int& pn) const {
        const long L = (long)i * G + c; if (L >= nwg) return false;
        int wgid = (int)L; { const int q = nwg / 8, r = nwg % 8, xcd = wgid % 8, off = wgid / 8; wgid = (xcd < r ? xcd * (q + 1) : r * (q + 1) + (xcd - r) * q) + off; }
        const int nig = 8 * nN, gid = wgid / nig, fm = gid * 8, gsz = (nM - fm) < 8 ? (nM - fm) : 8;
        pm = fm + ((wgid % nig) % gsz); pn = (wgid % nig) / gsz; return true;
    }
};
template <int SUB>
struct DenseSched {
    static constexpr bool GATHER = false;
    TileOrder O; const char* A; const char* Bm; int lda, ldb; size_t a_sub, b_sub; int lat_only;
    __device__ __forceinline__ bool next(int i, pg::Unit& u) const {
        const int ti = i / SUB, s = i - ti * SUB; int pm, pn;
        if (!O.tile(ti, pm, pn)) return false;
        if (lat_only) pm = (pm >> 4) * 17 + (pm & 15);
        u.pm = pm; u.pn = pn; u.e = s; u.nrows = 256; u.aux0 = 0;
        u.A = A + (size_t)pm * 256 * lda * 2 + s * a_sub; u.B = Bm + (size_t)pn * 256 * ldb * 2 + s * b_sub;
        return true;
    }
    __device__ __forceinline__ int arow(const pg::Unit&, int r) const { return r; }
};
struct EpiInproj {
    static constexpr bool PERM = true; static constexpr int NVM = 16;
    __device__ __forceinline__ bool full(const pg::Unit&) const { return !dry; }
    f16* O; f16* X1T; f16* VHT; f16* VT; int dry;
    __device__ __forceinline__ void operator()(const f32x4 (&acc)[2][2][4][2], const pg::Unit& u, int wr, int wc, int fr, int fq) const {
        const int pn = u.pn;
        f16* tb = (pn == 2 || pn == 3) ? X1T : ((pn == 4 || pn == 5) ? VHT : ((pn == 16 || pn == 17) ? VT : nullptr));
        if (tb == nullptr) {
#pragma unroll
            for (int ai = 0; ai < 2; ++ai)
#pragma unroll
                for (int m = 0; m < 4; ++m) { f16* rowp = O + (size_t)(u.pm * 256 + ai * 128 + wr * 64 + m * 16 + fr) * DIN + pn * 256 + wc * 64 + 8 * fq;
#pragma unroll
                    for (int bj = 0; bj < 2; ++bj) { const f32x4 v0 = acc[ai][bj][m][0], v1 = acc[ai][bj][m][1];
                        u32x4 o; o.x = pkh(v0[0], v0[1]); o.y = pkh(v0[2], v0[3]); o.z = pkh(v1[0], v1[1]); o.w = pkh(v1[2], v1[3]);
                        if (!dry || o.x == 0x12345678u) *(u32x4*)(rowp + bj * 32) = o; } }
        } else {
            const int row_t = u.pm * 256, b = row_t / SE, i0 = row_t - b * SE;
            const int ch0 = (pn & 1) * 256 + wc * 64 + 8 * fq;
            f16* cb = tb + ((size_t)b * DH + ch0) * SE + i0 + wr * 64 + fr;
#pragma unroll
            for (int bj = 0; bj < 2; ++bj)
#pragma unroll
                for (int e = 0; e < 8; ++e) { f16* cp = cb + (size_t)(bj * 32 + e) * SE;
#pragma unroll
                    for (int ai = 0; ai < 2; ++ai)
#pragma unroll
                        for (int m = 0; m < 4; ++m) if (!dry) cp[ai * 128 + m * 16] = (f16)acc[ai][bj][m][e >> 2][e & 3]; }
        }
    }
};
struct EpiBranch {
    static constexpr bool PERM = true; static constexpr int NVM = 16;
    __device__ __forceinline__ bool full(const pg::Unit&) const { return pf == 0; }
    const f16* P; f16* MG; u32x4* scr; int tid, pf;
    __device__ __forceinline__ void operator()(const f32x4 (&acc)[2][2][4][2], const pg::Unit& u, int wr, int wc, int fr, int fq) const {
        const int br = (pf & 512) ? 2 : u.e;
        const int col0 = u.pn * 256 + wc * 64 + 8 * fq;
        const size_t row0 = (size_t)(u.pm * 256 + wr * 64 + fr);
        const f16* gp = P + row0 * DIN + OFF_GATE + br * D + col0;
        f16* mp = MG + row0 * D + col0;
        u32x4* sp = scr + tid;
        h8 G[2][2]; u32x4 Sv[2][2];
        if (!(pf & 1024)) { G[0][0] = *(const h8*)gp; G[0][1] = *(const h8*)(gp + 32); } else { G[0][0] = __builtin_bit_cast(h8, (u32x4){(unsigned)fr, 0u, 0u, 0u}); G[0][1] = G[0][0]; G[1][0] = G[0][0]; G[1][1] = G[0][0]; }
        if (br == 1 || (br == 2 && !(pf & 512))) { Sv[0][0] = sp[0]; Sv[0][1] = sp[NTHR]; }
#pragma unroll
        for (int g = 0; g < 8; ++g) {
            const int ai = g >> 2, m = g & 3, cb = g & 1, nb = cb ^ 1;
            const f16* gpn = gp + ((m == 3 ? (size_t)(128 - 48) : (size_t)16) * DIN); u32x4* spn = sp + 2 * NTHR;
            if (g < 7) {
                if (!(pf & 1024)) { G[nb][0] = *(const h8*)gpn; G[nb][1] = *(const h8*)(gpn + 32); }
                if (br == 1 || (br == 2 && !(pf & 512))) { Sv[nb][0] = spn[0]; Sv[nb][1] = spn[NTHR]; }
            }
            asm volatile("" ::: "memory");
#pragma unroll
            for (int bj = 0; bj < 2; ++bj) {
                const h8 gg = G[cb][bj];
                f32x4 v0 = acc[ai][bj][m][0], v1 = acc[ai][bj][m][1];
#pragma unroll
                for (int j = 0; j < 4; ++j) { v0[j] *= sigm((float)gg[j]); v1[j] *= sigm((float)gg[4 + j]); }
                if (br == 1 || (br == 2 && !(pf & 512))) { const h8 pv = __builtin_bit_cast(h8, Sv[cb][bj]);
#pragma unroll
                    for (int j = 0; j < 4; ++j) { v0[j] += (float)pv[j]; v1[j] += (float)pv[4 + j]; } }
                u32x4 o; o.x = pkh(v0[0], v0[1]); o.y = pkh(v0[2], v0[3]); o.z = pkh(v1[0], v1[1]); o.w = pkh(v1[2], v1[3]);
                if (br < 2) sp[(size_t)bj * NTHR] = o; else if (!(pf & 2048)) *(u32x4*)(mp + bj * 32) = o;
            }
            gp = gpn; sp = spn; mp += (m == 3 ? (size_t)(128 - 48) : (size_t)16) * D;
            asm volatile("" : "+v"(gp), "+v"(mp), "+v"(sp) :: "memory");
        }
    }
};
struct EpiOut {
    static constexpr bool PERM = false; static constexpr int NVM = 32;
    __device__ __forceinline__ bool full(const pg::Unit&) const { return !dry; }
    float* X; const float* mods_l; int dry;
    __device__ __forceinline__ void operator()(const f32x4 (&acc)[2][2][4][2], const pg::Unit& u, int wr, int wc, int fr, int fq) const {
        const int row_t = u.pm * 256;
        const float* gt = mods_l + (size_t)mod_row(row_t) * 6 * D + 2 * D + u.pn * 256 + wc * 32 + 4 * fq;
        f32x4 gv[2][2];
#pragma unroll
        for (int bj = 0; bj < 2; ++bj)
#pragma unroll
            for (int n = 0; n < 2; ++n) gv[bj][n] = *(const f32x4*)(gt + bj * 128 + n * 16);
        float* xp = X + (size_t)(row_t + wr * 64 + fr) * D + u.pn * 256 + wc * 32 + 4 * fq;
        f32x4 Xv[2][4];
#pragma unroll
        for (int q = 0; q < 4; ++q) Xv[0][q] = *(const f32x4*)(xp + (q >> 1) * 128 + (q & 1) * 16);
#pragma unroll
        for (int g = 0; g < 8; ++g) {
            const int ai = g >> 2, m = g & 3, cb = g & 1, nb = cb ^ 1;
            float* xpn = xp + (m == 3 ? (size_t)(128 - 48) : (size_t)16) * D;
            if (g < 7) {
#pragma unroll
                for (int q = 0; q < 4; ++q) Xv[nb][q] = *(const f32x4*)(xpn + (q >> 1) * 128 + (q & 1) * 16);
            }
            asm volatile("" ::: "memory");
#pragma unroll
            for (int bj = 0; bj < 2; ++bj)
#pragma unroll
                for (int n = 0; n < 2; ++n) { const f32x4 nv_ = Xv[cb][bj * 2 + n] * ALPHA + gv[bj][n] * acc[ai][bj][m][n]; if (!dry) *(f32x4*)(xp + bj * 128 + n * 16) = nv_; }
            xp = xpn;
            asm volatile("" : "+v"(xp) :: "memory");
        }
    }
};
__device__ __forceinline__ void inproj_phase(Frame& F) {
    DenseSched<1> Sc; Sc.lat_only = 0; Sc.O.init(T, DIN, F.G, F.bid); Sc.A = (const char*)(F.ws + WS_HMH); Sc.Bm = (const char*)(F.ws + WS_WIN); Sc.lda = D; Sc.ldb = D; Sc.a_sub = 0; Sc.b_sub = 0;
    EpiInproj E; E.O = (f16*)(F.ws + WS_P); E.X1T = (f16*)(F.ws + WS_ZT); E.VHT = (f16*)(F.ws + WS_VHT); E.VT = (f16*)(F.ws + WS_VT); E.dry = F.dry;
    pg::gemm_phase<EpiInproj, DenseSched<1>, false>(F.lds, F.wave, D, D, D, Sc, E);
}
__device__ __forceinline__ void branch_phase(Frame& F, int lat_only, int pf) {
    DenseSched<3> Sc; Sc.lat_only = lat_only; Sc.O.init(lat_only ? B * S : T, D, F.G, F.bid); Sc.A = (const char*)(F.ws + WS_Y); Sc.Bm = (const char*)(F.ws + WS_PJ); Sc.lda = 1536; Sc.ldb = DH; Sc.a_sub = (size_t)DH * 2; Sc.b_sub = (size_t)D * DH * 2;
    EpiBranch E; E.P = (const f16*)(F.ws + WS_P); E.MG = (f16*)(F.ws + WS_HMH); E.scr = (u32x4*)(F.ws + WS_SCR) + (size_t)F.bid * 16 * NTHR; E.tid = F.tid; E.pf = pf;
    pg::gemm_phase<EpiBranch, DenseSched<3>, true>(F.lds, F.wave, DH, 1536, DH, Sc, E);
}
__device__ __forceinline__ void outproj_phase(Frame& F, int l) {
    const int lat_only = l == DEPTH - 1;
    DenseSched<1> Sc; Sc.lat_only = lat_only; Sc.O.init(lat_only ? B * S : T, D, F.G, F.bid); Sc.A = (const char*)(F.ws + WS_HMH); Sc.Bm = (const char*)(F.ws + WS_WO); Sc.lda = D; Sc.ldb = D; Sc.a_sub = 0; Sc.b_sub = 0;
    EpiOut E; E.X = (float*)(F.ws + WS_X); E.mods_l = (const float*)(F.ws + WS_MODS) + (size_t)l * 9 * 6 * D; E.dry = F.dry;
    pg::gemm_phase<EpiOut, DenseSched<1>, false>(F.lds, F.wave, D, D, D, Sc, E);
}
constexpr int LDS_TAB_OFF = pg::STAGE_BYTES;
constexpr int LDS_MISC_OFF = LDS_TAB_OFF + 1024;
constexpr int LDS_BYTES = 147456;
constexpr int NPH_L = 13, NPHASE = 2 + NPH_L * DEPTH;
constexpr int FLAG_HYB_MOE = 1;
constexpr int FLAG_HYB_MIX = 2;
constexpr int FLAG_DRY = 4;

template <class P> __device__ __forceinline__ P launder_uniform(P p) {
    unsigned long long v = (unsigned long long)p; unsigned lo = (unsigned)v, hi = (unsigned)(v >> 32);
    unsigned vlo, vhi;
    asm volatile("v_mov_b32 %0, %2\n\tv_mov_b32 %1, %3" : "=&v"(vlo), "=&v"(vhi) : "s"(lo), "s"(hi));
    lo = __builtin_amdgcn_readfirstlane(vlo); hi = __builtin_amdgcn_readfirstlane(vhi);
    return (P)(((unsigned long long)hi << 32) | lo);
}
typedef unsigned* gu32p;
__device__ __forceinline__ int launder_int(int v) { int o; asm volatile("v_mov_b32 %0, %1" : "=v"(o) : "s"(v)); return __builtin_amdgcn_readfirstlane(o); }
__device__ __forceinline__ void launder(Frame& F, CArgsP& ap) { F.lane = lane_id(); asm volatile("" : "+v"(F.lane)); ap = launder_uniform((CArgsP)__builtin_amdgcn_kernarg_segment_ptr()); F.ws = (GAS unsigned char*)ap->ws; F.G = launder_int(F.G); F.bid = launder_int(F.bid); F.vcu = launder_int(F.vcu); F.wave = launder_int(F.wave); F.dry = launder_int(F.dry); F.tid = F.wave * 64 + F.lane; }
#ifndef MOE_SPLIT_NUM
#define MOE_SPLIT_NUM 144
#endif
#ifndef PROBE_REP
#define PROBE_REP -1
#endif
#ifndef PROBE_SLO
#define PROBE_SLO -1
#define PROBE_SHI -1
#endif
#define REP(k, ...) do { __VA_ARGS__; if (PROBE_REP == (k)) { __syncthreads(); __VA_ARGS__; } } while (0)
__global__ void __launch_bounds__(NTHR, 2) fwd(Args a_unused) {
    CArgsP ap = (CArgsP)__builtin_amdgcn_kernarg_segment_ptr();
    extern __shared__ __attribute__((aligned(16))) unsigned char lds_raw[];
    Frame F;
    F.lds = (LAS unsigned char*)lds_raw;
    F.tid = threadIdx.x; F.lane = F.tid & 63; F.wave = __builtin_amdgcn_readfirstlane(F.tid >> 6);
    F.G = gridDim.x; F.bid = blockIdx.x; { const int bx = blockIdx.x; F.vcu = (F.G % 8 == 0) ? (bx % 8) * (F.G / 8) + bx / 8 : bx; }
    F.ws = (GAS unsigned char*)ap->ws; F.dry = (ap->flags & FLAG_DRY) ? 1 : 0;
    for (int u = F.tid; u < (1024 + 64) / 4; u += NTHR) ((LAS unsigned*)(F.lds + LDS_TAB_OFF))[u] = 0u;
    __syncthreads();
    XcdBarrier bar; bar.bar = (unsigned*)(F.ws + WS_CTL) + CW_BAR; bar.x = 0; bar.st = nullptr;
    if (ap->use_bar) bar = xcd_barrier_post((unsigned*)(F.ws + WS_CTL) + CW_BAR, (volatile LAS unsigned*)(F.lds + LDS_MISC_OFF + 32), F.tid);
#define IN(k) (launder(F, ap), ap->ph_lo <= (k) && (k) < ap->ph_hi)
#define SEAM(k) do { if (IN(k) && IN((k) + 1)) { bar.bar = (unsigned*)((unsigned char*)F.ws + WS_CTL) + CW_BAR; bar.x = (unsigned)launder_int((int)bar.x); xcd_barrier(bar, F.tid); if (PROBE_REP == 99) xcd_barrier(bar, F.tid); } } while (0)
    if (IN(0)) { pro_mods(F, ap->in); pro_z2(F, ap->in); convert_mixer_weights(F, ap->in, 0); }
    SEAM(0);
    if (IN(1)) { filters_phase(F, ap->in, 0); init_mod1_rows(F, ap->in); }
    SEAM(1);
    unsigned long long tacc = 0ull, tst = 0ull;
#define ST_B(k) do { if (PROBE_SLO == (k)) tst = __builtin_amdgcn_s_memrealtime(); } while (0)
#define ST_E(k) do { if (PROBE_SHI == (k)) tacc += __builtin_amdgcn_s_memrealtime() - tst; } while (0)
    for (int l = 0; l < DEPTH; ++l) {
        const int pb = 2 + NPH_L * l;
        ST_B(0); if (IN(pb + 0)) REP(0, inproj_phase(F));
        SEAM(pb + 0); ST_E(0);
        ST_B(2); if (IN(pb + 2)) { if (!(ap->flags & 8)) { fftconv_tasks(F, ap->in, l, ap->flags); launder(F, ap); if (l + 1 < DEPTH && !(ap->flags & 4096)) ctxconv_tasks(F, ap->in, l); launder(F, ap); } if (!(ap->flags & 16)) REP(2, attn_tasks(F, ap->in, l, F.dry ? ap->flags : 0)); }
        SEAM(pb + 2); ST_E(2);
        ST_B(3); if (IN(pb + 3)) REP(3, ymix_phase(F, ap->in, l));
        SEAM(pb + 3); ST_E(3);
        ST_B(4); if (IN(pb + 4)) REP(4, branch_phase(F, l == DEPTH - 1, F.dry ? ap->flags : 0));
        SEAM(pb + 4); ST_E(4);
        ST_B(5); if (IN(pb + 5)) { convert_router(F, ap->in, l); outproj_phase(F, l); }
        SEAM(pb + 5); ST_E(5);
        ST_B(6); if (IN(pb + 6)) { if (!(ap->flags & 64)) ln1_router_phase(F, ap->in, l); __syncthreads(); if (!(ap->flags & 32)) convert_moe_weights(F, ap->in, l); }
        SEAM(pb + 6); ST_E(6);
        ST_B(8); if (IN(pb + 8)) moe_up_phase(F, l, 0, F.G, F.bid);
        SEAM(pb + 8); ST_E(8);
        ST_B(9); if (IN(pb + 9)) moe_down_phase(F, l, 0, F.G, F.bid);
        SEAM(pb + 9); ST_E(9);
        ST_B(10); if (IN(pb + 10)) { ln2_rows(F, ap->in, (float*)ap->out, l, 0); launder(F, ap); moe_up_phase(F, l, 1, F.G, F.bid); }
        SEAM(pb + 10); ST_E(10);
        ST_B(11); if (IN(pb + 11)) moe_down_phase(F, l, 1, F.G, F.bid);
        SEAM(pb + 11); ST_E(11);
        ST_B(12); if (IN(pb + 12)) {
            if (!(ap->flags & FLAG_HYB_MIX)) ln2_rows(F, ap->in, (float*)ap->out, l, 1);
            if (l + 1 < DEPTH && !(ap->flags & FLAG_HYB_MOE)) {
                __syncthreads(); convert_mixer_weights(F, ap->in, l + 1); __syncthreads(); filters_phase(F, ap->in, l + 1);
                if (ap->flags & FLAG_HYB_MIX) mod1_rows(F, l + 1);
            }
        }
        SEAM(pb + 12); ST_E(12);
    }
    if (PROBE_SLO >= 0) {
        gu32p dbg = (gu32p)((unsigned*)(F.ws + WS_CTL) + CW_DBG);
        bar.bar = (unsigned*)((unsigned char*)F.ws + WS_CTL) + CW_BAR; xcd_barrier(bar, F.tid);
        if (F.bid == 0 && F.tid == 0) __hip_atomic_store((unsigned*)dbg, (unsigned)tacc, __ATOMIC_RELAXED, __HIP_MEMORY_SCOPE_AGENT);
        xcd_barrier(bar, F.tid);
        const unsigned tv = __hip_atomic_load((unsigned*)dbg, __ATOMIC_RELAXED, __HIP_MEMORY_SCOPE_AGENT);
        const float v = sqrtf((float)tv * (1.0f / 100000.0f));
        float* o = (float*)ap->out;
        for (size_t i = (size_t)F.bid * NTHR + F.tid; i < (size_t)B * S * D; i += (size_t)F.G * NTHR) o[i] = v;
    }
#undef IN
#undef SEAM
}

static int g_grid = 0;
static bool setup_grid() {
    if (g_grid) return g_grid > 0;
    int dev = 0, cus = 0, per_cu = 0;
    if (hipGetDevice(&dev) != hipSuccess || hipDeviceGetAttribute(&cus, hipDeviceAttributeMultiprocessorCount, dev) != hipSuccess) { g_grid = -1; return false; }
    if (hipFuncSetAttribute((const void*)fwd, hipFuncAttributeMaxDynamicSharedMemorySize, LDS_BYTES) != hipSuccess) { fprintf(stderr, "hipFuncSetAttribute failed\n"); g_grid = -1; return false; }
    if (hipOccupancyMaxActiveBlocksPerMultiprocessor(&per_cu, (const void*)fwd, NTHR, LDS_BYTES) != hipSuccess || per_cu < 1) { fprintf(stderr, "occupancy query: %d\n", per_cu); (void)hipGetLastError(); g_grid = -1; return false; }
    g_grid = cus;
    return true;
}
static void launch_phases(const Args& base, int lo, int hi, int use_bar, hipStream_t st) {
    Args a = base; a.ph_lo = lo; a.ph_hi = hi; a.use_bar = use_bar;
    hipLaunchKernelGGL(fwd, dim3(g_grid), dim3(NTHR), LDS_BYTES, st, a);
}
}
#ifndef PROBE_XFLAGS
#define PROBE_XFLAGS 0
#endif
#ifndef PROBE_PH
#define PROBE_PH -1
#endif
#ifndef HYB
#define HYB 1
#endif
#ifndef GAS
#define GAS __attribute__((address_space(1)))
#endif
extern "C" void kernel_launch(void* const* d_in, const int* in_sizes, int n_in, void* d_out, int out_size, void* d_ws, size_t ws_size, hipStream_t stream) {
    if (n_in != 34 || ws_size < fk::WS_END + (size_t)64 * fk::MiB) { fprintf(stderr, "kernel_launch: unexpected inputs / workspace (%d, %zu)\n", n_in, ws_size); return; }
    nv::In in{};
    { const float** f = (const float**)&in; for (int i = 0; i < 34; ++i) f[i] = (const float*)d_in[i]; }
    fk::Args a{};
    { const float** f = (const float**)&a.in; for (int i = 0; i < 34; ++i) f[i] = (const float*)d_in[i]; }
    a.out = (GAS float*)d_out; a.ws = (unsigned char*)d_ws;
    if (!fk::setup_grid()) return;
    (void)hipMemsetAsync((char*)d_ws + fk::WS_CTL, 0, fk::CTL_ZERO_BYTES, stream);
    nv::Ctx c = nv::make_ctx((unsigned char*)d_ws, fk::WS_DYN);
#if HYB == 0
    nv::prologue(in, c, stream);
    for (int l = 0; l < 4; ++l) { nv::mixer_layer(in, c, l, stream); nv::moe_layer(in, c, l, stream); }
    nv::finalize(c, (float*)d_out, stream);
#elif HYB == 1
    a.flags = fk::FLAG_HYB_MOE;
    nv::prologue(in, c, stream);
    for (int l = 0; l < 4; ++l) {
        nv::mixer_layer(in, c, l, stream);
        const int pb = 2 + fk::NPH_L * l;
        for (int p = pb + 6; p <= pb + 12; ++p) fk::launch_phases(a, p, p + 1, 0, stream);
    }
#elif HYB == 2
    a.flags = fk::FLAG_HYB_MIX;
    fk::launch_phases(a, 0, 1, 0, stream); fk::launch_phases(a, 1, 2, 0, stream);
    for (int l = 0; l < 4; ++l) {
        const int pb = 2 + fk::NPH_L * l;
        for (int p = pb; p <= pb + 6; ++p) fk::launch_phases(a, p, p + 1, 0, stream);
        nv::moe_layer(in, c, l, stream);
        if (l < 3) fk::launch_phases(a, pb + 12, pb + 13, 0, stream);
    }
    nv::finalize(c, (float*)d_out, stream);
#elif HYB == 3
    for (int p = 0; p < fk::NPHASE; ++p) fk::launch_phases(a, p, p + 1, 0, stream);
#elif HYB == 5
    for (int p = 0; p < fk::NPHASE; ++p) {
        const bool hit = (PROBE_PH >= 100) ? (p == PROBE_PH - 100) : (p >= 2 && (p - 2) % fk::NPH_L == PROBE_PH);
        if (hit) { fk::Args d = a; d.flags |= fk::FLAG_DRY | PROBE_XFLAGS; fk::launch_phases(d, p, p + 1, 0, stream); }
        fk::launch_phases(a, p, p + 1, 0, stream);
    }
#elif HYB == 4
    fk::launch_phases(a, 0, fk::NPHASE, 1, stream);
#endif
}
```

```cpp
#define HYB 4
#define PROBE_REP -1
#define PROBE_SLO -1
#define PROBE_SHI -1
#define PROBE_PH -1
#define PROBE_XFLAGS 0

#include <hip/hip_runtime.h>
#include <cstdio>
#include <cstdint>
namespace nv {
constexpr int B = 8, S = 4096, CL = 256, SE = S + CL, T = B * SE, D = 1024, DEPTH = 4;
constexpr int DH = 512, DIN = 7680, OFF_SC = 1536, OFF_NA = 3072, OFF_GATE = 4608;
constexpr int NE = 64, TOPK = 8, DEXP = 256;
constexpr int GRIDW = 64, NHEAD = 8, HDIM = 64;
constexpr float LN_EPS = 1e-5f;
constexpr float ALPHA = 1.681792830507429f;

__device__ __forceinline__ float sigmoidf_(float x) { return 1.f / (1.f + expf(-x)); }
__device__ __forceinline__ float siluf_(float x) { return x / (1.f + expf(-x)); }
__device__ __forceinline__ float wsum(float v) {
#pragma unroll
    for (int o = 1; o < 64; o <<= 1) v += __shfl_xor(v, o);
    return v;
}
__device__ __forceinline__ float wmax(float v) {
#pragma unroll
    for (int o = 1; o < 64; o <<= 1) v = fmaxf(v, __shfl_xor(v, o));
    return v;
}

__global__ void k_cond(const float* c, const float* c_ctx, float* cond) {
    int i = blockIdx.x * blockDim.x + threadIdx.x;
    if (i < 9 * D) { float v = i < 8 * D ? c[i] : c_ctx[i - 8 * D]; cond[i] = siluf_(v); }
}
__global__ void k_mods(const float* cond, const float* w_ada, const float* b_ada, float* mods) {
    int j = blockIdx.x * blockDim.x + threadIdx.x;
    if (j >= DEPTH * 6 * D) return;
    int l = j / (6 * D), col = j % (6 * D);
    float acc[9];
#pragma unroll
    for (int r = 0; r < 9; ++r) acc[r] = 0.f;
    const float* w = w_ada + (size_t)l * D * 6 * D + col;
    for (int k = 0; k < D; ++k) { float wv = w[(size_t)k * 6 * D];
#pragma unroll
        for (int r = 0; r < 9; ++r) acc[r] += cond[r * D + k] * wv; }
    float bb = b_ada[l * 6 * D + col];
#pragma unroll
    for (int r = 0; r < 9; ++r) mods[((size_t)l * 9 + r) * 6 * D + col] = acc[r] + bb;
}
__global__ void k_init_x(const float* x, const float* ctx, float* X) {
    size_t i = (size_t)blockIdx.x * blockDim.x + threadIdx.x;
    if (i >= (size_t)T * D) return;
    int row = (int)(i / D), d = (int)(i % D), b = row / SE, ii = row % SE;
    X[i] = ii < S ? x[((size_t)b * S + ii) * D + d] : ctx[((size_t)b * CL + (ii - S)) * D + d];
}
__global__ void k_modulate(const float* X, const float* mods_l, float* HM, int which) {
    size_t i = (size_t)blockIdx.x * blockDim.x + threadIdx.x;
    if (i >= (size_t)T * D) return;
    int row = (int)(i / D), d = (int)(i % D), b = row / SE, ii = row % SE, mb = ii < S ? b : 8;
    const float* m = mods_l + (size_t)mb * 6 * D;
    HM[i] = X[i] * (1.f + m[(which + 1) * D + d]) + m[which * D + d];
}
struct GemmP { const float* A; int lda; const int* gidx; const float* Bm; int ldb; float* C; int ldc; int M; const int* Mdev; int N, K; int mode;
               const int* sidx; const float* sw; long long eB, eG; const int* coff; const int* aoff; };
__global__ void __launch_bounds__(256) k_gemm(GemmP p) {
    __shared__ float As[16][68];
    __shared__ float Bs[16][64];
    const int z = blockIdx.z;
    const int M = p.Mdev ? p.Mdev[z] : p.M;
    const int row0 = blockIdx.y * 64, col0 = blockIdx.x * 64;
    if (row0 >= M) return;
    const float* A = p.A; const float* Bm = p.Bm + (size_t)z * p.eB;
    const int* gidx = p.gidx ? p.gidx + (size_t)z * p.eG : nullptr;
    const int* sidx = p.sidx ? p.sidx + (size_t)z * p.eG : nullptr;
    const float* sw = p.sw ? p.sw + (size_t)z * p.eG : nullptr;
    const int crow_off = p.coff ? p.coff[z] : 0;
    const int arow_off = p.aoff ? p.aoff[z] : 0;
    float* C = p.C;
    const int tid = threadIdx.x, tx = tid & 15, ty = tid >> 4;
    const int ar = tid >> 2, ak = (tid & 3) * 4;
    const int bk = tid >> 4, bn = (tid & 15) * 4;
    int arow = row0 + ar; if (arow >= M) arow = M - 1;
    const size_t asrc = gidx ? (size_t)gidx[arow] : (size_t)(arow_off + arow);
    const float* ap = A + asrc * p.lda + ak;
    const float* bp = Bm + (size_t)bk * p.ldb + col0 + bn;
    float acc[4][4];
#pragma unroll
    for (int i = 0; i < 4; ++i)
#pragma unroll
        for (int j = 0; j < 4; ++j) acc[i][j] = 0.f;
    for (int k0 = 0; k0 < p.K; k0 += 16) {
        float4 av = *(const float4*)(ap + k0);
        float4 bv = *(const float4*)(bp + (size_t)k0 * p.ldb);
        As[ak + 0][ar] = av.x; As[ak + 1][ar] = av.y; As[ak + 2][ar] = av.z; As[ak + 3][ar] = av.w;
        *(float4*)&Bs[bk][bn] = bv;
        __syncthreads();
#pragma unroll
        for (int kk = 0; kk < 16; ++kk) {
            float4 a4 = *(const float4*)&As[kk][ty * 4];
            float4 b4 = *(const float4*)&Bs[kk][tx * 4];
            float a[4] = {a4.x, a4.y, a4.z, a4.w}, b[4] = {b4.x, b4.y, b4.z, b4.w};
#pragma unroll
            for (int i = 0; i < 4; ++i)
#pragma unroll
                for (int j = 0; j < 4; ++j) acc[i][j] += a[i] * b[j];
        }
        __syncthreads();
    }
#pragma unroll
    for (int i = 0; i < 4; ++i) {
        int r = row0 + ty * 4 + i; if (r >= M) continue;
        if (p.mode == 0) {
            float* cp = C + (size_t)(crow_off + r) * p.ldc + col0 + tx * 4;
            *(float4*)cp = make_float4(acc[i][0], acc[i][1], acc[i][2], acc[i][3]);
        } else {
            int tok = sidx[r]; float w = sw[r];
            float* cp = C + (size_t)tok * p.ldc + col0 + tx * 4;
#pragma unroll
            for (int j = 0; j < 4; ++j) atomicAdd(cp + j, w * acc[i][j]);
        }
    }
}
static void gemm(hipStream_t st, const float* A, int lda, const float* Bm, int ldb, float* C, int ldc, int M, int N, int K) {
    GemmP p{}; p.A = A; p.lda = lda; p.Bm = Bm; p.ldb = ldb; p.C = C; p.ldc = ldc; p.M = M; p.N = N; p.K = K; p.mode = 0;
    hipLaunchKernelGGL(k_gemm, dim3(N / 64, (M + 63) / 64, 1), dim3(256), 0, st, p);
}

__global__ void k_hy_z2(const float* w1, const float* b1, const float* w2, const float* b2, const float* sf, int L, float* z2tab) {
    const int t = blockIdx.x * (blockDim.x / 64) + (threadIdx.x >> 6), lane = threadIdx.x & 63;
    if (t >= L) return;
    const double PI2 = 6.283185307179586476925;
    float tt = (float)((double)t / (double)(L - 1));
    float ang = (float)(PI2 / (double)L) * (float)t;
    float a = b1[lane];
    a += tt * w1[0 * 64 + lane];
    for (int j = 0; j < 16; ++j) {
        float band = (float)(1e-4 + (double)j * ((15.0 - 1e-4) / 15.0));
        float arg = band * ang;
        a += cosf(arg) * w1[(1 + j) * 64 + lane];
        a += -sinf(arg) * w1[(17 + j) * 64 + lane];
    }
    float z1 = sinf(sf[lane] * a);
    float a2 = b2[lane];
    for (int i = 0; i < 64; ++i) a2 += __shfl(z1, i) * w2[i * 64 + lane];
    z2tab[(size_t)t * 64 + lane] = sinf(sf[64 + lane] * a2);
}
__global__ void k_hy_filt(const float* z2tab, const float* w3, int L, float* hf, float* hb) {
    int i = blockIdx.x * blockDim.x + threadIdx.x;
    if (i >= L * DH) return;
    int t = i / DH, c = i % DH;
    float af = 0.f, ab = 0.f;
    for (int j = 0; j < 64; ++j) { float z = z2tab[(size_t)t * 64 + j]; af += z * w3[j * 1024 + c]; ab += z * w3[j * 1024 + 512 + c]; }
    const double la = log(1e-2) / 1.5, lb = log(1e-2) / 0.3;
    float delta = fabsf((float)(la + (double)c * ((lb - la) / 511.0)));
    float tt = (float)((double)t / (double)(L - 1));
    float dec = expf(-tt * delta);
    hf[i] = af * dec; hb[i] = ab * dec;
}
__global__ void k_hy_conv(const float* PB, const float* cw, const float* cb, float* UC) {
    int idx = blockIdx.x * blockDim.x + threadIdx.x;
    if (idx >= SE * 1536) return;
    int i = idx / 1536, c = idx % 1536;
    int lo = i < S ? 0 : S, hi = i < S ? S : SE;
    float v = PB[(size_t)i * DIN + c] * cw[1536 + c];
    if (i - 1 >= lo) v += PB[(size_t)(i - 1) * DIN + c] * cw[c];
    if (i + 1 < hi) v += PB[(size_t)(i + 1) * DIN + c] * cw[2 * 1536 + c];
    UC[idx] = v + cb[c];
}
__global__ void k_hy_z(const float* UC, float* Z) {
    int idx = blockIdx.x * blockDim.x + threadIdx.x;
    if (idx >= SE * DH) return;
    int i = idx / DH, c = idx % DH;
    Z[idx] = UC[(size_t)i * 1536 + 1024 + c] * UC[(size_t)i * 1536 + 512 + c];
}
__global__ void k_hy_long(const float* Z, const float* UC, const float* hf, const float* hb, const float* hfc, const float* hbc, const float* bias_d, float* YHY) {
    int idx = blockIdx.x * blockDim.x + threadIdx.x;
    if (idx >= SE * DH) return;
    int i = idx / DH, c = idx % DH;
    int lo = i < S ? 0 : S, L = i < S ? S : CL;
    const float* f = i < S ? hf : hfc; const float* g = i < S ? hb : hbc;
    int t = i - lo;
    float acc = 0.f;
    for (int s = 0; s <= t; ++s) acc += f[(size_t)(t - s) * DH + c] * Z[(size_t)(lo + s) * DH + c];
    for (int s = t + 1; s < L; ++s) acc += g[(size_t)(s - t) * DH + c] * Z[(size_t)(lo + s) * DH + c];
    float z = Z[idx];
    YHY[idx] = UC[(size_t)i * 1536 + c] * (acc + z * bias_d[c]);
}
__global__ void k_sconv(const float* PB, const float* cw, float* YSC) {
    int idx = blockIdx.x * blockDim.x + threadIdx.x;
    if (idx >= SE * DH) return;
    int i = idx / DH, c = idx % DH;
    int lo = i < S ? 0 : S, hi = i < S ? S : SE;
    const float* p = PB + OFF_SC;
    float v = p[(size_t)i * DIN + 512 + c] * p[(size_t)i * DIN + 1024 + c] * cw[512 + c];
    if (i - 1 >= lo) v += p[(size_t)(i - 1) * DIN + 512 + c] * p[(size_t)(i - 1) * DIN + 1024 + c] * cw[c];
    if (i + 1 < hi) v += p[(size_t)(i + 1) * DIN + 512 + c] * p[(size_t)(i + 1) * DIN + 1024 + c] * cw[1024 + c];
    YSC[idx] = p[(size_t)i * DIN + c] * v;
}
__global__ void k_attn(const float* PB, const float* rpb, float* YAT) {
    const int wt = blockIdx.x * (blockDim.x / 64) + (threadIdx.x >> 6), lane = threadIdx.x & 63;
    if (wt >= SE * NHEAD) return;
    const int i = wt / NHEAD, h = wt % NHEAD;
    const float* Q = PB + OFF_NA + h * HDIM; const float* Kp = PB + OFF_NA + 512 + h * HDIM; const float* V = PB + OFF_NA + 1024 + h * HDIM;
    const float q = Q[(size_t)i * DIN + lane];
    float m = -3.0e38f, l = 0.f, o = 0.f;
    if (i < S) {
        const int r = i / GRIDW, qc = i % GRIDW;
        int rs = r - 4; rs = rs < 0 ? 0 : (rs > 56 ? 56 : rs);
        int cs = qc - 8; cs = cs < 0 ? 0 : (cs > 48 ? 48 : cs);
        for (int j = 0; j < 8; ++j) for (int kc = cs; kc < cs + 16; ++kc) {
            const int kt = (rs + j) * GRIDW + kc;
            float s = wsum(q * Kp[(size_t)kt * DIN + lane]) * 0.125f + rpb[(h * 15 + (rs + j - r + 7)) * 31 + (kc - qc + 15)];
            float mn = fmaxf(m, s), a = expf(m - mn), pp = expf(s - mn);
            l = l * a + pp; o = o * a + pp * V[(size_t)kt * DIN + lane]; m = mn;
        }
    }
    for (int kt = S; kt < SE; ++kt) {
        float s = wsum(q * Kp[(size_t)kt * DIN + lane]) * 0.125f;
        float mn = fmaxf(m, s), a = expf(m - mn), pp = expf(s - mn);
        l = l * a + pp; o = o * a + pp * V[(size_t)kt * DIN + lane]; m = mn;
    }
    YAT[(size_t)i * DH + h * HDIM + lane] = o / l;
}
__global__ void k_merge(const float* PB, const float* T0, const float* T1, const float* T2, float* MG) {
    int idx = blockIdx.x * blockDim.x + threadIdx.x;
    if (idx >= SE * D) return;
    int i = idx / D, c = idx % D;
    const float* g = PB + (size_t)i * DIN + OFF_GATE;
    MG[idx] = sigmoidf_(g[c]) * T0[idx] + sigmoidf_(g[D + c]) * T1[idx] + sigmoidf_(g[2 * D + c]) * T2[idx];
}
__global__ void k_res_ln(float* X, const float* O, const float* mods_l, int gate_idx, const float* lg, const float* lb, int row0, int n) {
    const int w = blockIdx.x * (blockDim.x / 64) + (threadIdx.x >> 6), lane = threadIdx.x & 63;
    if (w >= n) return;
    const int row = row0 + w, b = row / SE, ii = row % SE, mb = ii < S ? b : 8;
    const float* gt = mods_l + (size_t)mb * 6 * D + gate_idx * D;
    float v[16]; float s = 0.f;
#pragma unroll
    for (int j = 0; j < 16; ++j) { int d = lane + 64 * j; v[j] = ALPHA * X[(size_t)row * D + d] + gt[d] * O[(size_t)w * D + d]; s += v[j]; }
    const float mu = wsum(s) * (1.f / D); float q = 0.f;
#pragma unroll
    for (int j = 0; j < 16; ++j) { v[j] -= mu; q += v[j] * v[j]; }
    const float rstd = rsqrtf(wsum(q) * (1.f / D) + LN_EPS);
#pragma unroll
    for (int j = 0; j < 16; ++j) { int d = lane + 64 * j; X[(size_t)row * D + d] = v[j] * rstd * lg[d] + lb[d]; }
}
__global__ void k_route(const float* logits, const float* rbias, int* cnt, int* ltok, float* lw) {
    const int tok = blockIdx.x * (blockDim.x / 64) + (threadIdx.x >> 6), lane = threadIdx.x & 63;
    if (tok >= T) return;
    const float score = sigmoidf_(logits[(size_t)tok * NE + lane]);
    const float sel = score + rbias[lane];
    float m1 = sel;
    m1 = fmaxf(m1, __shfl_xor(m1, 1)); m1 = fmaxf(m1, __shfl_xor(m1, 2)); m1 = fmaxf(m1, __shfl_xor(m1, 4));
    unsigned long long eq = __ballot(sel == m1);
    const int g = lane >> 3;
    const unsigned geq = (unsigned)((eq >> (g * 8)) & 0xffull);
    const int first = __ffs(geq) - 1;
    float s2 = ((lane & 7) == first) ? -3.0e38f : sel;
    s2 = fmaxf(s2, __shfl_xor(s2, 1)); s2 = fmaxf(s2, __shfl_xor(s2, 2)); s2 = fmaxf(s2, __shfl_xor(s2, 4));
    const float gs = m1 + s2;
    int grank = 0;
    for (int gg = 0; gg < 8; ++gg) { float o = __shfl(gs, gg * 8); if (o > gs || (o == gs && gg < g)) ++grank; }
    const bool gsel = grank < 4;
    const float val = gsel ? sel : -3.0e38f;
    int rank = 0;
    for (int j = 0; j < 64; ++j) { float o = __shfl(val, j); if (o > val || (o == val && j < lane)) ++rank; }
    const bool chosen = gsel && rank < TOPK;
    const float tot = wsum(chosen ? score : 0.f);
    if (chosen) {
        const float w = score / tot * 2.5f;
        int pos = atomicAdd(&cnt[lane], 1);
        ltok[(size_t)lane * T + pos] = tok; lw[(size_t)lane * T + pos] = w;
    }
}
__global__ void k_prefix(const int* cnt, int* off) { if (threadIdx.x == 0) { int a = 0; for (int e = 0; e < NE; ++e) { off[e] = a; a += cnt[e]; } } }
__global__ void k_swiglu(const float* U1, const float* U3, float* H, size_t n) {
    size_t i = (size_t)blockIdx.x * blockDim.x + threadIdx.x;
    if (i < n) H[i] = siluf_(U1[i]) * U3[i];
}
__global__ void k_final(const float* X, float* out) {
    size_t i = (size_t)blockIdx.x * blockDim.x + threadIdx.x;
    if (i >= (size_t)B * S * D) return;
    int d = (int)(i % D); size_t r = i / D; int b = (int)(r / S), t = (int)(r % S);
    out[i] = X[((size_t)b * SE + t) * D + d];
}

struct In {
    const float *x, *c, *ctx, *c_ctx, *w_ada, *b_ada, *w_in, *hy_conv_w, *hy_conv_b, *hy_w1, *hy_b1, *hy_w2, *hy_b2, *hy_w3, *hy_sin_freq, *hy_bias_d,
        *hy_proj, *sc_conv_w, *sc_proj, *na_rpb, *na_proj, *w_o, *ln1_g, *ln1_b, *ln2_g, *ln2_b, *moe_router, *moe_bias, *moe_w1, *moe_w3, *moe_w2, *sh_w1, *sh_w3, *sh_w2;
};


struct Ctx {
    float *X, *HM, *cond, *mods, *MIX, *PB, *UC, *Z, *YB, *T0, *T1, *T2, *MG, *OB, *z2a, *z2c, *hf, *hb, *hfc, *hbc, *logits, *lw, *U1, *U3, *F, *YHY, *YSC, *YAT;
    int *cnt, *off, *ltok;
};
static Ctx make_ctx(unsigned char* ws, size_t dyn_off) {
    Ctx c{};
    c.X = (float*)(ws + (size_t)2 * 1024 * 1024); c.mods = (float*)(ws + (size_t)1024 * 1024); c.cond = (float*)(ws + (size_t)256 * 1024);
    size_t o = dyn_off; auto alloc = [&](size_t bytes) { size_t r = o; o += (bytes + 255) & ~(size_t)255; return (void*)(ws + r); };
    c.HM = (float*)alloc((size_t)T * D * 4);
    c.MIX = (float*)alloc((size_t)SE * 16384 * 4);
    c.PB = c.MIX; c.UC = c.PB + (size_t)SE * DIN; c.Z = c.UC + (size_t)SE * 1536; c.YB = c.Z + (size_t)SE * DH;
    c.T0 = c.YB + (size_t)SE * 1536; c.T1 = c.T0 + (size_t)SE * D; c.T2 = c.T1 + (size_t)SE * D; c.MG = c.T2 + (size_t)SE * D; c.OB = c.MG + (size_t)SE * D;
    c.z2a = (float*)alloc((size_t)S * 64 * 4); c.z2c = (float*)alloc((size_t)CL * 64 * 4);
    c.hf = (float*)alloc((size_t)S * DH * 4); c.hb = (float*)alloc((size_t)S * DH * 4);
    c.hfc = (float*)alloc((size_t)CL * DH * 4); c.hbc = (float*)alloc((size_t)CL * DH * 4);
    c.logits = (float*)alloc((size_t)T * NE * 4);
    c.cnt = (int*)alloc(256); c.off = (int*)alloc(256);
    c.ltok = (int*)alloc((size_t)NE * T * 4); c.lw = (float*)alloc((size_t)NE * T * 4);
    c.U1 = (float*)alloc((size_t)T * TOPK * DEXP * 4);
    c.U3 = c.MIX; c.F = c.MIX + (size_t)32 * 1024 * 1024;
    c.YHY = c.YB; c.YSC = c.YB + (size_t)SE * DH; c.YAT = c.YB + 2 * (size_t)SE * DH;
    return c;
}
static void prologue(const In& in, const Ctx& c, hipStream_t st) {
    hipLaunchKernelGGL(k_cond, dim3((9 * D + 255) / 256), dim3(256), 0, st, in.c, in.c_ctx, c.cond);
    hipLaunchKernelGGL(k_mods, dim3(DEPTH * 6 * D / 256), dim3(256), 0, st, c.cond, in.w_ada, in.b_ada, c.mods);
    hipLaunchKernelGGL(k_init_x, dim3((unsigned)(((size_t)T * D + 255) / 256)), dim3(256), 0, st, in.x, in.ctx, c.X);
}
static void mixer_layer(const In& in, const Ctx& c, int l, hipStream_t st) {
    const unsigned gTD = (unsigned)(((size_t)T * D + 255) / 256);
    const float* ml = c.mods + (size_t)l * 9 * 6 * D;
    hipLaunchKernelGGL(k_hy_z2, dim3(S / 4), dim3(256), 0, st, in.hy_w1 + l * 33 * 64, in.hy_b1 + l * 64, in.hy_w2 + l * 4096, in.hy_b2 + l * 64, in.hy_sin_freq + l * 128, S, c.z2a);
    hipLaunchKernelGGL(k_hy_z2, dim3(CL / 4), dim3(256), 0, st, in.hy_w1 + l * 33 * 64, in.hy_b1 + l * 64, in.hy_w2 + l * 4096, in.hy_b2 + l * 64, in.hy_sin_freq + l * 128, CL, c.z2c);
    hipLaunchKernelGGL(k_hy_filt, dim3(S * DH / 256), dim3(256), 0, st, c.z2a, in.hy_w3 + (size_t)l * 64 * 1024, S, c.hf, c.hb);
    hipLaunchKernelGGL(k_hy_filt, dim3(CL * DH / 256), dim3(256), 0, st, c.z2c, in.hy_w3 + (size_t)l * 64 * 1024, CL, c.hfc, c.hbc);
    hipLaunchKernelGGL(k_modulate, dim3(gTD), dim3(256), 0, st, c.X, ml, c.HM, 0);
    for (int b = 0; b < B; ++b) {
        gemm(st, c.HM + (size_t)b * SE * D, D, in.w_in + (size_t)l * D * DIN, DIN, c.PB, DIN, SE, DIN, D);
        hipLaunchKernelGGL(k_hy_conv, dim3(SE * 1536 / 256), dim3(256), 0, st, c.PB, in.hy_conv_w + l * 3 * 1536, in.hy_conv_b + l * 1536, c.UC);
        hipLaunchKernelGGL(k_hy_z, dim3(SE * DH / 256), dim3(256), 0, st, c.UC, c.Z);
        hipLaunchKernelGGL(k_hy_long, dim3(SE * DH / 256), dim3(256), 0, st, c.Z, c.UC, c.hf, c.hb, c.hfc, c.hbc, in.hy_bias_d + l * DH, c.YHY);
        hipLaunchKernelGGL(k_sconv, dim3(SE * DH / 256), dim3(256), 0, st, c.PB, in.sc_conv_w + l * 3 * DH, c.YSC);
        hipLaunchKernelGGL(k_attn, dim3(SE * NHEAD / 4), dim3(256), 0, st, c.PB, in.na_rpb + l * NHEAD * 15 * 31, c.YAT);
        gemm(st, c.YHY, DH, in.hy_proj + (size_t)l * DH * D, D, c.T0, D, SE, D, DH);
        gemm(st, c.YSC, DH, in.sc_proj + (size_t)l * DH * D, D, c.T1, D, SE, D, DH);
        gemm(st, c.YAT, DH, in.na_proj + (size_t)l * DH * D, D, c.T2, D, SE, D, DH);
        hipLaunchKernelGGL(k_merge, dim3(SE * D / 256), dim3(256), 0, st, c.PB, c.T0, c.T1, c.T2, c.MG);
        gemm(st, c.MG, D, in.w_o + (size_t)l * D * D, D, c.OB, D, SE, D, D);
        hipLaunchKernelGGL(k_res_ln, dim3(SE / 4), dim3(256), 0, st, c.X, c.OB, ml, 2, in.ln1_g + l * D, in.ln1_b + l * D, b * SE, SE);
    }
}
static void moe_layer(const In& in, const Ctx& c, int l, hipStream_t st) {
    const unsigned gTD = (unsigned)(((size_t)T * D + 255) / 256);
    const float* ml = c.mods + (size_t)l * 9 * 6 * D;
    hipLaunchKernelGGL(k_modulate, dim3(gTD), dim3(256), 0, st, c.X, ml, c.HM, 3);
    gemm(st, c.HM, D, in.moe_router + (size_t)l * D * NE, NE, c.logits, NE, T, NE, D);
    (void)hipMemsetAsync(c.cnt, 0, 256, st);
    hipLaunchKernelGGL(k_route, dim3(T / 4), dim3(256), 0, st, c.logits, in.moe_bias + l * NE, c.cnt, c.ltok, c.lw);
    hipLaunchKernelGGL(k_prefix, dim3(1), dim3(64), 0, st, c.cnt, c.off);
    {
        GemmP p{}; p.A = c.HM; p.lda = D; p.gidx = c.ltok; p.eG = T; p.ldb = DEXP; p.ldc = DEXP; p.Mdev = c.cnt; p.N = DEXP; p.K = D; p.mode = 0; p.eB = (long long)D * DEXP; p.coff = c.off;
        p.Bm = in.moe_w1 + (size_t)l * NE * D * DEXP; p.C = c.U1;
        hipLaunchKernelGGL(k_gemm, dim3(DEXP / 64, T / 64, NE), dim3(256), 0, st, p);
        p.Bm = in.moe_w3 + (size_t)l * NE * D * DEXP; p.C = c.U3;
        hipLaunchKernelGGL(k_gemm, dim3(DEXP / 64, T / 64, NE), dim3(256), 0, st, p);
    }
    hipLaunchKernelGGL(k_swiglu, dim3((unsigned)(((size_t)T * TOPK * DEXP + 255) / 256)), dim3(256), 0, st, c.U1, c.U3, c.U1, (size_t)T * TOPK * DEXP);
    {
        float* V1 = c.U3; float* V3 = c.U3 + (size_t)T * DEXP;
        gemm(st, c.HM, D, in.sh_w1 + (size_t)l * D * DEXP, DEXP, V1, DEXP, T, DEXP, D);
        gemm(st, c.HM, D, in.sh_w3 + (size_t)l * D * DEXP, DEXP, V3, DEXP, T, DEXP, D);
        hipLaunchKernelGGL(k_swiglu, dim3((unsigned)(((size_t)T * DEXP + 255) / 256)), dim3(256), 0, st, V1, V3, V1, (size_t)T * DEXP);
        gemm(st, V1, DEXP, in.sh_w2 + (size_t)l * DEXP * D, D, c.F, D, T, D, DEXP);
    }
    {
        GemmP p{}; p.A = c.U1; p.lda = DEXP; p.aoff = c.off; p.sidx = c.ltok; p.sw = c.lw; p.eG = T; p.Bm = in.moe_w2 + (size_t)l * NE * DEXP * D; p.ldb = D; p.C = c.F; p.ldc = D; p.Mdev = c.cnt; p.N = D; p.K = DEXP; p.mode = 1;
        p.eB = (long long)DEXP * D;
        hipLaunchKernelGGL(k_gemm, dim3(D / 64, T / 64, NE), dim3(256), 0, st, p);
    }
    hipLaunchKernelGGL(k_res_ln, dim3(T / 4), dim3(256), 0, st, c.X, c.F, ml, 5, in.ln2_g + l * D, in.ln2_b + l * D, 0, T);
}
static void finalize(const Ctx& c, float* out, hipStream_t st) {
    hipLaunchKernelGGL(k_final, dim3((unsigned)(((size_t)B * S * D + 255) / 256)), dim3(256), 0, st, c.X, out);
}
}
namespace fk {
#define LAS __attribute__((address_space(3)))
#define GAS __attribute__((address_space(1)))
typedef _Float16 f16;
typedef _Float16 h8 __attribute__((ext_vector_type(8)));
typedef _Float16 h4 __attribute__((ext_vector_type(4)));
typedef _Float16 h2 __attribute__((ext_vector_type(2)));
typedef float f32x4 __attribute__((ext_vector_type(4)));
typedef float f32x2 __attribute__((ext_vector_type(2)));
typedef unsigned u32x4 __attribute__((ext_vector_type(4)));
typedef unsigned u32x2 __attribute__((ext_vector_type(2)));

constexpr int B = 8, S = 4096, CL = 256, SE = S + CL, T = B * SE, D = 1024, DEPTH = 4;
constexpr int DH = 512, DIN = 7680, OFF_SC = 1536, OFF_NA = 3072, OFF_GATE = 4608;
constexpr int NE = 64, TOPK = 8, DEXP = 256;
constexpr int GRIDW = 64, NHEAD = 8, HDIM = 64;
constexpr float LN_EPS = 1e-5f;
constexpr float ALPHA = 1.681792830507429f;
constexpr int NWAVES = 8, NTHR = 512;
constexpr int TH = T / 2;
constexpr int MAXT_H = TH * TOPK / 256 + NE;
constexpr int SH_T = TH / 256;

__device__ __forceinline__ unsigned pkh(float a, float b) { f32x2 v = {a, b}; h2 h = __builtin_convertvector(v, h2); return __builtin_bit_cast(unsigned, h); }
__device__ __forceinline__ float sigm(float x) { return __builtin_amdgcn_rcpf(1.f + __expf(-x)); }
__device__ __forceinline__ float bperm(int src, float v) { return __int_as_float(__builtin_amdgcn_ds_bpermute(src << 2, __float_as_int(v))); }
__device__ __forceinline__ int bpermi(int src, int v) { return __builtin_amdgcn_ds_bpermute(src << 2, v); }
#define SHX(v, o) bperm(lane ^ (o), (v))
__device__ __forceinline__ float wsum(float v, int lane) {
#pragma unroll
    for (int o = 1; o < 64; o <<= 1) v += SHX(v, o);
    return v;
}
__device__ __forceinline__ int lane_id() { int v; asm volatile("v_mbcnt_lo_u32_b32 %0, -1, 0\n\tv_mbcnt_hi_u32_b32 %0, -1, %0" : "=v"(v)); return v; }
#define LDS_WAIT() asm volatile("s_waitcnt lgkmcnt(0)" ::: "memory")
#define VM_WAIT() asm volatile("s_waitcnt vmcnt(0)" ::: "memory")

#define XB_TMO      128
#define XB_XCNT(j)  (256  + 64 * (j))
#define XB_XSUB(j)  (1280 + 64 * (j))
#define XB_XGEN(j)  (2304 + 64 * (j))
#define XB_TOP      3328
#define XB_TOPGEN   3392
#define XCD_BAR_WORDS 3456
#define XB_SPIN_CAP (1u << 18)
__device__ __forceinline__ unsigned xb_ld(unsigned* p)              { return __hip_atomic_load(p, __ATOMIC_RELAXED, __HIP_MEMORY_SCOPE_AGENT); }
__device__ __forceinline__ unsigned xb_add(unsigned* p, unsigned v) { return __hip_atomic_fetch_add(p, v, __ATOMIC_RELAXED, __HIP_MEMORY_SCOPE_AGENT); }
__device__ __forceinline__ unsigned xb_xcc_id() { return (unsigned)__builtin_amdgcn_s_getreg((3 << 11) | 20) & 0xFu; }
#define XB_SPIN(cond, bar) do { unsigned _sp = 0; while (cond) { __builtin_amdgcn_s_sleep(1); \
    if ((++_sp & 255u) == 0u) { if (xb_ld(&(bar)[XB_TMO])) break; if (_sp > XB_SPIN_CAP) { atomicAdd(&(bar)[XB_TMO], 1u); break; } } } } while (0)
struct XcdBarrier { unsigned* bar; unsigned x; volatile LAS unsigned* st; };
__device__ __forceinline__ XcdBarrier xcd_barrier_post(unsigned* bar, volatile LAS unsigned* st, int tid) {
    XcdBarrier b; b.bar = bar; b.x = xb_xcc_id(); b.st = st;
    if (tid == 0) (void)xb_add(&bar[XB_XCNT(b.x)], 1u);
    return b;
}
__device__ __forceinline__ void xcd_barrier_complete(unsigned* bar, unsigned x, unsigned& nloc, unsigned& nx) {
    const unsigned G = gridDim.x * gridDim.y * gridDim.z;
    unsigned sum, cnt, mine, sp = 0u;
    for (;;) {
        sum = 0u; cnt = 0u; mine = 0u;
#pragma unroll
        for (unsigned j = 0; j < 16; ++j) { const unsigned c = xb_ld(&bar[XB_XCNT(j)]); sum += c; cnt += (c > 0u) ? 1u : 0u; mine = (j == x) ? c : mine; }
        if (sum == G) break;
        __builtin_amdgcn_s_sleep(1);
        if ((++sp & 255u) == 0u) { if (xb_ld(&bar[XB_TMO])) break; if (sp > XB_SPIN_CAP) { atomicAdd(&bar[XB_TMO], 1u); break; } }
    }
    nloc = mine > 0u ? mine : 1u; nx = cnt > 0u ? cnt : 1u;
}
__device__ __forceinline__ void xcd_barrier(const XcdBarrier& b, int tid) {
    asm volatile("s_waitcnt vmcnt(0)" ::: "memory");
    __syncthreads();
    if (tid == 0) {
        unsigned* bar = b.bar;
        __builtin_amdgcn_s_waitcnt(0);
        unsigned nloc = b.st[0], nx = b.st[1];
        if (nloc == 0u) { xcd_barrier_complete(bar, b.x, nloc, nx); b.st[0] = nloc; b.st[1] = nx; }
        const unsigned old = xb_add(&bar[XB_XSUB(b.x)], 1u);
        const unsigned gen = old / nloc;
        if (old + 1u == (gen + 1u) * nloc) {
            __builtin_amdgcn_fence(__ATOMIC_RELEASE, "agent");
            asm volatile("s_waitcnt vmcnt(0)" ::: "memory");
            const unsigned og = xb_add(&bar[XB_TOP], 1u);
            const unsigned tg = og / nx;
            if (og + 1u == (tg + 1u) * nx) xb_add(&bar[XB_TOPGEN], 1u);
            else XB_SPIN(xb_ld(&bar[XB_TOPGEN]) == tg, bar);
            __builtin_amdgcn_fence(__ATOMIC_ACQUIRE, "agent");
            xb_add(&bar[XB_XGEN(b.x)], 1u);
            asm volatile("s_waitcnt vmcnt(0)" ::: "memory");
        } else {
            XB_SPIN(xb_ld(&bar[XB_XGEN(b.x)]) == gen, bar);
            __builtin_amdgcn_fence(__ATOMIC_ACQUIRE, "agent");
            asm volatile("s_waitcnt vmcnt(0)" ::: "memory");
        }
    }
    __syncthreads();
}

namespace pg {
constexpr int BM = 256, BK = 64, HALF = 128, HTB = HALF * BK * 2, STAGE_BYTES = 8 * HTB;
__host__ __device__ __forceinline__ int lds_byte(int r, int c) { const int st = (r >> 4) * 2 + (c >> 5), rr = r & 15, cc = c & 31, ob = rr * 64 + cc * 2; return st * 1024 + (ob ^ (((ob >> 9) & 1) << 5)); }
__host__ __device__ __forceinline__ void stage_rc(int b, int& R, int& C) { const int st = b / 1024, sb = b % 1024, swz = sb ^ (((sb >> 9) & 1) << 5); R = (st >> 1) * 16 + swz / 64; C = (st & 1) * 32 + (swz % 64) / 2; }
__host__ __device__ __forceinline__ int perm32(int rho) { const int n = rho >> 4, i = rho & 15; return 8 * (i >> 2) + 4 * n + (i & 3); }

struct Unit { const char* A; const char* B; int pm, pn, e, nrows, aux0; };

template <int N> __device__ __forceinline__ void wait_vm() { asm volatile("s_waitcnt vmcnt(%0)" :: "n"(N) : "memory"); }
template <class Epi, class Sched, bool ALIGN_EPI>
__device__ __forceinline__ void gemm_phase(LAS unsigned char* lds, const int wave, const int K, const int lda, const int ldb, const Sched& S, const Epi& E) {
    int tid_ = wave * 64 + lane_id(); asm volatile("" : "+v"(tid_));
    const int tid = tid_, wid = __builtin_amdgcn_readfirstlane(tid >> 6), lane = tid & 63, wr = wid >> 2, wc = wid & 3, fr = lane & 15, fq = lane >> 4;
    const int nt = K / BK;
    int sR[2], sC[2];
    unsigned voffB[2];
#pragma unroll
    for (int i = 0; i < 2; ++i) { int R, C; stage_rc(tid * 16 + i * 8192, R, C); sR[i] = R; sC[i] = C; const int p32 = perm32(R & 31); const int Rb = Epi::PERM2 ? (64 * (R >> 5) + 2 * (p32 & 24) + (p32 & 7)) : Epi::PERM ? (64 * (R >> 5) + p32) : R;
        voffB[i] = (unsigned)(Rb * ldb + C) * 2u; }
    const size_t kstep = (size_t)(BK * 2);
    const size_t hstepB = (size_t)(Epi::PERM2 ? 8 : Epi::PERM ? 32 : HALF) * ldb * 2;
    const unsigned ldsw = (unsigned)wid * 1024u;
    const int aoff = lds_byte(wr * 64 + fr, fq * 8), boff = lds_byte(wc * 32 + fr, fq * 8);
#define PG_SA(b, h) (((b) * 2 + (h)) * HTB)
#define PG_SB(b, h) ((4 + (b) * 2 + (h)) * HTB)
#define PG_STAGE2(bufoff, gbase, o0, o1) do { \
        __builtin_amdgcn_global_load_lds((const unsigned*)((const char*)(gbase) + (o0)), (LAS unsigned*)(lds + (bufoff) + ldsw), 16, 0, 0); \
        __builtin_amdgcn_global_load_lds((const unsigned*)((const char*)(gbase) + (o1)), (LAS unsigned*)(lds + (bufoff) + ldsw + 8192), 16, 0, 0); } while (0)
#define PG_STAGEB(bufoff, gbase) PG_STAGE2(bufoff, gbase, voffB[0], voffB[1])
#define PG_LDA(dst, b, h) do { _Pragma("unroll") for (int m = 0; m < 4; ++m) _Pragma("unroll") for (int k = 0; k < 2; ++k) dst[m][k] = *(const LAS h8*)(lds + PG_SA(b, h) + aoff + m * 2048 + k * 1024); } while (0)
#define PG_LDB(dst, b, h) do { _Pragma("unroll") for (int n = 0; n < 2; ++n) _Pragma("unroll") for (int k = 0; k < 2; ++k) dst[n][k] = *(const LAS h8*)(lds + PG_SB(b, h) + boff + n * 2048 + k * 1024); } while (0)
#define PG_MMA(ai, bj, At, Bt) do { __builtin_amdgcn_s_setprio(1); _Pragma("unroll") for (int m = 0; m < 4; ++m) _Pragma("unroll") for (int n = 0; n < 2; ++n) _Pragma("unroll") for (int k = 0; k < 2; ++k) \
        acc[ai][bj][m][n] = __builtin_amdgcn_mfma_f32_16x16x32_f16(Bt[n][k], At[m][k], acc[ai][bj][m][n], 0, 0, 0); __builtin_amdgcn_s_setprio(0); } while (0)
#define PG_WAIT_V(n) asm volatile("s_waitcnt vmcnt(" #n ")" ::: "memory")
#define PG_WAIT_L(n) asm volatile("s_waitcnt lgkmcnt(" #n ")" ::: "memory")
#define PG_BAR __builtin_amdgcn_s_barrier()
#define PG_SCHED __builtin_amdgcn_sched_barrier(0)
    constexpr bool RELAX = !Sched::GATHER && Epi::NVM > 0;
    bool prev_full = false;
    Unit cur, nxt; int ui = 0;
    if (!S.next(0, cur)) return;
    unsigned c00, c01, c10, c11;
    LAS unsigned* otab = (LAS unsigned*)(lds + STAGE_BYTES + 2048) + tid;
    { c00 = (unsigned)(S.arow(cur, sR[0]) * lda + sC[0]) * 2u; c01 = (unsigned)(S.arow(cur, sR[1]) * lda + sC[1]) * 2u;
      c10 = (unsigned)(S.arow(cur, HALF + sR[0]) * lda + sC[0]) * 2u; c11 = (unsigned)(S.arow(cur, HALF + sR[1]) * lda + sC[1]) * 2u; }
    f32x4 acc[2][2][4][2];
#pragma unroll
    for (int a = 0; a < 2; ++a)
#pragma unroll
        for (int b = 0; b < 2; ++b)
#pragma unroll
            for (int m = 0; m < 4; ++m)
#pragma unroll
                for (int n = 0; n < 2; ++n) acc[a][b][m][n] = (f32x4){0.f, 0.f, 0.f, 0.f};
    h8 At[4][2], B0[2][2], B1[2][2];
    const char* cA = cur.A; const char* cB = cur.B;
    PG_STAGEB(PG_SB(0, 0), cB); PG_STAGEB(PG_SB(0, 1), cB + hstepB); PG_STAGE2(PG_SA(0, 0), cA, c00, c01); PG_STAGE2(PG_SA(0, 1), cA, c10, c11);
    if (wr == 1) PG_BAR;
    PG_WAIT_V(2); PG_BAR;
    PG_STAGEB(PG_SB(1, 0), cB + kstep); PG_STAGE2(PG_SA(1, 0), cA + kstep, c00, c01); PG_STAGEB(PG_SB(1, 1), cB + hstepB + kstep);
    PG_WAIT_V(6); PG_BAR;
    for (;;) {
        const bool has_next = S.next(ui + 1, nxt);
        const char* nA = has_next ? nxt.A : cA; const char* nB = has_next ? nxt.B : cB;
        if (Sched::GATHER) {
            if (has_next) { otab[0] = (unsigned)(S.arow(nxt, sR[0]) * lda + sC[0]) * 2u; otab[512] = (unsigned)(S.arow(nxt, sR[1]) * lda + sC[1]) * 2u;
                            otab[1024] = (unsigned)(S.arow(nxt, HALF + sR[0]) * lda + sC[0]) * 2u; otab[1536] = (unsigned)(S.arow(nxt, HALF + sR[1]) * lda + sC[1]) * 2u; }
            else { otab[0] = c00; otab[512] = c01; otab[1024] = c10; otab[1536] = c11; }
        }
#pragma unroll 1
        for (int t = 0; t < nt; t += 2) {
            const bool last = (t == nt - 2);
            const char* a1 = cA + (size_t)(t + 1) * kstep;
            const char* a2 = last ? nA : cA + (size_t)(t + 2) * kstep; const char* b2 = last ? nB : cB + (size_t)(t + 2) * kstep;
            const char* a3 = a2 + kstep; const char* b3 = b2 + kstep;
            unsigned q00 = c00, q01 = c01, q10 = c10, q11 = c11;
            if (Sched::GATHER) { if (last) { q00 = otab[0]; q01 = otab[512]; q10 = otab[1024]; q11 = otab[1536]; } }
            const bool pre = RELAX && t == 0 && ui > 0;
            const bool rlx = pre && prev_full;
            PG_LDB(B0, 0, 0); PG_LDB(B1, 0, 1); PG_SCHED; PG_LDA(At, 0, 0); if (!pre) PG_STAGE2(PG_SA(1, 1), a1, c10, c11);
            if (rlx) wait_vm<8 + Epi::NVM>(); else PG_WAIT_V(8);
            PG_WAIT_L(0); PG_BAR; PG_MMA(0, 0, At, B0); PG_MMA(0, 1, At, B1); PG_BAR; PG_SCHED;
            PG_LDA(At, 0, 1); PG_STAGEB(PG_SB(0, 0), b2); PG_STAGEB(PG_SB(0, 1), b2 + hstepB); PG_STAGE2(PG_SA(0, 0), a2, q00, q01);
            if (rlx) wait_vm<8 + Epi::NVM>(); else PG_WAIT_V(8);
            PG_WAIT_L(0); PG_BAR; PG_MMA(1, 0, At, B0); PG_MMA(1, 1, At, B1); PG_BAR; PG_SCHED;
            PG_LDB(B0, 1, 0); PG_LDB(B1, 1, 1); PG_SCHED; PG_LDA(At, 1, 0); PG_STAGE2(PG_SA(0, 1), a2, q10, q11);
            if (rlx) wait_vm<8 + Epi::NVM>(); else PG_WAIT_V(8);
            PG_WAIT_L(0); PG_BAR; PG_MMA(0, 0, At, B0); PG_MMA(0, 1, At, B1); PG_BAR; PG_SCHED;
            PG_LDA(At, 1, 1); PG_STAGEB(PG_SB(1, 0), b3); PG_STAGEB(PG_SB(1, 1), b3 + hstepB); PG_STAGE2(PG_SA(1, 0), a3, q00, q01);
            PG_WAIT_V(8); PG_WAIT_L(0); PG_BAR; PG_MMA(1, 0, At, B0); PG_MMA(1, 1, At, B1); PG_BAR; PG_SCHED;
        }
        if constexpr (ALIGN_EPI) { if (wr == 0) PG_BAR; }
        if (RELAX && has_next) PG_STAGE2(PG_SA(1, 1), nA + kstep, c10, c11);
        E(acc, cur, wr, wc, fr, fq);
        prev_full = E.full(cur);
        if (!has_next) break;
#pragma unroll
        for (int a = 0; a < 2; ++a)
#pragma unroll
            for (int b = 0; b < 2; ++b)
#pragma unroll
                for (int m = 0; m < 4; ++m)
#pragma unroll
                    for (int n = 0; n < 2; ++n) acc[a][b][m][n] = (f32x4){0.f, 0.f, 0.f, 0.f};
        cur = nxt; cA = nA; cB = nB; ++ui;
        if (Sched::GATHER) { c00 = otab[0]; c01 = otab[512]; c10 = otab[1024]; c11 = otab[1536]; }
        if constexpr (ALIGN_EPI) { if (wr == 1) PG_BAR; }
    }
    PG_WAIT_V(0);
    if constexpr (!ALIGN_EPI) { if (wr == 0) PG_BAR; }
    PG_BAR;
#undef PG_SA
#undef PG_SB
#undef PG_STAGE2
#undef PG_STAGEB
#undef PG_LDA
#undef PG_LDB
#undef PG_MMA
#undef PG_WAIT_V
#undef PG_WAIT_L
#undef PG_BAR
#undef PG_SCHED
}
}
constexpr size_t MiB = 1u << 20;
constexpr size_t al256(size_t x) { return (x + 255) & ~(size_t)255; }
constexpr size_t WS_CTL = 0, CTL_ZERO_BYTES = 2 * MiB;
constexpr size_t WS_MODS = 1 * MiB;
constexpr size_t WS_X = 2 * MiB;
constexpr size_t WS_Z2 = WS_X + (size_t)T * D * 4;
constexpr size_t WS_DYN = al256(WS_Z2 + (size_t)DEPTH * SE * 64 * 4);
constexpr size_t WS_WIN = WS_DYN;
constexpr size_t WS_PJ = WS_WIN + (size_t)DIN * D * 2;
constexpr size_t WS_WO = WS_PJ + (size_t)3 * D * DH * 2;
constexpr size_t WS_RT = WS_WO + (size_t)D * D * 2;
constexpr size_t WS_SD = WS_RT + (size_t)2 * NE * D * 2;
constexpr size_t WS_GC = al256(WS_SD + (size_t)256 * 4097 * 16);
constexpr size_t WS_HMH = WS_GC + (size_t)DH * 512 * 4;
constexpr size_t WS_LIST = WS_HMH + (size_t)T * D * 2;
constexpr size_t WS_P = WS_LIST + (size_t)2 * NE * TH * 8;
constexpr size_t P_BYTES = (size_t)T * DIN * 2;
constexpr size_t WS_SLOT = WS_P;
constexpr size_t WS_SLSH = WS_SLOT + (size_t)TH * 8 * D;
constexpr float SLOT_SC = 64.f;
constexpr size_t WS_W13 = WS_SLOT + (size_t)TH * 9 * D * 2;
constexpr size_t WS_W2 = WS_W13 + (size_t)65 * 512 * D * 2;
constexpr size_t WS_H = WS_W2 + (size_t)65 * D * DEXP * 2;
static_assert(WS_H + (size_t)(MAXT_H + SH_T) * 256 * DEXP * 2 <= WS_P + P_BYTES, "MoE overlay fits the P region");
constexpr size_t WS_ZT = WS_P + P_BYTES;
constexpr size_t WS_VT = WS_ZT + (size_t)B * DH * SE * 2;
constexpr size_t WS_SCR = WS_ZT;
static_assert((size_t)256 * 32 * 512 * 16 <= (size_t)2 * B * DH * SE * 2, "scratch fits ZT|VT");
constexpr size_t WS_VHT = WS_VT + (size_t)B * DH * SE * 2;
constexpr size_t WS_Y = WS_VHT + (size_t)B * DH * SE * 2;
constexpr size_t WS_END = WS_Y + (size_t)T * 1536 * 2;
static_assert((size_t)(MAXT_H + SH_T) * 256 * DEXP * 2 <= (size_t)T * 1536 * 2, "half 1's H fits the Y region");
constexpr int CW_BAR = 4096;
constexpr int CW_CNT = 16384;
constexpr int CW_DBG = 32768;

struct In {
    const GAS float *x, *c, *ctx, *c_ctx, *w_ada, *b_ada, *w_in, *hy_conv_w, *hy_conv_b, *hy_w1, *hy_b1, *hy_w2, *hy_b2, *hy_w3, *hy_sin_freq, *hy_bias_d,
        *hy_proj, *sc_conv_w, *sc_proj, *na_rpb, *na_proj, *w_o, *ln1_g, *ln1_b, *ln2_g, *ln2_b, *moe_router, *moe_bias, *moe_w1, *moe_w3, *moe_w2, *sh_w1, *sh_w3, *sh_w2;
};
struct Args { In in; GAS float* out; unsigned char* ws; int ph_lo, ph_hi, use_bar, flags; };

typedef const __attribute__((address_space(4))) In& CIN;
#define INP(name) ((const float*)(in.name))
typedef const __attribute__((address_space(4))) Args* CArgsP;
struct Frame {
    LAS unsigned char* lds;
    int tid, lane, wave, vcu, G, bid, dry;
    GAS unsigned char* ws;
};
__device__ __forceinline__ int mod_row(int row) { const int b = row / SE, ii = row - b * SE; return ii < S ? b : 8; }

struct TrItem { const float* W; int K, N; f16* WT; int row_off, row_mul, item; };
__device__ __forceinline__ void tr_load(const TrItem& q, f32x4 (&t)[8], int lane) {
    const int nblk = q.N / 32, kb = q.item / nblk, nb = q.item % nblk, k0 = 64 * kb, n0 = 32 * nb;
    const int kr = lane >> 3, c4 = (lane & 7) * 4;
#pragma unroll
    for (int i = 0; i < 8; ++i) t[i] = *(const f32x4*)(q.W + (size_t)(k0 + 8 * i + kr) * q.N + n0 + c4);
}
__device__ __forceinline__ void tr_store(const TrItem& q, const f32x4 (&t)[8], LAS float* scr, int lane) {
    const int nblk = q.N / 32, kb = q.item / nblk, nb = q.item % nblk, k0 = 64 * kb, n0 = 32 * nb;
    const int kr = lane >> 3, c4 = (lane & 7) * 4;
#pragma unroll
    for (int i = 0; i < 8; ++i) { LAS float* d = scr + (8 * i + kr) * 33 + c4; d[0] = t[i][0]; d[1] = t[i][1]; d[2] = t[i][2]; d[3] = t[i][3]; }
    LDS_WAIT(); asm volatile("" ::: "memory");
    const int c = lane & 7;
#pragma unroll
    for (int j = 0; j < 4; ++j) { const int n = (lane >> 3) + 8 * j; const LAS float* s = scr + (8 * c) * 33 + n;
        u32x4 o; o.x = pkh(s[0 * 33], s[1 * 33]); o.y = pkh(s[2 * 33], s[3 * 33]); o.z = pkh(s[4 * 33], s[5 * 33]); o.w = pkh(s[6 * 33], s[7 * 33]);
        *(u32x4*)(q.WT + (size_t)(q.row_off + (n0 + n) * q.row_mul) * q.K + k0 + 8 * c) = o; }
    LDS_WAIT(); asm volatile("" ::: "memory");
}
__device__ __forceinline__ TrItem mixer_item(Frame& F, CIN in, int l, int it) {
    constexpr int I_IN = (D / 64) * (DIN / 32), I_PJ = (DH / 64) * (D / 32);
    f16* win = (f16*)(F.ws + WS_WIN); f16* pj = (f16*)(F.ws + WS_PJ); f16* wo = (f16*)(F.ws + WS_WO);
    int r = it;
    if (r < I_IN) return TrItem{INP(w_in) + (size_t)l * D * DIN, D, DIN, win, 0, 1, r}; r -= I_IN;
    if (r < I_PJ) return TrItem{INP(hy_proj) + (size_t)l * DH * D, DH, D, pj, 0, 1, r}; r -= I_PJ;
    if (r < I_PJ) return TrItem{INP(sc_proj) + (size_t)l * DH * D, DH, D, pj, D, 1, r}; r -= I_PJ;
    if (r < I_PJ) return TrItem{INP(na_proj) + (size_t)l * DH * D, DH, D, pj, 2 * D, 1, r}; r -= I_PJ;
    return TrItem{INP(w_o) + (size_t)l * D * D, D, D, wo, 0, 1, r};
}
__device__ __forceinline__ void convert_mixer_weights(Frame& F, CIN in, int l) {
    LAS float* scr = (LAS float*)(F.lds + F.wave * 16384);
    const int gw = F.vcu * NWAVES + F.wave, NGW = F.G * NWAVES;
    constexpr int NIT = (D / 64) * (DIN / 32) + 3 * (DH / 64) * (D / 32) + (D / 64) * (D / 32);
    int it = gw; if (it >= NIT) return;
    f32x4 ta[8], tb[8];
    TrItem qa = mixer_item(F, in, l, it), qb = qa; tr_load(qa, ta, F.lane);
    for (;;) {
        const bool hb = it + NGW < NIT; if (hb) { qb = mixer_item(F, in, l, it + NGW); tr_load(qb, tb, F.lane); }
        tr_store(qa, ta, scr, F.lane); if (!hb) break; it += NGW;
        const bool ha = it + NGW < NIT; if (ha) { qa = mixer_item(F, in, l, it + NGW); tr_load(qa, ta, F.lane); }
        tr_store(qb, tb, scr, F.lane); if (!ha) break; it += NGW;
    }
}
__device__ __forceinline__ TrItem moe_item(Frame& F, CIN in, int l, int it) {
    constexpr int I_UP = (D / 64) * (DEXP / 32)  , I_DN = (DEXP / 64) * (D / 32)  , PER_E = 2 * I_UP + I_DN;
    f16* w13 = (f16*)(F.ws + WS_W13); f16* w2 = (f16*)(F.ws + WS_W2);
    const int e = it / PER_E; int r = it - e * PER_E;
    if (r < I_UP) return TrItem{e < NE ? INP(moe_w1) + ((size_t)l * NE + e) * D * DEXP : INP(sh_w1) + (size_t)l * D * DEXP, D, DEXP, w13 + (size_t)e * 512 * D, 0, 2, r}; r -= I_UP;
    if (r < I_UP) return TrItem{e < NE ? INP(moe_w3) + ((size_t)l * NE + e) * D * DEXP : INP(sh_w3) + (size_t)l * D * DEXP, D, DEXP, w13 + (size_t)e * 512 * D, 1, 2, r}; r -= I_UP;
    return TrItem{e < NE ? INP(moe_w2) + ((size_t)l * NE + e) * DEXP * D : INP(sh_w2) + (size_t)l * DEXP * D, DEXP, D, w2 + (size_t)e * D * DEXP, 0, 1, r};
}
__device__ __forceinline__ void convert_moe_weights(Frame& F, CIN in, int l) {
    LAS float* scr = (LAS float*)(F.lds + F.wave * 16384);
    const int gw = F.vcu * NWAVES + F.wave, NGW = F.G * NWAVES;
    constexpr int NIT = 65 * 384;
    int it = gw; if (it >= NIT) return;
    f32x4 ta[8], tb[8];
    TrItem qa = moe_item(F, in, l, it), qb = qa; tr_load(qa, ta, F.lane);
    for (;;) {
        const bool hb = it + NGW < NIT; if (hb) { qb = moe_item(F, in, l, it + NGW); tr_load(qb, tb, F.lane); }
        tr_store(qa, ta, scr, F.lane); if (!hb) break; it += NGW;
        const bool ha = it + NGW < NIT; if (ha) { qa = moe_item(F, in, l, it + NGW); tr_load(qa, ta, F.lane); }
        tr_store(qb, tb, scr, F.lane); if (!ha) break; it += NGW;
    }
}

struct MoeTab { int ptile[NE + 2]; };
__device__ __forceinline__ void moe_build_tab(Frame& F, const int* cnt, LAS int* tab) {
    if (F.tid < 64) {
        const int c = __hip_atomic_load(cnt + F.tid, __ATOMIC_RELAXED, __HIP_MEMORY_SCOPE_AGENT); int tl = (c + 255) >> 8; int inc = tl;
#pragma unroll
        for (int o = 1; o < 64; o <<= 1) { const int v = bpermi(F.lane - o, inc); if (F.lane >= o) inc += v; }
        tab[F.tid] = inc - tl; tab[128 + F.tid] = c;
        if (F.tid == 63) tab[64] = inc;
    }
    __syncthreads();
}
template <int NPN, bool UP>
struct MoeSched {
    static constexpr bool GATHER = UP;
    const LAS int* tab; int G, c, half; const unsigned long long* list; const char* Abase; const char* Bbase; int NT, lat_only;
    int sh_mode, NT_other;
    __device__ __forceinline__ bool next(int i, pg::Unit& u) const {
        const int SH = lat_only ? SH_T - 4 : SH_T;
        const int L = i * G + c; const int nun = (NT + (sh_mode == 2 ? 0 : (sh_mode == 1 ? 2 * SH : SH))) * NPN;
        if (L >= nun) return false;
        const int tile = L / NPN; u.pn = L - tile * NPN;
        int e;
        if (tile < NT) { e = 0;
#pragma unroll
            for (int s = 32; s >= 1; s >>= 1) { const int v = __builtin_amdgcn_readfirstlane(tab[(e + s) & 63]); if (e + s < NE && v <= tile) e += s; }
            u.pm = tile - __builtin_amdgcn_readfirstlane(tab[e]); int nr = __builtin_amdgcn_readfirstlane(tab[128 + e]) - u.pm * 256; u.nrows = nr > 256 ? 256 : nr;
        } else { e = NE; u.pm = tile - NT; u.nrows = 256;
            if (u.pm >= SH) { u.pm -= SH; u.nrows = 257; }
            if (lat_only) u.pm = (u.pm >> 4) * 17 + (u.pm & 15); }
        u.e = e;
        if (UP) { u.A = Abase; u.B = Bbase + ((size_t)e * 512 + (size_t)u.pn * 256) * D * 2; }
        else { u.A = Abase + (size_t)tile * 256 * DEXP * 2; u.B = Bbase + ((size_t)e * D + (size_t)u.pn * 256) * DEXP * 2; }
        u.aux0 = u.nrows == 257 ? NT_other + u.pm : tile;
        return true;
    }
    __device__ __forceinline__ int arow(const pg::Unit& u, int r) const {
        if (!UP) return r;
        if (u.e == NE) return (u.nrows == 257 ? (half ^ 1) : half) * TH + u.pm * 256 + r;
        int rr = u.pm * 256 + r; const int n = __builtin_amdgcn_readfirstlane(tab[128 + u.e]); if (rr >= n) rr = n - 1;
        const unsigned long long en = list[((size_t)half * NE + u.e) * TH + rr];
        return half * TH + (int)(en >> 36);
    }
};
struct EpiUp {
    static constexpr bool PERM = true; static constexpr bool PERM2 = false; static constexpr int NVM = 0;
    __device__ __forceinline__ bool full(const pg::Unit&) const { return false; }
    f16* H; f16* Hother;
    __device__ __forceinline__ void operator()(const f32x4 (&acc)[2][2][4][2], const pg::Unit& u, int wr, int wc, int fr, int fq) const {
        f16* Hb = u.nrows == 257 ? Hother : H;
#pragma unroll
        for (int ai = 0; ai < 2; ++ai)
#pragma unroll
            for (int m = 0; m < 4; ++m) { const int r = ai * 128 + wr * 64 + m * 16 + fr; f16* rowp = Hb + ((size_t)u.aux0 * 256 + r) * DEXP + u.pn * 128;
#pragma unroll
                for (int bj = 0; bj < 2; ++bj) { const f32x4 v0 = acc[ai][bj][m][0], v1 = acc[ai][bj][m][1];
                    const float h0 = v0[0] * sigm(v0[0]) * v0[1], h1 = v0[2] * sigm(v0[2]) * v0[3], h2_ = v1[0] * sigm(v1[0]) * v1[1], h3 = v1[2] * sigm(v1[2]) * v1[3];
                    u32x2 w; w.x = pkh(h0, h1); w.y = pkh(h2_, h3);
                    *(u32x2*)(rowp + (wc * 64 + bj * 32 + 8 * fq) / 2) = w; }
                asm volatile("" ::: "memory"); }
    }
};
struct EpiDown {
    static constexpr bool PERM = true; static constexpr bool PERM2 = true; static constexpr int NVM = 8;
    __device__ __forceinline__ bool full(const pg::Unit& u) const { return !dry && (u.e == NE || u.nrows == 256); }
    f16* SL; f16* SH; const unsigned long long* list; int half, dry;
    __device__ __forceinline__ void operator()(const f32x4 (&acc)[2][2][4][2], const pg::Unit& u, int wr, int wc, int fr, int fq) const {
        unsigned long long en[8];
        const unsigned long long* lp = list + ((size_t)half * NE + (u.e < NE ? u.e : 0)) * TH + u.pm * 256;
#pragma unroll
        for (int g = 0; g < 8; ++g) { const int r = (g >> 2) * 128 + wr * 64 + (g & 3) * 16 + fr; en[g] = (u.e < NE && r < u.nrows) ? lp[r] : 0ull; }
#pragma unroll
        for (int ai = 0; ai < 2; ++ai)
#pragma unroll
            for (int m = 0; m < 4; ++m) { const int r = ai * 128 + wr * 64 + m * 16 + fr;
                float w = 1.f; int srow = u.pm * 256 + r; bool ok = true;
                if (u.e < NE) { ok = r < u.nrows; const unsigned long long e8 = en[ai * 4 + m]; w = __uint_as_float((unsigned)e8); const unsigned hi = (unsigned)(e8 >> 32); srow = (int)(hi >> 4) * 8 + (int)(hi & 15u); }
                if (ok) {
                    if (u.e < NE) {
                        unsigned char* rowp = (unsigned char*)SL + (size_t)srow * D + u.pn * 256 + wc * 64 + 16 * fq; w *= SLOT_SC;
                        u32x4 o;
#pragma unroll
                        for (int bj = 0; bj < 2; ++bj) { const f32x4 v0 = acc[ai][bj][m][0] * w, v1 = acc[ai][bj][m][1] * w;
                            int a = __builtin_amdgcn_cvt_pk_fp8_f32(v0[0], v0[1], 0, false); a = __builtin_amdgcn_cvt_pk_fp8_f32(v0[2], v0[3], a, true);
                            int b = __builtin_amdgcn_cvt_pk_fp8_f32(v1[0], v1[1], 0, false); b = __builtin_amdgcn_cvt_pk_fp8_f32(v1[2], v1[3], b, true);
                            if (bj == 0) { o.x = (unsigned)a; o.y = (unsigned)b; } else { o.z = (unsigned)a; o.w = (unsigned)b; } }
                        if (!dry || o.x == 0x12345678u) __builtin_nontemporal_store(o, (u32x4*)rowp);
                    } else {
                        f16* rowp = SH + (size_t)srow * D + u.pn * 256 + wc * 64 + 16 * fq;
#pragma unroll
                        for (int bj = 0; bj < 2; ++bj) { const f32x4 v0 = acc[ai][bj][m][0], v1 = acc[ai][bj][m][1];
                            u32x4 o; o.x = pkh(v0[0], v0[1]); o.y = pkh(v0[2], v0[3]); o.z = pkh(v1[0], v1[1]); o.w = pkh(v1[2], v1[3]);
                            if (!dry || o.x == 0x12345678u) __builtin_nontemporal_store(o, (u32x4*)(rowp + bj * 8)); } } } }
    }
};
template <bool DO_LN>
__device__ __forceinline__ void ln1_rows(Frame& F, CIN in, int l) {
    const int gw = F.vcu * NWAVES + F.wave, NGW = F.G * NWAVES;
    float* X = (float*)(F.ws + WS_X); f16* HM = (f16*)(F.ws + WS_HMH);
    const float* mods = (const float*)(F.ws + WS_MODS) + (size_t)l * 9 * 6 * D;
    const f32x4* g4 = (const f32x4*)(INP(ln1_g) + l * D) + F.lane; const f32x4* b4 = (const f32x4*)(INP(ln1_b) + l * D) + F.lane;
    for (int row = gw; row < T; row += NGW) {
        f32x4* xr = (f32x4*)(X + (size_t)row * D) + F.lane;
        f32x4 v[4];
#pragma unroll
        for (int j = 0; j < 4; ++j) v[j] = xr[64 * j];
        if (DO_LN) {
            float s = 0.f;
#pragma unroll
            for (int j = 0; j < 4; ++j) s += (v[j].x + v[j].y) + (v[j].z + v[j].w);
            const float mean = wsum(s, F.lane) * (1.f / D); float s2 = 0.f;
#pragma unroll
            for (int j = 0; j < 4; ++j) { v[j] = v[j] - mean; s2 += (v[j].x * v[j].x + v[j].y * v[j].y) + (v[j].z * v[j].z + v[j].w * v[j].w); }
            const float rstd = 1.f / sqrtf(wsum(s2, F.lane) * (1.f / D) + LN_EPS);
#pragma unroll
            for (int j = 0; j < 4; ++j) { v[j] = v[j] * rstd * g4[64 * j] + b4[64 * j]; if (!F.dry) xr[64 * j] = v[j]; }
        }
        const float* m = mods + (size_t)mod_row(row) * 6 * D;
        const f32x4* sh = (const f32x4*)(m + 3 * D) + F.lane; const f32x4* sc = (const f32x4*)(m + 4 * D) + F.lane;
        u32x2* o8 = (u32x2*)(HM + (size_t)row * D) + F.lane;
#pragma unroll
        for (int j = 0; j < 4; ++j) { const f32x4 h = v[j] * (sc[64 * j] + 1.f) + sh[64 * j]; u32x2 w; w.x = pkh(h.x, h.y); w.y = pkh(h.z, h.w); if (!F.dry) o8[64 * j] = w; }
    }
}

__device__ __forceinline__ void router_phase(Frame& F, CIN in, int l) {
    const int gw = F.vcu * NWAVES + F.wave, NGW = F.G * NWAVES, lane = F.lane, fr = lane & 15, fq = lane >> 4;
    const float* X = (const float*)(F.ws + WS_X);
    const float* mods = (const float*)(F.ws + WS_MODS) + (size_t)l * 9 * 6 * D;
    const f16* rth = (const f16*)(F.ws + WS_RT); const f16* rtl = rth + NE * D;
    int* cntl = (int*)(F.ws + WS_CTL) + CW_CNT + l * 128;
    unsigned long long* list = (unsigned long long*)(F.ws + WS_LIST);
    LAS float* lgs = (LAS float*)(F.lds + F.wave * 4096);
    const float rb = INP(moe_bias)[l * NE + lane];
    for (int task = gw; task < T / 16; task += NGW) {
        const int row0 = task * 16;
        const float* m = mods + (size_t)mod_row(row0) * 6 * D;
        const float* xr = X + (size_t)(row0 + fr) * D + fq * 8;
        f32x4 acc[4];
#pragma unroll
        for (int nb = 0; nb < 4; ++nb) acc[nb] = (f32x4){0.f, 0.f, 0.f, 0.f};
#pragma unroll 2
        for (int s = 0; s < 32; ++s) {
            const int k = s * 32 + fq * 8;
            const f32x4 x0 = *(const f32x4*)(xr + s * 32), x1 = *(const f32x4*)(xr + s * 32 + 4);
            const f32x4 sc0 = *(const f32x4*)(m + 4 * D + k), sc1 = *(const f32x4*)(m + 4 * D + k + 4);
            const f32x4 sh0 = *(const f32x4*)(m + 3 * D + k), sh1 = *(const f32x4*)(m + 3 * D + k + 4);
            const f32x4 h0 = x0 * (sc0 + 1.f) + sh0, h1 = x1 * (sc1 + 1.f) + sh1;
            h8 ahi, alo;
#pragma unroll
            for (int j = 0; j < 4; ++j) { ahi[j] = (f16)h0[j]; alo[j] = (f16)(h0[j] - (float)ahi[j]); ahi[4 + j] = (f16)h1[j]; alo[4 + j] = (f16)(h1[j] - (float)ahi[4 + j]); }
#pragma unroll
            for (int nb = 0; nb < 4; ++nb) {
                const h8 bhi = *(const h8*)(rth + (size_t)(nb * 16 + fr) * D + k), blo = *(const h8*)(rtl + (size_t)(nb * 16 + fr) * D + k);
                acc[nb] = __builtin_amdgcn_mfma_f32_16x16x32_f16(ahi, bhi, acc[nb], 0, 0, 0);
                acc[nb] = __builtin_amdgcn_mfma_f32_16x16x32_f16(alo, bhi, acc[nb], 0, 0, 0);
                acc[nb] = __builtin_amdgcn_mfma_f32_16x16x32_f16(ahi, blo, acc[nb], 0, 0, 0);
            }
        }
#pragma unroll
        for (int nb = 0; nb < 4; ++nb)
#pragma unroll
            for (int i = 0; i < 4; ++i) lgs[(4 * fq + i) * 64 + nb * 16 + fr] = acc[nb][i];
        LDS_WAIT(); asm volatile("" ::: "memory");
        unsigned chosen_mask = 0u; float wv[16]; int kv[16];
#pragma unroll
        for (int t = 0; t < 16; ++t) {
            const float score = 1.f / (1.f + expf(-lgs[t * 64 + lane]));
            const float sel = score + rb;
            float m1 = sel;
            m1 = fmaxf(m1, SHX(m1, 1)); m1 = fmaxf(m1, SHX(m1, 2)); m1 = fmaxf(m1, SHX(m1, 4));
            const unsigned long long eq = __ballot(sel == m1);
            const int g = lane >> 3;
            const unsigned geq = (unsigned)((eq >> (g * 8)) & 0xffull);
            const int first = __ffs(geq) - 1;
            float s2 = ((lane & 7) == first) ? -3.0e38f : sel;
            s2 = fmaxf(s2, SHX(s2, 1)); s2 = fmaxf(s2, SHX(s2, 2)); s2 = fmaxf(s2, SHX(s2, 4));
            const float gs = m1 + s2;
            int grank = 0;
#pragma unroll
            for (int gg = 0; gg < 8; ++gg) { const float o = bperm(gg * 8, gs); grank += (o > gs || (o == gs && gg < g)) ? 1 : 0; }
            const bool gsel = grank < 4;
            const float val = gsel ? sel : -3.0e38f;
            int rank = 0;
            for (int j = 0; j < 64; ++j) { const float o = bperm(j, val); rank += (o > val || (o == val && j < lane)) ? 1 : 0; }
            const bool ch = gsel && rank < TOPK;
            const float tot = wsum(ch ? score : 0.f, lane);
            wv[t] = score / tot * 2.5f; kv[t] = rank;
            chosen_mask |= ch ? (1u << t) : 0u;
        }
        const int half = row0 >= TH ? 1 : 0;
        const int nch = __popc(chosen_mask);
        int base = 0;
        if (nch && !F.dry) base = atomicAdd(cntl + half * 64 + lane, nch);
        unsigned long long* lp = list + ((size_t)half * NE + lane) * TH;
        int pos = base;
#pragma unroll
        for (int t = 0; t < 16; ++t) if ((chosen_mask & (1u << t)) && !F.dry) {
            const unsigned tokh = (unsigned)(row0 + t - half * TH);
            lp[pos++] = ((unsigned long long)((tokh << 4) | (unsigned)kv[t]) << 32) | (unsigned long long)__float_as_uint(wv[t]);
        }
        LDS_WAIT(); asm volatile("" ::: "memory");
    }
}


constexpr int RL_PITCH = 1032;
constexpr int RL_LO = 16 * RL_PITCH * 2, RL_PART = 2 * RL_LO;
constexpr int RL_ENT = RL_PART + 32768, RL_MAXTASK = 18, RL_CNT = RL_ENT + RL_MAXTASK * 128 * 16, RL_BASE = RL_CNT + 512;
static_assert(RL_BASE + 512 <= 147456 - 1088, "router LDS map");
__device__ __forceinline__ void ln1_router_phase(Frame& F, CIN in, int l) {
    const int lane = F.lane, w = F.wave, fr = lane & 15, fq = lane >> 4;
    float* X = (float*)(F.ws + WS_X); f16* HM = (f16*)(F.ws + WS_HMH);
    const float* mods = (const float*)(F.ws + WS_MODS) + (size_t)l * 9 * 6 * D;
    const f32x4* g4 = (const f32x4*)(INP(ln1_g) + l * D) + lane; const f32x4* b4 = (const f32x4*)(INP(ln1_b) + l * D) + lane;
    int* cntl = (int*)(F.ws + WS_CTL) + CW_CNT + l * 128;
    unsigned long long* list = (unsigned long long*)(F.ws + WS_LIST);
    LAS f16* ahi = (LAS f16*)F.lds; LAS f16* alo = (LAS f16*)(F.lds + RL_LO); LAS float* part = (LAS float*)(F.lds + RL_PART);
    const f16* rth = (const f16*)(F.ws + WS_RT); const f16* rtl = rth + NE * D;
    h8 bh[4][4];
#pragma unroll
    for (int s = 0; s < 4; ++s)
#pragma unroll
        for (int nb = 0; nb < 4; ++nb) { const size_t o = (size_t)(nb * 16 + fr) * D + 128 * w + 32 * s + 8 * fq; bh[s][nb] = *(const h8*)(rth + o); }
    const float rb = INP(moe_bias)[l * NE + lane];
    if (F.tid < 128) ((LAS int*)(F.lds + RL_CNT))[F.tid] = 0;
    __syncthreads();
    int ti = 0;
    for (int task = F.bid; task < T / 16 && ti < RL_MAXTASK; task += F.G, ++ti) {
        const int row0 = task * 16;
        if (l == DEPTH - 1 && row0 % SE >= S) { --ti; continue; }
        const float* m = mods + (size_t)mod_row(row0) * 6 * D;
        f32x4 va[2][4], pg[4], pb[4], psh[4], psc[4];
#pragma unroll
        for (int j = 0; j < 4; ++j) {
            va[0][j] = ((const f32x4*)(X + (size_t)(row0 + 2 * w) * D) + lane)[64 * j]; va[1][j] = ((const f32x4*)(X + (size_t)(row0 + 2 * w + 1) * D) + lane)[64 * j];
            pg[j] = g4[64 * j]; pb[j] = b4[64 * j]; psh[j] = ((const f32x4*)(m + 3 * D) + lane)[64 * j]; psc[j] = ((const f32x4*)(m + 4 * D) + lane)[64 * j];
        }
        asm volatile("" ::: "memory");
#pragma unroll
        for (int rr = 0; rr < 2; ++rr) {
            const int lr = 2 * w + rr, row = row0 + lr;
            f32x4* xr = (f32x4*)(X + (size_t)row * D) + lane;
            f32x4 v[4]; float s = 0.f;
#pragma unroll
            for (int j = 0; j < 4; ++j) { v[j] = va[rr][j]; s += (v[j].x + v[j].y) + (v[j].z + v[j].w); }
            const float mean = wsum(s, lane) * (1.f / D); float s2 = 0.f;
#pragma unroll
            for (int j = 0; j < 4; ++j) { v[j] = v[j] - mean; s2 += (v[j].x * v[j].x + v[j].y * v[j].y) + (v[j].z * v[j].z + v[j].w * v[j].w); }
            const float rstd = 1.f / sqrtf(wsum(s2, lane) * (1.f / D) + LN_EPS);
            u32x2* o8 = (u32x2*)(HM + (size_t)row * D) + lane;
#pragma unroll
            for (int j = 0; j < 4; ++j) {
                v[j] = v[j] * rstd * pg[j] + pb[j];
                if (!F.dry) xr[64 * j] = v[j];
                const f32x4 h = v[j] * (psc[j] + 1.f) + psh[j];
                h4 hh, hl;
#pragma unroll
                for (int q = 0; q < 4; ++q) { hh[q] = (f16)h[q]; hl[q] = (f16)(h[q] - (float)hh[q]); }
                if (!F.dry) o8[64 * j] = __builtin_bit_cast(u32x2, hh);
                *(LAS h4*)(ahi + lr * RL_PITCH + 4 * lane + 256 * j) = hh; *(LAS h4*)(alo + lr * RL_PITCH + 4 * lane + 256 * j) = hl;
            }
        }
        __syncthreads();
        {
            h8 bl[4][4];
#pragma unroll
            for (int s = 0; s < 4; ++s)
#pragma unroll
                for (int nb = 0; nb < 4; ++nb) bl[s][nb] = *(const h8*)(rtl + (size_t)(nb * 16 + fr) * D + 128 * w + 32 * s + 8 * fq);
            f32x4 acc[4];
#pragma unroll
            for (int nb = 0; nb < 4; ++nb) acc[nb] = (f32x4){0.f, 0.f, 0.f, 0.f};
#pragma unroll
            for (int s = 0; s < 4; ++s) {
                const int k = 128 * w + 32 * s + 8 * fq;
                const h8 xh = *(const LAS h8*)(ahi + fr * RL_PITCH + k), xl = *(const LAS h8*)(alo + fr * RL_PITCH + k);
#pragma unroll
                for (int nb = 0; nb < 4; ++nb) {
                    acc[nb] = __builtin_amdgcn_mfma_f32_16x16x32_f16(xh, bh[s][nb], acc[nb], 0, 0, 0);
                    acc[nb] = __builtin_amdgcn_mfma_f32_16x16x32_f16(xl, bh[s][nb], acc[nb], 0, 0, 0);
                    acc[nb] = __builtin_amdgcn_mfma_f32_16x16x32_f16(xh, bl[s][nb], acc[nb], 0, 0, 0);
                }
            }
#pragma unroll
            for (int nb = 0; nb < 4; ++nb)
#pragma unroll
                for (int i = 0; i < 4; ++i) part[(w * 16 + 4 * fq + i) * 64 + nb * 16 + fr] = acc[nb][i];
        }
        __syncthreads();
        {
            unsigned chosen_mask = 0u; float wv[2]; int kv[2];
#pragma unroll
            for (int t = 0; t < 2; ++t) {
                const int lt = 2 * w + t;
                float lg = 0.f;
#pragma unroll
                for (int ww = 0; ww < 8; ++ww) lg += part[(ww * 16 + lt) * 64 + lane];
                const float score = 1.f / (1.f + expf(-lg));
                const float sel = score + rb;
                float m1 = sel;
                m1 = fmaxf(m1, SHX(m1, 1)); m1 = fmaxf(m1, SHX(m1, 2)); m1 = fmaxf(m1, SHX(m1, 4));
                const unsigned long long eq = __ballot(sel == m1);
                const int g = lane >> 3;
                const unsigned geq = (unsigned)((eq >> (g * 8)) & 0xffull);
                const int first = __ffs(geq) - 1;
                float s2 = ((lane & 7) == first) ? -3.0e38f : sel;
                s2 = fmaxf(s2, SHX(s2, 1)); s2 = fmaxf(s2, SHX(s2, 2)); s2 = fmaxf(s2, SHX(s2, 4));
                const float gs = m1 + s2;
                int grank = 0;
#pragma unroll
                for (int gg = 0; gg < 8; ++gg) { const float o = __int_as_float(__builtin_amdgcn_readlane(__float_as_int(gs), gg * 8)); grank += (o > gs || (o == gs && gg < g)) ? 1 : 0; }
                const bool gsel = grank < 4;
                const float val = gsel ? sel : -3.0e38f;
                int rank = 0;
#pragma unroll
                for (int j = 0; j < 64; ++j) { const float o = __int_as_float(__builtin_amdgcn_readlane(__float_as_int(val), j)); rank += (o > val || (o == val && j < lane)) ? 1 : 0; }
                const bool ch = gsel && rank < TOPK;
                const float tot = wsum(ch ? score : 0.f, lane);
                wv[t] = score / tot * 2.5f; kv[t] = rank;
                chosen_mask |= ch ? (1u << t) : 0u;
            }
            const int half = row0 >= TH ? 1 : 0;
#pragma unroll
            for (int t = 0; t < 2; ++t) if (chosen_mask & (1u << t)) {
                const unsigned lrank = (unsigned)__hip_atomic_fetch_add((LAS int*)(F.lds + RL_CNT) + half * 64 + lane, 1, __ATOMIC_RELAXED, __HIP_MEMORY_SCOPE_WORKGROUP);
                const unsigned tokh = (unsigned)(row0 + 2 * w + t - half * TH);
                u32x4 en; en.x = __float_as_uint(wv[t]); en.y = (tokh << 4) | (unsigned)kv[t]; en.z = (unsigned)(half * 64 + lane); en.w = lrank;
                ((LAS u32x4*)(F.lds + RL_ENT))[(ti * 16 + 2 * w + t) * 8 + kv[t]] = en;
            }
        }
        __syncthreads();
    }
    const int ntask = ti;
    if (F.tid < 128) {
        const int n = ((LAS int*)(F.lds + RL_CNT))[F.tid];
        ((LAS int*)(F.lds + RL_BASE))[F.tid] = (n && !F.dry) ? atomicAdd(cntl + F.tid, n) : 0;
    }
    __syncthreads();
    for (int idx = F.tid; idx < ntask * 128; idx += NTHR) {
        const u32x4 en = ((const LAS u32x4*)(F.lds + RL_ENT))[idx];
        const int he = (int)en.z; const int pos = ((const LAS int*)(F.lds + RL_BASE))[he] + (int)en.w;
        if (!F.dry) list[(size_t)he * TH + pos] = ((unsigned long long)en.y << 32) | (unsigned long long)en.x;
    }
    __syncthreads();
}
__device__ __forceinline__ void convert_router(Frame& F, CIN in, int l) {
    f16* rth = (f16*)(F.ws + WS_RT); f16* rtl = rth + NE * D;
    const float* rw = INP(moe_router) + (size_t)l * D * NE;
    for (int i = (F.vcu * NTHR + F.tid); i < NE * D; i += F.G * NTHR) { const int k = i / NE, n = i % NE; const float wgt = rw[i]; const f16 h = (f16)wgt; rth[n * D + k] = h; rtl[n * D + k] = (f16)(wgt - (float)h); }
}

__device__ __forceinline__ void moe_up_phase(Frame& F, int l, int half, int Gs, int cs) {
    LAS int* tab = (LAS int*)(F.lds + pg::STAGE_BYTES);
    const int* cnt = (const int*)(F.ws + WS_CTL) + CW_CNT + l * 128 + half * 64;
    const int lat_only = l == DEPTH - 1;
    int nt_other = 0;
    if (!lat_only && half == 0) { moe_build_tab(F, cnt + 64, tab); nt_other = __builtin_amdgcn_readfirstlane(tab[64]); __syncthreads(); }
    moe_build_tab(F, cnt, tab);
    MoeSched<2, true> Sc; Sc.tab = tab; Sc.G = Gs; Sc.c = cs; Sc.half = half; Sc.list = (const unsigned long long*)(F.ws + WS_LIST);
    Sc.Abase = (const char*)(F.ws + WS_HMH); Sc.Bbase = (const char*)(F.ws + WS_W13); Sc.NT = __builtin_amdgcn_readfirstlane(tab[64]); Sc.lat_only = lat_only;
    Sc.sh_mode = lat_only ? 0 : (half == 0 ? 1 : 2); Sc.NT_other = nt_other;
    EpiUp E; E.H = (f16*)(F.ws + (half ? WS_Y : WS_H)); E.Hother = (f16*)(F.ws + (half ? WS_H : WS_Y));
    pg::gemm_phase<EpiUp, MoeSched<2, true>, true>(F.lds, F.wave, D, D, D, Sc, E);
}
__device__ __forceinline__ void moe_down_phase(Frame& F, int l, int half, int Gs, int cs) {
    LAS int* tab = (LAS int*)(F.lds + pg::STAGE_BYTES);
    const int* cnt = (const int*)(F.ws + WS_CTL) + CW_CNT + l * 128 + half * 64;
    moe_build_tab(F, cnt, tab);
    MoeSched<4, false> Sc; Sc.tab = tab; Sc.G = Gs; Sc.c = cs; Sc.half = half; Sc.list = (const unsigned long long*)(F.ws + WS_LIST);
    Sc.Abase = (const char*)(F.ws + (half ? WS_Y : WS_H)); Sc.Bbase = (const char*)(F.ws + WS_W2); Sc.NT = __builtin_amdgcn_readfirstlane(tab[64]); Sc.lat_only = l == DEPTH - 1; Sc.sh_mode = 0; Sc.NT_other = 0;
    EpiDown E; E.SL = (f16*)(F.ws + WS_SLOT); E.SH = (f16*)(F.ws + WS_SLSH); E.list = Sc.list; E.half = half; E.dry = F.dry;
    pg::gemm_phase<EpiDown, MoeSched<4, false>, true>(F.lds, F.wave, DEXP, DEXP, DEXP, Sc, E);
}
__device__ __forceinline__ void ln2_rows(Frame& F, CIN in, float* out, int l, int half) {
    const int gw = F.vcu * NWAVES + F.wave, NGW = F.G * NWAVES;
    float* X = (float*)(F.ws + WS_X); f16* HM = (f16*)(F.ws + WS_HMH); const unsigned char* SL8 = (const unsigned char*)(F.ws + WS_SLOT); const f16* SH = (const f16*)(F.ws + WS_SLSH);
    const float* mods = (const float*)(F.ws + WS_MODS) + (size_t)l * 9 * 6 * D;
    const f32x4* g4 = (const f32x4*)(INP(ln2_g) + l * D) + F.lane; const f32x4* b4 = (const f32x4*)(INP(ln2_b) + l * D) + F.lane;
    f32x4 gL[4], bL[4];
#pragma unroll
    for (int j = 0; j < 4; ++j) { gL[j] = g4[64 * j]; bL[j] = b4[64 * j]; }
    for (int th = gw; th < TH; th += NGW) {
        const int row = half * TH + th;
        if (l == DEPTH - 1 && row % SE >= S) continue;
        const float* m = mods + (size_t)mod_row(row) * 6 * D;
        f32x4* xr = (f32x4*)(X + (size_t)row * D) + F.lane;
        const f32x4* gt = (const f32x4*)(m + 5 * D) + F.lane;
        f32x4 v[4]; float s = 0.f;
        unsigned q[4][8]; h4 qs[4]; f32x4 xv[4], gv[4], shv[4], scv[4];
        const float* mn = mods + (size_t)9 * 6 * D + (size_t)mod_row(row) * 6 * D;
#pragma unroll
        for (int j = 0; j < 4; ++j) {
#pragma unroll
            for (int k = 0; k < 8; ++k) q[j][k] = *((const unsigned*)(SL8 + ((size_t)th * 8 + k) * D) + F.lane + 64 * j);
            qs[j] = *((const h4*)(SH + (size_t)th * D) + F.lane + 64 * j);
            xv[j] = xr[64 * j]; gv[j] = gt[64 * j];
            if (l + 1 < DEPTH) { shv[j] = ((const f32x4*)(mn) + F.lane)[64 * j]; scv[j] = ((const f32x4*)(mn + D) + F.lane)[64 * j]; }
        }
        asm volatile("" ::: "memory");
#pragma unroll
        for (int j = 0; j < 4; ++j) {
            f32x4 f = (f32x4){0.f, 0.f, 0.f, 0.f};
#pragma unroll
            for (int k = 0; k < 8; ++k) { const int w8 = (int)q[j][k]; f += (f32x4){__builtin_amdgcn_cvt_f32_fp8(w8, 0), __builtin_amdgcn_cvt_f32_fp8(w8, 1), __builtin_amdgcn_cvt_f32_fp8(w8, 2), __builtin_amdgcn_cvt_f32_fp8(w8, 3)}; }
            f = f * (1.f / SLOT_SC) + (f32x4){(float)qs[j][0], (float)qs[j][1], (float)qs[j][2], (float)qs[j][3]};
            v[j] = xv[j] * ALPHA + gv[j] * f; s += (v[j].x + v[j].y) + (v[j].z + v[j].w);
        }
        const float mean = wsum(s, F.lane) * (1.f / D); float s2 = 0.f;
#pragma unroll
        for (int j = 0; j < 4; ++j) { v[j] = v[j] - mean; s2 += (v[j].x * v[j].x + v[j].y * v[j].y) + (v[j].z * v[j].z + v[j].w * v[j].w); }
        const float rstd = 1.f / sqrtf(wsum(s2, F.lane) * (1.f / D) + LN_EPS);
#pragma unroll
        for (int j = 0; j < 4; ++j) { v[j] = v[j] * rstd * gL[j] + bL[j]; if (!F.dry) xr[64 * j] = v[j]; }
        if (l + 1 < DEPTH) {
            u32x2* o8 = (u32x2*)(HM + (size_t)row * D) + F.lane;
#pragma unroll
            for (int j = 0; j < 4; ++j) { const f32x4 h = v[j] * (scv[j] + 1.f) + shv[j]; u32x2 w; w.x = pkh(h.x, h.y); w.y = pkh(h.z, h.w); if (!F.dry) o8[64 * j] = w; }
        } else {
            const int b = row / SE, ii = row - b * SE;
            if (ii < S) { f32x4* o = (f32x4*)(out + ((size_t)b * S + ii) * D) + F.lane;
#pragma unroll
                for (int j = 0; j < 4; ++j) if (!F.dry) o[64 * j] = v[j]; }
        }
    }
}
#ifndef FFT_HD
#define FFT_HD __host__ __device__ __forceinline__
#endif
namespace fft {
constexpr int N = 8192, LOGN = 13, NPAD = N + N / 8;
FFT_HD int pidx(int i) { return i + (i >> 3); }
FFT_HD int brev(int k) { return (int)(__builtin_bitreverse32((unsigned)k) >> (32 - LOGN)); }
typedef float c2 __attribute__((ext_vector_type(2)));
FFT_HD c2 cmul(c2 a, c2 b) { return c2{a.x * b.x - a.y * b.y, a.x * b.y + a.y * b.x}; }
FFT_HD c2 cmulc(c2 a, c2 b) { return c2{a.x * b.x + a.y * b.y, a.y * b.x - a.x * b.y}; }
FFT_HD c2 tw(float frac) {
#if defined(__HIP_DEVICE_COMPILE__)
    return c2{__builtin_amdgcn_cosf(frac), -__builtin_amdgcn_sinf(frac)};
#else
    return c2{(float)cos(6.283185307179586 * (double)frac), (float)-sin(6.283185307179586 * (double)frac)};
#endif
}
template <int LOG, bool INV, class BP, class TP, bool HALF = false>
FFT_HD void pass_group(BP buf, TP tab, int h2, int gidx) {
    constexpr int R = 1 << LOG;
    const int hi = gidx / h2, lo = gidx - hi * h2, base = hi * (R * h2) + lo;
    c2 x[R];
#pragma unroll
    for (int m = 0; m < R; ++m) { if (HALF && !INV && m >= R / 2) x[m] = c2{0.f, 0.f}; else x[m] = buf[pidx(base + m * h2)]; }
    if (!INV) {
#pragma unroll
        for (int q = 0; q < LOG; ++q) { const int mq = R >> (q + 1); const int sc = N / (2 * mq * h2);
#pragma unroll
            for (int m = 0; m < R; ++m) if ((m & mq) == 0) { const c2 w = tab[pidx(((m % mq) * h2 + lo) * sc)]; const c2 a = x[m], b = x[m + mq];
                x[m] = c2{a.x + b.x, a.y + b.y}; x[m + mq] = cmul(c2{a.x - b.x, a.y - b.y}, w); } }
    } else {
#pragma unroll
        for (int q = LOG - 1; q >= 0; --q) { const int mq = R >> (q + 1); const int sc = N / (2 * mq * h2);
#pragma unroll
            for (int m = 0; m < R; ++m) if ((m & mq) == 0) { const c2 w = tab[pidx(((m % mq) * h2 + lo) * sc)]; const c2 a = x[m], t = cmulc(x[m + mq], w);
                x[m] = c2{a.x + t.x, a.y + t.y}; x[m + mq] = c2{a.x - t.x, a.y - t.y}; } }
    }
#pragma unroll
    for (int m = 0; m < R; ++m) if (!(HALF && INV && m >= R / 2)) buf[pidx(base + m * h2)] = x[m];
}
}
__device__ __forceinline__ void pro_mods(Frame& F, CIN in) {
    const int gw = F.vcu * NWAVES + F.wave, NGW = F.G * NWAVES, lane = F.lane;
    float* mods = (float*)(F.ws + WS_MODS);
    for (int task = gw; task < DEPTH * 96 * 16; task += NGW) {
        const int l = task / 1536, r0 = task - l * 1536, jb = r0 >> 4, kc = r0 & 15, col = jb * 64 + lane, k = kc * 64 + lane;
        float cv[9];
#pragma unroll
        for (int r = 0; r < 9; ++r) { const float v = r < 8 ? INP(c)[r * D + k] : INP(c_ctx)[k]; cv[r] = v / (1.f + expf(-v)); }
        float acc[9];
#pragma unroll
        for (int r = 0; r < 9; ++r) acc[r] = 0.f;
        const float* w = INP(w_ada) + ((size_t)l * D + kc * 64) * 6 * D + col;
#pragma unroll 4
        for (int kk = 0; kk < 64; ++kk) { const float wv = w[(size_t)kk * 6 * D];
#pragma unroll
            for (int r = 0; r < 9; ++r) acc[r] += __shfl(cv[r], kk) * wv; }
        const float bb = kc == 0 ? INP(b_ada)[l * 6 * D + col] : 0.f;
#pragma unroll
        for (int r = 0; r < 9; ++r) if (!F.dry) atomicAdd(&mods[((size_t)l * 9 + r) * 6 * D + col], acc[r] + bb);
    }
}
__device__ __forceinline__ void pro_init_x(Frame& F, CIN in) {
    const int gw = F.vcu * NWAVES + F.wave, NGW = F.G * NWAVES;
    float* X = (float*)(F.ws + WS_X);
    for (int row = gw; row < T; row += NGW) {
        const int b = row / SE, ii = row - b * SE;
        const f32x4* src = (const f32x4*)(ii < S ? INP(x) + ((size_t)b * S + ii) * D : INP(ctx) + ((size_t)b * CL + (ii - S)) * D) + F.lane;
        f32x4* dst = (f32x4*)(X + (size_t)row * D) + F.lane;
        f32x4 t4[4];
#pragma unroll
        for (int j = 0; j < 4; ++j) t4[j] = src[64 * j];
#pragma unroll
        for (int j = 0; j < 4; ++j) dst[64 * j] = t4[j];
    }
}
__device__ __forceinline__ void pro_z2(Frame& F, CIN in) {
    const int gw = F.vcu * NWAVES + F.wave, NGW = F.G * NWAVES, lane = F.lane;
    float* Z2 = (float*)(F.ws + WS_Z2);
    for (int task = gw; task < DEPTH * SE; task += NGW) {
        const int l = task / SE, ti = task - l * SE, L = ti < S ? S : CL, t = ti < S ? ti : ti - S;
        const float* w1 = INP(hy_w1) + l * 33 * 64; const float* w2 = INP(hy_w2) + l * 4096; const float* sf = INP(hy_sin_freq) + l * 128;
        const double PI2 = 6.283185307179586476925;
        const float tt = (float)((double)t / (double)(L - 1));
        const float ang = (float)(PI2 / (double)L) * (float)t;
        float a = INP(hy_b1)[l * 64 + lane];
        a += tt * w1[lane];
        for (int j = 0; j < 16; ++j) {
            const float band = (float)(1e-4 + (double)j * ((15.0 - 1e-4) / 15.0));
            const float arg = band * ang;
            a += cosf(arg) * w1[(1 + j) * 64 + lane];
            a += -sinf(arg) * w1[(17 + j) * 64 + lane];
        }
        const float z1 = sinf(sf[lane] * a);
        float a2 = INP(hy_b2)[l * 64 + lane];
        for (int i = 0; i < 64; ++i) a2 += __shfl(z1, i) * w2[i * 64 + lane];
        Z2[(size_t)task * 64 + lane] = sinf(sf[64 + lane] * a2);
    }
}
__device__ __forceinline__ void init_mod1_rows(Frame& F, CIN in) {
    const int gw = F.vcu * NWAVES + F.wave, NGW = F.G * NWAVES;
    float* X = (float*)(F.ws + WS_X); f16* HM = (f16*)(F.ws + WS_HMH);
    const float* mods = (const float*)(F.ws + WS_MODS);
    for (int row = gw; row < T; row += NGW) {
        const int b = row / SE, ii = row - b * SE;
        const f32x4* src = (const f32x4*)(ii < S ? INP(x) + ((size_t)b * S + ii) * D : INP(ctx) + ((size_t)b * CL + (ii - S)) * D) + F.lane;
        const float* m = mods + (size_t)(ii < S ? b : 8) * 6 * D;
        const f32x4* sh = (const f32x4*)(m) + F.lane; const f32x4* sc = (const f32x4*)(m + D) + F.lane;
        f32x4* dst = (f32x4*)(X + (size_t)row * D) + F.lane; u32x2* o8 = (u32x2*)(HM + (size_t)row * D) + F.lane;
        f32x4 xv[4], sv[4], cv[4];
#pragma unroll
        for (int j = 0; j < 4; ++j) { xv[j] = src[64 * j]; sv[j] = sh[64 * j]; cv[j] = sc[64 * j]; }
#pragma unroll
        for (int j = 0; j < 4; ++j) { dst[64 * j] = xv[j]; const f32x4 h = xv[j] * (cv[j] + 1.f) + sv[j]; u32x2 w; w.x = pkh(h.x, h.y); w.y = pkh(h.z, h.w); o8[64 * j] = w; }
    }
}
__device__ __forceinline__ void mod1_rows(Frame& F, int l) {
    const int gw = F.vcu * NWAVES + F.wave, NGW = F.G * NWAVES;
    const float* X = (const float*)(F.ws + WS_X); f16* HM = (f16*)(F.ws + WS_HMH);
    const float* mods = (const float*)(F.ws + WS_MODS) + (size_t)l * 9 * 6 * D;
    for (int row = gw; row < T; row += NGW) {
        const f32x4* xr = (const f32x4*)(X + (size_t)row * D) + F.lane;
        const float* m = mods + (size_t)mod_row(row) * 6 * D;
        const f32x4* sh = (const f32x4*)(m) + F.lane; const f32x4* sc = (const f32x4*)(m + D) + F.lane;
        u32x2* o8 = (u32x2*)(HM + (size_t)row * D) + F.lane;
        f32x4 xv[4], sv[4], cv[4];
#pragma unroll
        for (int j = 0; j < 4; ++j) { xv[j] = xr[64 * j]; sv[j] = sh[64 * j]; cv[j] = sc[64 * j]; }
#pragma unroll
        for (int j = 0; j < 4; ++j) { const f32x4 h = xv[j] * (cv[j] + 1.f) + sv[j]; u32x2 w; w.x = pkh(h.x, h.y); w.y = pkh(h.z, h.w); o8[64 * j] = w; }
    }
}

typedef LAS fft::c2* LBuf;
#define FFT_OPQ(t) asm volatile("" : "+v"(t))
typedef const LAS fft::c2* LTab;
constexpr int LDS_FFT_TAB = fft::NPAD * 8, LDS_FFT_END = LDS_FFT_TAB + (fft::N / 2 + fft::N / 16) * 8;
__device__ __forceinline__ void fft_fill_tab(LAS unsigned char* lds, int tid) {
    LAS fft::c2* tab = (LAS fft::c2*)(lds + LDS_FFT_TAB);
    for (int i = tid; i < fft::N / 2; i += NTHR) tab[fft::pidx(i)] = fft::tw((float)i * (1.0f / (float)fft::N));
    __syncthreads();
}
template <bool ZERO_UPPER>
__device__ __forceinline__ void fft_fwd(LBuf buf, int tid) {
    LTab tab = (LTab)((const LAS unsigned char*)buf + LDS_FFT_TAB);
    FFT_OPQ(tid); fft::pass_group<4, false, LBuf, LTab, ZERO_UPPER>(buf, tab, 512, tid); __syncthreads();
    FFT_OPQ(tid); fft::pass_group<3, false>(buf, tab, 64, tid); FFT_OPQ(tid); fft::pass_group<3, false>(buf, tab, 64, tid + 512); __syncthreads();
    FFT_OPQ(tid); fft::pass_group<3, false>(buf, tab, 8, tid); FFT_OPQ(tid); fft::pass_group<3, false>(buf, tab, 8, tid + 512); __syncthreads();
    FFT_OPQ(tid); fft::pass_group<3, false>(buf, tab, 1, tid); FFT_OPQ(tid); fft::pass_group<3, false>(buf, tab, 1, tid + 512); __syncthreads();
}
__device__ __forceinline__ void fft_inv(LBuf buf, int tid) {
    LTab tab = (LTab)((const LAS unsigned char*)buf + LDS_FFT_TAB);
    FFT_OPQ(tid); fft::pass_group<3, true>(buf, tab, 1, tid); FFT_OPQ(tid); fft::pass_group<3, true>(buf, tab, 1, tid + 512); __syncthreads();
    FFT_OPQ(tid); fft::pass_group<3, true>(buf, tab, 8, tid); FFT_OPQ(tid); fft::pass_group<3, true>(buf, tab, 8, tid + 512); __syncthreads();
    FFT_OPQ(tid); fft::pass_group<3, true>(buf, tab, 64, tid); FFT_OPQ(tid); fft::pass_group<3, true>(buf, tab, 64, tid + 512); __syncthreads();
    FFT_OPQ(tid); fft::pass_group<4, true, LBuf, LTab, true>(buf, tab, 512, tid); __syncthreads();
}
__device__ __forceinline__ float hy_delta(int c) { const float la = -3.0701134573253944f  , st = (-15.350567286626972f + 3.0701134573253944f) / 511.0f; return fabsf(la + (float)c * st); }
__device__ __forceinline__ void filters_phase(Frame& F, CIN in, int l) {
    LBuf buf = (LBuf)F.lds;
    LAS float* w3s = (LAS float*)(F.lds + LDS_FFT_END);
    fft_fill_tab(F.lds, F.tid);
    const float* Z2 = (const float*)(F.ws + WS_Z2) + (size_t)l * SE * 64;
    const float* w3 = INP(hy_w3) + (size_t)l * 64 * 1024;
    f32x4* SD = (f32x4*)(F.ws + WS_SD);
    for (int p = F.bid; p < 256; p += F.G) {
        int tid = F.tid; asm volatile("" : "+v"(tid));
        const int ca = 2 * p, cb = 2 * p + 1;
        __syncthreads();
        if (tid < 256) { const int j = tid & 63, which = tid >> 6; const int col = (which & 1 ? cb : ca) + (which >> 1 ? 512 : 0); w3s[which * 64 + j] = w3[j * 1024 + col]; }
        __syncthreads();
        const float da = hy_delta(ca), db = hy_delta(cb);
        for (int i = 0; i < 8; ++i) {
            const int t = tid + 512 * i;
            const f32x4* zr = (const f32x4*)(Z2 + (size_t)t * 64);
            float fa = 0.f, fb = 0.f, ba = 0.f, bb = 0.f;
#pragma unroll 4
            for (int j4 = 0; j4 < 16; ++j4) { const f32x4 z = zr[j4];
#pragma unroll
                for (int u = 0; u < 4; ++u) { const int j = 4 * j4 + u; fa += z[u] * w3s[j]; fb += z[u] * w3s[64 + j]; ba += z[u] * w3s[128 + j]; bb += z[u] * w3s[192 + j]; } }
            const float tt = (float)t * (1.0f / (float)(S - 1));
            const float ea = expf(-tt * da), eb = expf(-tt * db);
            buf[fft::pidx(t)] = fft::c2{fa * ea, fb * eb};
            if (t == 0) { const float zf = (float)(tid >> 16); buf[fft::pidx(S)] = fft::c2{zf, zf}; } else buf[fft::pidx(2 * S - t)] = fft::c2{ba * ea, bb * eb};
        }
        __syncthreads();
        fft_fwd<false>(buf, tid);
        for (int j = tid; j <= S; j += NTHR) {
            const int pos = j < S ? 2 * j : 1, k = fft::brev(pos);
            const fft::c2 Xk = buf[fft::pidx(pos)], Xp = buf[fft::pidx(fft::brev((fft::N - k) & (fft::N - 1)))];
            const float gar = 0.5f * (Xk.x + Xp.x), gai = 0.5f * (Xk.y - Xp.y);
            const float ur = Xk.x - Xp.x, ui = Xk.y + Xp.y;
            const float gbr = 0.5f * ui, gbi = -0.5f * ur;
            SD[(size_t)p * 4097 + j] = (f32x4){0.5f * (gar + gbr), 0.5f * (gai + gbi), 0.5f * (gar - gbr), 0.5f * (gai - gbi)};
        }
    }
    __syncthreads();
    const int gw = F.vcu * NWAVES + F.wave, NGW = F.G * NWAVES, lane = F.lane;
    float* GC = (float*)(F.ws + WS_GC);
    const float* Z2c = Z2 + (size_t)S * 64;
    for (int task = gw; task < CL * 16; task += NGW) {
        const int t = task >> 4, col = (task & 15) * 64 + lane;
        const float* zr = Z2c + (size_t)t * 64;
        float a = 0.f;
#pragma unroll 8
        for (int j = 0; j < 64; ++j) a += zr[j] * w3[j * 1024 + col];
        const int c = col & 511;
        const float tt = (float)t * (1.0f / (float)(CL - 1));
        const float v = a * expf(-tt * hy_delta(c));
        if (col < 512) GC[(size_t)c * 512 + 256 + t] = v; else if (t >= 1) GC[(size_t)c * 512 + 256 - t] = v;
    }
}

__device__ __forceinline__ void transpose_phase(Frame& F, CIN in, int l) {
    LAS f16* tile = (LAS f16*)F.lds;
    const f16* P = (const f16*)(F.ws + WS_P);
    f16* ZT = (f16*)(F.ws + WS_ZT); f16* VT = (f16*)(F.ws + WS_VT);
    const float* cw = INP(hy_conv_w) + l * 3 * 1536; const float* cbias = INP(hy_conv_b) + l * 1536;
    const int tid = F.tid, t = tid >> 3, cg = tid & 7;
    for (int task = F.bid; task < B * 68 * 4; task += F.G) {
        const int q = task & 3, r0 = task >> 2, tl = r0 % 68, b = r0 / 68;
        const int i = tl * 64 + t, lo = i < S ? 0 : S, hi = i < S ? S : SE;
        const f16* prow = P + ((size_t)b * SE + i) * DIN;
        const bool hasp = i - 1 >= lo, hasn = i + 1 < hi;
        h8 outv[4];
        if (q < 2) {
            h8 cur[4][2], prv[4][2], nxt[4][2];
#pragma unroll
            for (int u = 0; u < 4; ++u)
#pragma unroll
                for (int part = 0; part < 2; ++part) { const int col = 512 * (part + 1) + (4 * q + u) * 64 + cg * 8;
                    cur[u][part] = *(const h8*)(prow + col);
#pragma unroll
                    for (int j = 0; j < 8; ++j) { prv[u][part][j] = (f16)0.f; nxt[u][part][j] = (f16)0.f; }
                    if (hasp) prv[u][part] = *(const h8*)(prow - DIN + col);
                    if (hasn) nxt[u][part] = *(const h8*)(prow + DIN + col); }
#pragma unroll
            for (int u = 0; u < 4; ++u) { float z[8];
#pragma unroll
                for (int part = 0; part < 2; ++part) { const int col = 512 * (part + 1) + (4 * q + u) * 64 + cg * 8;
#pragma unroll
                    for (int j = 0; j < 8; ++j) { const float uu = (float)prv[u][part][j] * cw[col + j] + (float)cur[u][part][j] * cw[1536 + col + j] + (float)nxt[u][part][j] * cw[3072 + col + j] + cbias[col + j];
                        z[j] = part == 0 ? uu : z[j] * uu; } }
#pragma unroll
                for (int j = 0; j < 8; ++j) outv[u][j] = (f16)z[j]; }
        } else {
#pragma unroll
            for (int u = 0; u < 4; ++u) outv[u] = *(const h8*)(prow + OFF_NA + 1024 + (4 * (q - 2) + u) * 64 + cg * 8);
        }
        __syncthreads();
#pragma unroll
        for (int u = 0; u < 4; ++u)
#pragma unroll
            for (int j = 0; j < 8; ++j) tile[u * 4608 + (cg * 8 + j) * 72 + t] = outv[u][j];
        __syncthreads();
        {
            const int ch = tid >> 3, part = tid & 7;
#pragma unroll
            for (int u = 0; u < 4; ++u) {
                const h8 v = *(const LAS h8*)(tile + u * 4608 + ch * 72 + part * 8);
                const int cb = q < 2 ? 4 * q + u : 4 * (q - 2) + u;
                f16* dst = (q < 2 ? ZT : VT) + ((size_t)b * DH + cb * 64 + ch) * SE + tl * 64 + part * 8;
                *(h8*)dst = v; }
        }
    }
    __syncthreads();
}

__device__ __forceinline__ void fftconv_tasks(Frame& F, CIN in, int l, int pflags) {
    LBuf buf = (LBuf)F.lds;
    f16* ZT = (f16*)(F.ws + WS_ZT); const f16* VHT = (const f16*)(F.ws + WS_VHT);
    const f32x4* SD = (const f32x4*)(F.ws + WS_SD);
    const float* bd = INP(hy_bias_d) + l * DH;
    const float* cwl = INP(hy_conv_w) + l * 3 * 1536; const float* cbl = INP(hy_conv_b) + l * 1536;
    fft_fill_tab(F.lds, F.tid);
    for (int task = F.bid; task < B * 256; task += F.G) {
        int tid = F.tid; asm volatile("" : "+v"(tid));
        const int b = task & 7, p = task >> 3;
        f16* za = ZT + ((size_t)b * DH + 2 * p) * SE; f16* zb = za + SE;
        const f16* ha = VHT + ((size_t)b * DH + 2 * p) * SE; const f16* hb = ha + SE;
        const int t0 = tid * 8;
        h8 va, vb;
        {
            const h8 xa = *(const h8*)(za + t0), xb = *(const h8*)(zb + t0), wa = *(const h8*)(ha + t0), wb = *(const h8*)(hb + t0);
            const bool hp = t0 > 0, hn = t0 + 8 < S;
            const f16 zf = (f16)0.f;
            const f16 xap = hp ? za[t0 - 1] : zf, xan = hn ? za[t0 + 8] : zf, xbp = hp ? zb[t0 - 1] : zf, xbn = hn ? zb[t0 + 8] : zf;
            const f16 wap = hp ? ha[t0 - 1] : zf, wan = hn ? ha[t0 + 8] : zf, wbp = hp ? hb[t0 - 1] : zf, wbn = hn ? hb[t0 + 8] : zf;
            const int ca = 2 * p, cbb = 2 * p + 1;
            const float x1a0 = cwl[512 + ca], x1a1 = cwl[1536 + 512 + ca], x1a2 = cwl[3072 + 512 + ca], x1ab = cbl[512 + ca];
            const float x1b0 = cwl[512 + cbb], x1b1 = cwl[1536 + 512 + cbb], x1b2 = cwl[3072 + 512 + cbb], x1bb = cbl[512 + cbb];
            const float vha0 = cwl[1024 + ca], vha1 = cwl[1536 + 1024 + ca], vha2 = cwl[3072 + 1024 + ca], vhab = cbl[1024 + ca];
            const float vhb0 = cwl[1024 + cbb], vhb1 = cwl[1536 + 1024 + cbb], vhb2 = cwl[3072 + 1024 + cbb], vhbb = cbl[1024 + cbb];
#pragma unroll
            for (int j = 0; j < 8; ++j) {
                const float xa_m = (float)(j == 0 ? xap : xa[j == 0 ? 0 : j - 1]), xa_p = (float)(j == 7 ? xan : xa[j == 7 ? 7 : j + 1]);
                const float xb_m = (float)(j == 0 ? xbp : xb[j == 0 ? 0 : j - 1]), xb_p = (float)(j == 7 ? xbn : xb[j == 7 ? 7 : j + 1]);
                const float wa_m = (float)(j == 0 ? wap : wa[j == 0 ? 0 : j - 1]), wa_p = (float)(j == 7 ? wan : wa[j == 7 ? 7 : j + 1]);
                const float wb_m = (float)(j == 0 ? wbp : wb[j == 0 ? 0 : j - 1]), wb_p = (float)(j == 7 ? wbn : wb[j == 7 ? 7 : j + 1]);
                const float ua = xa_m * x1a0 + (float)xa[j] * x1a1 + xa_p * x1a2 + x1ab, ub = xb_m * x1b0 + (float)xb[j] * x1b1 + xb_p * x1b2 + x1bb;
                const float ya = wa_m * vha0 + (float)wa[j] * vha1 + wa_p * vha2 + vhab, yb = wb_m * vhb0 + (float)wb[j] * vhb1 + wb_p * vhb2 + vhbb;
                va[j] = (f16)(ua * ya); vb[j] = (f16)(ub * yb);
            }
        }
        f32x4 sdv[8];
#pragma unroll
        for (int i = 0; i < 8; ++i) sdv[i] = SD[(size_t)p * 4097 + tid + NTHR * i];
        __syncthreads();
#pragma unroll
        for (int j = 0; j < 8; ++j) buf[fft::pidx(t0 + j)] = fft::c2{(float)va[j], (float)vb[j]};
        __syncthreads();
        if (!(pflags & 128)) fft_fwd<true>(buf, tid);
#pragma unroll
        for (int i = 0; i < 9; ++i) {
            if (i < 8 || tid == 0) {
                const int pos = i < 8 ? 2 * (tid + NTHR * i) : 1, k = fft::brev(pos);
                const int pa = fft::pidx(pos), pp = fft::pidx(fft::brev((fft::N - k) & (fft::N - 1)));
                const fft::c2 Xk = buf[pa], Xp = buf[pp]; const f32x4 sd = i < 8 ? sdv[i < 8 ? i : 0] : SD[(size_t)p * 4097 + S];
                const fft::c2 Sv{sd[0], sd[1]}, Dv{sd[2], sd[3]};
                const fft::c2 t1 = fft::cmul(Xk, Sv), t2 = fft::cmul(fft::c2{Xp.x, -Xp.y}, Dv);
                const fft::c2 u1 = fft::cmulc(Xp, Sv), u2 = fft::cmulc(fft::c2{Xk.x, -Xk.y}, Dv);
                buf[pa] = fft::c2{t1.x + t2.x, t1.y + t2.y};
                if (pp != pa) buf[pp] = fft::c2{u1.x + u2.x, u1.y + u2.y};
            }
        }
        __syncthreads();
        if (!(pflags & 256)) fft_inv(buf, tid);
        const float ba = bd[2 * p], bb = bd[2 * p + 1];
        h8 oa, ob;
#pragma unroll
        for (int j = 0; j < 8; ++j) { const fft::c2 y = buf[fft::pidx(t0 + j)]; oa[j] = (f16)(y.x * (1.f / fft::N) + (float)va[j] * ba); ob[j] = (f16)(y.y * (1.f / fft::N) + (float)vb[j] * bb); }
        if (!F.dry) { *(h8*)(za + t0) = oa; *(h8*)(zb + t0) = ob; }
    }
    __syncthreads();
}
__device__ __forceinline__ void ctxconv_tasks(Frame& F, CIN in, int l) {
    const int gw = F.vcu * NWAVES + F.wave, NGW = F.G * NWAVES, lane = F.lane;
    f16* ZT = (f16*)(F.ws + WS_ZT); const f16* VHT = (const f16*)(F.ws + WS_VHT);
    const float* GC = (const float*)(F.ws + WS_GC);
    const float* cwl = INP(hy_conv_w) + l * 3 * 1536; const float* cbl = INP(hy_conv_b) + l * 1536;
    for (int task = gw; task < B * DH; task += NGW) {
        const int c = task & (DH - 1);
        f16* zp = ZT + (size_t)task * SE + S; const f16* hp = VHT + (size_t)task * SE + S;
        float zv[4], acc[4];
        {
            const float xw0 = cwl[512 + c], xw1 = cwl[1536 + 512 + c], xw2 = cwl[3072 + 512 + c], xbb = cbl[512 + c];
            const float vw0 = cwl[1024 + c], vw1 = cwl[1536 + 1024 + c], vw2 = cwl[3072 + 1024 + c], vbb = cbl[1024 + c];
#pragma unroll
            for (int j = 0; j < 4; ++j) { const int t = lane + 64 * j;
                const float xm = t > 0 ? (float)zp[t - 1] : 0.f, x0 = (float)zp[t], xp = t + 1 < CL ? (float)zp[t + 1] : 0.f;
                const float vm = t > 0 ? (float)hp[t - 1] : 0.f, v0 = (float)hp[t], vp = t + 1 < CL ? (float)hp[t + 1] : 0.f;
                zv[j] = (float)(f16)((xm * xw0 + x0 * xw1 + xp * xw2 + xbb) * (vm * vw0 + v0 * vw1 + vp * vw2 + vbb)); acc[j] = 0.f; }
        }
        const float* g = GC + (size_t)c * 512 + 256 + lane;
#pragma unroll
        for (int sj = 0; sj < 4; ++sj)
            for (int s0 = 0; s0 < 64; ++s0) { const float zs = bperm(s0, zv[sj]); const int s = sj * 64 + s0;
#pragma unroll
                for (int j = 0; j < 4; ++j) acc[j] += g[64 * j - s] * zs; }
        const float bdv = INP(hy_bias_d)[l * DH + c];
#pragma unroll
        for (int j = 0; j < 4; ++j) if (!F.dry) zp[lane + 64 * j] = (f16)(acc[j] + zv[j] * bdv);
    }
}
constexpr int AT_KP = 72, AT_VP = 264;
constexpr int AT_VOFF = 256 * AT_KP * 2;
constexpr int AT_RPB = AT_VOFF + 64 * AT_VP * 2;
template <bool LOCAL>
__device__ __forceinline__ void attn_wtask(Frame& F, const float* rpb_l, int b, int h, int r, int n, int qrow0, int pf = 0) {
    const int lane = lane_id(), fr = lane & 15, fq = lane >> 4;
    const f16* P = (const f16*)(F.ws + WS_P); const f16* VT = (const f16*)(F.ws + WS_VT); f16* Y = (f16*)(F.ws + WS_Y);
    const LAS f16* Kc = (const LAS f16*)F.lds; const LAS f16* VcT = (const LAS f16*)(F.lds + AT_VOFF);
    const int rs = r - 4 < 0 ? 0 : (r - 4 > 56 ? 56 : r - 4);
    const int kb = n == 0 ? 0 : (n == 1 ? 8 : (n == 2 ? 24 : 32));
    const f16* Pb = P + (size_t)b * SE * DIN;
    const f16* qp = Pb + (size_t)(qrow0 + fr) * DIN + OFF_NA + h * 64 + fq * 8;
    const h8 bq0 = *(const h8*)qp, bq1 = *(const h8*)(qp + 32);
    const char* kub = (const char*)(Pb + OFF_NA + 512 + h * 64);
    const unsigned klo = (unsigned)fq * 16u;
    const f16* vbase = VT + ((size_t)b * DH + h * 64 + fr) * SE + 8 * fq;
    const int ko = 8 * (fr >> 2) + (fr & 3);
    const int qc = 16 * n + fr; const int cs = qc - 8 < 0 ? 0 : (qc - 8 > 48 ? 48 : qc - 8);
    float mrun = -3.0e38f, lsum = 0.f;
    f32x4 o[4];
#pragma unroll
    for (int d = 0; d < 4; ++d) o[d] = (f32x4){0.f, 0.f, 0.f, 0.f};
    constexpr int NCH = LOCAL ? 2 : 1;
#pragma unroll
    for (int ch = 0; ch < NCH; ++ch) {
        if (LOCAL && ((ch == 0 && (pf & 8192)) || (ch == 1 && (pf & 16384)))) continue;
        const bool loc = LOCAL && ch == 0;
        f32x4 st[16];
        if (loc) {
            h8 kf[3][8];
#pragma unroll
            for (int g0 = 0; g0 < 2; ++g0)
#pragma unroll
                for (int q = 0; q < 4; ++q) { const int tl = 4 * g0 + q; const char* kp = kub + ((unsigned)((rs + (tl >> 1)) * 64 + kb + 4 * (tl & 1) + ko) * (unsigned)(DIN * 2) + klo); kf[g0][2 * q] = *(const h8*)kp; kf[g0][2 * q + 1] = *(const h8*)(kp + 64); }
#pragma unroll
            for (int g = 0; g < 4; ++g) {
                if (g + 2 < 4) {
#pragma unroll
                    for (int q = 0; q < 4; ++q) { const int tl = 4 * (g + 2) + q; const char* kp = kub + ((unsigned)((rs + (tl >> 1)) * 64 + kb + 4 * (tl & 1) + ko) * (unsigned)(DIN * 2) + klo);
                        kf[(g + 2) % 3][2 * q] = *(const h8*)kp; kf[(g + 2) % 3][2 * q + 1] = *(const h8*)(kp + 64); }
                }
                asm volatile("" ::: "memory");
#pragma unroll
                for (int q = 0; q < 4; ++q) { f32x4 acc = (f32x4){0.f, 0.f, 0.f, 0.f};
                    acc = __builtin_amdgcn_mfma_f32_16x16x32_f16(kf[g % 3][2 * q], bq0, acc, 0, 0, 0);
                    acc = __builtin_amdgcn_mfma_f32_16x16x32_f16(kf[g % 3][2 * q + 1], bq1, acc, 0, 0, 0);
                    st[4 * g + q] = acc; }
            }
        } else {
#pragma unroll
            for (int tl = 0; tl < 16; ++tl) {
                const LAS f16* kp = Kc + (32 * (tl >> 1) + 4 * (tl & 1) + ko) * AT_KP + fq * 8;
                const h8 a0 = *(const LAS h8*)kp, a1 = *(const LAS h8*)(kp + 32);
                f32x4 acc = (f32x4){0.f, 0.f, 0.f, 0.f};
                acc = __builtin_amdgcn_mfma_f32_16x16x32_f16(a0, bq0, acc, 0, 0, 0);
                acc = __builtin_amdgcn_mfma_f32_16x16x32_f16(a1, bq1, acc, 0, 0, 0);
                st[tl] = acc;
                if ((tl & 3) == 3) asm volatile("" ::: "memory");
            }
        }
        h8 vf[4][4];
        if (loc) {
#pragma unroll
            for (int pre = 0; pre < 3; ++pre)
#pragma unroll
                for (int d = 0; d < 4; ++d) vf[pre][d] = *(const h8*)(vbase + (size_t)d * 16 * SE + (rs + pre) * 64 + kb);
        }
        float mx = -3.0e38f;
        if (loc) {
            const LAS float* rp = (const LAS float*)(F.lds + AT_RPB) + h * 15 * 32;
            const int cbase = kb + 8 * fq - qc + 15;
#pragma unroll
            for (int sp = 0; sp < 8; ++sp) {
                const LAS float* rrow = rp + (rs + sp - r + 7) * 32;
                float bz[8];
#pragma unroll
                for (int e = 0; e < 8; ++e) { int ci = cbase + e; ci = ci < 0 ? 0 : (ci > 30 ? 30 : ci); bz[e] = rrow[ci]; }
#pragma unroll
                for (int e = 0; e < 8; ++e) { const int kcol = kb + 8 * fq + e; const bool ok = kcol >= cs && kcol < cs + 16;
                    const float sv = ok ? st[2 * sp + (e >> 2)][e & 3] * 0.125f + bz[e] : -1.0e30f;
                    st[2 * sp + (e >> 2)][e & 3] = sv; mx = fmaxf(mx, sv); }
            }
        } else {
#pragma unroll
            for (int tl = 0; tl < 16; ++tl)
#pragma unroll
                for (int i = 0; i < 4; ++i) { const float sv = st[tl][i] * 0.125f; st[tl][i] = sv; mx = fmaxf(mx, sv); }
        }
        mx = fmaxf(mx, SHX(mx, 16)); mx = fmaxf(mx, SHX(mx, 32));
        const float mnew = fmaxf(mrun, mx), alpha = __expf(mrun - mnew);
        mrun = mnew;
        float ps = 0.f;
#pragma unroll
        for (int tl = 0; tl < 16; ++tl)
#pragma unroll
            for (int i = 0; i < 4; ++i) { const float pv = __expf(st[tl][i] - mnew); st[tl][i] = pv; ps += pv; }
        ps += SHX(ps, 16); ps += SHX(ps, 32);
        lsum = lsum * alpha + ps;
        if (ch > 0) {
#pragma unroll
            for (int i = 0; i < 4; ++i) { const float al = bperm(4 * fq + i, alpha);
#pragma unroll
                for (int d = 0; d < 4; ++d) o[d][i] *= al; }
        }
        if (loc) {
#pragma unroll
            for (int sp = 0; sp < 8; ++sp) {
                if (sp + 3 < 8) {
#pragma unroll
                    for (int d = 0; d < 4; ++d) vf[(sp + 3) & 3][d] = *(const h8*)(vbase + (size_t)d * 16 * SE + (rs + sp + 3) * 64 + kb);
                }
                asm volatile("" ::: "memory");
                h8 pa;
#pragma unroll
                for (int i = 0; i < 4; ++i) { pa[i] = (f16)st[2 * sp][i]; pa[4 + i] = (f16)st[2 * sp + 1][i]; }
#pragma unroll
                for (int d = 0; d < 4; ++d) o[d] = __builtin_amdgcn_mfma_f32_16x16x32_f16(pa, vf[sp & 3][d], o[d], 0, 0, 0);
            }
        } else {
#pragma unroll
            for (int sp = 0; sp < 8; ++sp) {
                h8 pa;
#pragma unroll
                for (int i = 0; i < 4; ++i) { pa[i] = (f16)st[2 * sp][i]; pa[4 + i] = (f16)st[2 * sp + 1][i]; }
#pragma unroll
                for (int d = 0; d < 4; ++d) {
                    const h8 bv = *(const LAS h8*)(VcT + (16 * d + fr) * AT_VP + 32 * sp + 8 * fq);
                    o[d] = __builtin_amdgcn_mfma_f32_16x16x32_f16(pa, bv, o[d], 0, 0, 0);
                }
                if (sp & 1) asm volatile("" ::: "memory");
            }
        }
    }
    const float inv = 1.f / lsum;
    f16* yb = Y + ((size_t)b * SE + qrow0) * 1536 + 1024 + h * 64 + fr;
#pragma unroll
    for (int i = 0; i < 4; ++i) { const float sc = bperm(4 * fq + i, inv);
#pragma unroll
        for (int d = 0; d < 4; ++d) yb[(size_t)(4 * fq + i) * 1536 + 16 * d] = (f16)(o[d][i] * sc); }
}
__device__ __forceinline__ void attn_tasks(Frame& F, CIN in, int l, int pf) {
    const float* rpb_l = INP(na_rpb) + (size_t)l * NHEAD * 15 * 31;
    const f16* P = (const f16*)(F.ws + WS_P); const f16* VT = (const f16*)(F.ws + WS_VT);
    LAS f16* Kc = (LAS f16*)F.lds; LAS f16* VcT = (LAS f16*)(F.lds + AT_VOFF);
    constexpr int NBT = 64 * 34;
    { LAS float* rp = (LAS float*)(F.lds + AT_RPB); __syncthreads();
      for (int i = F.tid; i < NHEAD * 15 * 31; i += NTHR) { const int hh = i / 465, rem = i - hh * 465, ri = rem / 31, ci = rem - ri * 31; rp[(hh * 15 + ri) * 32 + ci] = rpb_l[i]; } }
    const int t_lo = (int)(((long)F.bid * NBT) / F.G), t_hi = (int)(((long)(F.bid + 1) * NBT) / F.G);
    int staged = -1;
    __syncthreads();
    for (int bt = t_lo; bt < t_hi; ++bt) {
        const int bh = bt / 34, j = bt - bh * 34, b = bh >> 3, h = bh & 7;
        if (bh != staged) {
            __syncthreads();
            const int tid = F.wave * 64 + lane_id();
            h8 tk[4], tv[4];
#pragma unroll
            for (int i = 0; i < 4; ++i) { const int idx = tid + NTHR * i, key = idx >> 3, part = idx & 7;
                tk[i] = *(const h8*)(P + ((size_t)b * SE + S + key) * DIN + OFF_NA + 512 + h * 64 + part * 8); }
#pragma unroll
            for (int i = 0; i < 4; ++i) { const int idx = tid + NTHR * i, d = idx >> 5, part = idx & 31;
                tv[i] = *(const h8*)(VT + ((size_t)b * DH + h * 64 + d) * SE + S + part * 8); }
#pragma unroll
            for (int i = 0; i < 4; ++i) { const int idx = tid + NTHR * i; *(LAS h8*)(Kc + (idx >> 3) * AT_KP + (idx & 7) * 8) = tk[i]; *(LAS h8*)(VcT + (idx >> 5) * AT_VP + (idx & 31) * 8) = tv[i]; }
            staged = bh;
            __syncthreads();
        }
        const int w = F.wave;
        if (j < 32) { const int r = 2 * j + (w >> 2), n = w & 3; attn_wtask<true>(F, rpb_l, b, h, r, n, r * 64 + 16 * n, pf); }
        else if (l + 1 < DEPTH) { const int qb = (j - 32) * 8 + w; attn_wtask<false>(F, rpb_l, b, h, 0, 0, S + 16 * qb); }
    }
    __syncthreads();
}

__device__ __forceinline__ void ymix_phase(Frame& F, CIN in, int l) {
    LAS f16* tile = (LAS f16*)F.lds;
    const f16* P = (const f16*)(F.ws + WS_P); const f16* ZT = (const f16*)(F.ws + WS_ZT); f16* Y = (f16*)(F.ws + WS_Y);
    const float* cw = INP(hy_conv_w) + l * 3 * 1536; const float* cbias = INP(hy_conv_b) + l * 1536; const float* scw = INP(sc_conv_w) + l * 3 * DH;
    const int tid = F.tid;
    {
        const int c0 = (tid & 63) * 8, rsub = tid >> 6;
        float w0[8], w1[8], w2[8];
#pragma unroll
        for (int j = 0; j < 8; ++j) { w0[j] = scw[c0 + j]; w1[j] = scw[512 + c0 + j]; w2[j] = scw[1024 + c0 + j]; }
        const int rows_per = (T + F.G - 1) / F.G, rbeg = F.bid * rows_per, rend = rbeg + rows_per < T ? rbeg + rows_per : T;
        for (int row = rbeg + rsub; row < rend; row += 8) {
            const int b = row / SE, i = row - b * SE, lo = i < S ? 0 : S, hi = i < S ? S : SE;
            const f16* ps = P + (size_t)row * DIN + OFF_SC + c0;
            const h8 bg = *(const h8*)ps, c1 = *(const h8*)(ps + 512), x1 = *(const h8*)(ps + 1024);
            h8 c0v, x0v, c2v, x2v;
#pragma unroll
            for (int j = 0; j < 8; ++j) { c0v[j] = (f16)0.f; x0v[j] = (f16)0.f; c2v[j] = (f16)0.f; x2v[j] = (f16)0.f; }
            if (i - 1 >= lo) { c0v = *(const h8*)(ps - DIN + 512); x0v = *(const h8*)(ps - DIN + 1024); }
            if (i + 1 < hi) { c2v = *(const h8*)(ps + DIN + 512); x2v = *(const h8*)(ps + DIN + 1024); }
            h8 o;
#pragma unroll
            for (int j = 0; j < 8; ++j) { const float v = (float)c0v[j] * (float)x0v[j] * w0[j] + (float)c1[j] * (float)x1[j] * w1[j] + (float)c2v[j] * (float)x2v[j] * w2[j];
                o[j] = (f16)((float)bg[j] * v); }
            *(h8*)(Y + (size_t)row * 1536 + 512 + c0) = o;
        }
    }
    const int t = tid >> 3, cg = tid & 7;
    for (int task = F.bid; task < B * 68 * 2; task += F.G) {
        const int q = task & 1, r0 = task >> 1, tl = r0 % 68, b = r0 / 68;
        const int i = tl * 64 + t, lo = i < S ? 0 : S, hi = i < S ? S : SE;
        const f16* prow = P + ((size_t)b * SE + i) * DIN;
        f16* yrow = Y + ((size_t)b * SE + i) * 1536;
        const bool hasp = i - 1 >= lo, hasn = i + 1 < hi;
        h8 yt[4], cur[4], prv[4], nxt[4];
        { const int ch = tid >> 3, part = tid & 7;
#pragma unroll
          for (int u = 0; u < 4; ++u) yt[u] = *(const h8*)(ZT + ((size_t)b * DH + (4 * q + u) * 64 + ch) * SE + tl * 64 + part * 8); }
#pragma unroll
        for (int u = 0; u < 4; ++u) { const int c0 = (4 * q + u) * 64 + cg * 8;
            cur[u] = *(const h8*)(prow + c0);
#pragma unroll
            for (int j = 0; j < 8; ++j) { prv[u][j] = (f16)0.f; nxt[u][j] = (f16)0.f; }
            if (hasp) prv[u] = *(const h8*)(prow - DIN + c0);
            if (hasn) nxt[u] = *(const h8*)(prow + DIN + c0); }
        __syncthreads();
        { const int ch = tid >> 3, part = tid & 7;
#pragma unroll
          for (int u = 0; u < 4; ++u) *(LAS h8*)(tile + u * 4608 + ch * 72 + part * 8) = yt[u]; }
        __syncthreads();
#pragma unroll
        for (int u = 0; u < 4; ++u) { const int c0 = (4 * q + u) * 64 + cg * 8; h8 o;
#pragma unroll
            for (int j = 0; j < 8; ++j) { const float x0 = (float)prv[u][j] * cw[c0 + j] + (float)cur[u][j] * cw[1536 + c0 + j] + (float)nxt[u][j] * cw[3072 + c0 + j] + cbias[c0 + j];
                o[j] = (f16)(x0 * (float)tile[u * 4608 + (cg * 8 + j) * 72 + t]); }
            *(h8*)(yrow + c0) = o; }
    }
    __syncthreads();
}

struct TileOrder {
    int nM, nN, nwg, G, c;
    __device__ __forceinline__ void init(int M, int N, int G_, int c_) { nM = M / 256; nN = N / 256; nwg = nM * nN; G = G_; c = c_; }
    __device__ __forceinline__ bool tile(int i, int& pm, int& pn) const {
        const long L = (long)i * G + c; if (L >= nwg) return false;
        int wgid = (int)L; { const int q = nwg / 8, r = nwg % 8, xcd = wgid % 8, off = wgid / 8; wgid = (xcd < r ? xcd * (q + 1) : r * (q + 1) + (xcd - r) * q) + off; }
        const int nig = 8 * nN, gid = wgid / nig, fm = gid * 8, gsz = (nM - fm) < 8 ? (nM - fm) : 8;
        pm = fm + ((wgid % nig) % gsz); pn = (wgid % nig) / gsz; return true;
    }
};
template <int SUB>
struct DenseSched {
    static constexpr bool GATHER = false;
    TileOrder O; const char* A; const char* Bm; int lda, ldb; size_t a_sub, b_sub; int lat_only;
    __device__ __forceinline__ bool next(int i, pg::Unit& u) const {
        const int ti = i / SUB, s = i - ti * SUB; int pm, pn;
        if (!O.tile(ti, pm, pn)) return false;
        if (lat_only) pm = (pm >> 4) * 17 + (pm & 15);
        u.pm = pm; u.pn = pn; u.e = s; u.nrows = 256; u.aux0 = 0;
        u.A = A + (size_t)pm * 256 * lda * 2 + s * a_sub; u.B = Bm + (size_t)pn * 256 * ldb * 2 + s * b_sub;
        return true;
    }
    __device__ __forceinline__ int arow(const pg::Unit&, int r) const { return r; }
};
struct EpiInproj {
    static constexpr bool PERM = true; static constexpr bool PERM2 = false; static constexpr int NVM = 16;
    __device__ __forceinline__ bool full(const pg::Unit&) const { return !dry; }
    f16* O; f16* X1T; f16* VHT; f16* VT; int dry;
    __device__ __forceinline__ void operator()(const f32x4 (&acc)[2][2][4][2], const pg::Unit& u, int wr, int wc, int fr, int fq) const {
        const int pn = u.pn;
        f16* tb = (pn == 2 || pn == 3) ? X1T : ((pn == 4 || pn == 5) ? VHT : ((pn == 16 || pn == 17) ? VT : nullptr));
        if (tb == nullptr) {
#pragma unroll
            for (int ai = 0; ai < 2; ++ai)
#pragma unroll
                for (int m = 0; m < 4; ++m) { f16* rowp = O + (size_t)(u.pm * 256 + ai * 128 + wr * 64 + m * 16 + fr) * DIN + pn * 256 + wc * 64 + 8 * fq;
#pragma unroll
                    for (int bj = 0; bj < 2; ++bj) { const f32x4 v0 = acc[ai][bj][m][0], v1 = acc[ai][bj][m][1];
                        u32x4 o; o.x = pkh(v0[0], v0[1]); o.y = pkh(v0[2], v0[3]); o.z = pkh(v1[0], v1[1]); o.w = pkh(v1[2], v1[3]);
                        if (!dry || o.x == 0x12345678u) *(u32x4*)(rowp + bj * 32) = o; } }
        } else {
            const int row_t = u.pm * 256, b = row_t / SE, i0 = row_t - b * SE;
            const int ch0 = (pn & 1) * 256 + wc * 64 + 8 * fq;
            f16* cb = tb + ((size_t)b * DH + ch0) * SE + i0 + wr * 64 + fr;
#pragma unroll
            for (int bj = 0; bj < 2; ++bj)
#pragma unroll
                for (int e = 0; e < 8; ++e) { f16* cp = cb + (size_t)(bj * 32 + e) * SE;
#pragma unroll
                    for (int ai = 0; ai < 2; ++ai)
#pragma unroll
                        for (int m = 0; m < 4; ++m) if (!dry) cp[ai * 128 + m * 16] = (f16)acc[ai][bj][m][e >> 2][e & 3]; }
        }
    }
};
struct EpiBranch {
    static constexpr bool PERM = true; static constexpr bool PERM2 = false; static constexpr int NVM = 16;
    __device__ __forceinline__ bool full(const pg::Unit&) const { return pf == 0; }
    const f16* P; f16* MG; u32x4* scr; int tid, pf;
    __device__ __forceinline__ void operator()(const f32x4 (&acc)[2][2][4][2], const pg::Unit& u, int wr, int wc, int fr, int fq) const {
        const int br = (pf & 512) ? 2 : u.e;
        const int col0 = u.pn * 256 + wc * 64 + 8 * fq;
        const size_t row0 = (size_t)(u.pm * 256 + wr * 64 + fr);
        const f16* gp = P + row0 * DIN + OFF_GATE + br * D + col0;
        f16* mp = MG + row0 * D + col0;
        u32x4* sp = scr + tid;
        h8 G[2][2]; u32x4 Sv[2][2];
        if (!(pf & 1024)) { G[0][0] = *(const h8*)gp; G[0][1] = *(const h8*)(gp + 32); } else { G[0][0] = __builtin_bit_cast(h8, (u32x4){(unsigned)fr, 0u, 0u, 0u}); G[0][1] = G[0][0]; G[1][0] = G[0][0]; G[1][1] = G[0][0]; }
        if (br == 1 || (br == 2 && !(pf & 512))) { Sv[0][0] = sp[0]; Sv[0][1] = sp[NTHR]; }
#pragma unroll
        for (int g = 0; g < 8; ++g) {
            const int ai = g >> 2, m = g & 3, cb = g & 1, nb = cb ^ 1;
            const f16* gpn = gp + ((m == 3 ? (size_t)(128 - 48) : (size_t)16) * DIN); u32x4* spn = sp + 2 * NTHR;
            if (g < 7) {
                if (!(pf & 1024)) { G[nb][0] = *(const h8*)gpn; G[nb][1] = *(const h8*)(gpn + 32); }
                if (br == 1 || (br == 2 && !(pf & 512))) { Sv[nb][0] = spn[0]; Sv[nb][1] = spn[NTHR]; }
            }
            asm volatile("" ::: "memory");
#pragma unroll
            for (int bj = 0; bj < 2; ++bj) {
                const h8 gg = G[cb][bj];
                f32x4 v0 = acc[ai][bj][m][0], v1 = acc[ai][bj][m][1];
#pragma unroll
                for (int j = 0; j < 4; ++j) { v0[j] *= sigm((float)gg[j]); v1[j] *= sigm((float)gg[4 + j]); }
                if (br == 1 || (br == 2 && !(pf & 512))) { const h8 pv = __builtin_bit_cast(h8, Sv[cb][bj]);
#pragma unroll
                    for (int j = 0; j < 4; ++j) { v0[j] += (float)pv[j]; v1[j] += (float)pv[4 + j]; } }
                u32x4 o; o.x = pkh(v0[0], v0[1]); o.y = pkh(v0[2], v0[3]); o.z = pkh(v1[0], v1[1]); o.w = pkh(v1[2], v1[3]);
                if (br < 2) sp[(size_t)bj * NTHR] = o; else if (!(pf & 2048)) *(u32x4*)(mp + bj * 32) = o;
            }
            gp = gpn; sp = spn; mp += (m == 3 ? (size_t)(128 - 48) : (size_t)16) * D;
            asm volatile("" : "+v"(gp), "+v"(mp), "+v"(sp) :: "memory");
        }
    }
};
struct EpiOut {
    static constexpr bool PERM = false; static constexpr bool PERM2 = false; static constexpr int NVM = 32;
    __device__ __forceinline__ bool full(const pg::Unit&) const { return !dry; }
    float* X; const float* mods_l; int dry;
    __device__ __forceinline__ void operator()(const f32x4 (&acc)[2][2][4][2], const pg::Unit& u, int wr, int wc, int fr, int fq) const {
        const int row_t = u.pm * 256;
        const float* gt = mods_l + (size_t)mod_row(row_t) * 6 * D + 2 * D + u.pn * 256 + wc * 32 + 4 * fq;
        f32x4 gv[2][2];
#pragma unroll
        for (int bj = 0; bj < 2; ++bj)
#pragma unroll
            for (int n = 0; n < 2; ++n) gv[bj][n] = *(const f32x4*)(gt + bj * 128 + n * 16);
        float* xp = X + (size_t)(row_t + wr * 64 + fr) * D + u.pn * 256 + wc * 32 + 4 * fq;
        f32x4 Xv[2][4];
#pragma unroll
        for (int q = 0; q < 4; ++q) Xv[0][q] = *(const f32x4*)(xp + (q >> 1) * 128 + (q & 1) * 16);
#pragma unroll
        for (int g = 0; g < 8; ++g) {
            const int ai = g >> 2, m = g & 3, cb = g & 1, nb = cb ^ 1;
            float* xpn = xp + (m == 3 ? (size_t)(128 - 48) : (size_t)16) * D;
            if (g < 7) {
#pragma unroll
                for (int q = 0; q < 4; ++q) Xv[nb][q] = *(const f32x4*)(xpn + (q >> 1) * 128 + (q & 1) * 16);
            }
            asm volatile("" ::: "memory");
#pragma unroll
            for (int bj = 0; bj < 2; ++bj)
#pragma unroll
                for (int n = 0; n < 2; ++n) { const f32x4 nv_ = Xv[cb][bj * 2 + n] * ALPHA + gv[bj][n] * acc[ai][bj][m][n]; if (!dry) *(f32x4*)(xp + bj * 128 + n * 16) = nv_; }
            xp = xpn;
            asm volatile("" : "+v"(xp) :: "memory");
        }
    }
};
__device__ __forceinline__ void inproj_phase(Frame& F) {
    DenseSched<1> Sc; Sc.lat_only = 0; Sc.O.init(T, DIN, F.G, F.bid); Sc.A = (const char*)(F.ws + WS_HMH); Sc.Bm = (const char*)(F.ws + WS_WIN); Sc.lda = D; Sc.ldb = D; Sc.a_sub = 0; Sc.b_sub = 0;
    EpiInproj E; E.O = (f16*)(F.ws + WS_P); E.X1T = (f16*)(F.ws + WS_ZT); E.VHT = (f16*)(F.ws + WS_VHT); E.VT = (f16*)(F.ws + WS_VT); E.dry = F.dry;
    pg::gemm_phase<EpiInproj, DenseSched<1>, false>(F.lds, F.wave, D, D, D, Sc, E);
}
__device__ __forceinline__ void branch_phase(Frame& F, int lat_only, int pf) {
    DenseSched<3> Sc; Sc.lat_only = lat_only; Sc.O.init(lat_only ? B * S : T, D, F.G, F.bid); Sc.A = (const char*)(F.ws + WS_Y); Sc.Bm = (const char*)(F.ws + WS_PJ); Sc.lda = 1536; Sc.ldb = DH; Sc.a_sub = (size_t)DH * 2; Sc.b_sub = (size_t)D * DH * 2;
    EpiBranch E; E.P = (const f16*)(F.ws + WS_P); E.MG = (f16*)(F.ws + WS_HMH); E.scr = (u32x4*)(F.ws + WS_SCR) + (size_t)F.bid * 16 * NTHR; E.tid = F.tid; E.pf = pf;
    pg::gemm_phase<EpiBranch, DenseSched<3>, true>(F.lds, F.wave, DH, 1536, DH, Sc, E);
}
__device__ __forceinline__ void outproj_phase(Frame& F, int l) {
    const int lat_only = l == DEPTH - 1;
    DenseSched<1> Sc; Sc.lat_only = lat_only; Sc.O.init(lat_only ? B * S : T, D, F.G, F.bid); Sc.A = (const char*)(F.ws + WS_HMH); Sc.Bm = (const char*)(F.ws + WS_WO); Sc.lda = D; Sc.ldb = D; Sc.a_sub = 0; Sc.b_sub = 0;
    EpiOut E; E.X = (float*)(F.ws + WS_X); E.mods_l = (const float*)(F.ws + WS_MODS) + (size_t)l * 9 * 6 * D; E.dry = F.dry;
    pg::gemm_phase<EpiOut, DenseSched<1>, false>(F.lds, F.wave, D, D, D, Sc, E);
}
constexpr int LDS_TAB_OFF = pg::STAGE_BYTES;
constexpr int LDS_MISC_OFF = LDS_TAB_OFF + 1024;
constexpr int LDS_BYTES = 147456;
constexpr int NPH_L = 13, NPHASE = 2 + NPH_L * DEPTH;
constexpr int FLAG_HYB_MOE = 1;
constexpr int FLAG_HYB_MIX = 2;
constexpr int FLAG_DRY = 4;

template <class P> __device__ __forceinline__ P launder_uniform(P p) {
    unsigned long long v = (unsigned long long)p; unsigned lo = (unsigned)v, hi = (unsigned)(v >> 32);
    unsigned vlo, vhi;
    asm volatile("v_mov_b32 %0, %2\n\tv_mov_b32 %1, %3" : "=&v"(vlo), "=&v"(vhi) : "s"(lo), "s"(hi));
    lo = __builtin_amdgcn_readfirstlane(vlo); hi = __builtin_amdgcn_readfirstlane(vhi);
    return (P)(((unsigned long long)hi << 32) | lo);
}
typedef unsigned* gu32p;
__device__ __forceinline__ int launder_int(int v) { int o; asm volatile("v_mov_b32 %0, %1" : "=v"(o) : "s"(v)); return __builtin_amdgcn_readfirstlane(o); }
__device__ __forceinline__ void launder(Frame& F, CArgsP& ap) { F.lane = lane_id(); asm volatile("" : "+v"(F.lane)); ap = launder_uniform((CArgsP)__builtin_amdgcn_kernarg_segment_ptr()); F.ws = (GAS unsigned char*)ap->ws; F.G = launder_int(F.G); F.bid = launder_int(F.bid); F.vcu = launder_int(F.vcu); F.wave = launder_int(F.wave); F.dry = launder_int(F.dry); F.tid = F.wave * 64 + F.lane; }
#ifndef MOE_SPLIT_NUM
#define MOE_SPLIT_NUM 144
#endif
#ifndef PROBE_REP
#define PROBE_REP -1
#endif
#ifndef PROBE_SLO
#define PROBE_SLO -1
#define PROBE_SHI -1
#endif
#define REP(k, ...) do { __VA_ARGS__; if (PROBE_REP == (k)) { __syncthreads(); __VA_ARGS__; } } while (0)
__global__ void __launch_bounds__(NTHR, 2) fwd(Args a_unused) {
    CArgsP ap = (CArgsP)__builtin_amdgcn_kernarg_segment_ptr();
    extern __shared__ __attribute__((aligned(16))) unsigned char lds_raw[];
    Frame F;
    F.lds = (LAS unsigned char*)lds_raw;
    F.tid = threadIdx.x; F.lane = F.tid & 63; F.wave = __builtin_amdgcn_readfirstlane(F.tid >> 6);
    F.G = gridDim.x; F.bid = blockIdx.x; { const int bx = blockIdx.x; F.vcu = (F.G % 8 == 0) ? (bx % 8) * (F.G / 8) + bx / 8 : bx; }
    F.ws = (GAS unsigned char*)ap->ws; F.dry = (ap->flags & FLAG_DRY) ? 1 : 0;
    for (int u = F.tid; u < (1024 + 64) / 4; u += NTHR) ((LAS unsigned*)(F.lds + LDS_TAB_OFF))[u] = 0u;
    __syncthreads();
    XcdBarrier bar; bar.bar = (unsigned*)(F.ws + WS_CTL) + CW_BAR; bar.x = 0; bar.st = nullptr;
    if (ap->use_bar) bar = xcd_barrier_post((unsigned*)(F.ws + WS_CTL) + CW_BAR, (volatile LAS unsigned*)(F.lds + LDS_MISC_OFF + 32), F.tid);
#define IN(k) (launder(F, ap), ap->ph_lo <= (k) && (k) < ap->ph_hi)
#define SEAM(k) do { if (IN(k) && IN((k) + 1)) { bar.bar = (unsigned*)((unsigned char*)F.ws + WS_CTL) + CW_BAR; bar.x = (unsigned)launder_int((int)bar.x); xcd_barrier(bar, F.tid); if (PROBE_REP == 99) xcd_barrier(bar, F.tid); } } while (0)
    if (IN(0)) { pro_mods(F, ap->in); pro_z2(F, ap->in); convert_mixer_weights(F, ap->in, 0); }
    SEAM(0);
    if (IN(1)) { filters_phase(F, ap->in, 0); init_mod1_rows(F, ap->in); }
    SEAM(1);
    unsigned long long tacc = 0ull, tst = 0ull;
#define ST_B(k) do { if (PROBE_SLO == (k)) tst = __builtin_amdgcn_s_memrealtime(); } while (0)
#define ST_E(k) do { if (PROBE_SHI == (k)) tacc += __builtin_amdgcn_s_memrealtime() - tst; } while (0)
    for (int l = 0; l < DEPTH; ++l) {
        const int pb = 2 + NPH_L * l;
        ST_B(0); if (IN(pb + 0)) REP(0, inproj_phase(F));
        SEAM(pb + 0); ST_E(0);
        ST_B(2); if (IN(pb + 2)) { if (!(ap->flags & 8)) { fftconv_tasks(F, ap->in, l, ap->flags); launder(F, ap); if (l + 1 < DEPTH && !(ap->flags & 4096)) ctxconv_tasks(F, ap->in, l); launder(F, ap); } if (!(ap->flags & 16)) REP(2, attn_tasks(F, ap->in, l, F.dry ? ap->flags : 0)); }
        SEAM(pb + 2); ST_E(2);
        ST_B(3); if (IN(pb + 3)) REP(3, ymix_phase(F, ap->in, l));
        SEAM(pb + 3); ST_E(3);
        ST_B(4); if (IN(pb + 4)) REP(4, branch_phase(F, l == DEPTH - 1, F.dry ? ap->flags : 0));
        SEAM(pb + 4); ST_E(4);
        ST_B(5); if (IN(pb + 5)) { convert_router(F, ap->in, l); outproj_phase(F, l); }
        SEAM(pb + 5); ST_E(5);
        ST_B(6); if (IN(pb + 6)) { if (!(ap->flags & 64)) ln1_router_phase(F, ap->in, l); __syncthreads(); if (!(ap->flags & 32)) convert_moe_weights(F, ap->in, l); }
        SEAM(pb + 6); ST_E(6);
        ST_B(8); if (IN(pb + 8)) moe_up_phase(F, l, 0, F.G, F.bid);
        SEAM(pb + 8); ST_E(8);
        ST_B(9); if (IN(pb + 9)) moe_down_phase(F, l, 0, F.G, F.bid);
        SEAM(pb + 9); ST_E(9);
        ST_B(10); if (IN(pb + 10)) { ln2_rows(F, ap->in, (float*)ap->out, l, 0); launder(F, ap); moe_up_phase(F, l, 1, F.G, F.bid); }
        SEAM(pb + 10); ST_E(10);
        ST_B(11); if (IN(pb + 11)) moe_down_phase(F, l, 1, F.G, F.bid);
        SEAM(pb + 11); ST_E(11);
        ST_B(12); if (IN(pb + 12)) {
            if (!(ap->flags & FLAG_HYB_MIX)) ln2_rows(F, ap->in, (float*)ap->out, l, 1);
            if (l + 1 < DEPTH && !(ap->flags & FLAG_HYB_MOE)) {
                __syncthreads(); convert_mixer_weights(F, ap->in, l + 1); __syncthreads(); filters_phase(F, ap->in, l + 1);
                if (ap->flags & FLAG_HYB_MIX) mod1_rows(F, l + 1);
            }
        }
        SEAM(pb + 12); ST_E(12);
    }
    if (PROBE_SLO >= 0) {
        gu32p dbg = (gu32p)((unsigned*)(F.ws + WS_CTL) + CW_DBG);
        bar.bar = (unsigned*)((unsigned char*)F.ws + WS_CTL) + CW_BAR; xcd_barrier(bar, F.tid);
        if (F.bid == 0 && F.tid == 0) __hip_atomic_store((unsigned*)dbg, (unsigned)tacc, __ATOMIC_RELAXED, __HIP_MEMORY_SCOPE_AGENT);
        xcd_barrier(bar, F.tid);
        const unsigned tv = __hip_atomic_load((unsigned*)dbg, __ATOMIC_RELAXED, __HIP_MEMORY_SCOPE_AGENT);
        const float v = sqrtf((float)tv * (1.0f / 100000.0f));
        float* o = (float*)ap->out;
        for (size_t i = (size_t)F.bid * NTHR + F.tid; i < (size_t)B * S * D; i += (size_t)F.G * NTHR) o[i] = v;
    }
#undef IN
#undef SEAM
}

static int g_grid = 0;
static bool setup_grid() {
    if (g_grid) return g_grid > 0;
    int dev = 0, cus = 0, per_cu = 0;
    if (hipGetDevice(&dev) != hipSuccess || hipDeviceGetAttribute(&cus, hipDeviceAttributeMultiprocessorCount, dev) != hipSuccess) { g_grid = -1; return false; }
    if (hipFuncSetAttribute((const void*)fwd, hipFuncAttributeMaxDynamicSharedMemorySize, LDS_BYTES) != hipSuccess) { fprintf(stderr, "hipFuncSetAttribute failed\n"); g_grid = -1; return false; }
    if (hipOccupancyMaxActiveBlocksPerMultiprocessor(&per_cu, (const void*)fwd, NTHR, LDS_BYTES) != hipSuccess || per_cu < 1) { fprintf(stderr, "occupancy query: %d\n", per_cu); (void)hipGetLastError(); g_grid = -1; return false; }
    g_grid = cus;
    return true;
}
static void launch_phases(const Args& base, int lo, int hi, int use_bar, hipStream_t st) {
    Args a = base; a.ph_lo = lo; a.ph_hi = hi; a.use_bar = use_bar;
    hipLaunchKernelGGL(fwd, dim3(g_grid), dim3(NTHR), LDS_BYTES, st, a);
}
}
#ifndef PROBE_XFLAGS
#define PROBE_XFLAGS 0
#endif
#ifndef PROBE_PH
#define PROBE_PH -1
#endif
#ifndef HYB
#define HYB 1
#endif
#ifndef GAS
#define GAS __attribute__((address_space(1)))
#endif
extern "C" void kernel_launch(void* const* d_in, const int* in_sizes, int n_in, void* d_out, int out_size, void* d_ws, size_t ws_size, hipStream_t stream) {
    if (n_in != 34 || ws_size < fk::WS_END + (size_t)64 * fk::MiB) { fprintf(stderr, "kernel_launch: unexpected inputs / workspace (%d, %zu)\n", n_in, ws_size); return; }
    nv::In in{};
    { const float** f = (const float**)&in; for (int i = 0; i < 34; ++i) f[i] = (const float*)d_in[i]; }
    fk::Args a{};
    { const float** f = (const float**)&a.in; for (int i = 0; i < 34; ++i) f[i] = (const float*)d_in[i]; }
    a.out = (GAS float*)d_out; a.ws = (unsigned char*)d_ws;
    if (!fk::setup_grid()) return;
    (void)hipMemsetAsync((char*)d_ws + fk::WS_CTL, 0, fk::CTL_ZERO_BYTES, stream);
    nv::Ctx c = nv::make_ctx((unsigned char*)d_ws, fk::WS_DYN);
#if HYB == 0
    nv::prologue(in, c, stream);
    for (int l = 0; l < 4; ++l) { nv::mixer_layer(in, c, l, stream); nv::moe_layer(in, c, l, stream); }
    nv::finalize(c, (float*)d_out, stream);
#elif HYB == 1
    a.flags = fk::FLAG_HYB_MOE;
    nv::prologue(in, c, stream);
    for (int l = 0; l < 4; ++l) {
        nv::mixer_layer(in, c, l, stream);
        const int pb = 2 + fk::NPH_L * l;
        for (int p = pb + 6; p <= pb + 12; ++p) fk::launch_phases(a, p, p + 1, 0, stream);
    }
#elif HYB == 2
    a.flags = fk::FLAG_HYB_MIX;
    fk::launch_phases(a, 0, 1, 0, stream); fk::launch_phases(a, 1, 2, 0, stream);
    for (int l = 0; l < 4; ++l) {
        const int pb = 2 + fk::NPH_L * l;
        for (int p = pb; p <= pb + 6; ++p) fk::launch_phases(a, p, p + 1, 0, stream);
        nv::moe_layer(in, c, l, stream);
        if (l < 3) fk::launch_phases(a, pb + 12, pb + 13, 0, stream);
    }
    nv::finalize(c, (float*)d_out, stream);
#elif HYB == 3
    for (int p = 0; p < fk::NPHASE; ++p) fk::launch_phases(a, p, p + 1, 0, stream);
#elif HYB == 5
    for (int p = 0; p < fk::NPHASE; ++p) {
        const bool hit = (PROBE_PH >= 100) ? (p == PROBE_PH - 100) : (p >= 2 && (p - 2) % fk::NPH_L == PROBE_PH);
        if (hit) { fk::Args d = a; d.flags |= fk::FLAG_DRY | PROBE_XFLAGS; fk::launch_phases(d, p, p + 1, 0, stream); }
        fk::launch_phases(a, p, p + 1, 0, stream);
    }
#elif HYB == 4
    fk::launch_phases(a, 0, fk::NPHASE, 1, stream);
#endif
}
```

```cpp
#define HYB 4
#define PROBE_REP -1
#define PROBE_SLO -1
#define PROBE_SHI -1
#define PROBE_PH -1
#define PROBE_XFLAGS 0

#include <hip/hip_runtime.h>
#include <cstdio>
#include <cstdint>
namespace nv {
constexpr int B = 8, S = 4096, CL = 256, SE = S + CL, T = B * SE, D = 1024, DEPTH = 4;
constexpr int DH = 512, DIN = 7680, OFF_SC = 1536, OFF_NA = 3072, OFF_GATE = 4608;
constexpr int NE = 64, TOPK = 8, DEXP = 256;
constexpr int GRIDW = 64, NHEAD = 8, HDIM = 64;
constexpr float LN_EPS = 1e-5f;
constexpr float ALPHA = 1.681792830507429f;

__device__ __forceinline__ float sigmoidf_(float x) { return 1.f / (1.f + expf(-x)); }
__device__ __forceinline__ float siluf_(float x) { return x / (1.f + expf(-x)); }
__device__ __forceinline__ float wsum(float v) {
#pragma unroll
    for (int o = 1; o < 64; o <<= 1) v += __shfl_xor(v, o);
    return v;
}
__device__ __forceinline__ float wmax(float v) {
#pragma unroll
    for (int o = 1; o < 64; o <<= 1) v = fmaxf(v, __shfl_xor(v, o));
    return v;
}

__global__ void k_cond(const float* c, const float* c_ctx, float* cond) {
    int i = blockIdx.x * blockDim.x + threadIdx.x;
    if (i < 9 * D) { float v = i < 8 * D ? c[i] : c_ctx[i - 8 * D]; cond[i] = siluf_(v); }
}
__global__ void k_mods(const float* cond, const float* w_ada, const float* b_ada, float* mods) {
    int j = blockIdx.x * blockDim.x + threadIdx.x;
    if (j >= DEPTH * 6 * D) return;
    int l = j / (6 * D), col = j % (6 * D);
    float acc[9];
#pragma unroll
    for (int r = 0; r < 9; ++r) acc[r] = 0.f;
    const float* w = w_ada + (size_t)l * D * 6 * D + col;
    for (int k = 0; k < D; ++k) { float wv = w[(size_t)k * 6 * D];
#pragma unroll
        for (int r = 0; r < 9; ++r) acc[r] += cond[r * D + k] * wv; }
    float bb = b_ada[l * 6 * D + col];
#pragma unroll
    for (int r = 0; r < 9; ++r) mods[((size_t)l * 9 + r) * 6 * D + col] = acc[r] + bb;
}
__global__ void k_init_x(const float* x, const float* ctx, float* X) {
    size_t i = (size_t)blockIdx.x * blockDim.x + threadIdx.x;
    if (i >= (size_t)T * D) return;
    int row = (int)(i / D), d = (int)(i % D), b = row / SE, ii = row % SE;
    X[i] = ii < S ? x[((size_t)b * S + ii) * D + d] : ctx[((size_t)b * CL + (ii - S)) * D + d];
}
__global__ void k_modulate(const float* X, const float* mods_l, float* HM, int which) {
    size_t i = (size_t)blockIdx.x * blockDim.x + threadIdx.x;
    if (i >= (size_t)T * D) return;
    int row = (int)(i / D), d = (int)(i % D), b = row / SE, ii = row % SE, mb = ii < S ? b : 8;
    const float* m = mods_l + (size_t)mb * 6 * D;
    HM[i] = X[i] * (1.f + m[(which + 1) * D + d]) + m[which * D + d];
}
struct GemmP { const float* A; int lda; const int* gidx; const float* Bm; int ldb; float* C; int ldc; int M; const int* Mdev; int N, K; int mode;
               const int* sidx; const float* sw; long long eB, eG; const int* coff; const int* aoff; };
__global__ void __launch_bounds__(256) k_gemm(GemmP p) {
    __shared__ float As[16][68];
    __shared__ float Bs[16][64];
    const int z = blockIdx.z;
    const int M = p.Mdev ? p.Mdev[z] : p.M;
    const int row0 = blockIdx.y * 64, col0 = blockIdx.x * 64;
    if (row0 >= M) return;
    const float* A = p.A; const float* Bm = p.Bm + (size_t)z * p.eB;
    const int* gidx = p.gidx ? p.gidx + (size_t)z * p.eG : nullptr;
    const int* sidx = p.sidx ? p.sidx + (size_t)z * p.eG : nullptr;
    const float* sw = p.sw ? p.sw + (size_t)z * p.eG : nullptr;
    const int crow_off = p.coff ? p.coff[z] : 0;
    const int arow_off = p.aoff ? p.aoff[z] : 0;
    float* C = p.C;
    const int tid = threadIdx.x, tx = tid & 15, ty = tid >> 4;
    const int ar = tid >> 2, ak = (tid & 3) * 4;
    const int bk = tid >> 4, bn = (tid & 15) * 4;
    int arow = row0 + ar; if (arow >= M) arow = M - 1;
    const size_t asrc = gidx ? (size_t)gidx[arow] : (size_t)(arow_off + arow);
    const float* ap = A + asrc * p.lda + ak;
    const float* bp = Bm + (size_t)bk * p.ldb + col0 + bn;
    float acc[4][4];
#pragma unroll
    for (int i = 0; i < 4; ++i)
#pragma unroll
        for (int j = 0; j < 4; ++j) acc[i][j] = 0.f;
    for (int k0 = 0; k0 < p.K; k0 += 16) {
        float4 av = *(const float4*)(ap + k0);
        float4 bv = *(const float4*)(bp + (size_t)k0 * p.ldb);
        As[ak + 0][ar] = av.x; As[ak + 1][ar] = av.y; As[ak + 2][ar] = av.z; As[ak + 3][ar] = av.w;
        *(float4*)&Bs[bk][bn] = bv;
        __syncthreads();
#pragma unroll
        for (int kk = 0; kk < 16; ++kk) {
            float4 a4 = *(const float4*)&As[kk][ty * 4];
            float4 b4 = *(const float4*)&Bs[kk][tx * 4];
            float a[4] = {a4.x, a4.y, a4.z, a4.w}, b[4] = {b4.x, b4.y, b4.z, b4.w};
#pragma unroll
            for (int i = 0; i < 4; ++i)
#pragma unroll
                for (int j = 0; j < 4; ++j) acc[i][j] += a[i] * b[j];
        }
        __syncthreads();
    }
#pragma unroll
    for (int i = 0; i < 4; ++i) {
        int r = row0 + ty * 4 + i; if (r >= M) continue;
        if (p.mode == 0) {
            float* cp = C + (size_t)(crow_off + r) * p.ldc + col0 + tx * 4;
            *(float4*)cp = make_float4(acc[i][0], acc[i][1], acc[i][2], acc[i][3]);
        } else {
            int tok = sidx[r]; float w = sw[r];
            float* cp = C + (size_t)tok * p.ldc + col0 + tx * 4;
#pragma unroll
            for (int j = 0; j < 4; ++j) atomicAdd(cp + j, w * acc[i][j]);
        }
    }
}
static void gemm(hipStream_t st, const float* A, int lda, const float* Bm, int ldb, float* C, int ldc, int M, int N, int K) {
    GemmP p{}; p.A = A; p.lda = lda; p.Bm = Bm; p.ldb = ldb; p.C = C; p.ldc = ldc; p.M = M; p.N = N; p.K = K; p.mode = 0;
    hipLaunchKernelGGL(k_gemm, dim3(N / 64, (M + 63) / 64, 1), dim3(256), 0, st, p);
}

__global__ void k_hy_z2(const float* w1, const float* b1, const float* w2, const float* b2, const float* sf, int L, float* z2tab) {
    const int t = blockIdx.x * (blockDim.x / 64) + (threadIdx.x >> 6), lane = threadIdx.x & 63;
    if (t >= L) return;
    const double PI2 = 6.283185307179586476925;
    float tt = (float)((double)t / (double)(L - 1));
    float ang = (float)(PI2 / (double)L) * (float)t;
    float a = b1[lane];
    a += tt * w1[0 * 64 + lane];
    for (int j = 0; j < 16; ++j) {
        float band = (float)(1e-4 + (double)j * ((15.0 - 1e-4) / 15.0));
        float arg = band * ang;
        a += cosf(arg) * w1[(1 + j) * 64 + lane];
        a += -sinf(arg) * w1[(17 + j) * 64 + lane];
    }
    float z1 = sinf(sf[lane] * a);
    float a2 = b2[lane];
    for (int i = 0; i < 64; ++i) a2 += __shfl(z1, i) * w2[i * 64 + lane];
    z2tab[(size_t)t * 64 + lane] = sinf(sf[64 + lane] * a2);
}
__global__ void k_hy_filt(const float* z2tab, const float* w3, int L, float* hf, float* hb) {
    int i = blockIdx.x * blockDim.x + threadIdx.x;
    if (i >= L * DH) return;
    int t = i / DH, c = i % DH;
    float af = 0.f, ab = 0.f;
    for (int j = 0; j < 64; ++j) { float z = z2tab[(size_t)t * 64 + j]; af += z * w3[j * 1024 + c]; ab += z * w3[j * 1024 + 512 + c]; }
    const double la = log(1e-2) / 1.5, lb = log(1e-2) / 0.3;
    float delta = fabsf((float)(la + (double)c * ((lb - la) / 511.0)));
    float tt = (float)((double)t / (double)(L - 1));
    float dec = expf(-tt * delta);
    hf[i] = af * dec; hb[i] = ab * dec;
}
__global__ void k_hy_conv(const float* PB, const float* cw, const float* cb, float* UC) {
    int idx = blockIdx.x * blockDim.x + threadIdx.x;
    if (idx >= SE * 1536) return;
    int i = idx / 1536, c = idx % 1536;
    int lo = i < S ? 0 : S, hi = i < S ? S : SE;
    float v = PB[(size_t)i * DIN + c] * cw[1536 + c];
    if (i - 1 >= lo) v += PB[(size_t)(i - 1) * DIN + c] * cw[c];
    if (i + 1 < hi) v += PB[(size_t)(i + 1) * DIN + c] * cw[2 * 1536 + c];
    UC[idx] = v + cb[c];
}
__global__ void k_hy_z(const float* UC, float* Z) {
    int idx = blockIdx.x * blockDim.x + threadIdx.x;
    if (idx >= SE * DH) return;
    int i = idx / DH, c = idx % DH;
    Z[idx] = UC[(size_t)i * 1536 + 1024 + c] * UC[(size_t)i * 1536 + 512 + c];
}
__global__ void k_hy_long(const float* Z, const float* UC, const float* hf, const float* hb, const float* hfc, const float* hbc, const float* bias_d, float* YHY) {
    int idx = blockIdx.x * blockDim.x + threadIdx.x;
    if (idx >= SE * DH) return;
    int i = idx / DH, c = idx % DH;
    int lo = i < S ? 0 : S, L = i < S ? S : CL;
    const float* f = i < S ? hf : hfc; const float* g = i < S ? hb : hbc;
    int t = i - lo;
    float acc = 0.f;
    for (int s = 0; s <= t; ++s) acc += f[(size_t)(t - s) * DH + c] * Z[(size_t)(lo + s) * DH + c];
    for (int s = t + 1; s < L; ++s) acc += g[(size_t)(s - t) * DH + c] * Z[(size_t)(lo + s) * DH + c];
    float z = Z[idx];
    YHY[idx] = UC[(size_t)i * 1536 + c] * (acc + z * bias_d[c]);
}
__global__ void k_sconv(const float* PB, const float* cw, float* YSC) {
    int idx = blockIdx.x * blockDim.x + threadIdx.x;
    if (idx >= SE * DH) return;
    int i = idx / DH, c = idx % DH;
    int lo = i < S ? 0 : S, hi = i < S ? S : SE;
    const float* p = PB + OFF_SC;
    float v = p[(size_t)i * DIN + 512 + c] * p[(size_t)i * DIN + 1024 + c] * cw[512 + c];
    if (i - 1 >= lo) v += p[(size_t)(i - 1) * DIN + 512 + c] * p[(size_t)(i - 1) * DIN + 1024 + c] * cw[c];
    if (i + 1 < hi) v += p[(size_t)(i + 1) * DIN + 512 + c] * p[(size_t)(i + 1) * DIN + 1024 + c] * cw[1024 + c];
    YSC[idx] = p[(size_t)i * DIN + c] * v;
}
__global__ void k_attn(const float* PB, const float* rpb, float* YAT) {
    const int wt = blockIdx.x * (blockDim.x / 64) + (threadIdx.x >> 6), lane = threadIdx.x & 63;
    if (wt >= SE * NHEAD) return;
    const int i = wt / NHEAD, h = wt % NHEAD;
    const float* Q = PB + OFF_NA + h * HDIM; const float* Kp = PB + OFF_NA + 512 + h * HDIM; const float* V = PB + OFF_NA + 1024 + h * HDIM;
    const float q = Q[(size_t)i * DIN + lane];
    float m = -3.0e38f, l = 0.f, o = 0.f;
    if (i < S) {
        const int r = i / GRIDW, qc = i % GRIDW;
        int rs = r - 4; rs = rs < 0 ? 0 : (rs > 56 ? 56 : rs);
        int cs = qc - 8; cs = cs < 0 ? 0 : (cs > 48 ? 48 : cs);
        for (int j = 0; j < 8; ++j) for (int kc = cs; kc < cs + 16; ++kc) {
            const int kt = (rs + j) * GRIDW + kc;
            float s = wsum(q * Kp[(size_t)kt * DIN + lane]) * 0.125f + rpb[(h * 15 + (rs + j - r + 7)) * 31 + (kc - qc + 15)];
            float mn = fmaxf(m, s), a = expf(m - mn), pp = expf(s - mn);
            l = l * a + pp; o = o * a + pp * V[(size_t)kt * DIN + lane]; m = mn;
        }
    }
    for (int kt = S; kt < SE; ++kt) {
        float s = wsum(q * Kp[(size_t)kt * DIN + lane]) * 0.125f;
        float mn = fmaxf(m, s), a = expf(m - mn), pp = expf(s - mn);
        l = l * a + pp; o = o * a + pp * V[(size_t)kt * DIN + lane]; m = mn;
    }
    YAT[(size_t)i * DH + h * HDIM + lane] = o / l;
}
__global__ void k_merge(const float* PB, const float* T0, const float* T1, const float* T2, float* MG) {
    int idx = blockIdx.x * blockDim.x + threadIdx.x;
    if (idx >= SE * D) return;
    int i = idx / D, c = idx % D;
    const float* g = PB + (size_t)i * DIN + OFF_GATE;
    MG[idx] = sigmoidf_(g[c]) * T0[idx] + sigmoidf_(g[D + c]) * T1[idx] + sigmoidf_(g[2 * D + c]) * T2[idx];
}
__global__ void k_res_ln(float* X, const float* O, const float* mods_l, int gate_idx, const float* lg, const float* lb, int row0, int n) {
    const int w = blockIdx.x * (blockDim.x / 64) + (threadIdx.x >> 6), lane = threadIdx.x & 63;
    if (w >= n) return;
    const int row = row0 + w, b = row / SE, ii = row % SE, mb = ii < S ? b : 8;
    const float* gt = mods_l + (size_t)mb * 6 * D + gate_idx * D;
    float v[16]; float s = 0.f;
#pragma unroll
    for (int j = 0; j < 16; ++j) { int d = lane + 64 * j; v[j] = ALPHA * X[(size_t)row * D + d] + gt[d] * O[(size_t)w * D + d]; s += v[j]; }
    const float mu = wsum(s) * (1.f / D); float q = 0.f;
#pragma unroll
    for (int j = 0; j < 16; ++j) { v[j] -= mu; q += v[j] * v[j]; }
    const float rstd = rsqrtf(wsum(q) * (1.f / D) + LN_EPS);
#pragma unroll
    for (int j = 0; j < 16; ++j) { int d = lane + 64 * j; X[(size_t)row * D + d] = v[j] * rstd * lg[d] + lb[d]; }
}
__global__ void k_route(const float* logits, const float* rbias, int* cnt, int* ltok, float* lw) {
    const int tok = blockIdx.x * (blockDim.x / 64) + (threadIdx.x >> 6), lane = threadIdx.x & 63;
    if (tok >= T) return;
    const float score = sigmoidf_(logits[(size_t)tok * NE + lane]);
    const float sel = score + rbias[lane];
    float m1 = sel;
    m1 = fmaxf(m1, __shfl_xor(m1, 1)); m1 = fmaxf(m1, __shfl_xor(m1, 2)); m1 = fmaxf(m1, __shfl_xor(m1, 4));
    unsigned long long eq = __ballot(sel == m1);
    const int g = lane >> 3;
    const unsigned geq = (unsigned)((eq >> (g * 8)) & 0xffull);
    const int first = __ffs(geq) - 1;
    float s2 = ((lane & 7) == first) ? -3.0e38f : sel;
    s2 = fmaxf(s2, __shfl_xor(s2, 1)); s2 = fmaxf(s2, __shfl_xor(s2, 2)); s2 = fmaxf(s2, __shfl_xor(s2, 4));
    const float gs = m1 + s2;
    int grank = 0;
    for (int gg = 0; gg < 8; ++gg) { float o = __shfl(gs, gg * 8); if (o > gs || (o == gs && gg < g)) ++grank; }
    const bool gsel = grank < 4;
    const float val = gsel ? sel : -3.0e38f;
    int rank = 0;
    for (int j = 0; j < 64; ++j) { float o = __shfl(val, j); if (o > val || (o == val && j < lane)) ++rank; }
    const bool chosen = gsel && rank < TOPK;
    const float tot = wsum(chosen ? score : 0.f);
    if (chosen) {
        const float w = score / tot * 2.5f;
        int pos = atomicAdd(&cnt[lane], 1);
        ltok[(size_t)lane * T + pos] = tok; lw[(size_t)lane * T + pos] = w;
    }
}
__global__ void k_prefix(const int* cnt, int* off) { if (threadIdx.x == 0) { int a = 0; for (int e = 0; e < NE; ++e) { off[e] = a; a += cnt[e]; } } }
__global__ void k_swiglu(const float* U1, const float* U3, float* H, size_t n) {
    size_t i = (size_t)blockIdx.x * blockDim.x + threadIdx.x;
    if (i < n) H[i] = siluf_(U1[i]) * U3[i];
}
__global__ void k_final(const float* X, float* out) {
    size_t i = (size_t)blockIdx.x * blockDim.x + threadIdx.x;
    if (i >= (size_t)B * S * D) return;
    int d = (int)(i % D); size_t r = i / D; int b = (int)(r / S), t = (int)(r % S);
    out[i] = X[((size_t)b * SE + t) * D + d];
}

struct In {
    const float *x, *c, *ctx, *c_ctx, *w_ada, *b_ada, *w_in, *hy_conv_w, *hy_conv_b, *hy_w1, *hy_b1, *hy_w2, *hy_b2, *hy_w3, *hy_sin_freq, *hy_bias_d,
        *hy_proj, *sc_conv_w, *sc_proj, *na_rpb, *na_proj, *w_o, *ln1_g, *ln1_b, *ln2_g, *ln2_b, *moe_router, *moe_bias, *moe_w1, *moe_w3, *moe_w2, *sh_w1, *sh_w3, *sh_w2;
};


struct Ctx {
    float *X, *HM, *cond, *mods, *MIX, *PB, *UC, *Z, *YB, *T0, *T1, *T2, *MG, *OB, *z2a, *z2c, *hf, *hb, *hfc, *hbc, *logits, *lw, *U1, *U3, *F, *YHY, *YSC, *YAT;
    int *cnt, *off, *ltok;
};
static Ctx make_ctx(unsigned char* ws, size_t dyn_off) {
    Ctx c{};
    c.X = (float*)(ws + (size_t)2 * 1024 * 1024); c.mods = (float*)(ws + (size_t)1024 * 1024); c.cond = (float*)(ws + (size_t)256 * 1024);
    size_t o = dyn_off; auto alloc = [&](size_t bytes) { size_t r = o; o += (bytes + 255) & ~(size_t)255; return (void*)(ws + r); };
    c.HM = (float*)alloc((size_t)T * D * 4);
    c.MIX = (float*)alloc((size_t)SE * 16384 * 4);
    c.PB = c.MIX; c.UC = c.PB + (size_t)SE * DIN; c.Z = c.UC + (size_t)SE * 1536; c.YB = c.Z + (size_t)SE * DH;
    c.T0 = c.YB + (size_t)SE * 1536; c.T1 = c.T0 + (size_t)SE * D; c.T2 = c.T1 + (size_t)SE * D; c.MG = c.T2 + (size_t)SE * D; c.OB = c.MG + (size_t)SE * D;
    c.z2a = (float*)alloc((size_t)S * 64 * 4); c.z2c = (float*)alloc((size_t)CL * 64 * 4);
    c.hf = (float*)alloc((size_t)S * DH * 4); c.hb = (float*)alloc((size_t)S * DH * 4);
    c.hfc = (float*)alloc((size_t)CL * DH * 4); c.hbc = (float*)alloc((size_t)CL * DH * 4);
    c.logits = (float*)alloc((size_t)T * NE * 4);
    c.cnt = (int*)alloc(256); c.off = (int*)alloc(256);
    c.ltok = (int*)alloc((size_t)NE * T * 4); c.lw = (float*)alloc((size_t)NE * T * 4);
    c.U1 = (float*)alloc((size_t)T * TOPK * DEXP * 4);
    c.U3 = c.MIX; c.F = c.MIX + (size_t)32 * 1024 * 1024;
    c.YHY = c.YB; c.YSC = c.YB + (size_t)SE * DH; c.YAT = c.YB + 2 * (size_t)SE * DH;
    return c;
}
static void prologue(const In& in, const Ctx& c, hipStream_t st) {
    hipLaunchKernelGGL(k_cond, dim3((9 * D + 255) / 256), dim3(256), 0, st, in.c, in.c_ctx, c.cond);
    hipLaunchKernelGGL(k_mods, dim3(DEPTH * 6 * D / 256), dim3(256), 0, st, c.cond, in.w_ada, in.b_ada, c.mods);
    hipLaunchKernelGGL(k_init_x, dim3((unsigned)(((size_t)T * D + 255) / 256)), dim3(256), 0, st, in.x, in.ctx, c.X);
}
static void mixer_layer(const In& in, const Ctx& c, int l, hipStream_t st) {
    const unsigned gTD = (unsigned)(((size_t)T * D + 255) / 256);
    const float* ml = c.mods + (size_t)l * 9 * 6 * D;
    hipLaunchKernelGGL(k_hy_z2, dim3(S / 4), dim3(256), 0, st, in.hy_w1 + l * 33 * 64, in.hy_b1 + l * 64, in.hy_w2 + l * 4096, in.hy_b2 + l * 64, in.hy_sin_freq + l * 128, S, c.z2a);
    hipLaunchKernelGGL(k_hy_z2, dim3(CL / 4), dim3(256), 0, st, in.hy_w1 + l * 33 * 64, in.hy_b1 + l * 64, in.hy_w2 + l * 4096, in.hy_b2 + l * 64, in.hy_sin_freq + l * 128, CL, c.z2c);
    hipLaunchKernelGGL(k_hy_filt, dim3(S * DH / 256), dim3(256), 0, st, c.z2a, in.hy_w3 + (size_t)l * 64 * 1024, S, c.hf, c.hb);
    hipLaunchKernelGGL(k_hy_filt, dim3(CL * DH / 256), dim3(256), 0, st, c.z2c, in.hy_w3 + (size_t)l * 64 * 1024, CL, c.hfc, c.hbc);
    hipLaunchKernelGGL(k_modulate, dim3(gTD), dim3(256), 0, st, c.X, ml, c.HM, 0);
    for (int b = 0; b < B; ++b) {
        gemm(st, c.HM + (size_t)b * SE * D, D, in.w_in + (size_t)l * D * DIN, DIN, c.PB, DIN, SE, DIN, D);
        hipLaunchKernelGGL(k_hy_conv, dim3(SE * 1536 / 256), dim3(256), 0, st, c.PB, in.hy_conv_w + l * 3 * 1536, in.hy_conv_b + l * 1536, c.UC);
        hipLaunchKernelGGL(k_hy_z, dim3(SE * DH / 256), dim3(256), 0, st, c.UC, c.Z);
        hipLaunchKernelGGL(k_hy_long, dim3(SE * DH / 256), dim3(256), 0, st, c.Z, c.UC, c.hf, c.hb, c.hfc, c.hbc, in.hy_bias_d + l * DH, c.YHY);
        hipLaunchKernelGGL(k_sconv, dim3(SE * DH / 256), dim3(256), 0, st, c.PB, in.sc_conv_w + l * 3 * DH, c.YSC);
        hipLaunchKernelGGL(k_attn, dim3(SE * NHEAD / 4), dim3(256), 0, st, c.PB, in.na_rpb + l * NHEAD * 15 * 31, c.YAT);
        gemm(st, c.YHY, DH, in.hy_proj + (size_t)l * DH * D, D, c.T0, D, SE, D, DH);
        gemm(st, c.YSC, DH, in.sc_proj + (size_t)l * DH * D, D, c.T1, D, SE, D, DH);
        gemm(st, c.YAT, DH, in.na_proj + (size_t)l * DH * D, D, c.T2, D, SE, D, DH);
        hipLaunchKernelGGL(k_merge, dim3(SE * D / 256), dim3(256), 0, st, c.PB, c.T0, c.T1, c.T2, c.MG);
        gemm(st, c.MG, D, in.w_o + (size_t)l * D * D, D, c.OB, D, SE, D, D);
        hipLaunchKernelGGL(k_res_ln, dim3(SE / 4), dim3(256), 0, st, c.X, c.OB, ml, 2, in.ln1_g + l * D, in.ln1_b + l * D, b * SE, SE);
    }
}
static void moe_layer(const In& in, const Ctx& c, int l, hipStream_t st) {
    const unsigned gTD = (unsigned)(((size_t)T * D + 255) / 256);
    const float* ml = c.mods + (size_t)l * 9 * 6 * D;
    hipLaunchKernelGGL(k_modulate, dim3(gTD), dim3(256), 0, st, c.X, ml, c.HM, 3);
    gemm(st, c.HM, D, in.moe_router + (size_t)l * D * NE, NE, c.logits, NE, T, NE, D);
    (void)hipMemsetAsync(c.cnt, 0, 256, st);
    hipLaunchKernelGGL(k_route, dim3(T / 4), dim3(256), 0, st, c.logits, in.moe_bias + l * NE, c.cnt, c.ltok, c.lw);
    hipLaunchKernelGGL(k_prefix, dim3(1), dim3(64), 0, st, c.cnt, c.off);
    {
        GemmP p{}; p.A = c.HM; p.lda = D; p.gidx = c.ltok; p.eG = T; p.ldb = DEXP; p.ldc = DEXP; p.Mdev = c.cnt; p.N = DEXP; p.K = D; p.mode = 0; p.eB = (long long)D * DEXP; p.coff = c.off;
        p.Bm = in.moe_w1 + (size_t)l * NE * D * DEXP; p.C = c.U1;
        hipLaunchKernelGGL(k_gemm, dim3(DEXP / 64, T / 64, NE), dim3(256), 0, st, p);
        p.Bm = in.moe_w3 + (size_t)l * NE * D * DEXP; p.C = c.U3;
        hipLaunchKernelGGL(k_gemm, dim3(DEXP / 64, T / 64, NE), dim3(256), 0, st, p);
    }
    hipLaunchKernelGGL(k_swiglu, dim3((unsigned)(((size_t)T * TOPK * DEXP + 255) / 256)), dim3(256), 0, st, c.U1, c.U3, c.U1, (size_t)T * TOPK * DEXP);
    {
        float* V1 = c.U3; float* V3 = c.U3 + (size_t)T * DEXP;
        gemm(st, c.HM, D, in.sh_w1 + (size_t)l * D * DEXP, DEXP, V1, DEXP, T, DEXP, D);
        gemm(st, c.HM, D, in.sh_w3 + (size_t)l * D * DEXP, DEXP, V3, DEXP, T, DEXP, D);
        hipLaunchKernelGGL(k_swiglu, dim3((unsigned)(((size_t)T * DEXP + 255) / 256)), dim3(256), 0, st, V1, V3, V1, (size_t)T * DEXP);
        gemm(st, V1, DEXP, in.sh_w2 + (size_t)l * DEXP * D, D, c.F, D, T, D, DEXP);
    }
    {
        GemmP p{}; p.A = c.U1; p.lda = DEXP; p.aoff = c.off; p.sidx = c.ltok; p.sw = c.lw; p.eG = T; p.Bm = in.moe_w2 + (size_t)l * NE * DEXP * D; p.ldb = D; p.C = c.F; p.ldc = D; p.Mdev = c.cnt; p.N = D; p.K = DEXP; p.mode = 1;
        p.eB = (long long)DEXP * D;
        hipLaunchKernelGGL(k_gemm, dim3(D / 64, T / 64, NE), dim3(256), 0, st, p);
    }
    hipLaunchKernelGGL(k_res_ln, dim3(T / 4), dim3(256), 0, st, c.X, c.F, ml, 5, in.ln2_g + l * D, in.ln2_b + l * D, 0, T);
}
static void finalize(const Ctx& c, float* out, hipStream_t st) {
    hipLaunchKernelGGL(k_final, dim3((unsigned)(((size_t)B * S * D + 255) / 256)), dim3(256), 0, st, c.X, out);
}
}
namespace fk {
#define LAS __attribute__((address_space(3)))
#define GAS __attribute__((address_space(1)))
typedef _Float16 f16;
typedef _Float16 h8 __attribute__((ext_vector_type(8)));
typedef _Float16 h4 __attribute__((ext_vector_type(4)));
typedef _Float16 h2 __attribute__((ext_vector_type(2)));
typedef float f32x4 __attribute__((ext_vector_type(4)));
typedef float f32x2 __attribute__((ext_vector_type(2)));
typedef unsigned u32x4 __attribute__((ext_vector_type(4)));
typedef unsigned u32x2 __attribute__((ext_vector_type(2)));

constexpr int B = 8, S = 4096, CL = 256, SE = S + CL, T = B * SE, D = 1024, DEPTH = 4;
constexpr int DH = 512, DIN = 7680, OFF_SC = 1536, OFF_NA = 3072, OFF_GATE = 4608;
constexpr int NE = 64, TOPK = 8, DEXP = 256;
constexpr int GRIDW = 64, NHEAD = 8, HDIM = 64;
constexpr float LN_EPS = 1e-5f;
constexpr float ALPHA = 1.681792830507429f;
constexpr int NWAVES = 8, NTHR = 512;
constexpr int TH = T / 2;
constexpr int MAXT_H = TH * TOPK / 256 + NE;
constexpr int SH_T = TH / 256;

__device__ __forceinline__ unsigned pkh(float a, float b) { f32x2 v = {a, b}; h2 h = __builtin_convertvector(v, h2); return __builtin_bit_cast(unsigned, h); }
__device__ __forceinline__ float sigm(float x) { return __builtin_amdgcn_rcpf(1.f + __expf(-x)); }
__device__ __forceinline__ float bperm(int src, float v) { return __int_as_float(__builtin_amdgcn_ds_bpermute(src << 2, __float_as_int(v))); }
__device__ __forceinline__ int bpermi(int src, int v) { return __builtin_amdgcn_ds_bpermute(src << 2, v); }
#define SHX(v, o) bperm(lane ^ (o), (v))
__device__ __forceinline__ float wsum(float v, int lane) {
#pragma unroll
    for (int o = 1; o < 64; o <<= 1) v += SHX(v, o);
    return v;
}
__device__ __forceinline__ int lane_id() { int v; asm volatile("v_mbcnt_lo_u32_b32 %0, -1, 0\n\tv_mbcnt_hi_u32_b32 %0, -1, %0" : "=v"(v)); return v; }
#define LDS_WAIT() asm volatile("s_waitcnt lgkmcnt(0)" ::: "memory")
#define VM_WAIT() asm volatile("s_waitcnt vmcnt(0)" ::: "memory")

#define XB_TMO      128
#define XB_XCNT(j)  (256  + 64 * (j))
#define XB_XSUB(j)  (1280 + 64 * (j))
#define XB_XGEN(j)  (2304 + 64 * (j))
#define XB_TOP      3328
#define XB_TOPGEN   3392
#define XCD_BAR_WORDS 3456
#define XB_SPIN_CAP (1u << 18)
__device__ __forceinline__ unsigned xb_ld(unsigned* p)              { return __hip_atomic_load(p, __ATOMIC_RELAXED, __HIP_MEMORY_SCOPE_AGENT); }
__device__ __forceinline__ unsigned xb_add(unsigned* p, unsigned v) { return __hip_atomic_fetch_add(p, v, __ATOMIC_RELAXED, __HIP_MEMORY_SCOPE_AGENT); }
__device__ __forceinline__ unsigned xb_xcc_id() { return (unsigned)__builtin_amdgcn_s_getreg((3 << 11) | 20) & 0xFu; }
#define XB_SPIN(cond, bar) do { unsigned _sp = 0; while (cond) { __builtin_amdgcn_s_sleep(1); \
    if ((++_sp & 255u) == 0u) { if (xb_ld(&(bar)[XB_TMO])) break; if (_sp > XB_SPIN_CAP) { atomicAdd(&(bar)[XB_TMO], 1u); break; } } } } while (0)
struct XcdBarrier { unsigned* bar; unsigned x; volatile LAS unsigned* st; };
__device__ __forceinline__ XcdBarrier xcd_barrier_post(unsigned* bar, volatile LAS unsigned* st, int tid) {
    XcdBarrier b; b.bar = bar; b.x = xb_xcc_id(); b.st = st;
    if (tid == 0) (void)xb_add(&bar[XB_XCNT(b.x)], 1u);
    return b;
}
__device__ __forceinline__ void xcd_barrier_complete(unsigned* bar, unsigned x, unsigned& nloc, unsigned& nx) {
    const unsigned G = gridDim.x * gridDim.y * gridDim.z;
    unsigned sum, cnt, mine, sp = 0u;
    for (;;) {
        sum = 0u; cnt = 0u; mine = 0u;
#pragma unroll
        for (unsigned j = 0; j < 16; ++j) { const unsigned c = xb_ld(&bar[XB_XCNT(j)]); sum += c; cnt += (c > 0u) ? 1u : 0u; mine = (j == x) ? c : mine; }
        if (sum == G) break;
        __builtin_amdgcn_s_sleep(1);
        if ((++sp & 255u) == 0u) { if (xb_ld(&bar[XB_TMO])) break; if (sp > XB_SPIN_CAP) { atomicAdd(&bar[XB_TMO], 1u); break; } }
    }
    nloc = mine > 0u ? mine : 1u; nx = cnt > 0u ? cnt : 1u;
}
__device__ __forceinline__ void xcd_barrier(const XcdBarrier& b, int tid) {
    asm volatile("s_waitcnt vmcnt(0)" ::: "memory");
    __syncthreads();
    if (tid == 0) {
        unsigned* bar = b.bar;
        __builtin_amdgcn_s_waitcnt(0);
        unsigned nloc = b.st[0], nx = b.st[1];
        if (nloc == 0u) { xcd_barrier_complete(bar, b.x, nloc, nx); b.st[0] = nloc; b.st[1] = nx; }
        const unsigned old = xb_add(&bar[XB_XSUB(b.x)], 1u);
        const unsigned gen = old / nloc;
        if (old + 1u == (gen + 1u) * nloc) {
            __builtin_amdgcn_fence(__ATOMIC_RELEASE, "agent");
            asm volatile("s_waitcnt vmcnt(0)" ::: "memory");
            const unsigned og = xb_add(&bar[XB_TOP], 1u);
            const unsigned tg = og / nx;
            if (og + 1u == (tg + 1u) * nx) xb_add(&bar[XB_TOPGEN], 1u);
            else XB_SPIN(xb_ld(&bar[XB_TOPGEN]) == tg, bar);
            __builtin_amdgcn_fence(__ATOMIC_ACQUIRE, "agent");
            xb_add(&bar[XB_XGEN(b.x)], 1u);
            asm volatile("s_waitcnt vmcnt(0)" ::: "memory");
        } else {
            XB_SPIN(xb_ld(&bar[XB_XGEN(b.x)]) == gen, bar);
            __builtin_amdgcn_fence(__ATOMIC_ACQUIRE, "agent");
            asm volatile("s_waitcnt vmcnt(0)" ::: "memory");
        }
    }
    __syncthreads();
}

namespace pg {
constexpr int BM = 256, BK = 64, HALF = 128, HTB = HALF * BK * 2, STAGE_BYTES = 8 * HTB;
__host__ __device__ __forceinline__ int lds_byte(int r, int c) { const int st = (r >> 4) * 2 + (c >> 5), rr = r & 15, cc = c & 31, ob = rr * 64 + cc * 2; return st * 1024 + (ob ^ (((ob >> 9) & 1) << 5)); }
__host__ __device__ __forceinline__ void stage_rc(int b, int& R, int& C) { const int st = b / 1024, sb = b % 1024, swz = sb ^ (((sb >> 9) & 1) << 5); R = (st >> 1) * 16 + swz / 64; C = (st & 1) * 32 + (swz % 64) / 2; }
__host__ __device__ __forceinline__ int perm32(int rho) { const int n = rho >> 4, i = rho & 15; return 8 * (i >> 2) + 4 * n + (i & 3); }

struct Unit { const char* A; const char* B; int pm, pn, e, nrows, aux0; };

template <int N> __device__ __forceinline__ void wait_vm() { asm volatile("s_waitcnt vmcnt(%0)" :: "n"(N) : "memory"); }
template <class Epi, class Sched, bool ALIGN_EPI>
__device__ __forceinline__ void gemm_phase(LAS unsigned char* lds, const int wave, const int K, const int lda, const int ldb, const Sched& S, const Epi& E) {
    int tid_ = wave * 64 + lane_id(); asm volatile("" : "+v"(tid_));
    const int tid = tid_, wid = __builtin_amdgcn_readfirstlane(tid >> 6), lane = tid & 63, wr = wid >> 2, wc = wid & 3, fr = lane & 15, fq = lane >> 4;
    const int nt = K / BK;
    int sR[2], sC[2];
    unsigned voffB[2];
#pragma unroll
    for (int i = 0; i < 2; ++i) { int R, C; stage_rc(tid * 16 + i * 8192, R, C); sR[i] = R; sC[i] = C; const int p32 = perm32(R & 31); const int Rb = Epi::PERM2 ? (64 * (R >> 5) + 2 * (p32 & 24) + (p32 & 7)) : Epi::PERM ? (64 * (R >> 5) + p32) : R;
        voffB[i] = (unsigned)(Rb * ldb + C) * 2u; }
    const size_t kstep = (size_t)(BK * 2);
    const size_t hstepB = (size_t)(Epi::PERM2 ? 8 : Epi::PERM ? 32 : HALF) * ldb * 2;
    const unsigned ldsw = (unsigned)wid * 1024u;
    const int aoff = lds_byte(wr * 64 + fr, fq * 8), boff = lds_byte(wc * 32 + fr, fq * 8);
#define PG_SA(b, h) (((b) * 2 + (h)) * HTB)
#define PG_SB(b, h) ((4 + (b) * 2 + (h)) * HTB)
#define PG_STAGE2(bufoff, gbase, o0, o1) do { \
        __builtin_amdgcn_global_load_lds((const unsigned*)((const char*)(gbase) + (o0)), (LAS unsigned*)(lds + (bufoff) + ldsw), 16, 0, 0); \
        __builtin_amdgcn_global_load_lds((const unsigned*)((const char*)(gbase) + (o1)), (LAS unsigned*)(lds + (bufoff) + ldsw + 8192), 16, 0, 0); } while (0)
#define PG_STAGEB(bufoff, gbase) PG_STAGE2(bufoff, gbase, voffB[0], voffB[1])
#define PG_LDA(dst, b, h) do { _Pragma("unroll") for (int m = 0; m < 4; ++m) _Pragma("unroll") for (int k = 0; k < 2; ++k) dst[m][k] = *(const LAS h8*)(lds + PG_SA(b, h) + aoff + m * 2048 + k * 1024); } while (0)
#define PG_LDB(dst, b, h) do { _Pragma("unroll") for (int n = 0; n < 2; ++n) _Pragma("unroll") for (int k = 0; k < 2; ++k) dst[n][k] = *(const LAS h8*)(lds + PG_SB(b, h) + boff + n * 2048 + k * 1024); } while (0)
#define PG_MMA(ai, bj, At, Bt) do { __builtin_amdgcn_s_setprio(1); _Pragma("unroll") for (int m = 0; m < 4; ++m) _Pragma("unroll") for (int n = 0; n < 2; ++n) _Pragma("unroll") for (int k = 0; k < 2; ++k) \
        acc[ai][bj][m][n] = __builtin_amdgcn_mfma_f32_16x16x32_f16(Bt[n][k], At[m][k], acc[ai][bj][m][n], 0, 0, 0); __builtin_amdgcn_s_setprio(0); } while (0)
#define PG_WAIT_V(n) asm volatile("s_waitcnt vmcnt(" #n ")" ::: "memory")
#define PG_WAIT_L(n) asm volatile("s_waitcnt lgkmcnt(" #n ")" ::: "memory")
#define PG_BAR __builtin_amdgcn_s_barrier()
#define PG_SCHED __builtin_amdgcn_sched_barrier(0)
    constexpr bool RELAX = !Sched::GATHER && Epi::NVM > 0;
    bool prev_full = false;
    Unit cur, nxt; int ui = 0;
    if (!S.next(0, cur)) return;
    unsigned c00, c01, c10, c11;
    LAS unsigned* otab = (LAS unsigned*)(lds + STAGE_BYTES + 2048) + tid;
    { c00 = (unsigned)(S.arow(cur, sR[0]) * lda + sC[0]) * 2u; c01 = (unsigned)(S.arow(cur, sR[1]) * lda + sC[1]) * 2u;
      c10 = (unsigned)(S.arow(cur, HALF + sR[0]) * lda + sC[0]) * 2u; c11 = (unsigned)(S.arow(cur, HALF + sR[1]) * lda + sC[1]) * 2u; }
    f32x4 acc[2][2][4][2];
#pragma unroll
    for (int a = 0; a < 2; ++a)
#pragma unroll
        for (int b = 0; b < 2; ++b)
#pragma unroll
            for (int m = 0; m < 4; ++m)
#pragma unroll
                for (int n = 0; n < 2; ++n) acc[a][b][m][n] = (f32x4){0.f, 0.f, 0.f, 0.f};
    h8 At[4][2], B0[2][2], B1[2][2];
    const char* cA = cur.A; const char* cB = cur.B;
    PG_STAGEB(PG_SB(0, 0), cB); PG_STAGEB(PG_SB(0, 1), cB + hstepB); PG_STAGE2(PG_SA(0, 0), cA, c00, c01); PG_STAGE2(PG_SA(0, 1), cA, c10, c11);
    if (wr == 1) PG_BAR;
    PG_WAIT_V(2); PG_BAR;
    PG_STAGEB(PG_SB(1, 0), cB + kstep); PG_STAGE2(PG_SA(1, 0), cA + kstep, c00, c01); PG_STAGEB(PG_SB(1, 1), cB + hstepB + kstep);
    PG_WAIT_V(6); PG_BAR;
    for (;;) {
        const bool has_next = S.next(ui + 1, nxt);
        const char* nA = has_next ? nxt.A : cA; const char* nB = has_next ? nxt.B : cB;
        if (Sched::GATHER) {
            if (has_next) { otab[0] = (unsigned)(S.arow(nxt, sR[0]) * lda + sC[0]) * 2u; otab[512] = (unsigned)(S.arow(nxt, sR[1]) * lda + sC[1]) * 2u;
                            otab[1024] = (unsigned)(S.arow(nxt, HALF + sR[0]) * lda + sC[0]) * 2u; otab[1536] = (unsigned)(S.arow(nxt, HALF + sR[1]) * lda + sC[1]) * 2u; }
            else { otab[0] = c00; otab[512] = c01; otab[1024] = c10; otab[1536] = c11; }
        }
#pragma unroll 1
        for (int t = 0; t < nt; t += 2) {
            const bool last = (t == nt - 2);
            const char* a1 = cA + (size_t)(t + 1) * kstep;
            const char* a2 = last ? nA : cA + (size_t)(t + 2) * kstep; const char* b2 = last ? nB : cB + (size_t)(t + 2) * kstep;
            const char* a3 = a2 + kstep; const char* b3 = b2 + kstep;
            unsigned q00 = c00, q01 = c01, q10 = c10, q11 = c11;
            if (Sched::GATHER) { if (last) { q00 = otab[0]; q01 = otab[512]; q10 = otab[1024]; q11 = otab[1536]; } }
            const bool pre = RELAX && t == 0 && ui > 0;
            const bool rlx = pre && prev_full;
            PG_LDB(B0, 0, 0); PG_LDB(B1, 0, 1); PG_SCHED; PG_LDA(At, 0, 0); if (!pre) PG_STAGE2(PG_SA(1, 1), a1, c10, c11);
            if (rlx) wait_vm<8 + Epi::NVM>(); else PG_WAIT_V(8);
            PG_WAIT_L(0); PG_BAR; PG_MMA(0, 0, At, B0); PG_MMA(0, 1, At, B1); PG_BAR; PG_SCHED;
            PG_LDA(At, 0, 1); PG_STAGEB(PG_SB(0, 0), b2); PG_STAGEB(PG_SB(0, 1), b2 + hstepB); PG_STAGE2(PG_SA(0, 0), a2, q00, q01);
            if (rlx) wait_vm<8 + Epi::NVM>(); else PG_WAIT_V(8);
            PG_WAIT_L(0); PG_BAR; PG_MMA(1, 0, At, B0); PG_MMA(1, 1, At, B1); PG_BAR; PG_SCHED;
            PG_LDB(B0, 1, 0); PG_LDB(B1, 1, 1); PG_SCHED; PG_LDA(At, 1, 0); PG_STAGE2(PG_SA(0, 1), a2, q10, q11);
            if (rlx) wait_vm<8 + Epi::NVM>(); else PG_WAIT_V(8);
            PG_WAIT_L(0); PG_BAR; PG_MMA(0, 0, At, B0); PG_MMA(0, 1, At, B1); PG_BAR; PG_SCHED;
            PG_LDA(At, 1, 1); PG_STAGEB(PG_SB(1, 0), b3); PG_STAGEB(PG_SB(1, 1), b3 + hstepB); PG_STAGE2(PG_SA(1, 0), a3, q00, q01);
            PG_WAIT_V(8); PG_WAIT_L(0); PG_BAR; PG_MMA(1, 0, At, B0); PG_MMA(1, 1, At, B1); PG_BAR; PG_SCHED;
        }
        if constexpr (ALIGN_EPI) { if (wr == 0) PG_BAR; }
        if (RELAX && has_next) PG_STAGE2(PG_SA(1, 1), nA + kstep, c10, c11);
        E(acc, cur, wr, wc, fr, fq);
        prev_full = E.full(cur);
        if (!has_next) break;
#pragma unroll
        for (int a = 0; a < 2; ++a)
#pragma unroll
            for (int b = 0; b < 2; ++b)
#pragma unroll
                for (int m = 0; m < 4; ++m)
#pragma unroll
                    for (int n = 0; n < 2; ++n) acc[a][b][m][n] = (f32x4){0.f, 0.f, 0.f, 0.f};
        cur = nxt; cA = nA; cB = nB; ++ui;
        if (Sched::GATHER) { c00 = otab[0]; c01 = otab[512]; c10 = otab[1024]; c11 = otab[1536]; }
        if constexpr (ALIGN_EPI) { if (wr == 1) PG_BAR; }
    }
    PG_WAIT_V(0);
    if constexpr (!ALIGN_EPI) { if (wr == 0) PG_BAR; }
    PG_BAR;
#undef PG_SA
#undef PG_SB
#undef PG_STAGE2
#undef PG_STAGEB
#undef PG_LDA
#undef PG_LDB
#undef PG_MMA
#undef PG_WAIT_V
#undef PG_WAIT_L
#undef PG_BAR
#undef PG_SCHED
}
}
constexpr size_t MiB = 1u << 20;
constexpr size_t al256(size_t x) { return (x + 255) & ~(size_t)255; }
constexpr size_t WS_CTL = 0, CTL_ZERO_BYTES = 2 * MiB;
constexpr size_t WS_MODS = 1 * MiB;
constexpr size_t WS_X = 2 * MiB;
constexpr size_t WS_Z2 = WS_X + (size_t)T * D * 4;
constexpr size_t WS_DYN = al256(WS_Z2 + (size_t)DEPTH * SE * 64 * 4);
constexpr size_t WS_WIN = WS_DYN;
constexpr size_t WS_PJ = WS_WIN + (size_t)DIN * D * 2;
constexpr size_t WS_WO = WS_PJ + (size_t)3 * D * DH * 2;
constexpr size_t WS_RT = WS_WO + (size_t)D * D * 2;
constexpr size_t WS_SD = WS_RT + (size_t)2 * NE * D * 2;
constexpr size_t WS_GC = al256(WS_SD + (size_t)256 * 4097 * 16);
constexpr size_t WS_HMH = WS_GC + (size_t)DH * 512 * 4;
constexpr size_t WS_LIST = WS_HMH + (size_t)T * D * 2;
constexpr size_t WS_P = WS_LIST + (size_t)2 * NE * TH * 8;
constexpr size_t P_BYTES = (size_t)T * DIN * 2;
constexpr size_t WS_SLOT = WS_P;
constexpr size_t WS_SLSH = WS_SLOT + (size_t)TH * 8 * D;
constexpr float SLOT_SC = 64.f;
constexpr size_t WS_W13 = WS_SLOT + (size_t)TH * 9 * D * 2;
constexpr size_t WS_W2 = WS_W13 + (size_t)65 * 512 * D * 2;
constexpr size_t WS_H = WS_W2 + (size_t)65 * D * DEXP * 2;
static_assert(WS_H + (size_t)(MAXT_H + SH_T) * 256 * DEXP * 2 <= WS_P + P_BYTES, "MoE overlay fits the P region");
constexpr size_t WS_ZT = WS_P + P_BYTES;
constexpr size_t WS_VT = WS_ZT + (size_t)B * DH * SE * 2;
constexpr size_t WS_SCR = WS_ZT;
static_assert((size_t)256 * 32 * 512 * 16 <= (size_t)2 * B * DH * SE * 2, "scratch fits ZT|VT");
constexpr size_t WS_VHT = WS_VT + (size_t)B * DH * SE * 2;
constexpr size_t WS_Y = WS_VHT + (size_t)B * DH * SE * 2;
constexpr size_t WS_END = WS_Y + (size_t)T * 1536 * 2;
static_assert((size_t)(MAXT_H + SH_T) * 256 * DEXP * 2 <= (size_t)T * 1536 * 2, "half 1's H fits the Y region");
constexpr int CW_BAR = 4096;
constexpr int CW_CNT = 16384;
constexpr int CW_DBG = 32768;

struct In {
    const GAS float *x, *c, *ctx, *c_ctx, *w_ada, *b_ada, *w_in, *hy_conv_w, *hy_conv_b, *hy_w1, *hy_b1, *hy_w2, *hy_b2, *hy_w3, *hy_sin_freq, *hy_bias_d,
        *hy_proj, *sc_conv_w, *sc_proj, *na_rpb, *na_proj, *w_o, *ln1_g, *ln1_b, *ln2_g, *ln2_b, *moe_router, *moe_bias, *moe_w1, *moe_w3, *moe_w2, *sh_w1, *sh_w3, *sh_w2;
};
struct Args { In in; GAS float* out; unsigned char* ws; int ph_lo, ph_hi, use_bar, flags; };

typedef const __attribute__((address_space(4))) In& CIN;
#define INP(name) ((const float*)(in.name))
typedef const __attribute__((address_space(4))) Args* CArgsP;
struct Frame {
    LAS unsigned char* lds;
    int tid, lane, wave, vcu, G, bid, dry;
    GAS unsigned char* ws;
};
__device__ __forceinline__ int mod_row(int row) { const int b = row / SE, ii = row - b * SE; return ii < S ? b : 8; }

struct TrItem { const float* W; int K, N; f16* WT; int row_off, row_mul, item; };
__device__ __forceinline__ void tr_load(const TrItem& q, f32x4 (&t)[8], int lane) {
    const int nblk = q.N / 32, kb = q.item / nblk, nb = q.item % nblk, k0 = 64 * kb, n0 = 32 * nb;
    const int kr = lane >> 3, c4 = (lane & 7) * 4;
#pragma unroll
    for (int i = 0; i < 8; ++i) t[i] = *(const f32x4*)(q.W + (size_t)(k0 + 8 * i + kr) * q.N + n0 + c4);
}
__device__ __forceinline__ void tr_store(const TrItem& q, const f32x4 (&t)[8], LAS float* scr, int lane) {
    const int nblk = q.N / 32, kb = q.item / nblk, nb = q.item % nblk, k0 = 64 * kb, n0 = 32 * nb;
    const int kr = lane >> 3, c4 = (lane & 7) * 4;
#pragma unroll
    for (int i = 0; i < 8; ++i) { LAS float* d = scr + (8 * i + kr) * 33 + c4; d[0] = t[i][0]; d[1] = t[i][1]; d[2] = t[i][2]; d[3] = t[i][3]; }
    LDS_WAIT(); asm volatile("" ::: "memory");
    const int c = lane & 7;
#pragma unroll
    for (int j = 0; j < 4; ++j) { const int n = (lane >> 3) + 8 * j; const LAS float* s = scr + (8 * c) * 33 + n;
        u32x4 o; o.x = pkh(s[0 * 33], s[1 * 33]); o.y = pkh(s[2 * 33], s[3 * 33]); o.z = pkh(s[4 * 33], s[5 * 33]); o.w = pkh(s[6 * 33], s[7 * 33]);
        *(u32x4*)(q.WT + (size_t)(q.row_off + (n0 + n) * q.row_mul) * q.K + k0 + 8 * c) = o; }
    LDS_WAIT(); asm volatile("" ::: "memory");
}
__device__ __forceinline__ TrItem mixer_item(Frame& F, CIN in, int l, int it) {
    constexpr int I_IN = (D / 64) * (DIN / 32), I_PJ = (DH / 64) * (D / 32);
    f16* win = (f16*)(F.ws + WS_WIN); f16* pj = (f16*)(F.ws + WS_PJ); f16* wo = (f16*)(F.ws + WS_WO);
    int r = it;
    if (r < I_IN) return TrItem{INP(w_in) + (size_t)l * D * DIN, D, DIN, win, 0, 1, r}; r -= I_IN;
    if (r < I_PJ) return TrItem{INP(hy_proj) + (size_t)l * DH * D, DH, D, pj, 0, 1, r}; r -= I_PJ;
    if (r < I_PJ) return TrItem{INP(sc_proj) + (size_t)l * DH * D, DH, D, pj, D, 1, r}; r -= I_PJ;
    if (r < I_PJ) return TrItem{INP(na_proj) + (size_t)l * DH * D, DH, D, pj, 2 * D, 1, r}; r -= I_PJ;
    return TrItem{INP(w_o) + (size_t)l * D * D, D, D, wo, 0, 1, r};
}
__device__ __forceinline__ void convert_mixer_weights(Frame& F, CIN in, int l) {
    LAS float* scr = (LAS float*)(F.lds + F.wave * 16384);
    const int gw = F.vcu * NWAVES + F.wave, NGW = F.G * NWAVES;
    constexpr int NIT = (D / 64) * (DIN / 32) + 3 * (DH / 64) * (D / 32) + (D / 64) * (D / 32);
    int it = gw; if (it >= NIT) return;
    f32x4 ta[8], tb[8];
    TrItem qa = mixer_item(F, in, l, it), qb = qa; tr_load(qa, ta, F.lane);
    for (;;) {
        const bool hb = it + NGW < NIT; if (hb) { qb = mixer_item(F, in, l, it + NGW); tr_load(qb, tb, F.lane); }
        tr_store(qa, ta, scr, F.lane); if (!hb) break; it += NGW;
        const bool ha = it + NGW < NIT; if (ha) { qa = mixer_item(F, in, l, it + NGW); tr_load(qa, ta, F.lane); }
        tr_store(qb, tb, scr, F.lane); if (!ha) break; it += NGW;
    }
}
__device__ __forceinline__ TrItem moe_item(Frame& F, CIN in, int l, int it) {
    constexpr int I_UP = (D / 64) * (DEXP / 32)  , I_DN = (DEXP / 64) * (D / 32)  , PER_E = 2 * I_UP + I_DN;
    f16* w13 = (f16*)(F.ws + WS_W13); f16* w2 = (f16*)(F.ws + WS_W2);
    const int e = it / PER_E; int r = it - e * PER_E;
    if (r < I_UP) return TrItem{e < NE ? INP(moe_w1) + ((size_t)l * NE + e) * D * DEXP : INP(sh_w1) + (size_t)l * D * DEXP, D, DEXP, w13 + (size_t)e * 512 * D, 0, 2, r}; r -= I_UP;
    if (r < I_UP) return TrItem{e < NE ? INP(moe_w3) + ((size_t)l * NE + e) * D * DEXP : INP(sh_w3) + (size_t)l * D * DEXP, D, DEXP, w13 + (size_t)e * 512 * D, 1, 2, r}; r -= I_UP;
    return TrItem{e < NE ? INP(moe_w2) + ((size_t)l * NE + e) * DEXP * D : INP(sh_w2) + (size_t)l * DEXP * D, DEXP, D, w2 + (size_t)e * D * DEXP, 0, 1, r};
}
__device__ __forceinline__ void convert_moe_weights(Frame& F, CIN in, int l) {
    LAS float* scr = (LAS float*)(F.lds + F.wave * 16384);
    const int gw = F.vcu * NWAVES + F.wave, NGW = F.G * NWAVES;
    constexpr int NIT = 65 * 384;
    int it = gw; if (it >= NIT) return;
    f32x4 ta[8], tb[8];
    TrItem qa = moe_item(F, in, l, it), qb = qa; tr_load(qa, ta, F.lane);
    for (;;) {
        const bool hb = it + NGW < NIT; if (hb) { qb = moe_item(F, in, l, it + NGW); tr_load(qb, tb, F.lane); }
        tr_store(qa, ta, scr, F.lane); if (!hb) break; it += NGW;
        const bool ha = it + NGW < NIT; if (ha) { qa = moe_item(F, in, l, it + NGW); tr_load(qa, ta, F.lane); }
        tr_store(qb, tb, scr, F.lane); if (!ha) break; it += NGW;
    }
}

struct MoeTab { int ptile[NE + 2]; };
__device__ __forceinline__ void moe_build_tab(Frame& F, const int* cnt, LAS int* tab) {
    if (F.tid < 64) {
        const int c = __hip_atomic_load(cnt + F.tid, __ATOMIC_RELAXED, __HIP_MEMORY_SCOPE_AGENT); int tl = (c + 255) >> 8; int inc = tl;
#pragma unroll
        for (int o = 1; o < 64; o <<= 1) { const int v = bpermi(F.lane - o, inc); if (F.lane >= o) inc += v; }
        tab[F.tid] = inc - tl; tab[128 + F.tid] = c;
        if (F.tid == 63) tab[64] = inc;
    }
    __syncthreads();
}
template <int NPN, bool UP>
struct MoeSched {
    static constexpr bool GATHER = UP;
    const LAS int* tab; int G, c, half; const unsigned long long* list; const char* Abase; const char* Bbase; int NT, lat_only;
    int sh_mode, NT_other;
    __device__ __forceinline__ bool next(int i, pg::Unit& u) const {
        const int SH = lat_only ? SH_T - 4 : SH_T;
        const int L = i * G + c; const int nun = (NT + (sh_mode == 2 ? 0 : (sh_mode == 1 ? 2 * SH : SH))) * NPN;
        if (L >= nun) return false;
        const int tile = L / NPN; u.pn = L - tile * NPN;
        int e;
        if (tile < NT) { e = 0;
#pragma unroll
            for (int s = 32; s >= 1; s >>= 1) { const int v = __builtin_amdgcn_readfirstlane(tab[(e + s) & 63]); if (e + s < NE && v <= tile) e += s; }
            u.pm = tile - __builtin_amdgcn_readfirstlane(tab[e]); int nr = __builtin_amdgcn_readfirstlane(tab[128 + e]) - u.pm * 256; u.nrows = nr > 256 ? 256 : nr;
        } else { e = NE; u.pm = tile - NT; u.nrows = 256;
            if (u.pm >= SH) { u.pm -= SH; u.nrows = 257; }
            if (lat_only) u.pm = (u.pm >> 4) * 17 + (u.pm & 15); }
        u.e = e;
        if (UP) { u.A = Abase; u.B = Bbase + ((size_t)e * 512 + (size_t)u.pn * 256) * D * 2; }
        else { u.A = Abase + (size_t)tile * 256 * DEXP * 2; u.B = Bbase + ((size_t)e * D + (size_t)u.pn * 256) * DEXP * 2; }
        u.aux0 = u.nrows == 257 ? NT_other + u.pm : tile;
        return true;
    }
    __device__ __forceinline__ int arow(const pg::Unit& u, int r) const {
        if (!UP) return r;
        if (u.e == NE) return (u.nrows == 257 ? (half ^ 1) : half) * TH + u.pm * 256 + r;
        int rr = u.pm * 256 + r; const int n = __builtin_amdgcn_readfirstlane(tab[128 + u.e]); if (rr >= n) rr = n - 1;
        const unsigned long long en = list[((size_t)half * NE + u.e) * TH + rr];
        return half * TH + (int)(en >> 36);
    }
};
struct EpiUp {
    static constexpr bool PERM = true; static constexpr bool PERM2 = true; static constexpr int NVM = 0;
    __device__ __forceinline__ bool full(const pg::Unit&) const { return false; }
    f16* H; f16* Hother;
    __device__ __forceinline__ void operator()(const f32x4 (&acc)[2][2][4][2], const pg::Unit& u, int wr, int wc, int fr, int fq) const {
        f16* Hb = u.nrows == 257 ? Hother : H;
#pragma unroll
        for (int ai = 0; ai < 2; ++ai)
#pragma unroll
            for (int m = 0; m < 4; ++m) { const int r = ai * 128 + wr * 64 + m * 16 + fr; f16* rowp = Hb + ((size_t)u.aux0 * 256 + r) * DEXP + u.pn * 128;
                u32x4 w;
#pragma unroll
                for (int bj = 0; bj < 2; ++bj) { const f32x4 v0 = acc[ai][bj][m][0], v1 = acc[ai][bj][m][1];
                    const float h0 = v0[0] * sigm(v0[0]) * v0[1], h1 = v0[2] * sigm(v0[2]) * v0[3], h2_ = v1[0] * sigm(v1[0]) * v1[1], h3 = v1[2] * sigm(v1[2]) * v1[3];
                    if (bj == 0) { w.x = pkh(h0, h1); w.y = pkh(h2_, h3); } else { w.z = pkh(h0, h1); w.w = pkh(h2_, h3); } }
                *(u32x4*)(rowp + wc * 32 + 8 * fq) = w;
                asm volatile("" ::: "memory"); }
    }
};
struct EpiDown {
    static constexpr bool PERM = true; static constexpr bool PERM2 = true; static constexpr int NVM = 8;
    __device__ __forceinline__ bool full(const pg::Unit& u) const { return !dry && (u.e == NE || u.nrows == 256); }
    f16* SL; f16* SH; const unsigned long long* list; int half, dry;
    __device__ __forceinline__ void operator()(const f32x4 (&acc)[2][2][4][2], const pg::Unit& u, int wr, int wc, int fr, int fq) const {
        unsigned long long en[8];
        const unsigned long long* lp = list + ((size_t)half * NE + (u.e < NE ? u.e : 0)) * TH + u.pm * 256;
#pragma unroll
        for (int g = 0; g < 8; ++g) { const int r = (g >> 2) * 128 + wr * 64 + (g & 3) * 16 + fr; en[g] = (u.e < NE && r < u.nrows) ? lp[r] : 0ull; }
#pragma unroll
        for (int ai = 0; ai < 2; ++ai)
#pragma unroll
            for (int m = 0; m < 4; ++m) { const int r = ai * 128 + wr * 64 + m * 16 + fr;
                float w = 1.f; int srow = u.pm * 256 + r; bool ok = true;
                if (u.e < NE) { ok = r < u.nrows; const unsigned long long e8 = en[ai * 4 + m]; w = __uint_as_float((unsigned)e8); const unsigned hi = (unsigned)(e8 >> 32); srow = (int)(hi >> 4) * 8 + (int)(hi & 15u); }
                if (ok) {
                    if (u.e < NE) {
                        unsigned char* rowp = (unsigned char*)SL + (size_t)srow * D + u.pn * 256 + wc * 64 + 16 * fq; w *= SLOT_SC;
                        u32x4 o;
#pragma unroll
                        for (int bj = 0; bj < 2; ++bj) { const f32x4 v0 = acc[ai][bj][m][0] * w, v1 = acc[ai][bj][m][1] * w;
                            int a = __builtin_amdgcn_cvt_pk_fp8_f32(v0[0], v0[1], 0, false); a = __builtin_amdgcn_cvt_pk_fp8_f32(v0[2], v0[3], a, true);
                            int b = __builtin_amdgcn_cvt_pk_fp8_f32(v1[0], v1[1], 0, false); b = __builtin_amdgcn_cvt_pk_fp8_f32(v1[2], v1[3], b, true);
                            if (bj == 0) { o.x = (unsigned)a; o.y = (unsigned)b; } else { o.z = (unsigned)a; o.w = (unsigned)b; } }
                        if (!dry || o.x == 0x12345678u) *(u32x4*)rowp = o;
                    } else {
                        f16* rowp = SH + (size_t)srow * D + u.pn * 256 + wc * 64 + 16 * fq;
#pragma unroll
                        for (int bj = 0; bj < 2; ++bj) { const f32x4 v0 = acc[ai][bj][m][0], v1 = acc[ai][bj][m][1];
                            u32x4 o; o.x = pkh(v0[0], v0[1]); o.y = pkh(v0[2], v0[3]); o.z = pkh(v1[0], v1[1]); o.w = pkh(v1[2], v1[3]);
                            if (!dry || o.x == 0x12345678u) *(u32x4*)(rowp + bj * 8) = o; } } } }
    }
};
template <bool DO_LN>
__device__ __forceinline__ void ln1_rows(Frame& F, CIN in, int l) {
    const int gw = F.vcu * NWAVES + F.wave, NGW = F.G * NWAVES;
    float* X = (float*)(F.ws + WS_X); f16* HM = (f16*)(F.ws + WS_HMH);
    const float* mods = (const float*)(F.ws + WS_MODS) + (size_t)l * 9 * 6 * D;
    const f32x4* g4 = (const f32x4*)(INP(ln1_g) + l * D) + F.lane; const f32x4* b4 = (const f32x4*)(INP(ln1_b) + l * D) + F.lane;
    for (int row = gw; row < T; row += NGW) {
        f32x4* xr = (f32x4*)(X + (size_t)row * D) + F.lane;
        f32x4 v[4];
#pragma unroll
        for (int j = 0; j < 4; ++j) v[j] = xr[64 * j];
        if (DO_LN) {
            float s = 0.f;
#pragma unroll
            for (int j = 0; j < 4; ++j) s += (v[j].x + v[j].y) + (v[j].z + v[j].w);
            const float mean = wsum(s, F.lane) * (1.f / D); float s2 = 0.f;
#pragma unroll
            for (int j = 0; j < 4; ++j) { v[j] = v[j] - mean; s2 += (v[j].x * v[j].x + v[j].y * v[j].y) + (v[j].z * v[j].z + v[j].w * v[j].w); }
            const float rstd = 1.f / sqrtf(wsum(s2, F.lane) * (1.f / D) + LN_EPS);
#pragma unroll
            for (int j = 0; j < 4; ++j) { v[j] = v[j] * rstd * g4[64 * j] + b4[64 * j]; if (!F.dry) xr[64 * j] = v[j]; }
        }
        const float* m = mods + (size_t)mod_row(row) * 6 * D;
        const f32x4* sh = (const f32x4*)(m + 3 * D) + F.lane; const f32x4* sc = (const f32x4*)(m + 4 * D) + F.lane;
        u32x2* o8 = (u32x2*)(HM + (size_t)row * D) + F.lane;
#pragma unroll
        for (int j = 0; j < 4; ++j) { const f32x4 h = v[j] * (sc[64 * j] + 1.f) + sh[64 * j]; u32x2 w; w.x = pkh(h.x, h.y); w.y = pkh(h.z, h.w); if (!F.dry) o8[64 * j] = w; }
    }
}

__device__ __forceinline__ void router_phase(Frame& F, CIN in, int l) {
    const int gw = F.vcu * NWAVES + F.wave, NGW = F.G * NWAVES, lane = F.lane, fr = lane & 15, fq = lane >> 4;
    const float* X = (const float*)(F.ws + WS_X);
    const float* mods = (const float*)(F.ws + WS_MODS) + (size_t)l * 9 * 6 * D;
    const f16* rth = (const f16*)(F.ws + WS_RT); const f16* rtl = rth + NE * D;
    int* cntl = (int*)(F.ws + WS_CTL) + CW_CNT + l * 128;
    unsigned long long* list = (unsigned long long*)(F.ws + WS_LIST);
    LAS float* lgs = (LAS float*)(F.lds + F.wave * 4096);
    const float rb = INP(moe_bias)[l * NE + lane];
    for (int task = gw; task < T / 16; task += NGW) {
        const int row0 = task * 16;
        const float* m = mods + (size_t)mod_row(row0) * 6 * D;
        const float* xr = X + (size_t)(row0 + fr) * D + fq * 8;
        f32x4 acc[4];
#pragma unroll
        for (int nb = 0; nb < 4; ++nb) acc[nb] = (f32x4){0.f, 0.f, 0.f, 0.f};
#pragma unroll 2
        for (int s = 0; s < 32; ++s) {
            const int k = s * 32 + fq * 8;
            const f32x4 x0 = *(const f32x4*)(xr + s * 32), x1 = *(const f32x4*)(xr + s * 32 + 4);
            const f32x4 sc0 = *(const f32x4*)(m + 4 * D + k), sc1 = *(const f32x4*)(m + 4 * D + k + 4);
            const f32x4 sh0 = *(const f32x4*)(m + 3 * D + k), sh1 = *(const f32x4*)(m + 3 * D + k + 4);
            const f32x4 h0 = x0 * (sc0 + 1.f) + sh0, h1 = x1 * (sc1 + 1.f) + sh1;
            h8 ahi, alo;
#pragma unroll
            for (int j = 0; j < 4; ++j) { ahi[j] = (f16)h0[j]; alo[j] = (f16)(h0[j] - (float)ahi[j]); ahi[4 + j] = (f16)h1[j]; alo[4 + j] = (f16)(h1[j] - (float)ahi[4 + j]); }
#pragma unroll
            for (int nb = 0; nb < 4; ++nb) {
                const h8 bhi = *(const h8*)(rth + (size_t)(nb * 16 + fr) * D + k), blo = *(const h8*)(rtl + (size_t)(nb * 16 + fr) * D + k);
                acc[nb] = __builtin_amdgcn_mfma_f32_16x16x32_f16(ahi, bhi, acc[nb], 0, 0, 0);
                acc[nb] = __builtin_amdgcn_mfma_f32_16x16x32_f16(alo, bhi, acc[nb], 0, 0, 0);
                acc[nb] = __builtin_amdgcn_mfma_f32_16x16x32_f16(ahi, blo, acc[nb], 0, 0, 0);
            }
        }
#pragma unroll
        for (int nb = 0; nb < 4; ++nb)
#pragma unroll
            for (int i = 0; i < 4; ++i) lgs[(4 * fq + i) * 64 + nb * 16 + fr] = acc[nb][i];
        LDS_WAIT(); asm volatile("" ::: "memory");
        unsigned chosen_mask = 0u; float wv[16]; int kv[16];
#pragma unroll
        for (int t = 0; t < 16; ++t) {
            const float score = 1.f / (1.f + expf(-lgs[t * 64 + lane]));
            const float sel = score + rb;
            float m1 = sel;
            m1 = fmaxf(m1, SHX(m1, 1)); m1 = fmaxf(m1, SHX(m1, 2)); m1 = fmaxf(m1, SHX(m1, 4));
            const unsigned long long eq = __ballot(sel == m1);
            const int g = lane >> 3;
            const unsigned geq = (unsigned)((eq >> (g * 8)) & 0xffull);
            const int first = __ffs(geq) - 1;
            float s2 = ((lane & 7) == first) ? -3.0e38f : sel;
            s2 = fmaxf(s2, SHX(s2, 1)); s2 = fmaxf(s2, SHX(s2, 2)); s2 = fmaxf(s2, SHX(s2, 4));
            const float gs = m1 + s2;
            int grank = 0;
#pragma unroll
            for (int gg = 0; gg < 8; ++gg) { const float o = bperm(gg * 8, gs); grank += (o > gs || (o == gs && gg < g)) ? 1 : 0; }
            const bool gsel = grank < 4;
            const float val = gsel ? sel : -3.0e38f;
            int rank = 0;
            for (int j = 0; j < 64; ++j) { const float o = bperm(j, val); rank += (o > val || (o == val && j < lane)) ? 1 : 0; }
            const bool ch = gsel && rank < TOPK;
            const float tot = wsum(ch ? score : 0.f, lane);
            wv[t] = score / tot * 2.5f; kv[t] = rank;
            chosen_mask |= ch ? (1u << t) : 0u;
        }
        const int half = row0 >= TH ? 1 : 0;
        const int nch = __popc(chosen_mask);
        int base = 0;
        if (nch && !F.dry) base = atomicAdd(cntl + half * 64 + lane, nch);
        unsigned long long* lp = list + ((size_t)half * NE + lane) * TH;
        int pos = base;
#pragma unroll
        for (int t = 0; t < 16; ++t) if ((chosen_mask & (1u << t)) && !F.dry) {
            const unsigned tokh = (unsigned)(row0 + t - half * TH);
            lp[pos++] = ((unsigned long long)((tokh << 4) | (unsigned)kv[t]) << 32) | (unsigned long long)__float_as_uint(wv[t]);
        }
        LDS_WAIT(); asm volatile("" ::: "memory");
    }
}


constexpr int RL_PITCH = 1032;
constexpr int RL_LO = 16 * RL_PITCH * 2, RL_PART = 2 * RL_LO;
constexpr int RL_ENT = RL_PART + 32768, RL_MAXTASK = 18, RL_CNT = RL_ENT + RL_MAXTASK * 128 * 16, RL_BASE = RL_CNT + 512;
static_assert(RL_BASE + 512 <= 147456 - 1088, "router LDS map");
__device__ __forceinline__ void ln1_router_phase(Frame& F, CIN in, int l) {
    const int lane = F.lane, w = F.wave, fr = lane & 15, fq = lane >> 4;
    float* X = (float*)(F.ws + WS_X); f16* HM = (f16*)(F.ws + WS_HMH);
    const float* mods = (const float*)(F.ws + WS_MODS) + (size_t)l * 9 * 6 * D;
    const f32x4* g4 = (const f32x4*)(INP(ln1_g) + l * D) + lane; const f32x4* b4 = (const f32x4*)(INP(ln1_b) + l * D) + lane;
    int* cntl = (int*)(F.ws + WS_CTL) + CW_CNT + l * 128;
    unsigned long long* list = (unsigned long long*)(F.ws + WS_LIST);
    LAS f16* ahi = (LAS f16*)F.lds; LAS f16* alo = (LAS f16*)(F.lds + RL_LO); LAS float* part = (LAS float*)(F.lds + RL_PART);
    const f16* rth = (const f16*)(F.ws + WS_RT); const f16* rtl = rth + NE * D;
    h8 bh[4][4];
#pragma unroll
    for (int s = 0; s < 4; ++s)
#pragma unroll
        for (int nb = 0; nb < 4; ++nb) { const size_t o = (size_t)(nb * 16 + fr) * D + 128 * w + 32 * s + 8 * fq; bh[s][nb] = *(const h8*)(rth + o); }
    const float rb = INP(moe_bias)[l * NE + lane];
    if (F.tid < 128) ((LAS int*)(F.lds + RL_CNT))[F.tid] = 0;
    __syncthreads();
    int ti = 0;
    for (int task = F.bid; task < T / 16 && ti < RL_MAXTASK; task += F.G, ++ti) {
        const int row0 = task * 16;
        if (l == DEPTH - 1 && row0 % SE >= S) { --ti; continue; }
        const float* m = mods + (size_t)mod_row(row0) * 6 * D;
        f32x4 va[2][4], pg[4], pb[4], psh[4], psc[4];
#pragma unroll
        for (int j = 0; j < 4; ++j) {
            va[0][j] = ((const f32x4*)(X + (size_t)(row0 + 2 * w) * D) + lane)[64 * j]; va[1][j] = ((const f32x4*)(X + (size_t)(row0 + 2 * w + 1) * D) + lane)[64 * j];
            pg[j] = g4[64 * j]; pb[j] = b4[64 * j]; psh[j] = ((const f32x4*)(m + 3 * D) + lane)[64 * j]; psc[j] = ((const f32x4*)(m + 4 * D) + lane)[64 * j];
        }
        asm volatile("" ::: "memory");
#pragma unroll
        for (int rr = 0; rr < 2; ++rr) {
            const int lr = 2 * w + rr, row = row0 + lr;
            f32x4* xr = (f32x4*)(X + (size_t)row * D) + lane;
            f32x4 v[4]; float s = 0.f;
#pragma unroll
            for (int j = 0; j < 4; ++j) { v[j] = va[rr][j]; s += (v[j].x + v[j].y) + (v[j].z + v[j].w); }
            const float mean = wsum(s, lane) * (1.f / D); float s2 = 0.f;
#pragma unroll
            for (int j = 0; j < 4; ++j) { v[j] = v[j] - mean; s2 += (v[j].x * v[j].x + v[j].y * v[j].y) + (v[j].z * v[j].z + v[j].w * v[j].w); }
            const float rstd = 1.f / sqrtf(wsum(s2, lane) * (1.f / D) + LN_EPS);
            u32x2* o8 = (u32x2*)(HM + (size_t)row * D) + lane;
#pragma unroll
            for (int j = 0; j < 4; ++j) {
                v[j] = v[j] * rstd * pg[j] + pb[j];
                if (!F.dry) xr[64 * j] = v[j];
                const f32x4 h = v[j] * (psc[j] + 1.f) + psh[j];
                h4 hh, hl;
#pragma unroll
                for (int q = 0; q < 4; ++q) { hh[q] = (f16)h[q]; hl[q] = (f16)(h[q] - (float)hh[q]); }
                if (!F.dry) o8[64 * j] = __builtin_bit_cast(u32x2, hh);
                *(LAS h4*)(ahi + lr * RL_PITCH + 4 * lane + 256 * j) = hh; *(LAS h4*)(alo + lr * RL_PITCH + 4 * lane + 256 * j) = hl;
            }
        }
        __syncthreads();
        {
            h8 bl[4][4];
#pragma unroll
            for (int s = 0; s < 4; ++s)
#pragma unroll
                for (int nb = 0; nb < 4; ++nb) bl[s][nb] = *(const h8*)(rtl + (size_t)(nb * 16 + fr) * D + 128 * w + 32 * s + 8 * fq);
            f32x4 acc[4];
#pragma unroll
            for (int nb = 0; nb < 4; ++nb) acc[nb] = (f32x4){0.f, 0.f, 0.f, 0.f};
#pragma unroll
            for (int s = 0; s < 4; ++s) {
                const int k = 128 * w + 32 * s + 8 * fq;
                const h8 xh = *(const LAS h8*)(ahi + fr * RL_PITCH + k), xl = *(const LAS h8*)(alo + fr * RL_PITCH + k);
#pragma unroll
                for (int nb = 0; nb < 4; ++nb) {
                    acc[nb] = __builtin_amdgcn_mfma_f32_16x16x32_f16(xh, bh[s][nb], acc[nb], 0, 0, 0);
                    acc[nb] = __builtin_amdgcn_mfma_f32_16x16x32_f16(xl, bh[s][nb], acc[nb], 0, 0, 0);
                    acc[nb] = __builtin_amdgcn_mfma_f32_16x16x32_f16(xh, bl[s][nb], acc[nb], 0, 0, 0);
                }
            }
#pragma unroll
            for (int nb = 0; nb < 4; ++nb)
#pragma unroll
                for (int i = 0; i < 4; ++i) part[(w * 16 + 4 * fq + i) * 64 + nb * 16 + fr] = acc[nb][i];
        }
        __syncthreads();
        {
            unsigned chosen_mask = 0u; float wv[2]; int kv[2];
#pragma unroll
            for (int t = 0; t < 2; ++t) {
                const int lt = 2 * w + t;
                float lg = 0.f;
#pragma unroll
                for (int ww = 0; ww < 8; ++ww) lg += part[(ww * 16 + lt) * 64 + lane];
                const float score = 1.f / (1.f + expf(-lg));
                const float sel = score + rb;
                float m1 = sel;
                m1 = fmaxf(m1, SHX(m1, 1)); m1 = fmaxf(m1, SHX(m1, 2)); m1 = fmaxf(m1, SHX(m1, 4));
                const unsigned long long eq = __ballot(sel == m1);
                const int g = lane >> 3;
                const unsigned geq = (unsigned)((eq >> (g * 8)) & 0xffull);
                const int first = __ffs(geq) - 1;
                float s2 = ((lane & 7) == first) ? -3.0e38f : sel;
                s2 = fmaxf(s2, SHX(s2, 1)); s2 = fmaxf(s2, SHX(s2, 2)); s2 = fmaxf(s2, SHX(s2, 4));
                const float gs = m1 + s2;
                int grank = 0;
#pragma unroll
                for (int gg = 0; gg < 8; ++gg) { const float o = __int_as_float(__builtin_amdgcn_readlane(__float_as_int(gs), gg * 8)); grank += (o > gs || (o == gs && gg < g)) ? 1 : 0; }
                const bool gsel = grank < 4;
                const float val = gsel ? sel : -3.0e38f;
                int rank = 0;
#pragma unroll
                for (int j = 0; j < 64; ++j) { const float o = __int_as_float(__builtin_amdgcn_readlane(__float_as_int(val), j)); rank += (o > val || (o == val && j < lane)) ? 1 : 0; }
                const bool ch = gsel && rank < TOPK;
                const float tot = wsum(ch ? score : 0.f, lane);
                wv[t] = score / tot * 2.5f; kv[t] = rank;
                chosen_mask |= ch ? (1u << t) : 0u;
            }
            const int half = row0 >= TH ? 1 : 0;
#pragma unroll
            for (int t = 0; t < 2; ++t) if (chosen_mask & (1u << t)) {
                const unsigned lrank = (unsigned)__hip_atomic_fetch_add((LAS int*)(F.lds + RL_CNT) + half * 64 + lane, 1, __ATOMIC_RELAXED, __HIP_MEMORY_SCOPE_WORKGROUP);
                const unsigned tokh = (unsigned)(row0 + 2 * w + t - half * TH);
                u32x4 en; en.x = __float_as_uint(wv[t]); en.y = (tokh << 4) | (unsigned)kv[t]; en.z = (unsigned)(half * 64 + lane); en.w = lrank;
                ((LAS u32x4*)(F.lds + RL_ENT))[(ti * 16 + 2 * w + t) * 8 + kv[t]] = en;
            }
        }
        __syncthreads();
    }
    const int ntask = ti;
    if (F.tid < 128) {
        const int n = ((LAS int*)(F.lds + RL_CNT))[F.tid];
        ((LAS int*)(F.lds + RL_BASE))[F.tid] = (n && !F.dry) ? atomicAdd(cntl + F.tid, n) : 0;
    }
    __syncthreads();
    for (int idx = F.tid; idx < ntask * 128; idx += NTHR) {
        const u32x4 en = ((const LAS u32x4*)(F.lds + RL_ENT))[idx];
        const int he = (int)en.z; const int pos = ((const LAS int*)(F.lds + RL_BASE))[he] + (int)en.w;
        if (!F.dry) list[(size_t)he * TH + pos] = ((unsigned long long)en.y << 32) | (unsigned long long)en.x;
    }
    __syncthreads();
}
__device__ __forceinline__ void convert_router(Frame& F, CIN in, int l) {
    f16* rth = (f16*)(F.ws + WS_RT); f16* rtl = rth + NE * D;
    const float* rw = INP(moe_router) + (size_t)l * D * NE;
    for (int i = (F.vcu * NTHR + F.tid); i < NE * D; i += F.G * NTHR) { const int k = i / NE, n = i % NE; const float wgt = rw[i]; const f16 h = (f16)wgt; rth[n * D + k] = h; rtl[n * D + k] = (f16)(wgt - (float)h); }
}

__device__ __forceinline__ void moe_up_phase(Frame& F, int l, int half, int Gs, int cs) {
    LAS int* tab = (LAS int*)(F.lds + pg::STAGE_BYTES);
    const int* cnt = (const int*)(F.ws + WS_CTL) + CW_CNT + l * 128 + half * 64;
    const int lat_only = l == DEPTH - 1;
    int nt_other = 0;
    if (!lat_only && half == 0) { moe_build_tab(F, cnt + 64, tab); nt_other = __builtin_amdgcn_readfirstlane(tab[64]); __syncthreads(); }
    moe_build_tab(F, cnt, tab);
    MoeSched<2, true> Sc; Sc.tab = tab; Sc.G = Gs; Sc.c = cs; Sc.half = half; Sc.list = (const unsigned long long*)(F.ws + WS_LIST);
    Sc.Abase = (const char*)(F.ws + WS_HMH); Sc.Bbase = (const char*)(F.ws + WS_W13); Sc.NT = __builtin_amdgcn_readfirstlane(tab[64]); Sc.lat_only = lat_only;
    Sc.sh_mode = lat_only ? 0 : (half == 0 ? 1 : 2); Sc.NT_other = nt_other;
    EpiUp E; E.H = (f16*)(F.ws + (half ? WS_Y : WS_H)); E.Hother = (f16*)(F.ws + (half ? WS_H : WS_Y));
    pg::gemm_phase<EpiUp, MoeSched<2, true>, true>(F.lds, F.wave, D, D, D, Sc, E);
}
__device__ __forceinline__ void moe_down_phase(Frame& F, int l, int half, int Gs, int cs) {
    LAS int* tab = (LAS int*)(F.lds + pg::STAGE_BYTES);
    const int* cnt = (const int*)(F.ws + WS_CTL) + CW_CNT + l * 128 + half * 64;
    moe_build_tab(F, cnt, tab);
    MoeSched<4, false> Sc; Sc.tab = tab; Sc.G = Gs; Sc.c = cs; Sc.half = half; Sc.list = (const unsigned long long*)(F.ws + WS_LIST);
    Sc.Abase = (const char*)(F.ws + (half ? WS_Y : WS_H)); Sc.Bbase = (const char*)(F.ws + WS_W2); Sc.NT = __builtin_amdgcn_readfirstlane(tab[64]); Sc.lat_only = l == DEPTH - 1; Sc.sh_mode = 0; Sc.NT_other = 0;
    EpiDown E; E.SL = (f16*)(F.ws + WS_SLOT); E.SH = (f16*)(F.ws + WS_SLSH); E.list = Sc.list; E.half = half; E.dry = F.dry;
    pg::gemm_phase<EpiDown, MoeSched<4, false>, true>(F.lds, F.wave, DEXP, DEXP, DEXP, Sc, E);
}
__device__ __forceinline__ void ln2_rows(Frame& F, CIN in, float* out, int l, int half) {
    const int gw = F.vcu * NWAVES + F.wave, NGW = F.G * NWAVES;
    float* X = (float*)(F.ws + WS_X); f16* HM = (f16*)(F.ws + WS_HMH); const unsigned char* SL8 = (const unsigned char*)(F.ws + WS_SLOT); const f16* SH = (const f16*)(F.ws + WS_SLSH);
    const float* mods = (const float*)(F.ws + WS_MODS) + (size_t)l * 9 * 6 * D;
    const f32x4* g4 = (const f32x4*)(INP(ln2_g) + l * D) + F.lane; const f32x4* b4 = (const f32x4*)(INP(ln2_b) + l * D) + F.lane;
    f32x4 gL[4], bL[4];
#pragma unroll
    for (int j = 0; j < 4; ++j) { gL[j] = g4[64 * j]; bL[j] = b4[64 * j]; }
    for (int th = gw; th < TH; th += NGW) {
        const int row = half * TH + th;
        if (l == DEPTH - 1 && row % SE >= S) continue;
        const float* m = mods + (size_t)mod_row(row) * 6 * D;
        f32x4* xr = (f32x4*)(X + (size_t)row * D) + F.lane;
        const f32x4* gt = (const f32x4*)(m + 5 * D) + F.lane;
        f32x4 v[4]; float s = 0.f;
        unsigned q[4][8]; h4 qs[4]; f32x4 xv[4], gv[4], shv[4], scv[4];
        const float* mn = mods + (size_t)9 * 6 * D + (size_t)mod_row(row) * 6 * D;
#pragma unroll
        for (int j = 0; j < 4; ++j) {
#pragma unroll
            for (int k = 0; k < 8; ++k) q[j][k] = *((const unsigned*)(SL8 + ((size_t)th * 8 + k) * D) + F.lane + 64 * j);
            qs[j] = *((const h4*)(SH + (size_t)th * D) + F.lane + 64 * j);
            xv[j] = xr[64 * j]; gv[j] = gt[64 * j];
            if (l + 1 < DEPTH) { shv[j] = ((const f32x4*)(mn) + F.lane)[64 * j]; scv[j] = ((const f32x4*)(mn + D) + F.lane)[64 * j]; }
        }
        asm volatile("" ::: "memory");
#pragma unroll
        for (int j = 0; j < 4; ++j) {
            f32x4 f = (f32x4){0.f, 0.f, 0.f, 0.f};
#pragma unroll
            for (int k = 0; k < 8; ++k) { const int w8 = (int)q[j][k]; f += (f32x4){__builtin_amdgcn_cvt_f32_fp8(w8, 0), __builtin_amdgcn_cvt_f32_fp8(w8, 1), __builtin_amdgcn_cvt_f32_fp8(w8, 2), __builtin_amdgcn_cvt_f32_fp8(w8, 3)}; }
            f = f * (1.f / SLOT_SC) + (f32x4){(float)qs[j][0], (float)qs[j][1], (float)qs[j][2], (float)qs[j][3]};
            v[j] = xv[j] * ALPHA + gv[j] * f; s += (v[j].x + v[j].y) + (v[j].z + v[j].w);
        }
        const float mean = wsum(s, F.lane) * (1.f / D); float s2 = 0.f;
#pragma unroll
        for (int j = 0; j < 4; ++j) { v[j] = v[j] - mean; s2 += (v[j].x * v[j].x + v[j].y * v[j].y) + (v[j].z * v[j].z + v[j].w * v[j].w); }
        const float rstd = 1.f / sqrtf(wsum(s2, F.lane) * (1.f / D) + LN_EPS);
#pragma unroll
        for (int j = 0; j < 4; ++j) { v[j] = v[j] * rstd * gL[j] + bL[j]; if (!F.dry) xr[64 * j] = v[j]; }
        if (l + 1 < DEPTH) {
            u32x2* o8 = (u32x2*)(HM + (size_t)row * D) + F.lane;
#pragma unroll
            for (int j = 0; j < 4; ++j) { const f32x4 h = v[j] * (scv[j] + 1.f) + shv[j]; u32x2 w; w.x = pkh(h.x, h.y); w.y = pkh(h.z, h.w); if (!F.dry) o8[64 * j] = w; }
        } else {
            const int b = row / SE, ii = row - b * SE;
            if (ii < S) { f32x4* o = (f32x4*)(out + ((size_t)b * S + ii) * D) + F.lane;
#pragma unroll
                for (int j = 0; j < 4; ++j) if (!F.dry) o[64 * j] = v[j]; }
        }
    }
}
#ifndef FFT_HD
#define FFT_HD __host__ __device__ __forceinline__
#endif
namespace fft {
constexpr int N = 8192, LOGN = 13, NPAD = N + N / 8;
FFT_HD int pidx(int i) { return i + (i >> 3); }
FFT_HD int brev(int k) { return (int)(__builtin_bitreverse32((unsigned)k) >> (32 - LOGN)); }
typedef float c2 __attribute__((ext_vector_type(2)));
FFT_HD c2 cmul(c2 a, c2 b) { return c2{a.x * b.x - a.y * b.y, a.x * b.y + a.y * b.x}; }
FFT_HD c2 cmulc(c2 a, c2 b) { return c2{a.x * b.x + a.y * b.y, a.y * b.x - a.x * b.y}; }
FFT_HD c2 tw(float frac) {
#if defined(__HIP_DEVICE_COMPILE__)
    return c2{__builtin_amdgcn_cosf(frac), -__builtin_amdgcn_sinf(frac)};
#else
    return c2{(float)cos(6.283185307179586 * (double)frac), (float)-sin(6.283185307179586 * (double)frac)};
#endif
}
template <int LOG, bool INV, class BP, class TP, bool HALF = false>
FFT_HD void pass_group(BP buf, TP tab, int h2, int gidx) {
    constexpr int R = 1 << LOG;
    const int hi = gidx / h2, lo = gidx - hi * h2, base = hi * (R * h2) + lo;
    c2 x[R];
#pragma unroll
    for (int m = 0; m < R; ++m) { if (HALF && !INV && m >= R / 2) x[m] = c2{0.f, 0.f}; else x[m] = buf[pidx(base + m * h2)]; }
    if (!INV) {
#pragma unroll
        for (int q = 0; q < LOG; ++q) { const int mq = R >> (q + 1); const int sc = N / (2 * mq * h2);
#pragma unroll
            for (int m = 0; m < R; ++m) if ((m & mq) == 0) { const c2 w = tab[pidx(((m % mq) * h2 + lo) * sc)]; const c2 a = x[m], b = x[m + mq];
                x[m] = c2{a.x + b.x, a.y + b.y}; x[m + mq] = cmul(c2{a.x - b.x, a.y - b.y}, w); } }
    } else {
#pragma unroll
        for (int q = LOG - 1; q >= 0; --q) { const int mq = R >> (q + 1); const int sc = N / (2 * mq * h2);
#pragma unroll
            for (int m = 0; m < R; ++m) if ((m & mq) == 0) { const c2 w = tab[pidx(((m % mq) * h2 + lo) * sc)]; const c2 a = x[m], t = cmulc(x[m + mq], w);
                x[m] = c2{a.x + t.x, a.y + t.y}; x[m + mq] = c2{a.x - t.x, a.y - t.y}; } }
    }
#pragma unroll
    for (int m = 0; m < R; ++m) if (!(HALF && INV && m >= R / 2)) buf[pidx(base + m * h2)] = x[m];
}
}
__device__ __forceinline__ void pro_mods(Frame& F, CIN in) {
    const int gw = F.vcu * NWAVES + F.wave, NGW = F.G * NWAVES, lane = F.lane;
    float* mods = (float*)(F.ws + WS_MODS);
    for (int task = gw; task < DEPTH * 96 * 16; task += NGW) {
        const int l = task / 1536, r0 = task - l * 1536, jb = r0 >> 4, kc = r0 & 15, col = jb * 64 + lane, k = kc * 64 + lane;
        float cv[9];
#pragma unroll
        for (int r = 0; r < 9; ++r) { const float v = r < 8 ? INP(c)[r * D + k] : INP(c_ctx)[k]; cv[r] = v / (1.f + expf(-v)); }
        float acc[9];
#pragma unroll
        for (int r = 0; r < 9; ++r) acc[r] = 0.f;
        const float* w = INP(w_ada) + ((size_t)l * D + kc * 64) * 6 * D + col;
#pragma unroll 4
        for (int kk = 0; kk < 64; ++kk) { const float wv = w[(size_t)kk * 6 * D];
#pragma unroll
            for (int r = 0; r < 9; ++r) acc[r] += __shfl(cv[r], kk) * wv; }
        const float bb = kc == 0 ? INP(b_ada)[l * 6 * D + col] : 0.f;
#pragma unroll
        for (int r = 0; r < 9; ++r) if (!F.dry) atomicAdd(&mods[((size_t)l * 9 + r) * 6 * D + col], acc[r] + bb);
    }
}
__device__ __forceinline__ void pro_init_x(Frame& F, CIN in) {
    const int gw = F.vcu * NWAVES + F.wave, NGW = F.G * NWAVES;
    float* X = (float*)(F.ws + WS_X);
    for (int row = gw; row < T; row += NGW) {
        const int b = row / SE, ii = row - b * SE;
        const f32x4* src = (const f32x4*)(ii < S ? INP(x) + ((size_t)b * S + ii) * D : INP(ctx) + ((size_t)b * CL + (ii - S)) * D) + F.lane;
        f32x4* dst = (f32x4*)(X + (size_t)row * D) + F.lane;
        f32x4 t4[4];
#pragma unroll
        for (int j = 0; j < 4; ++j) t4[j] = src[64 * j];
#pragma unroll
        for (int j = 0; j < 4; ++j) dst[64 * j] = t4[j];
    }
}
__device__ __forceinline__ void pro_z2(Frame& F, CIN in) {
    const int gw = F.vcu * NWAVES + F.wave, NGW = F.G * NWAVES, lane = F.lane;
    float* Z2 = (float*)(F.ws + WS_Z2);
    for (int task = gw; task < DEPTH * SE; task += NGW) {
        const int l = task / SE, ti = task - l * SE, L = ti < S ? S : CL, t = ti < S ? ti : ti - S;
        const float* w1 = INP(hy_w1) + l * 33 * 64; const float* w2 = INP(hy_w2) + l * 4096; const float* sf = INP(hy_sin_freq) + l * 128;
        const double PI2 = 6.283185307179586476925;
        const float tt = (float)((double)t / (double)(L - 1));
        const float ang = (float)(PI2 / (double)L) * (float)t;
        float a = INP(hy_b1)[l * 64 + lane];
        a += tt * w1[lane];
        for (int j = 0; j < 16; ++j) {
            const float band = (float)(1e-4 + (double)j * ((15.0 - 1e-4) / 15.0));
            const float arg = band * ang;
            a += cosf(arg) * w1[(1 + j) * 64 + lane];
            a += -sinf(arg) * w1[(17 + j) * 64 + lane];
        }
        const float z1 = sinf(sf[lane] * a);
        float a2 = INP(hy_b2)[l * 64 + lane];
        for (int i = 0; i < 64; ++i) a2 += __shfl(z1, i) * w2[i * 64 + lane];
        Z2[(size_t)task * 64 + lane] = sinf(sf[64 + lane] * a2);
    }
}
__device__ __forceinline__ void init_mod1_rows(Frame& F, CIN in) {
    const int gw = F.vcu * NWAVES + F.wave, NGW = F.G * NWAVES;
    float* X = (float*)(F.ws + WS_X); f16* HM = (f16*)(F.ws + WS_HMH);
    const float* mods = (const float*)(F.ws + WS_MODS);
    for (int row = gw; row < T; row += NGW) {
        const int b = row / SE, ii = row - b * SE;
        const f32x4* src = (const f32x4*)(ii < S ? INP(x) + ((size_t)b * S + ii) * D : INP(ctx) + ((size_t)b * CL + (ii - S)) * D) + F.lane;
        const float* m = mods + (size_t)(ii < S ? b : 8) * 6 * D;
        const f32x4* sh = (const f32x4*)(m) + F.lane; const f32x4* sc = (const f32x4*)(m + D) + F.lane;
        f32x4* dst = (f32x4*)(X + (size_t)row * D) + F.lane; u32x2* o8 = (u32x2*)(HM + (size_t)row * D) + F.lane;
        f32x4 xv[4], sv[4], cv[4];
#pragma unroll
        for (int j = 0; j < 4; ++j) { xv[j] = src[64 * j]; sv[j] = sh[64 * j]; cv[j] = sc[64 * j]; }
#pragma unroll
        for (int j = 0; j < 4; ++j) { dst[64 * j] = xv[j]; const f32x4 h = xv[j] * (cv[j] + 1.f) + sv[j]; u32x2 w; w.x = pkh(h.x, h.y); w.y = pkh(h.z, h.w); o8[64 * j] = w; }
    }
}
__device__ __forceinline__ void mod1_rows(Frame& F, int l) {
    const int gw = F.vcu * NWAVES + F.wave, NGW = F.G * NWAVES;
    const float* X = (const float*)(F.ws + WS_X); f16* HM = (f16*)(F.ws + WS_HMH);
    const float* mods = (const float*)(F.ws + WS_MODS) + (size_t)l * 9 * 6 * D;
    for (int row = gw; row < T; row += NGW) {
        const f32x4* xr = (const f32x4*)(X + (size_t)row * D) + F.lane;
        const float* m = mods + (size_t)mod_row(row) * 6 * D;
        const f32x4* sh = (const f32x4*)(m) + F.lane; const f32x4* sc = (const f32x4*)(m + D) + F.lane;
        u32x2* o8 = (u32x2*)(HM + (size_t)row * D) + F.lane;
        f32x4 xv[4], sv[4], cv[4];
#pragma unroll
        for (int j = 0; j < 4; ++j) { xv[j] = xr[64 * j]; sv[j] = sh[64 * j]; cv[j] = sc[64 * j]; }
#pragma unroll
        for (int j = 0; j < 4; ++j) { const f32x4 h = xv[j] * (cv[j] + 1.f) + sv[j]; u32x2 w; w.x = pkh(h.x, h.y); w.y = pkh(h.z, h.w); o8[64 * j] = w; }
    }
}

typedef LAS fft::c2* LBuf;
#define FFT_OPQ(t) asm volatile("" : "+v"(t))
typedef const LAS fft::c2* LTab;
constexpr int LDS_FFT_TAB = fft::NPAD * 8, LDS_FFT_END = LDS_FFT_TAB + (fft::N / 2 + fft::N / 16) * 8;
__device__ __forceinline__ void fft_fill_tab(LAS unsigned char* lds, int tid) {
    LAS fft::c2* tab = (LAS fft::c2*)(lds + LDS_FFT_TAB);
    for (int i = tid; i < fft::N / 2; i += NTHR) tab[fft::pidx(i)] = fft::tw((float)i * (1.0f / (float)fft::N));
    __syncthreads();
}
template <bool ZERO_UPPER>
__device__ __forceinline__ void fft_fwd(LBuf buf, int tid) {
    LTab tab = (LTab)((const LAS unsigned char*)buf + LDS_FFT_TAB);
    FFT_OPQ(tid); fft::pass_group<4, false, LBuf, LTab, ZERO_UPPER>(buf, tab, 512, tid); __syncthreads();
    FFT_OPQ(tid); fft::pass_group<3, false>(buf, tab, 64, tid); FFT_OPQ(tid); fft::pass_group<3, false>(buf, tab, 64, tid + 512); __syncthreads();
    FFT_OPQ(tid); fft::pass_group<3, false>(buf, tab, 8, tid); FFT_OPQ(tid); fft::pass_group<3, false>(buf, tab, 8, tid + 512); __syncthreads();
    FFT_OPQ(tid); fft::pass_group<3, false>(buf, tab, 1, tid); FFT_OPQ(tid); fft::pass_group<3, false>(buf, tab, 1, tid + 512); __syncthreads();
}
__device__ __forceinline__ void fft_inv(LBuf buf, int tid) {
    LTab tab = (LTab)((const LAS unsigned char*)buf + LDS_FFT_TAB);
    FFT_OPQ(tid); fft::pass_group<3, true>(buf, tab, 1, tid); FFT_OPQ(tid); fft::pass_group<3, true>(buf, tab, 1, tid + 512); __syncthreads();
    FFT_OPQ(tid); fft::pass_group<3, true>(buf, tab, 8, tid); FFT_OPQ(tid); fft::pass_group<3, true>(buf, tab, 8, tid + 512); __syncthreads();
    FFT_OPQ(tid); fft::pass_group<3, true>(buf, tab, 64, tid); FFT_OPQ(tid); fft::pass_group<3, true>(buf, tab, 64, tid + 512); __syncthreads();
    FFT_OPQ(tid); fft::pass_group<4, true, LBuf, LTab, true>(buf, tab, 512, tid); __syncthreads();
}
__device__ __forceinline__ float hy_delta(int c) { const float la = -3.0701134573253944f  , st = (-15.350567286626972f + 3.0701134573253944f) / 511.0f; return fabsf(la + (float)c * st); }
__device__ __forceinline__ void filters_phase(Frame& F, CIN in, int l) {
    LBuf buf = (LBuf)F.lds;
    LAS float* w3s = (LAS float*)(F.lds + LDS_FFT_END);
    fft_fill_tab(F.lds, F.tid);
    const float* Z2 = (const float*)(F.ws + WS_Z2) + (size_t)l * SE * 64;
    const float* w3 = INP(hy_w3) + (size_t)l * 64 * 1024;
    f32x4* SD = (f32x4*)(F.ws + WS_SD);
    for (int p = F.bid; p < 256; p += F.G) {
        int tid = F.tid; asm volatile("" : "+v"(tid));
        const int ca = 2 * p, cb = 2 * p + 1;
        __syncthreads();
        if (tid < 256) { const int j = tid & 63, which = tid >> 6; const int col = (which & 1 ? cb : ca) + (which >> 1 ? 512 : 0); w3s[which * 64 + j] = w3[j * 1024 + col]; }
        __syncthreads();
        const float da = hy_delta(ca), db = hy_delta(cb);
        for (int i = 0; i < 8; ++i) {
            const int t = tid + 512 * i;
            const f32x4* zr = (const f32x4*)(Z2 + (size_t)t * 64);
            float fa = 0.f, fb = 0.f, ba = 0.f, bb = 0.f;
#pragma unroll 4
            for (int j4 = 0; j4 < 16; ++j4) { const f32x4 z = zr[j4];
#pragma unroll
                for (int u = 0; u < 4; ++u) { const int j = 4 * j4 + u; fa += z[u] * w3s[j]; fb += z[u] * w3s[64 + j]; ba += z[u] * w3s[128 + j]; bb += z[u] * w3s[192 + j]; } }
            const float tt = (float)t * (1.0f / (float)(S - 1));
            const float ea = expf(-tt * da), eb = expf(-tt * db);
            buf[fft::pidx(t)] = fft::c2{fa * ea, fb * eb};
            if (t == 0) { const float zf = (float)(tid >> 16); buf[fft::pidx(S)] = fft::c2{zf, zf}; } else buf[fft::pidx(2 * S - t)] = fft::c2{ba * ea, bb * eb};
        }
        __syncthreads();
        fft_fwd<false>(buf, tid);
        for (int j = tid; j <= S; j += NTHR) {
            const int pos = j < S ? 2 * j : 1, k = fft::brev(pos);
            const fft::c2 Xk = buf[fft::pidx(pos)], Xp = buf[fft::pidx(fft::brev((fft::N - k) & (fft::N - 1)))];
            const float gar = 0.5f * (Xk.x + Xp.x), gai = 0.5f * (Xk.y - Xp.y);
            const float ur = Xk.x - Xp.x, ui = Xk.y + Xp.y;
            const float gbr = 0.5f * ui, gbi = -0.5f * ur;
            SD[(size_t)p * 4097 + j] = (f32x4){0.5f * (gar + gbr), 0.5f * (gai + gbi), 0.5f * (gar - gbr), 0.5f * (gai - gbi)};
        }
    }
    __syncthreads();
    const int gw = F.vcu * NWAVES + F.wave, NGW = F.G * NWAVES, lane = F.lane;
    float* GC = (float*)(F.ws + WS_GC);
    const float* Z2c = Z2 + (size_t)S * 64;
    for (int task = gw; task < CL * 16; task += NGW) {
        const int t = task >> 4, col = (task & 15) * 64 + lane;
        const float* zr = Z2c + (size_t)t * 64;
        float a = 0.f;
#pragma unroll 8
        for (int j = 0; j < 64; ++j) a += zr[j] * w3[j * 1024 + col];
        const int c = col & 511;
        const float tt = (float)t * (1.0f / (float)(CL - 1));
        const float v = a * expf(-tt * hy_delta(c));
        if (col < 512) GC[(size_t)c * 512 + 256 + t] = v; else if (t >= 1) GC[(size_t)c * 512 + 256 - t] = v;
    }
}

__device__ __forceinline__ void transpose_phase(Frame& F, CIN in, int l) {
    LAS f16* tile = (LAS f16*)F.lds;
    const f16* P = (const f16*)(F.ws + WS_P);
    f16* ZT = (f16*)(F.ws + WS_ZT); f16* VT = (f16*)(F.ws + WS_VT);
    const float* cw = INP(hy_conv_w) + l * 3 * 1536; const float* cbias = INP(hy_conv_b) + l * 1536;
    const int tid = F.tid, t = tid >> 3, cg = tid & 7;
    for (int task = F.bid; task < B * 68 * 4; task += F.G) {
        const int q = task & 3, r0 = task >> 2, tl = r0 % 68, b = r0 / 68;
        const int i = tl * 64 + t, lo = i < S ? 0 : S, hi = i < S ? S : SE;
        const f16* prow = P + ((size_t)b * SE + i) * DIN;
        const bool hasp = i - 1 >= lo, hasn = i + 1 < hi;
        h8 outv[4];
        if (q < 2) {
            h8 cur[4][2], prv[4][2], nxt[4][2];
#pragma unroll
            for (int u = 0; u < 4; ++u)
#pragma unroll
                for (int part = 0; part < 2; ++part) { const int col = 512 * (part + 1) + (4 * q + u) * 64 + cg * 8;
                    cur[u][part] = *(const h8*)(prow + col);
#pragma unroll
                    for (int j = 0; j < 8; ++j) { prv[u][part][j] = (f16)0.f; nxt[u][part][j] = (f16)0.f; }
                    if (hasp) prv[u][part] = *(const h8*)(prow - DIN + col);
                    if (hasn) nxt[u][part] = *(const h8*)(prow + DIN + col); }
#pragma unroll
            for (int u = 0; u < 4; ++u) { float z[8];
#pragma unroll
                for (int part = 0; part < 2; ++part) { const int col = 512 * (part + 1) + (4 * q + u) * 64 + cg * 8;
#pragma unroll
                    for (int j = 0; j < 8; ++j) { const float uu = (float)prv[u][part][j] * cw[col + j] + (float)cur[u][part][j] * cw[1536 + col + j] + (float)nxt[u][part][j] * cw[3072 + col + j] + cbias[col + j];
                        z[j] = part == 0 ? uu : z[j] * uu; } }
#pragma unroll
                for (int j = 0; j < 8; ++j) outv[u][j] = (f16)z[j]; }
        } else {
#pragma unroll
            for (int u = 0; u < 4; ++u) outv[u] = *(const h8*)(prow + OFF_NA + 1024 + (4 * (q - 2) + u) * 64 + cg * 8);
        }
        __syncthreads();
#pragma unroll
        for (int u = 0; u < 4; ++u)
#pragma unroll
            for (int j = 0; j < 8; ++j) tile[u * 4608 + (cg * 8 + j) * 72 + t] = outv[u][j];
        __syncthreads();
        {
            const int ch = tid >> 3, part = tid & 7;
#pragma unroll
            for (int u = 0; u < 4; ++u) {
                const h8 v = *(const LAS h8*)(tile + u * 4608 + ch * 72 + part * 8);
                const int cb = q < 2 ? 4 * q + u : 4 * (q - 2) + u;
                f16* dst = (q < 2 ? ZT : VT) + ((size_t)b * DH + cb * 64 + ch) * SE + tl * 64 + part * 8;
                *(h8*)dst = v; }
        }
    }
    __syncthreads();
}

__device__ __forceinline__ void fftconv_tasks(Frame& F, CIN in, int l, int pflags) {
    LBuf buf = (LBuf)F.lds;
    f16* ZT = (f16*)(F.ws + WS_ZT); const f16* VHT = (const f16*)(F.ws + WS_VHT);
    const f32x4* SD = (const f32x4*)(F.ws + WS_SD);
    const float* bd = INP(hy_bias_d) + l * DH;
    const float* cwl = INP(hy_conv_w) + l * 3 * 1536; const float* cbl = INP(hy_conv_b) + l * 1536;
    fft_fill_tab(F.lds, F.tid);
    for (int task = F.bid; task < B * 256; task += F.G) {
        int tid = F.tid; asm volatile("" : "+v"(tid));
        const int b = task & 7, p = task >> 3;
        f16* za = ZT + ((size_t)b * DH + 2 * p) * SE; f16* zb = za + SE;
        const f16* ha = VHT + ((size_t)b * DH + 2 * p) * SE; const f16* hb = ha + SE;
        const int t0 = tid * 8;
        h8 va, vb;
        {
            const h8 xa = *(const h8*)(za + t0), xb = *(const h8*)(zb + t0), wa = *(const h8*)(ha + t0), wb = *(const h8*)(hb + t0);
            const bool hp = t0 > 0, hn = t0 + 8 < S;
            const f16 zf = (f16)0.f;
            const f16 xap = hp ? za[t0 - 1] : zf, xan = hn ? za[t0 + 8] : zf, xbp = hp ? zb[t0 - 1] : zf, xbn = hn ? zb[t0 + 8] : zf;
            const f16 wap = hp ? ha[t0 - 1] : zf, wan = hn ? ha[t0 + 8] : zf, wbp = hp ? hb[t0 - 1] : zf, wbn = hn ? hb[t0 + 8] : zf;
            const int ca = 2 * p, cbb = 2 * p + 1;
            const float x1a0 = cwl[512 + ca], x1a1 = cwl[1536 + 512 + ca], x1a2 = cwl[3072 + 512 + ca], x1ab = cbl[512 + ca];
            const float x1b0 = cwl[512 + cbb], x1b1 = cwl[1536 + 512 + cbb], x1b2 = cwl[3072 + 512 + cbb], x1bb = cbl[512 + cbb];
            const float vha0 = cwl[1024 + ca], vha1 = cwl[1536 + 1024 + ca], vha2 = cwl[3072 + 1024 + ca], vhab = cbl[1024 + ca];
            const float vhb0 = cwl[1024 + cbb], vhb1 = cwl[1536 + 1024 + cbb], vhb2 = cwl[3072 + 1024 + cbb], vhbb = cbl[1024 + cbb];
#pragma unroll
            for (int j = 0; j < 8; ++j) {
                const float xa_m = (float)(j == 0 ? xap : xa[j == 0 ? 0 : j - 1]), xa_p = (float)(j == 7 ? xan : xa[j == 7 ? 7 : j + 1]);
                const float xb_m = (float)(j == 0 ? xbp : xb[j == 0 ? 0 : j - 1]), xb_p = (float)(j == 7 ? xbn : xb[j == 7 ? 7 : j + 1]);
                const float wa_m = (float)(j == 0 ? wap : wa[j == 0 ? 0 : j - 1]), wa_p = (float)(j == 7 ? wan : wa[j == 7 ? 7 : j + 1]);
                const float wb_m = (float)(j == 0 ? wbp : wb[j == 0 ? 0 : j - 1]), wb_p = (float)(j == 7 ? wbn : wb[j == 7 ? 7 : j + 1]);
                const float ua = xa_m * x1a0 + (float)xa[j] * x1a1 + xa_p * x1a2 + x1ab, ub = xb_m * x1b0 + (float)xb[j] * x1b1 + xb_p * x1b2 + x1bb;
                const float ya = wa_m * vha0 + (float)wa[j] * vha1 + wa_p * vha2 + vhab, yb = wb_m * vhb0 + (float)wb[j] * vhb1 + wb_p * vhb2 + vhbb;
                va[j] = (f16)(ua * ya); vb[j] = (f16)(ub * yb);
            }
        }
        f32x4 sdv[8];
#pragma unroll
        for (int i = 0; i < 8; ++i) sdv[i] = SD[(size_t)p * 4097 + tid + NTHR * i];
        __syncthreads();
#pragma unroll
        for (int j = 0; j < 8; ++j) buf[fft::pidx(t0 + j)] = fft::c2{(float)va[j], (float)vb[j]};
        __syncthreads();
        if (!(pflags & 128)) fft_fwd<true>(buf, tid);
#pragma unroll
        for (int i = 0; i < 9; ++i) {
            if (i < 8 || tid == 0) {
                const int pos = i < 8 ? 2 * (tid + NTHR * i) : 1, k = fft::brev(pos);
                const int pa = fft::pidx(pos), pp = fft::pidx(fft::brev((fft::N - k) & (fft::N - 1)));
                const fft::c2 Xk = buf[pa], Xp = buf[pp]; const f32x4 sd = i < 8 ? sdv[i < 8 ? i : 0] : SD[(size_t)p * 4097 + S];
                const fft::c2 Sv{sd[0], sd[1]}, Dv{sd[2], sd[3]};
                const fft::c2 t1 = fft::cmul(Xk, Sv), t2 = fft::cmul(fft::c2{Xp.x, -Xp.y}, Dv);
                const fft::c2 u1 = fft::cmulc(Xp, Sv), u2 = fft::cmulc(fft::c2{Xk.x, -Xk.y}, Dv);
                buf[pa] = fft::c2{t1.x + t2.x, t1.y + t2.y};
                if (pp != pa) buf[pp] = fft::c2{u1.x + u2.x, u1.y + u2.y};
            }
        }
        __syncthreads();
        if (!(pflags & 256)) fft_inv(buf, tid);
        const float ba = bd[2 * p], bb = bd[2 * p + 1];
        h8 oa, ob;
#pragma unroll
        for (int j = 0; j < 8; ++j) { const fft::c2 y = buf[fft::pidx(t0 + j)]; oa[j] = (f16)(y.x * (1.f / fft::N) + (float)va[j] * ba); ob[j] = (f16)(y.y * (1.f / fft::N) + (float)vb[j] * bb); }
        if (!F.dry) { *(h8*)(za + t0) = oa; *(h8*)(zb + t0) = ob; }
    }
    __syncthreads();
}
__device__ __forceinline__ void ctxconv_tasks(Frame& F, CIN in, int l) {
    const int gw = F.vcu * NWAVES + F.wave, NGW = F.G * NWAVES, lane = F.lane;
    f16* ZT = (f16*)(F.ws + WS_ZT); const f16* VHT = (const f16*)(F.ws + WS_VHT);
    const float* GC = (const float*)(F.ws + WS_GC);
    const float* cwl = INP(hy_conv_w) + l * 3 * 1536; const float* cbl = INP(hy_conv_b) + l * 1536;
    for (int task = gw; task < B * DH; task += NGW) {
        const int c = task & (DH - 1);
        f16* zp = ZT + (size_t)task * SE + S; const f16* hp = VHT + (size_t)task * SE + S;
        float zv[4], acc[4];
        {
            const float xw0 = cwl[512 + c], xw1 = cwl[1536 + 512 + c], xw2 = cwl[3072 + 512 + c], xbb = cbl[512 + c];
            const float vw0 = cwl[1024 + c], vw1 = cwl[1536 + 1024 + c], vw2 = cwl[3072 + 1024 + c], vbb = cbl[1024 + c];
#pragma unroll
            for (int j = 0; j < 4; ++j) { const int t = lane + 64 * j;
                const float xm = t > 0 ? (float)zp[t - 1] : 0.f, x0 = (float)zp[t], xp = t + 1 < CL ? (float)zp[t + 1] : 0.f;
                const float vm = t > 0 ? (float)hp[t - 1] : 0.f, v0 = (float)hp[t], vp = t + 1 < CL ? (float)hp[t + 1] : 0.f;
                zv[j] = (float)(f16)((xm * xw0 + x0 * xw1 + xp * xw2 + xbb) * (vm * vw0 + v0 * vw1 + vp * vw2 + vbb)); acc[j] = 0.f; }
        }
        const float* g = GC + (size_t)c * 512 + 256 + lane;
#pragma unroll
        for (int sj = 0; sj < 4; ++sj)
            for (int s0 = 0; s0 < 64; ++s0) { const float zs = bperm(s0, zv[sj]); const int s = sj * 64 + s0;
#pragma unroll
                for (int j = 0; j < 4; ++j) acc[j] += g[64 * j - s] * zs; }
        const float bdv = INP(hy_bias_d)[l * DH + c];
#pragma unroll
        for (int j = 0; j < 4; ++j) if (!F.dry) zp[lane + 64 * j] = (f16)(acc[j] + zv[j] * bdv);
    }
}
constexpr int AT_KP = 72, AT_VP = 264;
constexpr int AT_VOFF = 256 * AT_KP * 2;
constexpr int AT_RPB = AT_VOFF + 64 * AT_VP * 2;
template <bool LOCAL>
__device__ __forceinline__ void attn_wtask(Frame& F, const float* rpb_l, int b, int h, int r, int n, int qrow0, int pf = 0) {
    const int lane = lane_id(), fr = lane & 15, fq = lane >> 4;
    const f16* P = (const f16*)(F.ws + WS_P); const f16* VT = (const f16*)(F.ws + WS_VT); f16* Y = (f16*)(F.ws + WS_Y);
    const LAS f16* Kc = (const LAS f16*)F.lds; const LAS f16* VcT = (const LAS f16*)(F.lds + AT_VOFF);
    const int rs = r - 4 < 0 ? 0 : (r - 4 > 56 ? 56 : r - 4);
    const int kb = n == 0 ? 0 : (n == 1 ? 8 : (n == 2 ? 24 : 32));
    const f16* Pb = P + (size_t)b * SE * DIN;
    const f16* qp = Pb + (size_t)(qrow0 + fr) * DIN + OFF_NA + h * 64 + fq * 8;
    const h8 bq0 = *(const h8*)qp, bq1 = *(const h8*)(qp + 32);
    const char* kub = (const char*)(Pb + OFF_NA + 512 + h * 64);
    const unsigned klo = (unsigned)fq * 16u;
    const f16* vbase = VT + ((size_t)b * DH + h * 64 + fr) * SE + 8 * fq;
    const int ko = 8 * (fr >> 2) + (fr & 3);
    const int qc = 16 * n + fr; const int cs = qc - 8 < 0 ? 0 : (qc - 8 > 48 ? 48 : qc - 8);
    float mrun = -3.0e38f, lsum = 0.f;
    f32x4 o[4];
#pragma unroll
    for (int d = 0; d < 4; ++d) o[d] = (f32x4){0.f, 0.f, 0.f, 0.f};
    constexpr int NCH = LOCAL ? 2 : 1;
#pragma unroll
    for (int ch = 0; ch < NCH; ++ch) {
        if (LOCAL && ((ch == 0 && (pf & 8192)) || (ch == 1 && (pf & 16384)))) continue;
        const bool loc = LOCAL && ch == 0;
        f32x4 st[16];
        if (loc) {
            h8 kf[3][8];
#pragma unroll
            for (int g0 = 0; g0 < 2; ++g0)
#pragma unroll
                for (int q = 0; q < 4; ++q) { const int tl = 4 * g0 + q; const char* kp = kub + ((unsigned)((rs + (tl >> 1)) * 64 + kb + 4 * (tl & 1) + ko) * (unsigned)(DIN * 2) + klo); kf[g0][2 * q] = *(const h8*)kp; kf[g0][2 * q + 1] = *(const h8*)(kp + 64); }
#pragma unroll
            for (int g = 0; g < 4; ++g) {
                if (g + 2 < 4) {
#pragma unroll
                    for (int q = 0; q < 4; ++q) { const int tl = 4 * (g + 2) + q; const char* kp = kub + ((unsigned)((rs + (tl >> 1)) * 64 + kb + 4 * (tl & 1) + ko) * (unsigned)(DIN * 2) + klo);
                        kf[(g + 2) % 3][2 * q] = *(const h8*)kp; kf[(g + 2) % 3][2 * q + 1] = *(const h8*)(kp + 64); }
                }
                asm volatile("" ::: "memory");
#pragma unroll
                for (int q = 0; q < 4; ++q) { f32x4 acc = (f32x4){0.f, 0.f, 0.f, 0.f};
                    acc = __builtin_amdgcn_mfma_f32_16x16x32_f16(kf[g % 3][2 * q], bq0, acc, 0, 0, 0);
                    acc = __builtin_amdgcn_mfma_f32_16x16x32_f16(kf[g % 3][2 * q + 1], bq1, acc, 0, 0, 0);
                    st[4 * g + q] = acc; }
            }
        } else {
#pragma unroll
            for (int tl = 0; tl < 16; ++tl) {
                const LAS f16* kp = Kc + (32 * (tl >> 1) + 4 * (tl & 1) + ko) * AT_KP + fq * 8;
                const h8 a0 = *(const LAS h8*)kp, a1 = *(const LAS h8*)(kp + 32);
                f32x4 acc = (f32x4){0.f, 0.f, 0.f, 0.f};
                acc = __builtin_amdgcn_mfma_f32_16x16x32_f16(a0, bq0, acc, 0, 0, 0);
                acc = __builtin_amdgcn_mfma_f32_16x16x32_f16(a1, bq1, acc, 0, 0, 0);
                st[tl] = acc;
                if ((tl & 3) == 3) asm volatile("" ::: "memory");
            }
        }
        h8 vf[4][4];
        if (loc) {
#pragma unroll
            for (int pre = 0; pre < 3; ++pre)
#pragma unroll
                for (int d = 0; d < 4; ++d) vf[pre][d] = *(const h8*)(vbase + (size_t)d * 16 * SE + (rs + pre) * 64 + kb);
        }
        float mx = -3.0e38f;
        if (loc) {
            const LAS float* rp = (const LAS float*)(F.lds + AT_RPB) + h * 15 * 32;
            const int cbase = kb + 8 * fq - qc + 15;
#pragma unroll
            for (int sp = 0; sp < 8; ++sp) {
                const LAS float* rrow = rp + (rs + sp - r + 7) * 32;
                float bz[8];
#pragma unroll
                for (int e = 0; e < 8; ++e) { int ci = cbase + e; ci = ci < 0 ? 0 : (ci > 30 ? 30 : ci); bz[e] = rrow[ci]; }
#pragma unroll
                for (int e = 0; e < 8; ++e) { const int kcol = kb + 8 * fq + e; const bool ok = kcol >= cs && kcol < cs + 16;
                    const float sv = ok ? st[2 * sp + (e >> 2)][e & 3] * 0.125f + bz[e] : -1.0e30f;
                    st[2 * sp + (e >> 2)][e & 3] = sv; mx = fmaxf(mx, sv); }
            }
        } else {
#pragma unroll
            for (int tl = 0; tl < 16; ++tl)
#pragma unroll
                for (int i = 0; i < 4; ++i) { const float sv = st[tl][i] * 0.125f; st[tl][i] = sv; mx = fmaxf(mx, sv); }
        }
        mx = fmaxf(mx, SHX(mx, 16)); mx = fmaxf(mx, SHX(mx, 32));
        const float mnew = fmaxf(mrun, mx), alpha = __expf(mrun - mnew);
        mrun = mnew;
        float ps = 0.f;
#pragma unroll
        for (int tl = 0; tl < 16; ++tl)
#pragma unroll
            for (int i = 0; i < 4; ++i) { const float pv = __expf(st[tl][i] - mnew); st[tl][i] = pv; ps += pv; }
        ps += SHX(ps, 16); ps += SHX(ps, 32);
        lsum = lsum * alpha + ps;
        if (ch > 0) {
#pragma unroll
            for (int i = 0; i < 4; ++i) { const float al = bperm(4 * fq + i, alpha);
#pragma unroll
                for (int d = 0; d < 4; ++d) o[d][i] *= al; }
        }
        if (loc) {
#pragma unroll
            for (int sp = 0; sp < 8; ++sp) {
                if (sp + 3 < 8) {
#pragma unroll
                    for (int d = 0; d < 4; ++d) vf[(sp + 3) & 3][d] = *(const h8*)(vbase + (size_t)d * 16 * SE + (rs + sp + 3) * 64 + kb);
                }
                asm volatile("" ::: "memory");
                h8 pa;
#pragma unroll
                for (int i = 0; i < 4; ++i) { pa[i] = (f16)st[2 * sp][i]; pa[4 + i] = (f16)st[2 * sp + 1][i]; }
#pragma unroll
                for (int d = 0; d < 4; ++d) o[d] = __builtin_amdgcn_mfma_f32_16x16x32_f16(pa, vf[sp & 3][d], o[d], 0, 0, 0);
            }
        } else {
#pragma unroll
            for (int sp = 0; sp < 8; ++sp) {
                h8 pa;
#pragma unroll
                for (int i = 0; i < 4; ++i) { pa[i] = (f16)st[2 * sp][i]; pa[4 + i] = (f16)st[2 * sp + 1][i]; }
#pragma unroll
                for (int d = 0; d < 4; ++d) {
                    const h8 bv = *(const LAS h8*)(VcT + (16 * d + fr) * AT_VP + 32 * sp + 8 * fq);
                    o[d] = __builtin_amdgcn_mfma_f32_16x16x32_f16(pa, bv, o[d], 0, 0, 0);
                }
                if (sp & 1) asm volatile("" ::: "memory");
            }
        }
    }
    const float inv = 1.f / lsum;
    f16* yb = Y + ((size_t)b * SE + qrow0) * 1536 + 1024 + h * 64 + fr;
#pragma unroll
    for (int i = 0; i < 4; ++i) { const float sc = bperm(4 * fq + i, inv);
#pragma unroll
        for (int d = 0; d < 4; ++d) yb[(size_t)(4 * fq + i) * 1536 + 16 * d] = (f16)(o[d][i] * sc); }
}
__device__ __forceinline__ void attn_tasks(Frame& F, CIN in, int l, int pf) {
    const float* rpb_l = INP(na_rpb) + (size_t)l * NHEAD * 15 * 31;
    const f16* P = (const f16*)(F.ws + WS_P); const f16* VT = (const f16*)(F.ws + WS_VT);
    LAS f16* Kc = (LAS f16*)F.lds; LAS f16* VcT = (LAS f16*)(F.lds + AT_VOFF);
    constexpr int NBT = 64 * 34;
    { LAS float* rp = (LAS float*)(F.lds + AT_RPB); __syncthreads();
      for (int i = F.tid; i < NHEAD * 15 * 31; i += NTHR) { const int hh = i / 465, rem = i - hh * 465, ri = rem / 31, ci = rem - ri * 31; rp[(hh * 15 + ri) * 32 + ci] = rpb_l[i]; } }
    const int t_lo = (int)(((long)F.bid * NBT) / F.G), t_hi = (int)(((long)(F.bid + 1) * NBT) / F.G);
    int staged = -1;
    __syncthreads();
    for (int bt = t_lo; bt < t_hi; ++bt) {
        const int bh = bt / 34, j = bt - bh * 34, b = bh >> 3, h = bh & 7;
        if (bh != staged) {
            __syncthreads();
            const int tid = F.wave * 64 + lane_id();
            h8 tk[4], tv[4];
#pragma unroll
            for (int i = 0; i < 4; ++i) { const int idx = tid + NTHR * i, key = idx >> 3, part = idx & 7;
                tk[i] = *(const h8*)(P + ((size_t)b * SE + S + key) * DIN + OFF_NA + 512 + h * 64 + part * 8); }
#pragma unroll
            for (int i = 0; i < 4; ++i) { const int idx = tid + NTHR * i, d = idx >> 5, part = idx & 31;
                tv[i] = *(const h8*)(VT + ((size_t)b * DH + h * 64 + d) * SE + S + part * 8); }
#pragma unroll
            for (int i = 0; i < 4; ++i) { const int idx = tid + NTHR * i; *(LAS h8*)(Kc + (idx >> 3) * AT_KP + (idx & 7) * 8) = tk[i]; *(LAS h8*)(VcT + (idx >> 5) * AT_VP + (idx & 31) * 8) = tv[i]; }
            staged = bh;
            __syncthreads();
        }
        const int w = F.wave;
        if (j < 32) { const int r = 2 * j + (w >> 2), n = w & 3; attn_wtask<true>(F, rpb_l, b, h, r, n, r * 64 + 16 * n, pf); }
        else if (l + 1 < DEPTH) { const int qb = (j - 32) * 8 + w; attn_wtask<false>(F, rpb_l, b, h, 0, 0, S + 16 * qb); }
    }
    __syncthreads();
}

__device__ __forceinline__ void ymix_phase(Frame& F, CIN in, int l) {
    LAS f16* tile = (LAS f16*)F.lds;
    const f16* P = (const f16*)(F.ws + WS_P); const f16* ZT = (const f16*)(F.ws + WS_ZT); f16* Y = (f16*)(F.ws + WS_Y);
    const float* cw = INP(hy_conv_w) + l * 3 * 1536; const float* cbias = INP(hy_conv_b) + l * 1536; const float* scw = INP(sc_conv_w) + l * 3 * DH;
    const int tid = F.tid;
    {
        const int c0 = (tid & 63) * 8, rsub = tid >> 6;
        float w0[8], w1[8], w2[8];
#pragma unroll
        for (int j = 0; j < 8; ++j) { w0[j] = scw[c0 + j]; w1[j] = scw[512 + c0 + j]; w2[j] = scw[1024 + c0 + j]; }
        const int rows_per = (T + F.G - 1) / F.G, rbeg = F.bid * rows_per, rend = rbeg + rows_per < T ? rbeg + rows_per : T;
        for (int row = rbeg + rsub; row < rend; row += 8) {
            const int b = row / SE, i = row - b * SE, lo = i < S ? 0 : S, hi = i < S ? S : SE;
            const f16* ps = P + (size_t)row * DIN + OFF_SC + c0;
            const h8 bg = *(const h8*)ps, c1 = *(const h8*)(ps + 512), x1 = *(const h8*)(ps + 1024);
            h8 c0v, x0v, c2v, x2v;
#pragma unroll
            for (int j = 0; j < 8; ++j) { c0v[j] = (f16)0.f; x0v[j] = (f16)0.f; c2v[j] = (f16)0.f; x2v[j] = (f16)0.f; }
            if (i - 1 >= lo) { c0v = *(const h8*)(ps - DIN + 512); x0v = *(const h8*)(ps - DIN + 1024); }
            if (i + 1 < hi) { c2v = *(const h8*)(ps + DIN + 512); x2v = *(const h8*)(ps + DIN + 1024); }
            h8 o;
#pragma unroll
            for (int j = 0; j < 8; ++j) { const float v = (float)c0v[j] * (float)x0v[j] * w0[j] + (float)c1[j] * (float)x1[j] * w1[j] + (float)c2v[j] * (float)x2v[j] * w2[j];
                o[j] = (f16)((float)bg[j] * v); }
            *(h8*)(Y + (size_t)row * 1536 + 512 + c0) = o;
        }
    }
    const int t = tid >> 3, cg = tid & 7;
    for (int task = F.bid; task < B * 68 * 2; task += F.G) {
        const int q = task & 1, r0 = task >> 1, tl = r0 % 68, b = r0 / 68;
        const int i = tl * 64 + t, lo = i < S ? 0 : S, hi = i < S ? S : SE;
        const f16* prow = P + ((size_t)b * SE + i) * DIN;
        f16* yrow = Y + ((size_t)b * SE + i) * 1536;
        const bool hasp = i - 1 >= lo, hasn = i + 1 < hi;
        h8 yt[4], cur[4], prv[4], nxt[4];
        { const int ch = tid >> 3, part = tid & 7;
#pragma unroll
          for (int u = 0; u < 4; ++u) yt[u] = *(const h8*)(ZT + ((size_t)b * DH + (4 * q + u) * 64 + ch) * SE + tl * 64 + part * 8); }
#pragma unroll
        for (int u = 0; u < 4; ++u) { const int c0 = (4 * q + u) * 64 + cg * 8;
            cur[u] = *(const h8*)(prow + c0);
#pragma unroll
            for (int j = 0; j < 8; ++j) { prv[u][j] = (f16)0.f; nxt[u][j] = (f16)0.f; }
            if (hasp) prv[u] = *(const h8*)(prow - DIN + c0);
            if (hasn) nxt[u] = *(const h8*)(prow + DIN + c0); }
        __syncthreads();
        { const int ch = tid >> 3, part = tid & 7;
#pragma unroll
          for (int u = 0; u < 4; ++u) *(LAS h8*)(tile + u * 4608 + ch * 72 + part * 8) = yt[u]; }
        __syncthreads();
#pragma unroll
        for (int u = 0; u < 4; ++u) { const int c0 = (4 * q + u) * 64 + cg * 8; h8 o;
#pragma unroll
            for (int j = 0; j < 8; ++j) { const float x0 = (float)prv[u][j] * cw[c0 + j] + (float)cur[u][j] * cw[1536 + c0 + j] + (float)nxt[u][j] * cw[3072 + c0 + j] + cbias[c0 + j];
                o[j] = (f16)(x0 * (float)tile[u * 4608 + (cg * 8 + j) * 72 + t]); }
            *(h8*)(yrow + c0) = o; }
    }
    __syncthreads();
}

struct TileOrder {
    int nM, nN, nwg, G, c;
    __device__ __forceinline__ void init(int M, int N, int G_, int c_) { nM = M / 256; nN = N / 256; nwg = nM * nN; G = G_; c = c_; }
    __device__ __forceinline__ bool tile(int i, int& pm, int& pn) const {
        const long L = (long)i * G + c; if (L >= nwg) return false;
        int wgid = (int)L; { const int q = nwg / 8, r = nwg % 8, xcd = wgid % 8, off = wgid / 8; wgid = (xcd < r ? xcd * (q + 1) : r * (q + 1) + (xcd - r) * q) + off; }
        const int nig = 8 * nN, gid = wgid / nig, fm = gid * 8, gsz = (nM - fm) < 8 ? (nM - fm) : 8;
        pm = fm + ((wgid % nig) % gsz); pn = (wgid % nig) / gsz; return true;
    }
};
template <int SUB>
struct DenseSched {
    static constexpr bool GATHER = false;
    TileOrder O; const char* A; const char* Bm; int lda, ldb; size_t a_sub, b_sub; int lat_only;
    __device__ __forceinline__ bool next(int i, pg::Unit& u) const {
        const int ti = i / SUB, s = i - ti * SUB; int pm, pn;
        if (!O.tile(ti, pm, pn)) return false;
        if (lat_only) pm = (pm >> 4) * 17 + (pm & 15);
        u.pm = pm; u.pn = pn; u.e = s; u.nrows = 256; u.aux0 = 0;
        u.A = A + (size_t)pm * 256 * lda * 2 + s * a_sub; u.B = Bm + (size_t)pn * 256 * ldb * 2 + s * b_sub;
        return true;
    }
    __device__ __forceinline__ int arow(const pg::Unit&, int r) const { return r; }
};
struct EpiInproj {
    static constexpr bool PERM = true; static constexpr bool PERM2 = false; static constexpr int NVM = 16;
    __device__ __forceinline__ bool full(const pg::Unit&) const { return !dry; }
    f16* O; f16* X1T; f16* VHT; f16* VT; int dry, notrans;
    __device__ __forceinline__ void operator()(const f32x4 (&acc)[2][2][4][2], const pg::Unit& u, int wr, int wc, int fr, int fq) const {
        const int pn = u.pn;
        f16* tb = (pn == 2 || pn == 3) ? X1T : ((pn == 4 || pn == 5) ? VHT : ((pn == 16 || pn == 17) ? VT : nullptr));
        if (notrans) tb = nullptr;
        if (tb == nullptr) {
#pragma unroll
            for (int ai = 0; ai < 2; ++ai)
#pragma unroll
                for (int m = 0; m < 4; ++m) { f16* rowp = O + (size_t)(u.pm * 256 + ai * 128 + wr * 64 + m * 16 + fr) * DIN + pn * 256 + wc * 64 + 8 * fq;
#pragma unroll
                    for (int bj = 0; bj < 2; ++bj) { const f32x4 v0 = acc[ai][bj][m][0], v1 = acc[ai][bj][m][1];
                        u32x4 o; o.x = pkh(v0[0], v0[1]); o.y = pkh(v0[2], v0[3]); o.z = pkh(v1[0], v1[1]); o.w = pkh(v1[2], v1[3]);
                        if (!dry || o.x == 0x12345678u) *(u32x4*)(rowp + bj * 32) = o; } }
        } else {
            const int row_t = u.pm * 256, b = row_t / SE, i0 = row_t - b * SE;
            const int ch0 = (pn & 1) * 256 + wc * 64 + 8 * fq;
            f16* cb = tb + ((size_t)b * DH + ch0) * SE + i0 + wr * 64 + fr;
#pragma unroll
            for (int bj = 0; bj < 2; ++bj)
#pragma unroll
                for (int e = 0; e < 8; ++e) { f16* cp = cb + (size_t)(bj * 32 + e) * SE;
#pragma unroll
                    for (int ai = 0; ai < 2; ++ai)
#pragma unroll
                        for (int m = 0; m < 4; ++m) if (!dry) cp[ai * 128 + m * 16] = (f16)acc[ai][bj][m][e >> 2][e & 3]; }
        }
    }
};
struct EpiBranch {
    static constexpr bool PERM = true; static constexpr bool PERM2 = false; static constexpr int NVM = 16;
    __device__ __forceinline__ bool full(const pg::Unit&) const { return pf == 0; }
    const f16* P; f16* MG; u32x4* scr; int tid, pf;
    __device__ __forceinline__ void operator()(const f32x4 (&acc)[2][2][4][2], const pg::Unit& u, int wr, int wc, int fr, int fq) const {
        const int br = (pf & 512) ? 2 : u.e;
        const int col0 = u.pn * 256 + wc * 64 + 8 * fq;
        const size_t row0 = (size_t)(u.pm * 256 + wr * 64 + fr);
        const f16* gp = P + row0 * DIN + OFF_GATE + br * D + col0;
        f16* mp = MG + row0 * D + col0;
        u32x4* sp = scr + tid;
        h8 G[2][2]; u32x4 Sv[2][2];
        if (!(pf & 1024)) { G[0][0] = *(const h8*)gp; G[0][1] = *(const h8*)(gp + 32); } else { G[0][0] = __builtin_bit_cast(h8, (u32x4){(unsigned)fr, 0u, 0u, 0u}); G[0][1] = G[0][0]; G[1][0] = G[0][0]; G[1][1] = G[0][0]; }
        if (br == 1 || (br == 2 && !(pf & 512))) { Sv[0][0] = sp[0]; Sv[0][1] = sp[NTHR]; }
#pragma unroll
        for (int g = 0; g < 8; ++g) {
            const int ai = g >> 2, m = g & 3, cb = g & 1, nb = cb ^ 1;
            const f16* gpn = gp + ((m == 3 ? (size_t)(128 - 48) : (size_t)16) * DIN); u32x4* spn = sp + 2 * NTHR;
            if (g < 7) {
                if (!(pf & 1024)) { G[nb][0] = *(const h8*)gpn; G[nb][1] = *(const h8*)(gpn + 32); }
                if (br == 1 || (br == 2 && !(pf & 512))) { Sv[nb][0] = spn[0]; Sv[nb][1] = spn[NTHR]; }
            }
            asm volatile("" ::: "memory");
#pragma unroll
            for (int bj = 0; bj < 2; ++bj) {
                const h8 gg = G[cb][bj];
                f32x4 v0 = acc[ai][bj][m][0], v1 = acc[ai][bj][m][1];
#pragma unroll
                for (int j = 0; j < 4; ++j) { v0[j] *= sigm((float)gg[j]); v1[j] *= sigm((float)gg[4 + j]); }
                if (br == 1 || (br == 2 && !(pf & 512))) { const h8 pv = __builtin_bit_cast(h8, Sv[cb][bj]);
#pragma unroll
                    for (int j = 0; j < 4; ++j) { v0[j] += (float)pv[j]; v1[j] += (float)pv[4 + j]; } }
                u32x4 o; o.x = pkh(v0[0], v0[1]); o.y = pkh(v0[2], v0[3]); o.z = pkh(v1[0], v1[1]); o.w = pkh(v1[2], v1[3]);
                if (br < 2) sp[(size_t)bj * NTHR] = o; else if (!(pf & 2048)) *(u32x4*)(mp + bj * 32) = o;
            }
            gp = gpn; sp = spn; mp += (m == 3 ? (size_t)(128 - 48) : (size_t)16) * D;
            asm volatile("" : "+v"(gp), "+v"(mp), "+v"(sp) :: "memory");
        }
    }
};
struct EpiOut {
    static constexpr bool PERM = false; static constexpr bool PERM2 = false; static constexpr int NVM = 32;
    __device__ __forceinline__ bool full(const pg::Unit&) const { return !dry; }
    float* X; const float* mods_l; int dry;
    __device__ __forceinline__ void operator()(const f32x4 (&acc)[2][2][4][2], const pg::Unit& u, int wr, int wc, int fr, int fq) const {
        const int row_t = u.pm * 256;
        const float* gt = mods_l + (size_t)mod_row(row_t) * 6 * D + 2 * D + u.pn * 256 + wc * 32 + 4 * fq;
        f32x4 gv[2][2];
#pragma unroll
        for (int bj = 0; bj < 2; ++bj)
#pragma unroll
            for (int n = 0; n < 2; ++n) gv[bj][n] = *(const f32x4*)(gt + bj * 128 + n * 16);
        float* xp = X + (size_t)(row_t + wr * 64 + fr) * D + u.pn * 256 + wc * 32 + 4 * fq;
        f32x4 Xv[2][4];
#pragma unroll
        for (int q = 0; q < 4; ++q) Xv[0][q] = *(const f32x4*)(xp + (q >> 1) * 128 + (q & 1) * 16);
#pragma unroll
        for (int g = 0; g < 8; ++g) {
            const int ai = g >> 2, m = g & 3, cb = g & 1, nb = cb ^ 1;
            float* xpn = xp + (m == 3 ? (size_t)(128 - 48) : (size_t)16) * D;
            if (g < 7) {
#pragma unroll
                for (int q = 0; q < 4; ++q) Xv[nb][q] = *(const f32x4*)(xpn + (q >> 1) * 128 + (q & 1) * 16);
            }
            asm volatile("" ::: "memory");
#pragma unroll
            for (int bj = 0; bj < 2; ++bj)
#pragma unroll
                for (int n = 0; n < 2; ++n) { const f32x4 nv_ = Xv[cb][bj * 2 + n] * ALPHA + gv[bj][n] * acc[ai][bj][m][n]; if (!dry) *(f32x4*)(xp + bj * 128 + n * 16) = nv_; }
            xp = xpn;
            asm volatile("" : "+v"(xp) :: "memory");
        }
    }
};
__device__ __forceinline__ void inproj_phase(Frame& F, int pf = 0) {
    DenseSched<1> Sc; Sc.lat_only = 0; Sc.O.init(T, DIN, F.G, F.bid); Sc.A = (const char*)(F.ws + WS_HMH); Sc.Bm = (const char*)(F.ws + WS_WIN); Sc.lda = D; Sc.ldb = D; Sc.a_sub = 0; Sc.b_sub = 0;
    EpiInproj E; E.O = (f16*)(F.ws + WS_P); E.X1T = (f16*)(F.ws + WS_ZT); E.VHT = (f16*)(F.ws + WS_VHT); E.VT = (f16*)(F.ws + WS_VT); E.dry = (pf & 32768) ? 0 : F.dry; E.notrans = (pf & 65536) ? 1 : 0;
    pg::gemm_phase<EpiInproj, DenseSched<1>, false>(F.lds, F.wave, D, D, D, Sc, E);
}
__device__ __forceinline__ void branch_phase(Frame& F, int lat_only, int pf) {
    DenseSched<3> Sc; Sc.lat_only = lat_only; Sc.O.init(lat_only ? B * S : T, D, F.G, F.bid); Sc.A = (const char*)(F.ws + WS_Y); Sc.Bm = (const char*)(F.ws + WS_PJ); Sc.lda = 1536; Sc.ldb = DH; Sc.a_sub = (size_t)DH * 2; Sc.b_sub = (size_t)D * DH * 2;
    EpiBranch E; E.P = (const f16*)(F.ws + WS_P); E.MG = (f16*)(F.ws + WS_HMH); E.scr = (u32x4*)(F.ws + WS_SCR) + (size_t)F.bid * 16 * NTHR; E.tid = F.tid; E.pf = pf;
    pg::gemm_phase<EpiBranch, DenseSched<3>, true>(F.lds, F.wave, DH, 1536, DH, Sc, E);
}
__device__ __forceinline__ void outproj_phase(Frame& F, int l) {
    const int lat_only = l == DEPTH - 1;
    DenseSched<1> Sc; Sc.lat_only = lat_only; Sc.O.init(lat_only ? B * S : T, D, F.G, F.bid); Sc.A = (const char*)(F.ws + WS_HMH); Sc.Bm = (const char*)(F.ws + WS_WO); Sc.lda = D; Sc.ldb = D; Sc.a_sub = 0; Sc.b_sub = 0;
    EpiOut E; E.X = (float*)(F.ws + WS_X); E.mods_l = (const float*)(F.ws + WS_MODS) + (size_t)l * 9 * 6 * D; E.dry = F.dry;
    pg::gemm_phase<EpiOut, DenseSched<1>, false>(F.lds, F.wave, D, D, D, Sc, E);
}
constexpr int LDS_TAB_OFF = pg::STAGE_BYTES;
constexpr int LDS_MISC_OFF = LDS_TAB_OFF + 1024;
constexpr int LDS_BYTES = 147456;
constexpr int NPH_L = 13, NPHASE = 2 + NPH_L * DEPTH;
constexpr int FLAG_HYB_MOE = 1;
constexpr int FLAG_HYB_MIX = 2;
constexpr int FLAG_DRY = 4;

template <class P> __device__ __forceinline__ P launder_uniform(P p) {
    unsigned long long v = (unsigned long long)p; unsigned lo = (unsigned)v, hi = (unsigned)(v >> 32);
    unsigned vlo, vhi;
    asm volatile("v_mov_b32 %0, %2\n\tv_mov_b32 %1, %3" : "=&v"(vlo), "=&v"(vhi) : "s"(lo), "s"(hi));
    lo = __builtin_amdgcn_readfirstlane(vlo); hi = __builtin_amdgcn_readfirstlane(vhi);
    return (P)(((unsigned long long)hi << 32) | lo);
}
typedef unsigned* gu32p;
__device__ __forceinline__ int launder_int(int v) { int o; asm volatile("v_mov_b32 %0, %1" : "=v"(o) : "s"(v)); return __builtin_amdgcn_readfirstlane(o); }
__device__ __forceinline__ void launder(Frame& F, CArgsP& ap) { F.lane = lane_id(); asm volatile("" : "+v"(F.lane)); ap = launder_uniform((CArgsP)__builtin_amdgcn_kernarg_segment_ptr()); F.ws = (GAS unsigned char*)ap->ws; F.G = launder_int(F.G); F.bid = launder_int(F.bid); F.vcu = launder_int(F.vcu); F.wave = launder_int(F.wave); F.dry = launder_int(F.dry); F.tid = F.wave * 64 + F.lane; }
#ifndef MOE_SPLIT_NUM
#define MOE_SPLIT_NUM 144
#endif
#ifndef PROBE_REP
#define PROBE_REP -1
#endif
#ifndef PROBE_SLO
#define PROBE_SLO -1
#define PROBE_SHI -1
#endif
#define REP(k, ...) do { __VA_ARGS__; if (PROBE_REP == (k)) { __syncthreads(); __VA_ARGS__; } } while (0)
__global__ void __launch_bounds__(NTHR, 2) fwd(Args a_unused) {
    CArgsP ap = (CArgsP)__builtin_amdgcn_kernarg_segment_ptr();
    extern __shared__ __attribute__((aligned(16))) unsigned char lds_raw[];
    Frame F;
    F.lds = (LAS unsigned char*)lds_raw;
    F.tid = threadIdx.x; F.lane = F.tid & 63; F.wave = __builtin_amdgcn_readfirstlane(F.tid >> 6);
    F.G = gridDim.x; F.bid = blockIdx.x; { const int bx = blockIdx.x; F.vcu = (F.G % 8 == 0) ? (bx % 8) * (F.G / 8) + bx / 8 : bx; }
    F.ws = (GAS unsigned char*)ap->ws; F.dry = (ap->flags & FLAG_DRY) ? 1 : 0;
    for (int u = F.tid; u < (1024 + 64) / 4; u += NTHR) ((LAS unsigned*)(F.lds + LDS_TAB_OFF))[u] = 0u;
    __syncthreads();
    XcdBarrier bar; bar.bar = (unsigned*)(F.ws + WS_CTL) + CW_BAR; bar.x = 0; bar.st = nullptr;
    if (ap->use_bar) bar = xcd_barrier_post((unsigned*)(F.ws + WS_CTL) + CW_BAR, (volatile LAS unsigned*)(F.lds + LDS_MISC_OFF + 32), F.tid);
#define IN(k) (launder(F, ap), ap->ph_lo <= (k) && (k) < ap->ph_hi)
#define SEAM(k) do { if (IN(k) && IN((k) + 1)) { bar.bar = (unsigned*)((unsigned char*)F.ws + WS_CTL) + CW_BAR; bar.x = (unsigned)launder_int((int)bar.x); xcd_barrier(bar, F.tid); if (PROBE_REP == 99) xcd_barrier(bar, F.tid); } } while (0)
    if (IN(0)) { pro_mods(F, ap->in); pro_z2(F, ap->in); convert_mixer_weights(F, ap->in, 0); }
    SEAM(0);
    if (IN(1)) { filters_phase(F, ap->in, 0); init_mod1_rows(F, ap->in); }
    SEAM(1);
    unsigned long long tacc = 0ull, tst = 0ull;
#define ST_B(k) do { if (PROBE_SLO == (k)) tst = __builtin_amdgcn_s_memrealtime(); } while (0)
#define ST_E(k) do { if (PROBE_SHI == (k)) tacc += __builtin_amdgcn_s_memrealtime() - tst; } while (0)
    for (int l = 0; l < DEPTH; ++l) {
        const int pb = 2 + NPH_L * l;
        ST_B(0); if (IN(pb + 0)) REP(0, inproj_phase(F, ap->flags));
        SEAM(pb + 0); ST_E(0);
        ST_B(2); if (IN(pb + 2)) { if (!(ap->flags & 8)) { fftconv_tasks(F, ap->in, l, ap->flags); launder(F, ap); if (l + 1 < DEPTH && !(ap->flags & 4096)) ctxconv_tasks(F, ap->in, l); launder(F, ap); } if (!(ap->flags & 16)) REP(2, attn_tasks(F, ap->in, l, F.dry ? ap->flags : 0)); }
        SEAM(pb + 2); ST_E(2);
        ST_B(3); if (IN(pb + 3)) REP(3, ymix_phase(F, ap->in, l));
        SEAM(pb + 3); ST_E(3);
        ST_B(4); if (IN(pb + 4)) REP(4, branch_phase(F, l == DEPTH - 1, F.dry ? ap->flags : 0));
        SEAM(pb + 4); ST_E(4);
        ST_B(5); if (IN(pb + 5)) { convert_router(F, ap->in, l); outproj_phase(F, l); }
        SEAM(pb + 5); ST_E(5);
        ST_B(6); if (IN(pb + 6)) { if (!(ap->flags & 64)) ln1_router_phase(F, ap->in, l); __syncthreads(); if (!(ap->flags & 32)) convert_moe_weights(F, ap->in, l); }
        SEAM(pb + 6); ST_E(6);
        ST_B(8); if (IN(pb + 8)) moe_up_phase(F, l, 0, F.G, F.bid);
        SEAM(pb + 8); ST_E(8);
        ST_B(9); if (IN(pb + 9)) moe_down_phase(F, l, 0, F.G, F.bid);
        SEAM(pb + 9); ST_E(9);
        ST_B(10); if (IN(pb + 10)) { ln2_rows(F, ap->in, (float*)ap->out, l, 0); launder(F, ap); moe_up_phase(F, l, 1, F.G, F.bid); }
        SEAM(pb + 10); ST_E(10);
        ST_B(11); if (IN(pb + 11)) moe_down_phase(F, l, 1, F.G, F.bid);
        SEAM(pb + 11); ST_E(11);
        ST_B(12); if (IN(pb + 12)) {
            if (!(ap->flags & FLAG_HYB_MIX)) ln2_rows(F, ap->in, (float*)ap->out, l, 1);
            if (l + 1 < DEPTH && !(ap->flags & FLAG_HYB_MOE)) {
                __syncthreads(); convert_mixer_weights(F, ap->in, l + 1); __syncthreads(); filters_phase(F, ap->in, l + 1);
                if (ap->flags & FLAG_HYB_MIX) mod1_rows(F, l + 1);
            }
        }
        SEAM(pb + 12); ST_E(12);
    }
    if (PROBE_SLO >= 0) {
        gu32p dbg = (gu32p)((unsigned*)(F.ws + WS_CTL) + CW_DBG);
        bar.bar = (unsigned*)((unsigned char*)F.ws + WS_CTL) + CW_BAR; xcd_barrier(bar, F.tid);
        if (F.bid == 0 && F.tid == 0) __hip_atomic_store((unsigned*)dbg, (unsigned)tacc, __ATOMIC_RELAXED, __HIP_MEMORY_SCOPE_AGENT);
        xcd_barrier(bar, F.tid);
        const unsigned tv = __hip_atomic_load((unsigned*)dbg, __ATOMIC_RELAXED, __HIP_MEMORY_SCOPE_AGENT);
        const float v = sqrtf((float)tv * (1.0f / 100000.0f));
        float* o = (float*)ap->out;
        for (size_t i = (size_t)F.bid * NTHR + F.tid; i < (size_t)B * S * D; i += (size_t)F.G * NTHR) o[i] = v;
    }
#undef IN
#undef SEAM
}

static int g_grid = 0;
static bool setup_grid() {
    if (g_grid) return g_grid > 0;
    int dev = 0, cus = 0, per_cu = 0;
    if (hipGetDevice(&dev) != hipSuccess || hipDeviceGetAttribute(&cus, hipDeviceAttributeMultiprocessorCount, dev) != hipSuccess) { g_grid = -1; return false; }
    if (hipFuncSetAttribute((const void*)fwd, hipFuncAttributeMaxDynamicSharedMemorySize, LDS_BYTES) != hipSuccess) { fprintf(stderr, "hipFuncSetAttribute failed\n"); g_grid = -1; return false; }
    if (hipOccupancyMaxActiveBlocksPerMultiprocessor(&per_cu, (const void*)fwd, NTHR, LDS_BYTES) != hipSuccess || per_cu < 1) { fprintf(stderr, "occupancy query: %d\n", per_cu); (void)hipGetLastError(); g_grid = -1; return false; }
    g_grid = cus;
    return true;
}
static void launch_phases(const Args& base, int lo, int hi, int use_bar, hipStream_t st) {
    Args a = base; a.ph_lo = lo; a.ph_hi = hi; a.use_bar = use_bar;
    hipLaunchKernelGGL(fwd, dim3(g_grid), dim3(NTHR), LDS_BYTES, st, a);
}
}
#ifndef PROBE_XFLAGS
#define PROBE_XFLAGS 0
#endif
#ifndef PROBE_PH
#define PROBE_PH -1
#endif
#ifndef HYB
#define HYB 1
#endif
#ifndef GAS
#define GAS __attribute__((address_space(1)))
#endif
extern "C" void kernel_launch(void* const* d_in, const int* in_sizes, int n_in, void* d_out, int out_size, void* d_ws, size_t ws_size, hipStream_t stream) {
    if (n_in != 34 || ws_size < fk::WS_END + (size_t)64 * fk::MiB) { fprintf(stderr, "kernel_launch: unexpected inputs / workspace (%d, %zu)\n", n_in, ws_size); return; }
    nv::In in{};
    { const float** f = (const float**)&in; for (int i = 0; i < 34; ++i) f[i] = (const float*)d_in[i]; }
    fk::Args a{};
    { const float** f = (const float**)&a.in; for (int i = 0; i < 34; ++i) f[i] = (const float*)d_in[i]; }
    a.out = (GAS float*)d_out; a.ws = (unsigned char*)d_ws;
    if (!fk::setup_grid()) return;
    (void)hipMemsetAsync((char*)d_ws + fk::WS_CTL, 0, fk::CTL_ZERO_BYTES, stream);
    nv::Ctx c = nv::make_ctx((unsigned char*)d_ws, fk::WS_DYN);
#if HYB == 0
    nv::prologue(in, c, stream);
    for (int l = 0; l < 4; ++l) { nv::mixer_layer(in, c, l, stream); nv::moe_layer(in, c, l, stream); }
    nv::finalize(c, (float*)d_out, stream);
#elif HYB == 1
    a.flags = fk::FLAG_HYB_MOE;
    nv::prologue(in, c, stream);
    for (int l = 0; l < 4; ++l) {
        nv::mixer_layer(in, c, l, stream);
        const int pb = 2 + fk::NPH_L * l;
        for (int p = pb + 6; p <= pb + 12; ++p) fk::launch_phases(a, p, p + 1, 0, stream);
    }
#elif HYB == 2
    a.flags = fk::FLAG_HYB_MIX;
    fk::launch_phases(a, 0, 1, 0, stream); fk::launch_phases(a, 1, 2, 0, stream);
    for (int l = 0; l < 4; ++l) {
        const int pb = 2 + fk::NPH_L * l;
        for (int p = pb; p <= pb + 6; ++p) fk::launch_phases(a, p, p + 1, 0, stream);
        nv::moe_layer(in, c, l, stream);
        if (l < 3) fk::launch_phases(a, pb + 12, pb + 13, 0, stream);
    }
    nv::finalize(c, (float*)d_out, stream);
#elif HYB == 3
    for (int p = 0; p < fk::NPHASE; ++p) fk::launch_phases(a, p, p + 1, 0, stream);
#elif HYB == 5
    for (int p = 0; p < fk::NPHASE; ++p) {
        const bool hit = (PROBE_PH >= 100) ? (p == PROBE_PH - 100) : (p >= 2 && (p - 2) % fk::NPH_L == PROBE_PH);
        if (hit) { fk::Args d = a; d.flags |= fk::FLAG_DRY | PROBE_XFLAGS; fk::launch_phases(d, p, p + 1, 0, stream); }
        fk::launch_phases(a, p, p + 1, 0, stream);
    }
#elif HYB == 4
    fk::launch_phases(a, 0, fk::NPHASE, 1, stream);
#endif
}
```
